# Optimizing an MI355X kernel written in HIP

```python
import jax
import jax.numpy as jnp
from jax import lax
import numpy as np

D_MODEL = 2048
BATCH = 8
SEQ = 2048
DEPTH = 2

GRID_W = 64
CTX_LEN = 256
N_MOD = 9
D_FF = 5632
D_SC = D_MODEL // 2
SC_WIDTH = 3
D_CC = D_MODEL // 2
CC_WIDTH = 31
D_EVEN_IN = 3 * D_SC + 2 * D_CC
HEAD_DIM = 64
D_NA = D_MODEL // 2
NA_HEADS = D_NA // HEAD_DIM
WIN_ROWS = 8
WIN_COLS = 16
D_LRU = D_MODEL // 2
LRU_BLOCKS = 16
LRU_CONV = 4
LRU_C = 8.0
D_ODD_IN = 3 * D_NA + 2 * D_LRU
D_MIX = D_MODEL
EPS = 1e-6
NEG_INF = -1e30

kernel_name = 'hybrid_dit_shortconv_conformer_natten_rglru'


def rms_norm(x, g):
    xf = x.astype(jnp.float32)
    y = xf * lax.rsqrt(jnp.mean(xf * xf, axis=-1, keepdims=True) + EPS)
    return (y * g.astype(jnp.float32)).astype(x.dtype)


def layer_norm(x, g, b):
    xf = x.astype(jnp.float32)
    mu = jnp.mean(xf, axis=-1, keepdims=True)
    xc = xf - mu
    y = xc * lax.rsqrt(jnp.mean(xc * xc, axis=-1, keepdims=True) + EPS)
    return (y * g.astype(jnp.float32) + b.astype(jnp.float32)).astype(x.dtype)


def modulate(x, g, shift, scale):
    return rms_norm(x, g) * (1.0 + scale) + shift


def swiglu_ffn(h, w_in, w_out):
    gate, up = jnp.split(h @ w_in, 2, axis=-1)
    return (jax.nn.silu(gate) * up) @ w_out


def half_ffn(x, g, mod, w_in, w_out):
    shift, scale, gate = mod
    return x + 0.5 * gate * swiglu_ffn(modulate(x, g, shift, scale), w_in, w_out)


def dwconv(u, w, b):
    k, ch = w.shape
    lo = (k - 1) // 2
    y = lax.conv_general_dilated(u, w[:, None, :].astype(u.dtype), (1,), [(lo, k - 1 - lo)],
                                 dimension_numbers=('NWC', 'WIO', 'NWC'), feature_group_count=ch)
    return y + b


def even_mixer(h, w_in, sc_w, sc_b, cc_w, cc_b, cc_ln_g, cc_ln_b, w_out):
    z = h @ w_in
    b_gate, c_gate, val, glu_v, glu_g = jnp.split(
        z, [D_SC, 2 * D_SC, 3 * D_SC, 3 * D_SC + D_CC], axis=-1)
    y_sc = b_gate * dwconv(c_gate * val, sc_w, sc_b)
    u = dwconv(glu_v * jax.nn.sigmoid(glu_g), cc_w, cc_b)
    y_cc = jax.nn.silu(layer_norm(u, cc_ln_g, cc_ln_b))
    return jnp.concatenate([y_sc, y_cc], axis=-1) @ w_out


def neighbourhood_attention(q, k, v, k_ctx, v_ctx, rpb):
    bsz, seq, nh, hd = q.shape
    rows = seq // GRID_W
    kr = min(WIN_ROWS, rows)
    qg = jnp.moveaxis(q.reshape(bsz, rows, GRID_W, nh, hd), 1, 0)
    kg = k.reshape(bsz, rows, GRID_W, nh, hd)
    vg = v.reshape(bsz, rows, GRID_W, nh, hd)
    col = jnp.arange(GRID_W)
    col_start = jnp.clip(col - WIN_COLS // 2, 0, GRID_W - WIN_COLS)
    col_in = (col[None, :] >= col_start[:, None]) & (col[None, :] < col_start[:, None] + WIN_COLS)
    dcol = jnp.clip(col[None, :] - col[:, None] + WIN_COLS - 1, 0, 2 * WIN_COLS - 2)
    bias_cols = jnp.where(col_in, rpb.astype(jnp.float32)[:, :, dcol], NEG_INF)
    n_loc = kr * GRID_W

    def row_block(args):
        q_row, r = args
        r0 = jnp.clip(r - kr // 2, 0, rows - kr)
        k_blk = lax.dynamic_slice_in_dim(kg, r0, kr, axis=1).reshape(bsz, n_loc, nh, hd)
        v_blk = lax.dynamic_slice_in_dim(vg, r0, kr, axis=1).reshape(bsz, n_loc, nh, hd)
        drow = r0 + jnp.arange(kr) - r + WIN_ROWS - 1
        bias = jnp.moveaxis(bias_cols[:, drow], 1, 2).reshape(nh, GRID_W, n_loc)
        s_loc = jnp.einsum('bqhd,bkhd->bhqk', q_row, k_blk).astype(jnp.float32) + bias
        s_ctx = jnp.einsum('bqhd,bkhd->bhqk', q_row, k_ctx).astype(jnp.float32)
        p = jax.nn.softmax(jnp.concatenate([s_loc, s_ctx], axis=-1), axis=-1).astype(v.dtype)
        return (jnp.einsum('bhqk,bkhd->bqhd', p[..., :n_loc], v_blk)
                + jnp.einsum('bhqk,bkhd->bqhd', p[..., n_loc:], v_ctx))

    out = lax.map(row_block, (qg, jnp.arange(rows)))
    return jnp.moveaxis(out, 0, 1).reshape(bsz, seq, nh * hd)


def context_attention(q, k, v):
    s = jnp.einsum('bqhd,bkhd->bhqk', q, k).astype(jnp.float32)
    p = jax.nn.softmax(s, axis=-1).astype(v.dtype)
    o = jnp.einsum('bhqk,bkhd->bqhd', p, v)
    return o.reshape(o.shape[0], o.shape[1], -1)


def rglru(x, w_gate, b_gate, lam, h0, reverse):
    bsz, t, _ = x.shape
    xb = x.reshape(bsz, t, LRU_BLOCKS, D_LRU // LRU_BLOCKS)
    gates = jnp.einsum('btni,gnij->gbtnj', xb, w_gate).reshape(2, bsz, t, D_LRU)
    gates = (gates + b_gate[:, None, None, :]).astype(jnp.float32)
    r = jax.nn.sigmoid(gates[0])
    i = jax.nn.sigmoid(gates[1])
    log_a = -LRU_C * r * jax.nn.softplus(-lam.astype(jnp.float32))
    a = jnp.exp(log_a)
    u = jnp.sqrt(-jnp.expm1(2.0 * log_a)) * i * x.astype(jnp.float32)
    start = -1 if reverse else 0
    end = 0 if reverse else -1
    u = u.at[:, start].add(a[:, start] * h0)

    def combine(e1, e2):
        a1, b1 = e1
        a2, b2 = e2
        return a1 * a2, a2 * b1 + b2

    _, h = lax.associative_scan(combine, (a, u), reverse=reverse, axis=1)
    return h, h[:, end]


def odd_mixer(h_ctx, h_lat, w_in, q_g, k_g, rpb, conv_w, conv_b, gate_w, gate_b, lam, w_out, ctx_out):
    bsz, seq, _ = h_lat.shape
    heads = lambda t: t.reshape(t.shape[0], t.shape[1], NA_HEADS, HEAD_DIM)
    scale = HEAD_DIM ** -0.5
    q, k, v, xr, gr = jnp.split(h_lat @ w_in, [D_NA, 2 * D_NA, 3 * D_NA, 3 * D_NA + D_LRU], axis=-1)
    if ctx_out:
        qc, kc, vc, xrc, grc = jnp.split(h_ctx @ w_in, [D_NA, 2 * D_NA, 3 * D_NA, 3 * D_NA + D_LRU], axis=-1)
    else:
        kc, vc, xrc = jnp.split(h_ctx @ w_in[:, D_NA:3 * D_NA + D_LRU], [D_NA, 2 * D_NA], axis=-1)
    qh = rms_norm(heads(q), q_g) * scale
    kh = rms_norm(heads(k), k_g)
    kch = rms_norm(heads(kc), k_g)
    vch = heads(vc)
    o_lat = neighbourhood_attention(qh, kh, heads(v), kch, vch, rpb)
    xr = dwconv(xr, conv_w, conv_b)
    xrc = dwconv(xrc, conv_w, conv_b)
    h0 = jnp.zeros((bsz, D_LRU), jnp.float32)
    hc_f, s_f = rglru(xrc, gate_w[0], gate_b[0], lam[0], h0, False)
    hc_b, s_b = rglru(xrc, gate_w[1], gate_b[1], lam[1], h0, True)
    hl_f, _ = rglru(xr, gate_w[0], gate_b[0], lam[0], s_f, False)
    hl_b, _ = rglru(xr, gate_w[1], gate_b[1], lam[1], s_b, True)
    r_lat = (hl_f + hl_b).astype(h_lat.dtype) * jax.nn.gelu(gr)
    y_lat = jnp.concatenate([o_lat, r_lat], axis=-1) @ w_out
    if ctx_out:
        o_ctx = context_attention(rms_norm(heads(qc), q_g) * scale, kch, vch)
        r_ctx = (hc_f + hc_b).astype(h_ctx.dtype) * jax.nn.gelu(grc)
        y_ctx = jnp.concatenate([o_ctx, r_ctx], axis=-1) @ w_out
    else:
        y_ctx = None
    return y_ctx, y_lat


def setup_inputs(seed: int = 0) -> dict:
    key = jax.random.key(seed)
    keys = jax.random.split(key, 32)
    ks = iter([keys[i] for i in range(32)])
    f32 = jnp.float32
    n_even = (DEPTH + 1) // 2
    n_odd = DEPTH // 2

    def nrm(shape, scale):
        return jax.random.normal(next(ks), shape, f32) * scale

    def gain(shape):
        return 1.0 + nrm(shape, 0.02)

    lru_u = jax.random.uniform(next(ks), (n_odd, 2, D_LRU), f32, 0.9, 0.999)
    lru_a = lru_u ** (1.0 / LRU_C)
    lru_lam = jnp.log(lru_a) - jnp.log1p(-lru_a)
    bs = D_LRU // LRU_BLOCKS
    return {
        'x': nrm((BATCH, SEQ, D_MODEL), 1.0),
        'c': nrm((BATCH, D_MODEL), 1.0),
        'ctx': nrm((BATCH, CTX_LEN, D_MODEL), 1.0),
        'c_ctx': nrm((D_MODEL,), 1.0),
        'w_mod': nrm((DEPTH, D_MODEL, N_MOD * D_MODEL), 0.5 * D_MODEL ** -0.5),
        'b_mod': nrm((DEPTH, N_MOD * D_MODEL), 0.02),
        'norm_g': gain((DEPTH, 3, D_MODEL)),
        'ffn_w_in': nrm((DEPTH, 2, D_MODEL, 2 * D_FF), D_MODEL ** -0.5),
        'ffn_w_out': nrm((DEPTH, 2, D_FF, D_MODEL), D_FF ** -0.5),
        'ev_w_in': nrm((n_even, D_MODEL, D_EVEN_IN), D_MODEL ** -0.5),
        'sc_w': nrm((n_even, SC_WIDTH, D_SC), SC_WIDTH ** -0.5),
        'sc_b': nrm((n_even, D_SC), 0.02),
        'cc_w': nrm((n_even, CC_WIDTH, D_CC), CC_WIDTH ** -0.5),
        'cc_b': nrm((n_even, D_CC), 0.02),
        'cc_ln_g': gain((n_even, D_CC)),
        'cc_ln_b': nrm((n_even, D_CC), 0.02),
        'ev_w_out': nrm((n_even, D_MIX, D_MODEL), D_MIX ** -0.5),
        'od_w_in': nrm((n_odd, D_MODEL, D_ODD_IN), D_MODEL ** -0.5),
        'q_norm_g': gain((n_odd, HEAD_DIM)),
        'k_norm_g': gain((n_odd, HEAD_DIM)),
        'na_rpb': nrm((n_odd, NA_HEADS, 2 * WIN_ROWS - 1, 2 * WIN_COLS - 1), 0.1),
        'lru_conv_w': nrm((n_odd, LRU_CONV, D_LRU), LRU_CONV ** -0.5),
        'lru_conv_b': nrm((n_odd, D_LRU), 0.02),
        'lru_gate_w': nrm((n_odd, 2, 2, LRU_BLOCKS, bs, bs), bs ** -0.5),
        'lru_gate_b': nrm((n_odd, 2, 2, D_LRU), 0.02),
        'lru_lam': lru_lam,
        'od_w_out': nrm((n_odd, D_MIX, D_MODEL), D_MIX ** -0.5),
    }


def reference(x, c, ctx, c_ctx, w_mod, b_mod, norm_g, ffn_w_in, ffn_w_out,
              ev_w_in, sc_w, sc_b, cc_w, cc_b, cc_ln_g, cc_ln_b, ev_w_out,
              od_w_in, q_norm_g, k_norm_g, na_rpb, lru_conv_w, lru_conv_b,
              lru_gate_w, lru_gate_b, lru_lam, od_w_out):
    silu_c = jax.nn.silu(c)
    silu_cc = jax.nn.silu(c_ctx)
    x_lat, x_ctx = x, ctx
    for l in range(DEPTH):
        last = l == DEPTH - 1
        odd = l % 2 == 1
        j = l // 2
        ctx_in = odd or not last
        ctx_out = not last
        m_lat = jnp.split((silu_c @ w_mod[l] + b_mod[l])[:, None, :], N_MOD, axis=-1)
        m_ctx = jnp.split(silu_cc @ w_mod[l] + b_mod[l], N_MOD, axis=-1)
        g = norm_g[l]
        x_lat = half_ffn(x_lat, g[0], m_lat[0:3], ffn_w_in[l, 0], ffn_w_out[l, 0])
        if ctx_in:
            x_ctx = half_ffn(x_ctx, g[0], m_ctx[0:3], ffn_w_in[l, 0], ffn_w_out[l, 0])
        h_lat = modulate(x_lat, g[1], m_lat[3], m_lat[4])
        h_ctx = modulate(x_ctx, g[1], m_ctx[3], m_ctx[4]) if ctx_in else None
        if odd:
            y_ctx, y_lat = odd_mixer(h_ctx, h_lat, od_w_in[j], q_norm_g[j], k_norm_g[j], na_rpb[j],
                                     lru_conv_w[j], lru_conv_b[j], lru_gate_w[j], lru_gate_b[j],
                                     lru_lam[j], od_w_out[j], ctx_out)
        else:
            y_lat = even_mixer(h_lat, ev_w_in[j], sc_w[j], sc_b[j], cc_w[j], cc_b[j],
                               cc_ln_g[j], cc_ln_b[j], ev_w_out[j])
            y_ctx = (even_mixer(h_ctx, ev_w_in[j], sc_w[j], sc_b[j], cc_w[j], cc_b[j],
                                cc_ln_g[j], cc_ln_b[j], ev_w_out[j]) if ctx_out else None)
        x_lat = x_lat + m_lat[5] * y_lat
        x_lat = half_ffn(x_lat, g[2], m_lat[6:9], ffn_w_in[l, 1], ffn_w_out[l, 1])
        if ctx_out:
            x_ctx = x_ctx + m_ctx[5] * y_ctx
            x_ctx = half_ffn(x_ctx, g[2], m_ctx[6:9], ffn_w_in[l, 1], ffn_w_out[l, 1])
    return x_lat
```

```cpp
#include <hip/hip_runtime.h>
#include <cstdio>
#include <cstdint>

#ifndef MK_SPLIT
#define MK_SPLIT 1
#endif

namespace pg8 {
#define PG8_LAS __attribute__((address_space(3)))
typedef unsigned short bf16_t;
typedef short bf16x8 __attribute__((ext_vector_type(8)));
typedef float f32x4 __attribute__((ext_vector_type(4)));
typedef unsigned u32x4 __attribute__((ext_vector_type(4)));
typedef unsigned u32x2 __attribute__((ext_vector_type(2)));
constexpr int BM = 256, BK = 64, HALF = 128, HTB = HALF * BK * 2  , STAGE_BYTES = 8 * HTB, NXCD = 8, WGM = 8;

__host__ __device__ __forceinline__ int lds_byte(int r, int c) { const int st = (r >> 4) * 2 + (c >> 5), rr = r & 15, cc = c & 31, ob = rr * 64 + cc * 2; return st * 1024 + (ob ^ (((ob >> 9) & 1) << 5)); }
__host__ __device__ __forceinline__ void stage_rc(int b, int& R, int& C) { const int st = b / 1024, sb = b % 1024, swz = sb ^ (((sb >> 9) & 1) << 5); R = (st >> 1) * 16 + swz / 64; C = (st & 1) * 32 + (swz % 64) / 2; }
__host__ __device__ __forceinline__ int perm32(int rho) { const int n = rho >> 4, i = rho & 15; return 8 * (i >> 2) + 4 * n + (i & 3); }

struct Unit { int pm, pn, kind; };

__host__ __device__ __forceinline__ void tile_map(int wgid, int nM, int nN, int& pm, int& pn) {
    const int nwg = nM * nN;
    { const int q = nwg / NXCD, r = nwg % NXCD, xcd = wgid % NXCD, off = wgid / NXCD; wgid = (xcd < r ? xcd * (q + 1) : r * (q + 1) + (xcd - r) * q) + off; }
    const int nig = WGM * nN, gid = wgid / nig, fm = gid * WGM, gsz = (nM - fm) < WGM ? (nM - fm) : WGM;
    pm = fm + ((wgid % nig) % gsz); pn = (wgid % nig) / gsz;
}

__device__ __forceinline__ unsigned cvt_pk_bf16(float lo, float hi) { unsigned r; asm volatile("v_cvt_pk_bf16_f32 %0, %1, %2" : "=v"(r) : "v"(lo), "v"(hi)); return r; }

template <class Epi, class Sched, bool ALIGN_EPI = true, bool SP2 = true>
__device__ __forceinline__ void gemm_phase(PG8_LAS unsigned char* lds, const int K, const Sched& S, const Epi& E) {
    const int tid = threadIdx.x, wid = __builtin_amdgcn_readfirstlane(tid >> 6), lane = tid & 63, wr = wid >> 2, wc = wid & 3, fr = lane & 15, fq = lane >> 4;
    const int nt = K / BK;
    unsigned voffA[2], voffB[2];
#pragma unroll
    for (int i = 0; i < 2; ++i) { int R, C; stage_rc(tid * 16 + i * 8192, R, C); const int Rb = Epi::PERM ? ((R & ~31) + perm32(R & 31)) : R;
        voffA[i] = (unsigned)(R * K + C) * 2u; voffB[i] = (unsigned)(Rb * K + C) * 2u; }
    const size_t kstep = (size_t)(BK * 2);
    const size_t hstep = (size_t)HALF * K * 2;
    const unsigned ldsw = (unsigned)wid * 1024u;
    const int aoff = lds_byte(wr * 64 + fr, fq * 8), boff = lds_byte(wc * 32 + fr, fq * 8);
#define PG8_SA(b, h) (((b) * 2 + (h)) * HTB)
#define PG8_SB(b, h) ((4 + (b) * 2 + (h)) * HTB)
#define PG8_STAGE(bufoff, gbase, voff) do { _Pragma("unroll") for (int _i = 0; _i < 2; ++_i) \
        __builtin_amdgcn_global_load_lds((const unsigned*)((const char*)(gbase) + (voff)[_i]), (PG8_LAS unsigned*)(lds + (bufoff) + ldsw + _i * 8192), 16, 0, 0); } while (0)
#define PG8_LDA(dst, b, h) do { _Pragma("unroll") for (int m = 0; m < 4; ++m) _Pragma("unroll") for (int k = 0; k < 2; ++k) dst[m][k] = *(const PG8_LAS bf16x8*)(lds + PG8_SA(b, h) + aoff + m * 2048 + k * 1024); } while (0)
#define PG8_LDB(dst, b, h) do { _Pragma("unroll") for (int n = 0; n < 2; ++n) _Pragma("unroll") for (int k = 0; k < 2; ++k) dst[n][k] = *(const PG8_LAS bf16x8*)(lds + PG8_SB(b, h) + boff + n * 2048 + k * 1024); } while (0)
#define PG8_MMA(ai, bj, At, Bt) do { __builtin_amdgcn_s_setprio(1); _Pragma("unroll") for (int m = 0; m < 4; ++m) _Pragma("unroll") for (int n = 0; n < 2; ++n) _Pragma("unroll") for (int k = 0; k < 2; ++k) \
        acc[ai][bj][m][n] = __builtin_amdgcn_mfma_f32_16x16x32_bf16(Bt[n][k], At[m][k], acc[ai][bj][m][n], 0, 0, 0); __builtin_amdgcn_s_setprio(0); } while (0)
#define PG8_WAIT_V(n) asm volatile("s_waitcnt vmcnt(" #n ")" ::: "memory")
#define PG8_WAIT_L(n) asm volatile("s_waitcnt lgkmcnt(" #n ")" ::: "memory")
#define PG8_BAR __builtin_amdgcn_s_barrier()
#define PG8_SCHED __builtin_amdgcn_sched_barrier(0)
    Unit cur, nxt; int ui = 0;
    if (!S.next(0, cur)) return;
    f32x4 acc[2][2][4][2];
#pragma unroll
    for (int a = 0; a < 2; ++a)
#pragma unroll
        for (int b = 0; b < 2; ++b)
#pragma unroll
            for (int m = 0; m < 4; ++m)
#pragma unroll
                for (int n = 0; n < 2; ++n) acc[a][b][m][n] = (f32x4){0.f, 0.f, 0.f, 0.f};
    bf16x8 At[4][2], B0[2][2], B1[2][2];
    const char* cA = S.a_base(cur); const char* cB = S.b_base(cur);
    if constexpr (SP2) {
        PG8_STAGE(PG8_SB(0, 0), cB, voffB); PG8_STAGE(PG8_SB(0, 1), cB + hstep, voffB); PG8_STAGE(PG8_SA(0, 0), cA, voffA); PG8_STAGE(PG8_SA(0, 1), cA + hstep, voffA);
        if (wr == 1) PG8_BAR;
        PG8_WAIT_V(2); PG8_BAR;
        PG8_STAGE(PG8_SB(1, 0), cB + kstep, voffB); PG8_STAGE(PG8_SA(1, 0), cA + kstep, voffA); PG8_STAGE(PG8_SB(1, 1), cB + hstep + kstep, voffB);
        PG8_WAIT_V(6); PG8_BAR;
    } else {
        PG8_STAGE(PG8_SB(0, 0), cB, voffB); PG8_STAGE(PG8_SA(0, 0), cA, voffA); PG8_STAGE(PG8_SB(0, 1), cB + hstep, voffB); PG8_STAGE(PG8_SA(0, 1), cA + hstep, voffA);
        if (wr == 1) PG8_BAR;
        PG8_WAIT_V(4); PG8_BAR;
        PG8_STAGE(PG8_SB(1, 0), cB + kstep, voffB); PG8_STAGE(PG8_SA(1, 0), cA + kstep, voffA); PG8_STAGE(PG8_SB(1, 1), cB + hstep + kstep, voffB);
        PG8_WAIT_V(6); PG8_BAR;
    }
    for (;;) {
        const bool has_next = S.next(ui + 1, nxt);
        const char* nA = has_next ? S.a_base(nxt) : cA; const char* nB = has_next ? S.b_base(nxt) : cB;
        for (int t = 0; t < nt; t += 2) {
            const bool last = (t == nt - 2);
            const char* a1 = cA + (size_t)(t + 1) * kstep;
            const char* a2 = last ? nA : cA + (size_t)(t + 2) * kstep; const char* b2 = last ? nB : cB + (size_t)(t + 2) * kstep;
            const char* a3 = a2 + kstep; const char* b3 = b2 + kstep;
            if constexpr (SP2) {
            PG8_LDB(B0, 0, 0); PG8_LDB(B1, 0, 1); PG8_SCHED; PG8_LDA(At, 0, 0); PG8_STAGE(PG8_SA(1, 1), a1 + hstep, voffA);
            PG8_WAIT_V(8); PG8_WAIT_L(0); PG8_BAR; PG8_MMA(0, 0, At, B0); PG8_MMA(0, 1, At, B1); PG8_BAR; PG8_SCHED;
            PG8_LDA(At, 0, 1); PG8_STAGE(PG8_SB(0, 0), b2, voffB); PG8_STAGE(PG8_SB(0, 1), b2 + hstep, voffB); PG8_STAGE(PG8_SA(0, 0), a2, voffA);
            PG8_WAIT_V(8); PG8_WAIT_L(0); PG8_BAR; PG8_MMA(1, 0, At, B0); PG8_MMA(1, 1, At, B1); PG8_BAR; PG8_SCHED;
            PG8_LDB(B0, 1, 0); PG8_LDB(B1, 1, 1); PG8_SCHED; PG8_LDA(At, 1, 0); PG8_STAGE(PG8_SA(0, 1), a2 + hstep, voffA);
            PG8_WAIT_V(8); PG8_WAIT_L(0); PG8_BAR; PG8_MMA(0, 0, At, B0); PG8_MMA(0, 1, At, B1); PG8_BAR; PG8_SCHED;
            PG8_LDA(At, 1, 1); PG8_STAGE(PG8_SB(1, 0), b3, voffB); PG8_STAGE(PG8_SB(1, 1), b3 + hstep, voffB); PG8_STAGE(PG8_SA(1, 0), a3, voffA);
            PG8_WAIT_V(8); PG8_WAIT_L(0); PG8_BAR; PG8_MMA(1, 0, At, B0); PG8_MMA(1, 1, At, B1); PG8_BAR; PG8_SCHED;
            } else {
            PG8_LDB(B0, 0, 0); PG8_SCHED; PG8_LDA(At, 0, 0); PG8_STAGE(PG8_SA(1, 1), a1 + hstep, voffA);
            PG8_WAIT_L(8); PG8_BAR; PG8_WAIT_L(0); PG8_MMA(0, 0, At, B0); PG8_BAR; PG8_SCHED;
            PG8_LDB(B1, 0, 1); PG8_STAGE(PG8_SB(0, 0), b2, voffB);
            PG8_BAR; PG8_WAIT_L(0); PG8_MMA(0, 1, At, B1); PG8_BAR;
            PG8_LDA(At, 0, 1); PG8_STAGE(PG8_SA(0, 0), a2, voffA);
            PG8_BAR; PG8_WAIT_L(0); PG8_MMA(1, 0, At, B0); PG8_BAR; PG8_SCHED;
            PG8_STAGE(PG8_SB(0, 1), b2 + hstep, voffB);
            PG8_WAIT_V(6); PG8_BAR; PG8_MMA(1, 1, At, B1); PG8_BAR;
            PG8_LDB(B0, 1, 0); PG8_SCHED; PG8_LDA(At, 1, 0); PG8_STAGE(PG8_SA(0, 1), a2 + hstep, voffA);
            PG8_WAIT_L(8); PG8_BAR; PG8_WAIT_L(0); PG8_MMA(0, 0, At, B0); PG8_BAR; PG8_SCHED;
            PG8_LDB(B1, 1, 1); PG8_STAGE(PG8_SB(1, 0), b3, voffB);
            PG8_BAR; PG8_WAIT_L(0); PG8_MMA(0, 1, At, B1); PG8_BAR;
            PG8_LDA(At, 1, 1); PG8_STAGE(PG8_SA(1, 0), a3, voffA);
            PG8_BAR; PG8_WAIT_L(0); PG8_MMA(1, 0, At, B0); PG8_BAR; PG8_SCHED;
            PG8_STAGE(PG8_SB(1, 1), b3 + hstep, voffB);
            PG8_WAIT_V(6); PG8_BAR; PG8_MMA(1, 1, At, B1); PG8_BAR;
            }
        }
        if constexpr (ALIGN_EPI) { if (wr == 0) PG8_BAR; }
        E(acc, cur, wr, wc, fr, fq);
        if (!has_next) break;
#pragma unroll
        for (int a = 0; a < 2; ++a)
#pragma unroll
            for (int b = 0; b < 2; ++b)
#pragma unroll
                for (int m = 0; m < 4; ++m)
#pragma unroll
                    for (int n = 0; n < 2; ++n) acc[a][b][m][n] = (f32x4){0.f, 0.f, 0.f, 0.f};
        cur = nxt; cA = nA; cB = nB; ++ui;
        if constexpr (ALIGN_EPI) { if (wr == 1) PG8_BAR; }
    }
    PG8_WAIT_V(0);
    if constexpr (!ALIGN_EPI) { if (wr == 0) PG8_BAR; }
    PG8_BAR;
#undef PG8_SA
#undef PG8_SB
#undef PG8_STAGE
#undef PG8_LDA
#undef PG8_LDB
#undef PG8_MMA
#undef PG8_WAIT_V
#undef PG8_WAIT_L
#undef PG8_BAR
#undef PG8_SCHED
}
}

constexpr int D = 2048, NBATCH = 8, SEQ = 2048, CTXL = 256, DFF = 5632, NMODV = 9, DMODW = NMODV * D  ;
constexpr int M_LAT = NBATCH * SEQ  , M_CTX = NBATCH * CTXL  , M_ALL = M_LAT + M_CTX  ;
constexpr int NH = 16, HD = 64, GW = 64  , GROWS = SEQ / GW  , WIN_R = 8, WIN_C = 16;
constexpr int D_EIN = 5120, D_OIN = 5120, ZE_LD = 3072  , ZO_LD = 5120;
constexpr float EPS = 1e-6f;
constexpr int NPHASE = 21;

constexpr size_t MiB = 1u << 20;
constexpr size_t WS_CTL = 0, CTL_ZERO_BYTES = 1 * MiB;
constexpr size_t WS_MOD = 1 * MiB;
constexpr size_t WS_WFI = 4 * MiB, WFI_STRIDE = 44 * MiB;
constexpr size_t WS_WFO = 180 * MiB, WFO_STRIDE = 22 * MiB;
constexpr size_t WS_WEI = 268 * MiB, WS_WEO = 288 * MiB, WS_WOI = 296 * MiB, WS_WOO = 316 * MiB;
constexpr size_t WS_X = 324 * MiB;
constexpr size_t WS_HN = 468 * MiB;
constexpr size_t WS_ACT = 540 * MiB;
constexpr size_t WS_Z = 738 * MiB;
constexpr size_t WS_MIX = 918 * MiB;
constexpr size_t WS_VT = 990 * MiB;
constexpr size_t WS_HF = 1026 * MiB;
constexpr size_t WS_END = 1090 * MiB;
constexpr int CW_BAR = 4096;

constexpr int RING_BYTES = 131072;
constexpr int LDS_BYTES = 147456;
constexpr int MISC_OFF = LDS_BYTES - 256;

#define GAS __attribute__((address_space(1)))
#define LAS __attribute__((address_space(3)))
typedef unsigned short bf16;
typedef float f32x4 __attribute__((ext_vector_type(4)));
typedef float f32x2 __attribute__((ext_vector_type(2)));
typedef unsigned u32x4 __attribute__((ext_vector_type(4)));
typedef unsigned u32x2 __attribute__((ext_vector_type(2)));
typedef short bf16x8 __attribute__((ext_vector_type(8)));
#define LDS_WAIT() asm volatile("s_waitcnt lgkmcnt(0)" ::: "memory")
#define VM_WAIT() asm volatile("s_waitcnt vmcnt(0)" ::: "memory")
__device__ __forceinline__ unsigned f2bf(float f) { unsigned u = __builtin_bit_cast(unsigned, f); return (u + 0x7fffu + ((u >> 16) & 1u)) >> 16; }
__device__ __forceinline__ unsigned pk2(float lo, float hi) { return f2bf(lo) | (f2bf(hi) << 16); }
__device__ __forceinline__ float bf_lo(unsigned v) { return __builtin_bit_cast(float, v << 16); }
__device__ __forceinline__ float bf_hi(unsigned v) { return __builtin_bit_cast(float, v & 0xffff0000u); }
__device__ __forceinline__ float bf2f(bf16 v) { return __builtin_bit_cast(float, (unsigned)v << 16); }
__device__ __forceinline__ float fast_sigmoid(float x) { return __builtin_amdgcn_rcpf(1.0f + __builtin_amdgcn_exp2f(-1.44269504089f * x)); }
__device__ __forceinline__ float wave_sum(float v) {
#pragma unroll
    for (int o = 1; o < 64; o <<= 1) v += __shfl_xor(v, o);
    return v;
}

#define XB_TMO      128
#define XB_XCNT(j)  (256  + 64 * (j))
#define XB_XSUB(j)  (1280 + 64 * (j))
#define XB_XGEN(j)  (2304 + 64 * (j))
#define XB_TOP      3328
#define XB_TOPGEN   3392
#define XCD_BAR_WORDS 3456
#define XB_SPIN_CAP (1u << 18)

__device__ __forceinline__ unsigned xb_ld(unsigned* p)              { return __hip_atomic_load(p, __ATOMIC_RELAXED, __HIP_MEMORY_SCOPE_AGENT); }
__device__ __forceinline__ unsigned xb_add(unsigned* p, unsigned v) { return __hip_atomic_fetch_add(p, v, __ATOMIC_RELAXED, __HIP_MEMORY_SCOPE_AGENT); }
__device__ __forceinline__ unsigned xb_xcc_id() { return (unsigned)__builtin_amdgcn_s_getreg((3 << 11) | 20) & 0xFu; }
#define XB_SPIN(cond, bar) do { unsigned _sp = 0; while (cond) { __builtin_amdgcn_s_sleep(1); \
    if ((++_sp & 255u) == 0u) { if (xb_ld(&(bar)[XB_TMO])) break; if (_sp > XB_SPIN_CAP) { atomicAdd(&(bar)[XB_TMO], 1u); break; } } } } while (0)

struct XcdBarrier {
    unsigned* bar; unsigned x;
    volatile LAS unsigned* st;
};

__device__ __forceinline__ XcdBarrier xcd_barrier_post(unsigned* bar, volatile LAS unsigned* st) {
    XcdBarrier b; b.bar = bar; b.x = xb_xcc_id(); b.st = st;
    if (threadIdx.x == 0) (void)xb_add(&bar[XB_XCNT(b.x)], 1u);
    return b;
}
__device__ __forceinline__ void xcd_barrier_complete(unsigned* bar, unsigned x, unsigned& nloc, unsigned& nx) {
    const unsigned G = gridDim.x * gridDim.y * gridDim.z;
    unsigned sum, cnt, mine, sp = 0u;
    for (;;) {
        sum = 0u; cnt = 0u; mine = 0u;
#pragma unroll
        for (unsigned j = 0; j < 16; ++j) { const unsigned c = xb_ld(&bar[XB_XCNT(j)]); sum += c; cnt += (c > 0u) ? 1u : 0u; mine = (j == x) ? c : mine; }
        if (sum == G) break;
        __builtin_amdgcn_s_sleep(1);
        if ((++sp & 255u) == 0u) { if (xb_ld(&bar[XB_TMO])) break; if (sp > XB_SPIN_CAP) { atomicAdd(&bar[XB_TMO], 1u); break; } }
    }
    nloc = mine > 0u ? mine : 1u; nx = cnt > 0u ? cnt : 1u;
}

__device__ __forceinline__ void xcd_barrier(const XcdBarrier& b) {
    asm volatile("s_waitcnt vmcnt(0)" ::: "memory");
    __syncthreads();
    if (threadIdx.x == 0) {
        unsigned* bar = b.bar;
        __builtin_amdgcn_s_waitcnt(0);
        unsigned nloc = b.st[0], nx = b.st[1];
        if (nloc == 0u) { xcd_barrier_complete(bar, b.x, nloc, nx); b.st[0] = nloc; b.st[1] = nx; }
        const unsigned old = xb_add(&bar[XB_XSUB(b.x)], 1u);
        const unsigned gen = old / nloc;
        if (old + 1u == (gen + 1u) * nloc) {
            __builtin_amdgcn_fence(__ATOMIC_RELEASE, "agent");
            asm volatile("s_waitcnt vmcnt(0)" ::: "memory");
            const unsigned og = xb_add(&bar[XB_TOP], 1u);
            const unsigned tg = og / nx;
            if (og + 1u == (tg + 1u) * nx) xb_add(&bar[XB_TOPGEN], 1u);
            else XB_SPIN(xb_ld(&bar[XB_TOPGEN]) == tg, bar);
            __builtin_amdgcn_fence(__ATOMIC_ACQUIRE, "agent");
            xb_add(&bar[XB_XGEN(b.x)], 1u);
            asm volatile("s_waitcnt vmcnt(0)" ::: "memory");
        } else {
            XB_SPIN(xb_ld(&bar[XB_XGEN(b.x)]) == gen, bar);
            __builtin_amdgcn_fence(__ATOMIC_ACQUIRE, "agent");
            asm volatile("s_waitcnt vmcnt(0)" ::: "memory");
        }
    }
    __syncthreads();
}

struct Params {
    const float* in[27];
    float* out;
    unsigned char* ws;
    int ph_lo, ph_hi;
};
enum { IN_X = 0, IN_C, IN_CTX, IN_CCTX, IN_WMOD, IN_BMOD, IN_NORMG, IN_FWI, IN_FWO, IN_EWI, IN_SCW, IN_SCB, IN_CCW, IN_CCB, IN_LNG, IN_LNB, IN_EWO,
       IN_OWI, IN_QG, IN_KG, IN_RPB, IN_LCW, IN_LCB, IN_LGW, IN_LGB, IN_LAM, IN_OWO };

struct SchedStd {
    const char* A; const char* Bt; size_t tstep; int nM, nN, G, c;
    __device__ __forceinline__ bool next(int i, pg8::Unit& u) const {
        const long L = (long)i * G + c; if (L >= (long)nM * nN) return false;
        pg8::tile_map((int)L, nM, nN, u.pm, u.pn); u.kind = 0; return true;
    }
    __device__ __forceinline__ const char* a_base(const pg8::Unit& u) const { return A + (size_t)u.pm * tstep; }
    __device__ __forceinline__ const char* b_base(const pg8::Unit& u) const { return Bt + (size_t)u.pn * tstep; }
};
struct SchedOdIn {
    const char* HN; const char* W; size_t tstep; int G, c;
    __device__ __forceinline__ bool next(int i, pg8::Unit& u) const {
        const long L = (long)i * G + c;
        if (L < 72 * 16) { int pm, pnv; pg8::tile_map((int)L, 72, 16, pm, pnv); u.pm = pm; u.pn = pnv < 8 ? pnv : pnv + 4; u.kind = 0; return true; }
        if (L < 72 * 16 + 4 * 72) { int pm, pn; pg8::tile_map((int)L - 72 * 16, 4, 72, pm, pn); u.pm = pm; u.pn = pn; u.kind = 1; return true; }
        return false;
    }
    __device__ __forceinline__ const char* a_base(const pg8::Unit& u) const { return u.kind == 0 ? HN + (size_t)u.pm * tstep : W + (size_t)(8 + u.pm) * tstep; }
    __device__ __forceinline__ const char* b_base(const pg8::Unit& u) const { return u.kind == 0 ? W + (size_t)u.pn * tstep : HN + (size_t)u.pn * tstep; }
};

struct EpiSwiGLU {
    static constexpr bool PERM = true;
    bf16* O;
    __device__ __forceinline__ void operator()(const f32x4 (&acc)[2][2][4][2], const pg8::Unit& u, int wr, int wc, int fr, int fq) const {
        const int row0 = u.pm * 256 + wr * 64 + fr, col0 = u.pn * 128 + wc * 32 + 8 * fq;
#pragma unroll
        for (int ai = 0; ai < 2; ++ai)
#pragma unroll
            for (int m = 0; m < 4; ++m) {
                bf16* rowp = O + (size_t)(row0 + ai * 128 + m * 16) * DFF + col0;
                float v[8];
#pragma unroll
                for (int n = 0; n < 2; ++n)
#pragma unroll
                    for (int j = 0; j < 4; ++j) { const float g = acc[ai][0][m][n][j], up = acc[ai][1][m][n][j]; v[4 * n + j] = g * fast_sigmoid(g) * up; }
                u32x4 w; w.x = pg8::cvt_pk_bf16(v[0], v[1]); w.y = pg8::cvt_pk_bf16(v[2], v[3]); w.z = pg8::cvt_pk_bf16(v[4], v[5]); w.w = pg8::cvt_pk_bf16(v[6], v[7]);
                *(u32x4*)rowp = w;
            }
    }
};
struct EpiResid {
    static constexpr bool PERM = false;
    const float* base_lat; const float* base_ctx; float* out; const float* gate; float coef;
    __device__ __forceinline__ void operator()(const f32x4 (&acc)[2][2][4][2], const pg8::Unit& u, int wr, int wc, int fr, int fq) const {
        const int row0 = u.pm * 256 + wr * 64 + fr, col0 = u.pn * 256 + wc * 32 + 4 * fq;
        const int r = u.pm < 64 ? (u.pm >> 3) : 8;
        const float* gv = gate + (size_t)r * DMODW + col0;
        const float* bp = u.pm < 64 ? base_lat + (size_t)row0 * D + col0 : base_ctx + (size_t)(row0 - M_LAT) * D + col0;
        float* op = out + (size_t)row0 * D + col0;
        f32x4 gvv[2][2];
#pragma unroll
        for (int bj = 0; bj < 2; ++bj)
#pragma unroll
            for (int n = 0; n < 2; ++n) gvv[bj][n] = *(const f32x4*)(gv + bj * 128 + n * 16) * coef;
#pragma unroll
        for (int ai = 0; ai < 2; ++ai)
#pragma unroll
            for (int m = 0; m < 4; ++m) {
                const size_t ro = (size_t)(ai * 128 + m * 16) * D;
#pragma unroll
                for (int bj = 0; bj < 2; ++bj)
#pragma unroll
                    for (int n = 0; n < 2; ++n) { const f32x4 b = *(const f32x4*)(bp + ro + bj * 128 + n * 16); *(f32x4*)(op + ro + bj * 128 + n * 16) = b + gvv[bj][n] * acc[ai][bj][m][n]; }
                asm volatile("" ::: "memory");
            }
    }
};
struct EpiEvIn {
    static constexpr bool PERM = true;
    bf16* O;
    __device__ __forceinline__ void operator()(const f32x4 (&acc)[2][2][4][2], const pg8::Unit& u, int wr, int wc, int fr, int fq) const {
        const int row0 = u.pm * 256 + wr * 64 + fr;
        if (u.pn < 4) {
            const int col0 = u.pn * 256 + wc * 32 + 8 * fq;
#pragma unroll
            for (int ai = 0; ai < 2; ++ai)
#pragma unroll
                for (int m = 0; m < 4; ++m) { bf16* rowp = O + (size_t)(row0 + ai * 128 + m * 16) * ZE_LD + col0;
#pragma unroll
                    for (int bj = 0; bj < 2; ++bj) { const f32x4 v0 = acc[ai][bj][m][0], v1 = acc[ai][bj][m][1];
                        u32x4 w; w.x = pg8::cvt_pk_bf16(v0[0], v0[1]); w.y = pg8::cvt_pk_bf16(v0[2], v0[3]); w.z = pg8::cvt_pk_bf16(v1[0], v1[1]); w.w = pg8::cvt_pk_bf16(v1[2], v1[3]);
                        *(u32x4*)(rowp + bj * 128) = w; } }
        } else {
            const bool glu = u.pn >= 12;
            const int col0 = (glu ? 2048 + (u.pn - 12) * 128 : 1024 + (u.pn - 4) * 128) + wc * 32 + 8 * fq;
#pragma unroll
            for (int ai = 0; ai < 2; ++ai)
#pragma unroll
                for (int m = 0; m < 4; ++m) { bf16* rowp = O + (size_t)(row0 + ai * 128 + m * 16) * ZE_LD + col0;
                    float v[8];
#pragma unroll
                    for (int n = 0; n < 2; ++n)
#pragma unroll
                        for (int j = 0; j < 4; ++j) { const float a = acc[ai][0][m][n][j], b = acc[ai][1][m][n][j]; v[4 * n + j] = glu ? a * fast_sigmoid(b) : a * b; }
                    u32x4 w; w.x = pg8::cvt_pk_bf16(v[0], v[1]); w.y = pg8::cvt_pk_bf16(v[2], v[3]); w.z = pg8::cvt_pk_bf16(v[4], v[5]); w.w = pg8::cvt_pk_bf16(v[6], v[7]);
                    *(u32x4*)rowp = w; }
        }
    }
};
struct EpiOdIn {
    static constexpr bool PERM = true;
    bf16* ZO; bf16* VT;
    __device__ __forceinline__ void operator()(const f32x4 (&acc)[2][2][4][2], const pg8::Unit& u, int wr, int wc, int fr, int fq) const {
        const int row0 = u.pm * 256 + wr * 64 + fr, col0 = u.pn * 256 + wc * 32 + 8 * fq;
        bf16* base = u.kind == 0 ? ZO : VT; const size_t ld = u.kind == 0 ? (size_t)ZO_LD : (size_t)M_ALL;
#pragma unroll
        for (int ai = 0; ai < 2; ++ai)
#pragma unroll
            for (int m = 0; m < 4; ++m) { bf16* rowp = base + (size_t)(row0 + ai * 128 + m * 16) * ld + col0;
#pragma unroll
                for (int bj = 0; bj < 2; ++bj) { const f32x4 v0 = acc[ai][bj][m][0], v1 = acc[ai][bj][m][1];
                    u32x4 w; w.x = pg8::cvt_pk_bf16(v0[0], v0[1]); w.y = pg8::cvt_pk_bf16(v0[2], v0[3]); w.z = pg8::cvt_pk_bf16(v1[0], v1[1]); w.w = pg8::cvt_pk_bf16(v1[2], v1[3]);
                    *(u32x4*)(rowp + bj * 128) = w; } }
    }
};

__device__ __forceinline__ void p0_modvec(const Params& p, LAS unsigned char* lds, int tid, int lane, int wave) {
    LAS float* sv = (LAS float*)lds;
    LAS float* red = (LAS float*)(lds + 9 * 2048 * 4);
    const float* c = p.in[IN_C]; const float* cc = p.in[IN_CCTX];
    for (int i = tid; i < 9 * 2048; i += 512) { const float v = i < 8 * 2048 ? c[i] : cc[i - 8 * 2048]; sv[i] = v / (1.0f + __expf(-v)); }
    __syncthreads();
    float* MOD = (float*)(p.ws + WS_MOD);
    for (int item = blockIdx.x; item < 2 * 288; item += gridDim.x) {
        const int l = item / 288, col0 = (item % 288) * 64;
        const float* W = p.in[IN_WMOD] + (size_t)l * D * DMODW + col0 + lane;
        float acc[9];
#pragma unroll
        for (int r = 0; r < 9; ++r) acc[r] = 0.f;
        const int kb = wave * 256;
#pragma unroll 2
        for (int k4 = 0; k4 < 64; ++k4) {
            const int k = kb + 4 * k4;
            const float w0 = W[(size_t)(k + 0) * DMODW], w1 = W[(size_t)(k + 1) * DMODW], w2 = W[(size_t)(k + 2) * DMODW], w3 = W[(size_t)(k + 3) * DMODW];
#pragma unroll
            for (int r = 0; r < 9; ++r) { const f32x4 s = *(const LAS f32x4*)(sv + r * 2048 + k); acc[r] += s[0] * w0 + s[1] * w1 + s[2] * w2 + s[3] * w3; }
        }
#pragma unroll
        for (int r = 0; r < 9; ++r) red[(wave * 9 + r) * 64 + lane] = acc[r];
        __syncthreads();
        for (int o = tid; o < 9 * 64; o += 512) {
            const int r = o >> 6, ln = o & 63; float s = 0.f;
#pragma unroll
            for (int w = 0; w < 8; ++w) s += red[(w * 9 + r) * 64 + ln];
            MOD[((size_t)l * 9 + r) * DMODW + col0 + ln] = s + p.in[IN_BMOD][(size_t)l * DMODW + col0 + ln];
        }
        __syncthreads();
    }
}
__device__ __forceinline__ int srccol(int map, int n) {
    if (map == 0) return n;
    const int pn = n >> 8, bj = (n >> 7) & 1, i = n & 127;
    if (map == 1) return bj * DFF + 128 * pn + i;
    if (pn < 4) return n;
    if (pn < 12) return 1024 + bj * 1024 + 128 * (pn - 4) + i;
    return 3072 + bj * 1024 + 128 * (pn - 12) + i;
}
__device__ __forceinline__ void p0_transpose_item(const float* W, int K, int N, bf16* WT, int map, LAS float* scr, int item, int lane) {
    const int nblk = N / 64, kb = item / nblk, nb = item % nblk, k0 = 64 * kb, n0 = 64 * nb, s0 = srccol(map, n0);
    const float* src = W + (size_t)k0 * N + s0 + lane;
#pragma unroll 16
    for (int i = 0; i < 64; ++i) scr[i * 65 + lane] = src[(size_t)i * N];
    LDS_WAIT(); asm volatile("" ::: "memory");
    const int c = lane & 7;
#pragma unroll
    for (int j = 0; j < 8; ++j) { const int n = (lane >> 3) + 8 * j; const LAS float* s = scr + (8 * c) * 65 + n;
        u32x4 o; o.x = pk2(s[0 * 65], s[1 * 65]); o.y = pk2(s[2 * 65], s[3 * 65]); o.z = pk2(s[4 * 65], s[5 * 65]); o.w = pk2(s[6 * 65], s[7 * 65]);
        *(u32x4*)(WT + (size_t)(n0 + n) * K + k0 + 8 * c) = o; }
    LDS_WAIT(); asm volatile("" ::: "memory");
}
__device__ __forceinline__ void p0_weights(const Params& p, LAS unsigned char* lds, int lane, int wave) {
    LAS float* scr = (LAS float*)(lds + wave * (64 * 65 * 4));
    const int gw = blockIdx.x * 8 + wave, NGW = gridDim.x * 8;
    constexpr int I_FI = (D / 64) * (2 * DFF / 64), I_FO = (DFF / 64) * (D / 64), I_IN = (D / 64) * (D_EIN / 64), I_OUT = (D / 64) * (D / 64);
    constexpr int NITEMS = 4 * I_FI + 4 * I_FO + 2 * I_IN + 2 * I_OUT;
    for (int it = gw; it < NITEMS; it += NGW) {
        int r = it;
        if (r < 4 * I_FI) { const int q = r / I_FI; p0_transpose_item(p.in[IN_FWI] + (size_t)q * D * 2 * DFF, D, 2 * DFF, (bf16*)(p.ws + WS_WFI + q * WFI_STRIDE), 1, scr, r % I_FI, lane); continue; } r -= 4 * I_FI;
        if (r < 4 * I_FO) { const int q = r / I_FO; p0_transpose_item(p.in[IN_FWO] + (size_t)q * DFF * D, DFF, D, (bf16*)(p.ws + WS_WFO + q * WFO_STRIDE), 0, scr, r % I_FO, lane); continue; } r -= 4 * I_FO;
        if (r < I_IN) { p0_transpose_item(p.in[IN_EWI], D, D_EIN, (bf16*)(p.ws + WS_WEI), 2, scr, r, lane); continue; } r -= I_IN;
        if (r < I_IN) { p0_transpose_item(p.in[IN_OWI], D, D_OIN, (bf16*)(p.ws + WS_WOI), 0, scr, r, lane); continue; } r -= I_IN;
        if (r < I_OUT) { p0_transpose_item(p.in[IN_EWO], D, D, (bf16*)(p.ws + WS_WEO), 0, scr, r, lane); continue; } r -= I_OUT;
        p0_transpose_item(p.in[IN_OWO], D, D, (bf16*)(p.ws + WS_WOO), 0, scr, r, lane);
    }
}

__device__ __forceinline__ void norm_phase(const float* src_lat, const float* src_ctx, int nrows, const float* g, const float* modl, int shift_idx, int scale_idx, bf16* HN, int lane, int wave) {
    const int gw = blockIdx.x * 8 + wave, NGW = gridDim.x * 8;
    for (int row = gw; row < nrows; row += NGW) {
        const float* xr = row < M_LAT ? src_lat + (size_t)row * D : src_ctx + (size_t)(row - M_LAT) * D;
        const int r = row < M_LAT ? (row >> 11) : 8;
        const float* sh = modl + (size_t)r * DMODW + shift_idx * D; const float* sc = modl + (size_t)r * DMODW + scale_idx * D;
        f32x4 v[8]; float ss = 0.f;
#pragma unroll
        for (int j = 0; j < 8; ++j) { v[j] = *(const f32x4*)(xr + 4 * lane + 256 * j); ss += (v[j][0] * v[j][0] + v[j][1] * v[j][1]) + (v[j][2] * v[j][2] + v[j][3] * v[j][3]); }
        const float rstd = 1.0f / sqrtf(wave_sum(ss) * (1.0f / D) + EPS);
        bf16* o = HN + (size_t)row * D;
#pragma unroll
        for (int j = 0; j < 8; ++j) { const int c = 4 * lane + 256 * j; const f32x4 gg = *(const f32x4*)(g + c), s1 = *(const f32x4*)(sc + c), s0 = *(const f32x4*)(sh + c);
            const f32x4 y = (v[j] * rstd) * gg * (1.0f + s1) + s0;
            u32x2 w; w.x = pk2(y[0], y[1]); w.y = pk2(y[2], y[3]); *(u32x2*)(o + c) = w; }
    }
}

__device__ __forceinline__ void even_conv_phase(const Params& p, LAS unsigned char* lds, int tid, int lane, int wave) {
    const bf16* Z3 = (const bf16*)(p.ws + WS_Z); bf16* MIX = (bf16*)(p.ws + WS_MIX);
    LAS unsigned* tile = (LAS unsigned*)lds;
    LAS float* red = (LAS float*)(lds + 62 * 2048);
    LAS float* stat = red + 256;
    const float* ccw = p.in[IN_CCW]; const float* ccb = p.in[IN_CCB]; const float* lng = p.in[IN_LNG]; const float* lnb = p.in[IN_LNB];
    const float* scw = p.in[IN_SCW]; const float* scb = p.in[IN_SCB];
    for (int u = blockIdx.x; u < 576; u += gridDim.x) {
        int base, T, t0;
        if (u < 512) { base = (u >> 6) * SEQ; T = SEQ; t0 = (u & 63) * 32; } else { const int v = u - 512; base = M_LAT + (v >> 3) * CTXL; T = CTXL; t0 = (v & 7) * 32; }
        for (int ch = tid; ch < 62 * 128; ch += 512) {
            const int rr = ch >> 7, cc = ch & 127, t = t0 - 15 + rr;
            u32x4 v = (u32x4){0u, 0u, 0u, 0u};
            if (t >= 0 && t < T) v = *(const u32x4*)(Z3 + (size_t)(base + t) * ZE_LD + 2048 + cc * 8);
            *(LAS u32x4*)(tile + rr * 512 + cc * 4) = v;
        }
        __syncthreads();
        float acc[32][2];
#pragma unroll
        for (int i = 0; i < 32; ++i) { acc[i][0] = 0.f; acc[i][1] = 0.f; }
        for (int k = 0; k < 31; ++k) {
            const f32x2 w = *(const f32x2*)(ccw + (size_t)k * 1024 + 2 * tid);
            const LAS unsigned* tp = tile + k * 512 + tid;
#pragma unroll
            for (int i = 0; i < 32; ++i) { const unsigned v = tp[i * 512]; acc[i][0] += w[0] * bf_lo(v); acc[i][1] += w[1] * bf_hi(v); }
        }
        { const f32x2 b = *(const f32x2*)(ccb + 2 * tid);
#pragma unroll
          for (int i = 0; i < 32; ++i) { acc[i][0] += b[0]; acc[i][1] += b[1]; } }
#pragma unroll
        for (int i = 0; i < 32; ++i) { const float s = wave_sum(acc[i][0] + acc[i][1]); if (lane == 0) red[wave * 32 + i] = s; }
        __syncthreads();
        if (tid < 32) { float s = 0.f;
#pragma unroll
            for (int w = 0; w < 8; ++w) s += red[w * 32 + tid]; stat[tid] = s * (1.0f / 1024.0f); }
        __syncthreads();
#pragma unroll
        for (int i = 0; i < 32; ++i) { const float mu = stat[i]; acc[i][0] -= mu; acc[i][1] -= mu; }
        __syncthreads();
#pragma unroll
        for (int i = 0; i < 32; ++i) { const float s = wave_sum(acc[i][0] * acc[i][0] + acc[i][1] * acc[i][1]); if (lane == 0) red[wave * 32 + i] = s; }
        __syncthreads();
        if (tid < 32) { float s = 0.f;
#pragma unroll
            for (int w = 0; w < 8; ++w) s += red[w * 32 + tid]; stat[tid] = 1.0f / sqrtf(s * (1.0f / 1024.0f) + EPS); }
        __syncthreads();
        { const f32x2 g = *(const f32x2*)(lng + 2 * tid), b = *(const f32x2*)(lnb + 2 * tid);
#pragma unroll
          for (int i = 0; i < 32; ++i) { const float rs = stat[i]; const float y0 = acc[i][0] * rs * g[0] + b[0], y1 = acc[i][1] * rs * g[1] + b[1];
              const float o0 = y0 / (1.0f + __expf(-y0)), o1 = y1 / (1.0f + __expf(-y1));
              *(unsigned*)(MIX + (size_t)(base + t0 + i) * D + 1024 + 2 * tid) = pk2(o0, o1); } }
        { const f32x2 w0 = *(const f32x2*)(scw + 2 * tid), w1 = *(const f32x2*)(scw + 1024 + 2 * tid), w2 = *(const f32x2*)(scw + 2048 + 2 * tid), b = *(const f32x2*)(scb + 2 * tid);
          unsigned pv[34];
#pragma unroll
          for (int i = 0; i < 34; ++i) { const int t = t0 - 1 + i; pv[i] = (t >= 0 && t < T) ? *(const unsigned*)(Z3 + (size_t)(base + t) * ZE_LD + 1024 + 2 * tid) : 0u; }
#pragma unroll
          for (int i = 0; i < 32; ++i) { const unsigned bg = *(const unsigned*)(Z3 + (size_t)(base + t0 + i) * ZE_LD + 2 * tid);
              const float c0 = w0[0] * bf_lo(pv[i]) + w1[0] * bf_lo(pv[i + 1]) + w2[0] * bf_lo(pv[i + 2]) + b[0];
              const float c1 = w0[1] * bf_hi(pv[i]) + w1[1] * bf_hi(pv[i + 1]) + w2[1] * bf_hi(pv[i + 2]) + b[1];
              *(unsigned*)(MIX + (size_t)(base + t0 + i) * D + 2 * tid) = pk2(bf_lo(bg) * c0, bf_hi(bg) * c1); } }
        __syncthreads();
    }
}

__device__ __forceinline__ void attn_wave_unit(const Params& p, int b, int h, int r, int qg, int lane) {
    const bf16* ZO = (const bf16*)(p.ws + WS_Z); const bf16* VT = (const bf16*)(p.ws + WS_VT); bf16* MIX = (bf16*)(p.ws + WS_MIX);
    const float* qgain = p.in[IN_QG]; const float* kgain = p.in[IN_KG]; const float* rpb = p.in[IN_RPB] + (size_t)h * 15 * 31;
    const int l15 = lane & 15, g = lane >> 4;
    const int c0 = 16 * qg, qc = c0 + l15, qrow = b * SEQ + r * GW + qc;
    const int r0 = min(max(r - WIN_R / 2, 0), GROWS - WIN_R);
    const int kb = qg == 0 ? 0 : (qg == 1 ? 8 : (qg == 2 ? 24 : 32));
    const int cs = min(max(qc - WIN_C / 2, 0), GW - WIN_C);
    float kg[16];
    bf16x8 qf[2];
    {
        float qv[16]; float ss = 0.f;
#pragma unroll
        for (int kk = 0; kk < 2; ++kk) { const u32x4 raw = *(const u32x4*)(ZO + (size_t)qrow * ZO_LD + h * HD + 8 * g + 32 * kk);
#pragma unroll
            for (int e = 0; e < 4; ++e) { qv[8 * kk + 2 * e] = bf_lo(raw[e]); qv[8 * kk + 2 * e + 1] = bf_hi(raw[e]); } }
#pragma unroll
        for (int e = 0; e < 16; ++e) ss += qv[e] * qv[e];
        ss += __shfl_xor(ss, 16); ss += __shfl_xor(ss, 32);
        const float rs = 0.125f / sqrtf(ss * (1.0f / HD) + EPS);
#pragma unroll
        for (int kk = 0; kk < 2; ++kk) {
            const f32x4 g0 = *(const f32x4*)(qgain + 8 * g + 32 * kk), g1 = *(const f32x4*)(qgain + 8 * g + 32 * kk + 4);
            const f32x4 k0 = *(const f32x4*)(kgain + 8 * g + 32 * kk), k1 = *(const f32x4*)(kgain + 8 * g + 32 * kk + 4);
#pragma unroll
            for (int e = 0; e < 4; ++e) { kg[8 * kk + e] = k0[e]; kg[8 * kk + 4 + e] = k1[e]; }
            u32x4 w;
            w.x = pk2(qv[8 * kk + 0] * rs * g0[0], qv[8 * kk + 1] * rs * g0[1]); w.y = pk2(qv[8 * kk + 2] * rs * g0[2], qv[8 * kk + 3] * rs * g0[3]);
            w.z = pk2(qv[8 * kk + 4] * rs * g1[0], qv[8 * kk + 5] * rs * g1[1]); w.w = pk2(qv[8 * kk + 6] * rs * g1[2], qv[8 * kk + 7] * rs * g1[3]);
            qf[kk] = __builtin_bit_cast(bf16x8, w);
        }
    }
    f32x4 o[4];
#pragma unroll
    for (int d = 0; d < 4; ++d) o[d] = (f32x4){0.f, 0.f, 0.f, 0.f};
    float mrun = -1e30f, lsum = 0.f;
    const bf16* vbase = VT + (size_t)(h * HD + l15) * M_ALL + 4 * g;
    for (int ch = 0; ch < 16; ++ch) {
        const bool loc = ch >= 8;
        const int tok0 = loc ? b * SEQ + (r0 + (ch - 8)) * GW + kb : M_LAT + b * CTXL + 32 * ch;
        f32x4 s[2];
#pragma unroll
        for (int a = 0; a < 2; ++a) {
            const bf16* kp = ZO + (size_t)(tok0 + 16 * a + l15) * ZO_LD + 1024 + h * HD + 8 * g;
            const u32x4 r0v = *(const u32x4*)kp, r1v = *(const u32x4*)(kp + 32);
            float kv[16];
#pragma unroll
            for (int e = 0; e < 4; ++e) { kv[2 * e] = bf_lo(r0v[e]); kv[2 * e + 1] = bf_hi(r0v[e]); kv[8 + 2 * e] = bf_lo(r1v[e]); kv[8 + 2 * e + 1] = bf_hi(r1v[e]); }
            float ss = 0.f;
#pragma unroll
            for (int e = 0; e < 16; ++e) ss += kv[e] * kv[e];
            ss += __shfl_xor(ss, 16); ss += __shfl_xor(ss, 32);
            const float rs = 1.0f / sqrtf(ss * (1.0f / HD) + EPS);
            u32x4 w0, w1;
            w0.x = pk2(kv[0] * rs * kg[0], kv[1] * rs * kg[1]); w0.y = pk2(kv[2] * rs * kg[2], kv[3] * rs * kg[3]); w0.z = pk2(kv[4] * rs * kg[4], kv[5] * rs * kg[5]); w0.w = pk2(kv[6] * rs * kg[6], kv[7] * rs * kg[7]);
            w1.x = pk2(kv[8] * rs * kg[8], kv[9] * rs * kg[9]); w1.y = pk2(kv[10] * rs * kg[10], kv[11] * rs * kg[11]); w1.z = pk2(kv[12] * rs * kg[12], kv[13] * rs * kg[13]); w1.w = pk2(kv[14] * rs * kg[14], kv[15] * rs * kg[15]);
            f32x4 acc = (f32x4){0.f, 0.f, 0.f, 0.f};
            acc = __builtin_amdgcn_mfma_f32_16x16x32_bf16(__builtin_bit_cast(bf16x8, w0), qf[0], acc, 0, 0, 0);
            acc = __builtin_amdgcn_mfma_f32_16x16x32_bf16(__builtin_bit_cast(bf16x8, w1), qf[1], acc, 0, 0, 0);
            s[a] = acc;
        }
        if (loc) {
            const int drow = (r0 + (ch - 8)) - r + WIN_R - 1;
            const float* bp = rpb + drow * 31;
#pragma unroll
            for (int a = 0; a < 2; ++a)
#pragma unroll
                for (int e = 0; e < 4; ++e) { const int kc = kb + 16 * a + 4 * g + e; const bool ok = (kc >= cs) && (kc < cs + WIN_C);
                    const int dc = min(max(kc - qc + WIN_C - 1, 0), 2 * WIN_C - 2);
                    s[a][e] = ok ? s[a][e] + bp[dc] : -1e30f; }
        }
        float mx = fmaxf(fmaxf(fmaxf(s[0][0], s[0][1]), fmaxf(s[0][2], s[0][3])), fmaxf(fmaxf(s[1][0], s[1][1]), fmaxf(s[1][2], s[1][3])));
        mx = fmaxf(mx, __shfl_xor(mx, 16)); mx = fmaxf(mx, __shfl_xor(mx, 32));
        const float mnew = fmaxf(mrun, mx), alpha = __expf(mrun - mnew);
        mrun = mnew;
        float pe[8]; float ps = 0.f;
#pragma unroll
        for (int a = 0; a < 2; ++a)
#pragma unroll
            for (int e = 0; e < 4; ++e) { pe[4 * a + e] = __expf(s[a][e] - mnew); ps += pe[4 * a + e]; }
        lsum = lsum * alpha + ps;
        u32x4 pw; pw.x = pk2(pe[0], pe[1]); pw.y = pk2(pe[2], pe[3]); pw.z = pk2(pe[4], pe[5]); pw.w = pk2(pe[6], pe[7]);
        const bf16x8 pf = __builtin_bit_cast(bf16x8, pw);
#pragma unroll
        for (int d = 0; d < 4; ++d) {
            const bf16* vp = vbase + (size_t)(16 * d) * M_ALL + tok0;
            const u32x2 v0 = *(const u32x2*)vp, v1 = *(const u32x2*)(vp + 16);
            u32x4 vw; vw.x = v0.x; vw.y = v0.y; vw.z = v1.x; vw.w = v1.y;
            o[d] = o[d] * alpha;
            o[d] = __builtin_amdgcn_mfma_f32_16x16x32_bf16(__builtin_bit_cast(bf16x8, vw), pf, o[d], 0, 0, 0);
        }
    }
    lsum += __shfl_xor(lsum, 16); lsum += __shfl_xor(lsum, 32);
    const float inv = 1.0f / lsum;
#pragma unroll
    for (int d = 0; d < 4; ++d) { u32x2 w; w.x = pk2(o[d][0] * inv, o[d][1] * inv); w.y = pk2(o[d][2] * inv, o[d][3] * inv);
        *(u32x2*)(MIX + (size_t)qrow * D + h * HD + 16 * d + 4 * g) = w; }
}
__device__ __forceinline__ void attn_phase(const Params& p, int lane, int wave) {
    const int cls = blockIdx.x & 7, wgi = blockIdx.x >> 3, ncl = (gridDim.x - cls + 7) >> 3, nW = ncl * 8;
    if (gridDim.x >= 8) {
        for (int v = wgi * 8 + wave; v < NH * GROWS * 4; v += nW) { const int h = v >> 7, rem = v & 127; attn_wave_unit(p, cls, h, rem >> 2, rem & 3, lane); }
    } else {
        for (int v = blockIdx.x * 8 + wave; v < NBATCH * NH * GROWS * 4; v += gridDim.x * 8) { const int b = v >> 11, w = v & 2047, h = w >> 7, rem = w & 127; attn_wave_unit(p, b, h, rem >> 2, rem & 3, lane); }
    }
}

__device__ __forceinline__ float gelu_tanh(float x) { const float z = 0.7978845608028654f * (x + 0.044715f * x * x * x); return x / (1.0f + __expf(-2.0f * z)); }
__device__ __forceinline__ void lru_item(const Params& p, LAS unsigned char* lds, int item, int tid, int lane, int wave) {
    const bf16* ZO = (const bf16*)(p.ws + WS_Z); float* HF = (float*)(p.ws + WS_HF); bf16* MIX = (bf16*)(p.ws + WS_MIX);
    const int b = item >> 5, n = (item >> 1) & 15, half = item & 1, j0 = half * 32;
    LAS float* xcf = (LAS float*)lds;
    LAS bf16* xcb = (LAS bf16*)(lds + 64 * 65 * 4);
    LAS float* As = (LAS float*)(lds + 64 * 65 * 4 + 64 * 72 * 2);
    LAS float* Us = As + 64 * 33;
    LAS float* segA = Us + 64 * 33;
    LAS float* segH = segA + 16 * 32;
    const int ci = tid & 63, tq = tid >> 6, cch = n * 64 + ci;
    const float* lcw = p.in[IN_LCW]; const float cw0 = lcw[cch], cw1 = lcw[1024 + cch], cw2 = lcw[2048 + cch], cw3 = lcw[3072 + cch], cb = p.in[IN_LCB][cch];
    const int jb = wave & 1, tb = wave >> 1, l15 = lane & 15, g = lane >> 4, jl = 16 * jb + l15, gch = n * 64 + j0 + jl;
    const int sc = tid & 31, sg = tid >> 5, och = n * 64 + j0 + sc;
    for (int dir = 0; dir < 2; ++dir) {
        bf16x8 Bg[2][2];
        {
            const float* gw = p.in[IN_LGW] + (size_t)((dir * 2) * 16 + n) * 4096;
#pragma unroll
            for (int gt = 0; gt < 2; ++gt)
#pragma unroll
                for (int kk = 0; kk < 2; ++kk) { const float* wp = gw + (size_t)gt * 16 * 4096 + (size_t)(8 * g + 32 * kk) * 64 + j0 + jl;
                    u32x4 w; w.x = pk2(wp[0], wp[64]); w.y = pk2(wp[128], wp[192]); w.z = pk2(wp[256], wp[320]); w.w = pk2(wp[384], wp[448]); Bg[gt][kk] = __builtin_bit_cast(bf16x8, w); }
        }
        const float br = p.in[IN_LGB][(dir * 2 + 0) * 1024 + gch], bi = p.in[IN_LGB][(dir * 2 + 1) * 1024 + gch];
        const float lam = p.in[IN_LAM][dir * 1024 + gch];
        const float sp8 = -8.0f * log1pf(expf(-lam));
        float carry = 0.f;
        for (int cidx = 0; cidx < 36; ++cidx) {
            const bool isctx = cidx < 4;
            const int cc = isctx ? cidx : cidx - 4, ncs = isctx ? 4 : 32, cpos = dir == 0 ? cc : ncs - 1 - cc;
            const int base = isctx ? M_LAT + b * CTXL : b * SEQ, T = isctx ? CTXL : SEQ, t0 = cpos * 64;
            {
                float xw[11];
#pragma unroll
                for (int e = 0; e < 11; ++e) { const int t = t0 + 8 * tq - 1 + e; xw[e] = (t >= 0 && t < T) ? bf2f(ZO[(size_t)(base + t) * ZO_LD + 3072 + cch]) : 0.f; }
#pragma unroll
                for (int e = 0; e < 8; ++e) { const float y = cw0 * xw[e] + cw1 * xw[e + 1] + cw2 * xw[e + 2] + cw3 * xw[e + 3] + cb;
                    xcf[(8 * tq + e) * 65 + ci] = y; xcb[(8 * tq + e) * 72 + ci] = (bf16)f2bf(y); }
            }
            __syncthreads();
            {
                const bf16x8 a0 = *(const LAS bf16x8*)(xcb + (16 * tb + l15) * 72 + 8 * g), a1 = *(const LAS bf16x8*)(xcb + (16 * tb + l15) * 72 + 8 * g + 32);
                f32x4 gr_ = (f32x4){0.f, 0.f, 0.f, 0.f}, gi_ = (f32x4){0.f, 0.f, 0.f, 0.f};
                gr_ = __builtin_amdgcn_mfma_f32_16x16x32_bf16(a0, Bg[0][0], gr_, 0, 0, 0); gr_ = __builtin_amdgcn_mfma_f32_16x16x32_bf16(a1, Bg[0][1], gr_, 0, 0, 0);
                gi_ = __builtin_amdgcn_mfma_f32_16x16x32_bf16(a0, Bg[1][0], gi_, 0, 0, 0); gi_ = __builtin_amdgcn_mfma_f32_16x16x32_bf16(a1, Bg[1][1], gi_, 0, 0, 0);
#pragma unroll
                for (int e = 0; e < 4; ++e) {
                    const int tl = 16 * tb + 4 * g + e;
                    const float rg = 1.0f / (1.0f + expf(-(gr_[e] + br))), ig = 1.0f / (1.0f + expf(-(gi_[e] + bi)));
                    const float la = sp8 * rg, a = expf(la), mult = sqrtf(-expm1f(2.0f * la));
                    As[tl * 33 + jl] = a; Us[tl * 33 + jl] = mult * ig * xcf[tl * 65 + j0 + jl];
                }
            }
            __syncthreads();
            float av[4], uv[4];
            {
                float A = 1.f, H = 0.f;
#pragma unroll
                for (int e = 0; e < 4; ++e) { const int q = 4 * sg + e, tl = dir ? 63 - q : q; av[e] = As[tl * 33 + sc]; uv[e] = Us[tl * 33 + sc]; H = av[e] * H + uv[e]; A *= av[e]; }
                segA[sg * 32 + sc] = A; segH[sg * 32 + sc] = H;
            }
            __syncthreads();
            {
                float hin = carry, mine = 0.f;
#pragma unroll
                for (int s2 = 0; s2 < 16; ++s2) { if (s2 == sg) mine = hin; hin = segA[s2 * 32 + sc] * hin + segH[s2 * 32 + sc]; }
                carry = hin;
                if (!isctx) {
                    float hcur = mine;
#pragma unroll
                    for (int e = 0; e < 4; ++e) {
                        const int q = 4 * sg + e, tl = dir ? 63 - q : q; const size_t row = (size_t)(base + t0 + tl);
                        hcur = av[e] * hcur + uv[e];
                        if (dir == 0) HF[row * 1024 + och] = hcur;
                        else { const float hf = HF[row * 1024 + och]; const float gr = bf2f(ZO[row * ZO_LD + 4096 + och]);
                               MIX[row * D + 1024 + och] = (bf16)f2bf((hf + hcur) * gelu_tanh(gr)); }
                    }
                }
            }
        }
        VM_WAIT(); __syncthreads();
    }
}


#if MK_SPLIT
#define GRID_BAR() do { } while (0)
#else
#define GRID_BAR() xcd_barrier(bar)
#endif
#define IN(k) (lo <= (k) && (k) < hi)
#define SEAM(k) do { if (IN(k) && IN((k) + 1)) GRID_BAR(); } while (0)

template <int L>
__device__ __forceinline__ void layer_body(const Params& p, LAS unsigned char* lds, const XcdBarrier& bar, const int lo, const int hi) {
    constexpr int l = L;
    const int tid = threadIdx.x, lane = tid & 63, wave = __builtin_amdgcn_readfirstlane(tid >> 6);
    const int G = gridDim.x;
    float* MOD = (float*)(p.ws + WS_MOD);
    float* X = (float*)(p.ws + WS_X);
    bf16* HN = (bf16*)(p.ws + WS_HN);
    bf16* ACT = (bf16*)(p.ws + WS_ACT);
    bf16* Z = (bf16*)(p.ws + WS_Z);
    bf16* MIX = (bf16*)(p.ws + WS_MIX);
        const int pb = 1 + 10 * l;
        const float* modl = MOD + (size_t)l * 9 * DMODW;
        const float* ng = p.in[IN_NORMG] + (size_t)l * 3 * D;
        constexpr bool first = (l == 0);
        const float* xs_lat = first ? p.in[IN_X] : X; const float* xs_ctx = first ? p.in[IN_CTX] : X + (size_t)M_LAT * D;

        if (IN(pb + 0)) norm_phase(xs_lat, xs_ctx, M_ALL, ng + 0 * D, modl, 0, 1, HN, lane, wave);
        SEAM(pb + 0);
        if (IN(pb + 1)) {
            SchedStd S{(const char*)HN, (const char*)(p.ws + WS_WFI + (size_t)(l * 2 + 0) * WFI_STRIDE), (size_t)256 * D * 2, M_ALL / 256, 2 * DFF / 256, G, (int)blockIdx.x};
            EpiSwiGLU E{ACT};
            pg8::gemm_phase<EpiSwiGLU, SchedStd>(lds, D, S, E);
        }
        SEAM(pb + 1);
        if (IN(pb + 2)) {
            SchedStd S{(const char*)ACT, (const char*)(p.ws + WS_WFO + (size_t)(l * 2 + 0) * WFO_STRIDE), (size_t)256 * DFF * 2, M_ALL / 256, D / 256, G, (int)blockIdx.x};
            EpiResid E{xs_lat, xs_ctx, X, modl + 2 * D, 0.5f};
            pg8::gemm_phase<EpiResid, SchedStd>(lds, DFF, S, E);
        }
        SEAM(pb + 2);
        if (IN(pb + 3)) norm_phase(X, X + (size_t)M_LAT * D, M_ALL, ng + 1 * D, modl, 3, 4, HN, lane, wave);
        SEAM(pb + 3);
        if constexpr (first) {
            if (IN(pb + 4)) {
                SchedStd S{(const char*)HN, (const char*)(p.ws + WS_WEI), (size_t)256 * D * 2, M_ALL / 256, D_EIN / 256, G, (int)blockIdx.x};
                EpiEvIn E{Z};
                pg8::gemm_phase<EpiEvIn, SchedStd>(lds, D, S, E);
            }
            SEAM(pb + 4);
            if (IN(pb + 5)) even_conv_phase(p, lds, tid, lane, wave);
            SEAM(pb + 5);
            if (IN(pb + 6)) {
                SchedStd S{(const char*)MIX, (const char*)(p.ws + WS_WEO), (size_t)256 * D * 2, M_ALL / 256, D / 256, G, (int)blockIdx.x};
                EpiResid E{X, X + (size_t)M_LAT * D, X, modl + 5 * D, 1.0f};
                pg8::gemm_phase<EpiResid, SchedStd>(lds, D, S, E);
            }
            SEAM(pb + 6);
        } else {
            if (IN(pb + 4)) {
                SchedOdIn S{(const char*)HN, (const char*)(p.ws + WS_WOI), (size_t)256 * D * 2, G, (int)blockIdx.x};
                EpiOdIn E{Z, (bf16*)(p.ws + WS_VT)};
                pg8::gemm_phase<EpiOdIn, SchedOdIn>(lds, D, S, E);
            }
            SEAM(pb + 4);
            if (IN(pb + 5)) {
                for (int item = blockIdx.x; item < 256; item += G) lru_item(p, lds, item, tid, lane, wave);
                attn_phase(p, lane, wave);
            }
            SEAM(pb + 5);
            if (IN(pb + 6)) {
                SchedStd S{(const char*)MIX, (const char*)(p.ws + WS_WOO), (size_t)256 * D * 2, M_LAT / 256, D / 256, G, (int)blockIdx.x};
                EpiResid E{X, X + (size_t)M_LAT * D, X, modl + 5 * D, 1.0f};
                pg8::gemm_phase<EpiResid, SchedStd>(lds, D, S, E);
            }
            SEAM(pb + 6);
        }
        const int nrows2 = first ? M_ALL : M_LAT;
        if (IN(pb + 7)) norm_phase(X, X + (size_t)M_LAT * D, nrows2, ng + 2 * D, modl, 6, 7, HN, lane, wave);
        SEAM(pb + 7);
        if (IN(pb + 8)) {
            SchedStd S{(const char*)HN, (const char*)(p.ws + WS_WFI + (size_t)(l * 2 + 1) * WFI_STRIDE), (size_t)256 * D * 2, nrows2 / 256, 2 * DFF / 256, G, (int)blockIdx.x};
            EpiSwiGLU E{ACT};
            pg8::gemm_phase<EpiSwiGLU, SchedStd>(lds, D, S, E);
        }
        SEAM(pb + 8);
        if (IN(pb + 9)) {
            SchedStd S{(const char*)ACT, (const char*)(p.ws + WS_WFO + (size_t)(l * 2 + 1) * WFO_STRIDE), (size_t)256 * DFF * 2, nrows2 / 256, D / 256, G, (int)blockIdx.x};
            EpiResid E{X, X + (size_t)M_LAT * D, first ? X : p.out, modl + 8 * D, 0.5f};
            pg8::gemm_phase<EpiResid, SchedStd>(lds, DFF, S, E);
        }
        SEAM(pb + 9);
}
__global__ void __launch_bounds__(512, 2) mega_fwd(Params p) {
    extern __shared__ __attribute__((aligned(16))) unsigned char lds_raw[];
    LAS unsigned char* lds = (LAS unsigned char*)lds_raw;
    volatile LAS unsigned* MISC = (volatile LAS unsigned*)(lds + MISC_OFF);
    const int tid = threadIdx.x, lane = tid & 63, wave = __builtin_amdgcn_readfirstlane(tid >> 6);
    const int G = gridDim.x;
    if (tid < 64) MISC[tid] = 0u;
    __syncthreads();
    unsigned* ctl = (unsigned*)(p.ws + WS_CTL);
#if MK_SPLIT
    XcdBarrier bar; bar.bar = ctl + CW_BAR; bar.x = 0; bar.st = MISC + 8;
#else
    XcdBarrier bar = xcd_barrier_post(ctl + CW_BAR, MISC + 8);
#endif
    const int lo = p.ph_lo, hi = p.ph_hi;

    float* MOD = (float*)(p.ws + WS_MOD);
    float* X = (float*)(p.ws + WS_X);
    bf16* HN = (bf16*)(p.ws + WS_HN);
    bf16* ACT = (bf16*)(p.ws + WS_ACT);
    bf16* Z = (bf16*)(p.ws + WS_Z);
    bf16* MIX = (bf16*)(p.ws + WS_MIX);

    if (IN(0)) { p0_modvec(p, lds, tid, lane, wave); __syncthreads(); p0_weights(p, lds, lane, wave); __syncthreads(); }
    SEAM(0);

    layer_body<0>(p, lds, bar, lo, hi);
    layer_body<1>(p, lds, bar, lo, hi);
#undef IN
#undef SEAM
#undef GRID_BAR
}

extern "C" void kernel_launch(void* const* d_in, const int* in_sizes, int n_in, void* d_out, int out_size, void* d_ws, size_t ws_size, hipStream_t stream) {
    static int grid = 0;
    if (grid == 0) {
        if (n_in != 27 || in_sizes[0] != M_LAT * D || out_size != M_LAT * D || ws_size < WS_END) {
            fprintf(stderr, "kernel_launch: unexpected shapes (n_in %d, in0 %d, out %d, ws %zu; need ws >= %zu); nothing launched\n", n_in, n_in > 0 ? in_sizes[0] : -1, out_size, ws_size, (size_t)WS_END); grid = -1; return; }
        int dev = 0, cus = 0, per_cu = 0;
        if (hipGetDevice(&dev) != hipSuccess || hipDeviceGetAttribute(&cus, hipDeviceAttributeMultiprocessorCount, dev) != hipSuccess) { fprintf(stderr, "kernel_launch: device query failed\n"); grid = -1; return; }
        if (hipFuncSetAttribute((const void*)mega_fwd, hipFuncAttributeMaxDynamicSharedMemorySize, LDS_BYTES) != hipSuccess) { fprintf(stderr, "kernel_launch: hipFuncSetAttribute failed\n"); grid = -1; return; }
        if (hipOccupancyMaxActiveBlocksPerMultiprocessor(&per_cu, (const void*)mega_fwd, 512, LDS_BYTES) != hipSuccess || per_cu < 1) {
            fprintf(stderr, "kernel_launch: occupancy query reports %d workgroups per CU\n", per_cu); }
        (void)hipGetLastError();
        grid = cus;
    }
    if (grid < 0) return;
    if (hipMemsetAsync((char*)d_ws + WS_CTL, 0, CTL_ZERO_BYTES, stream) != hipSuccess) { fprintf(stderr, "kernel_launch: memset failed\n"); return; }
    Params a{};
    for (int i = 0; i < 27; ++i) a.in[i] = (const float*)d_in[i];
    a.out = (float*)d_out; a.ws = (unsigned char*)d_ws;
#if MK_SPLIT
    for (int ph = 0; ph < NPHASE; ++ph) { a.ph_lo = ph; a.ph_hi = ph + 1; hipLaunchKernelGGL(mega_fwd, dim3(grid), dim3(512), LDS_BYTES, stream, a); }
#else
    a.ph_lo = 0; a.ph_hi = NPHASE;
    hipLaunchKernelGGL(mega_fwd, dim3(grid), dim3(512), LDS_BYTES, stream, a);
#endif
    const hipError_t le = hipPeekAtLastError();
    if (le != hipSuccess) fprintf(stderr, "kernel_launch: launch failed: %s\n", hipGetErrorName(le));
}
```

```cpp
#include <hip/hip_runtime.h>
#include <cstdio>
#include <cstdint>

#ifndef MK_SPLIT
#define MK_SPLIT 0
#endif

namespace pg8 {
#define PG8_LAS __attribute__((address_space(3)))
typedef unsigned short bf16_t;
typedef short bf16x8 __attribute__((ext_vector_type(8)));
typedef float f32x4 __attribute__((ext_vector_type(4)));
typedef unsigned u32x4 __attribute__((ext_vector_type(4)));
typedef unsigned u32x2 __attribute__((ext_vector_type(2)));
constexpr int BM = 256, BK = 64, HALF = 128, HTB = HALF * BK * 2  , STAGE_BYTES = 8 * HTB, NXCD = 8, WGM = 8;

__host__ __device__ __forceinline__ int lds_byte(int r, int c) { const int st = (r >> 4) * 2 + (c >> 5), rr = r & 15, cc = c & 31, ob = rr * 64 + cc * 2; return st * 1024 + (ob ^ (((ob >> 9) & 1) << 5)); }
__host__ __device__ __forceinline__ void stage_rc(int b, int& R, int& C) { const int st = b / 1024, sb = b % 1024, swz = sb ^ (((sb >> 9) & 1) << 5); R = (st >> 1) * 16 + swz / 64; C = (st & 1) * 32 + (swz % 64) / 2; }
__host__ __device__ __forceinline__ int perm32(int rho) { const int n = rho >> 4, i = rho & 15; return 8 * (i >> 2) + 4 * n + (i & 3); }

struct Unit { int pm, pn, kind; };

__host__ __device__ __forceinline__ void tile_map(int wgid, int nM, int nN, int& pm, int& pn) {
    const int nwg = nM * nN;
    { const int q = nwg / NXCD, r = nwg % NXCD, xcd = wgid % NXCD, off = wgid / NXCD; wgid = (xcd < r ? xcd * (q + 1) : r * (q + 1) + (xcd - r) * q) + off; }
    const int nig = WGM * nN, gid = wgid / nig, fm = gid * WGM, gsz = (nM - fm) < WGM ? (nM - fm) : WGM;
    pm = fm + ((wgid % nig) % gsz); pn = (wgid % nig) / gsz;
}

__device__ __forceinline__ unsigned cvt_pk_bf16(float lo, float hi) { unsigned r; asm volatile("v_cvt_pk_bf16_f32 %0, %1, %2" : "=v"(r) : "v"(lo), "v"(hi)); return r; }

template <class Epi, class Sched, bool ALIGN_EPI = true, bool SP2 = true>
__device__ __forceinline__ void gemm_phase(PG8_LAS unsigned char* lds, const int K, const Sched& S, const Epi& E) {
    const int tid = threadIdx.x, wid = __builtin_amdgcn_readfirstlane(tid >> 6), lane = tid & 63, wr = wid >> 2, wc = wid & 3, fr = lane & 15, fq = lane >> 4;
    const int nt = K / BK;
    unsigned voffA[2], voffB[2];
#pragma unroll
    for (int i = 0; i < 2; ++i) { int R, C; stage_rc(tid * 16 + i * 8192, R, C); const int Rb = Epi::PERM ? ((R & ~31) + perm32(R & 31)) : R;
        voffA[i] = (unsigned)(R * K + C) * 2u; voffB[i] = (unsigned)(Rb * K + C) * 2u; }
    const size_t kstep = (size_t)(BK * 2);
    const size_t hstep = (size_t)HALF * K * 2;
    const unsigned ldsw = (unsigned)wid * 1024u;
    const int aoff = lds_byte(wr * 64 + fr, fq * 8), boff = lds_byte(wc * 32 + fr, fq * 8);
#define PG8_SA(b, h) (((b) * 2 + (h)) * HTB)
#define PG8_SB(b, h) ((4 + (b) * 2 + (h)) * HTB)
#define PG8_STAGE(bufoff, gbase, voff) do { _Pragma("unroll") for (int _i = 0; _i < 2; ++_i) \
        __builtin_amdgcn_global_load_lds((const unsigned*)((const char*)(gbase) + (voff)[_i]), (PG8_LAS unsigned*)(lds + (bufoff) + ldsw + _i * 8192), 16, 0, 0); } while (0)
#define PG8_LDA(dst, b, h) do { _Pragma("unroll") for (int m = 0; m < 4; ++m) _Pragma("unroll") for (int k = 0; k < 2; ++k) dst[m][k] = *(const PG8_LAS bf16x8*)(lds + PG8_SA(b, h) + aoff + m * 2048 + k * 1024); } while (0)
#define PG8_LDB(dst, b, h) do { _Pragma("unroll") for (int n = 0; n < 2; ++n) _Pragma("unroll") for (int k = 0; k < 2; ++k) dst[n][k] = *(const PG8_LAS bf16x8*)(lds + PG8_SB(b, h) + boff + n * 2048 + k * 1024); } while (0)
#define PG8_MMA(ai, bj, At, Bt) do { __builtin_amdgcn_s_setprio(1); _Pragma("unroll") for (int m = 0; m < 4; ++m) _Pragma("unroll") for (int n = 0; n < 2; ++n) _Pragma("unroll") for (int k = 0; k < 2; ++k) \
        acc[ai][bj][m][n] = __builtin_amdgcn_mfma_f32_16x16x32_bf16(Bt[n][k], At[m][k], acc[ai][bj][m][n], 0, 0, 0); __builtin_amdgcn_s_setprio(0); } while (0)
#define PG8_WAIT_V(n) asm volatile("s_waitcnt vmcnt(" #n ")" ::: "memory")
#define PG8_WAIT_L(n) asm volatile("s_waitcnt lgkmcnt(" #n ")" ::: "memory")
#define PG8_BAR __builtin_amdgcn_s_barrier()
#define PG8_SCHED __builtin_amdgcn_sched_barrier(0)
    Unit cur, nxt; int ui = 0;
    if (!S.next(0, cur)) return;
    f32x4 acc[2][2][4][2];
#pragma unroll
    for (int a = 0; a < 2; ++a)
#pragma unroll
        for (int b = 0; b < 2; ++b)
#pragma unroll
            for (int m = 0; m < 4; ++m)
#pragma unroll
                for (int n = 0; n < 2; ++n) acc[a][b][m][n] = (f32x4){0.f, 0.f, 0.f, 0.f};
    bf16x8 At[4][2], B0[2][2], B1[2][2];
    const char* cA = S.a_base(cur); const char* cB = S.b_base(cur);
    if constexpr (SP2) {
        PG8_STAGE(PG8_SB(0, 0), cB, voffB); PG8_STAGE(PG8_SB(0, 1), cB + hstep, voffB); PG8_STAGE(PG8_SA(0, 0), cA, voffA); PG8_STAGE(PG8_SA(0, 1), cA + hstep, voffA);
        if (wr == 1) PG8_BAR;
        PG8_WAIT_V(2); PG8_BAR;
        PG8_STAGE(PG8_SB(1, 0), cB + kstep, voffB); PG8_STAGE(PG8_SA(1, 0), cA + kstep, voffA); PG8_STAGE(PG8_SB(1, 1), cB + hstep + kstep, voffB);
        PG8_WAIT_V(6); PG8_BAR;
    } else {
        PG8_STAGE(PG8_SB(0, 0), cB, voffB); PG8_STAGE(PG8_SA(0, 0), cA, voffA); PG8_STAGE(PG8_SB(0, 1), cB + hstep, voffB); PG8_STAGE(PG8_SA(0, 1), cA + hstep, voffA);
        if (wr == 1) PG8_BAR;
        PG8_WAIT_V(4); PG8_BAR;
        PG8_STAGE(PG8_SB(1, 0), cB + kstep, voffB); PG8_STAGE(PG8_SA(1, 0), cA + kstep, voffA); PG8_STAGE(PG8_SB(1, 1), cB + hstep + kstep, voffB);
        PG8_WAIT_V(6); PG8_BAR;
    }
    for (;;) {
        const bool has_next = S.next(ui + 1, nxt);
        const char* nA = has_next ? S.a_base(nxt) : cA; const char* nB = has_next ? S.b_base(nxt) : cB;
        for (int t = 0; t < nt; t += 2) {
            const bool last = (t == nt - 2);
            const char* a1 = cA + (size_t)(t + 1) * kstep;
            const char* a2 = last ? nA : cA + (size_t)(t + 2) * kstep; const char* b2 = last ? nB : cB + (size_t)(t + 2) * kstep;
            const char* a3 = a2 + kstep; const char* b3 = b2 + kstep;
            if constexpr (SP2) {
            PG8_LDB(B0, 0, 0); PG8_LDB(B1, 0, 1); PG8_SCHED; PG8_LDA(At, 0, 0); PG8_STAGE(PG8_SA(1, 1), a1 + hstep, voffA);
            PG8_WAIT_V(8); PG8_WAIT_L(0); PG8_BAR; PG8_MMA(0, 0, At, B0); PG8_MMA(0, 1, At, B1); PG8_BAR; PG8_SCHED;
            PG8_LDA(At, 0, 1); PG8_STAGE(PG8_SB(0, 0), b2, voffB); PG8_STAGE(PG8_SB(0, 1), b2 + hstep, voffB); PG8_STAGE(PG8_SA(0, 0), a2, voffA);
            PG8_WAIT_V(8); PG8_WAIT_L(0); PG8_BAR; PG8_MMA(1, 0, At, B0); PG8_MMA(1, 1, At, B1); PG8_BAR; PG8_SCHED;
            PG8_LDB(B0, 1, 0); PG8_LDB(B1, 1, 1); PG8_SCHED; PG8_LDA(At, 1, 0); PG8_STAGE(PG8_SA(0, 1), a2 + hstep, voffA);
            PG8_WAIT_V(8); PG8_WAIT_L(0); PG8_BAR; PG8_MMA(0, 0, At, B0); PG8_MMA(0, 1, At, B1); PG8_BAR; PG8_SCHED;
            PG8_LDA(At, 1, 1); PG8_STAGE(PG8_SB(1, 0), b3, voffB); PG8_STAGE(PG8_SB(1, 1), b3 + hstep, voffB); PG8_STAGE(PG8_SA(1, 0), a3, voffA);
            PG8_WAIT_V(8); PG8_WAIT_L(0); PG8_BAR; PG8_MMA(1, 0, At, B0); PG8_MMA(1, 1, At, B1); PG8_BAR; PG8_SCHED;
            } else {
            PG8_LDB(B0, 0, 0); PG8_SCHED; PG8_LDA(At, 0, 0); PG8_STAGE(PG8_SA(1, 1), a1 + hstep, voffA);
            PG8_WAIT_L(8); PG8_BAR; PG8_WAIT_L(0); PG8_MMA(0, 0, At, B0); PG8_BAR; PG8_SCHED;
            PG8_LDB(B1, 0, 1); PG8_STAGE(PG8_SB(0, 0), b2, voffB);
            PG8_BAR; PG8_WAIT_L(0); PG8_MMA(0, 1, At, B1); PG8_BAR;
            PG8_LDA(At, 0, 1); PG8_STAGE(PG8_SA(0, 0), a2, voffA);
            PG8_BAR; PG8_WAIT_L(0); PG8_MMA(1, 0, At, B0); PG8_BAR; PG8_SCHED;
            PG8_STAGE(PG8_SB(0, 1), b2 + hstep, voffB);
            PG8_WAIT_V(6); PG8_BAR; PG8_MMA(1, 1, At, B1); PG8_BAR;
            PG8_LDB(B0, 1, 0); PG8_SCHED; PG8_LDA(At, 1, 0); PG8_STAGE(PG8_SA(0, 1), a2 + hstep, voffA);
            PG8_WAIT_L(8); PG8_BAR; PG8_WAIT_L(0); PG8_MMA(0, 0, At, B0); PG8_BAR; PG8_SCHED;
            PG8_LDB(B1, 1, 1); PG8_STAGE(PG8_SB(1, 0), b3, voffB);
            PG8_BAR; PG8_WAIT_L(0); PG8_MMA(0, 1, At, B1); PG8_BAR;
            PG8_LDA(At, 1, 1); PG8_STAGE(PG8_SA(1, 0), a3, voffA);
            PG8_BAR; PG8_WAIT_L(0); PG8_MMA(1, 0, At, B0); PG8_BAR; PG8_SCHED;
            PG8_STAGE(PG8_SB(1, 1), b3 + hstep, voffB);
            PG8_WAIT_V(6); PG8_BAR; PG8_MMA(1, 1, At, B1); PG8_BAR;
            }
        }
        if constexpr (ALIGN_EPI) { if (wr == 0) PG8_BAR; }
        E(acc, cur, wr, wc, fr, fq);
        if (!has_next) break;
#pragma unroll
        for (int a = 0; a < 2; ++a)
#pragma unroll
            for (int b = 0; b < 2; ++b)
#pragma unroll
                for (int m = 0; m < 4; ++m)
#pragma unroll
                    for (int n = 0; n < 2; ++n) acc[a][b][m][n] = (f32x4){0.f, 0.f, 0.f, 0.f};
        cur = nxt; cA = nA; cB = nB; ++ui;
        if constexpr (ALIGN_EPI) { if (wr == 1) PG8_BAR; }
    }
    PG8_WAIT_V(0);
    if constexpr (!ALIGN_EPI) { if (wr == 0) PG8_BAR; }
    PG8_BAR;
#undef PG8_SA
#undef PG8_SB
#undef PG8_STAGE
#undef PG8_LDA
#undef PG8_LDB
#undef PG8_MMA
#undef PG8_WAIT_V
#undef PG8_WAIT_L
#undef PG8_BAR
#undef PG8_SCHED
}
}

constexpr int D = 2048, NBATCH = 8, SEQ = 2048, CTXL = 256, DFF = 5632, NMODV = 9, DMODW = NMODV * D  ;
constexpr int M_LAT = NBATCH * SEQ  , M_CTX = NBATCH * CTXL  , M_ALL = M_LAT + M_CTX  ;
constexpr int NH = 16, HD = 64, GW = 64  , GROWS = SEQ / GW  , WIN_R = 8, WIN_C = 16;
constexpr int D_EIN = 5120, D_OIN = 5120, ZE_LD = 3072  , ZO_LD = 5120;
constexpr float EPS = 1e-6f;
constexpr int NPHASE = 21;

constexpr size_t MiB = 1u << 20;
constexpr size_t WS_CTL = 0, CTL_ZERO_BYTES = 1 * MiB;
constexpr size_t WS_MOD = 1 * MiB;
constexpr size_t WS_WFI = 4 * MiB, WFI_STRIDE = 44 * MiB;
constexpr size_t WS_WFO = 180 * MiB, WFO_STRIDE = 22 * MiB;
constexpr size_t WS_WEI = 268 * MiB, WS_WEO = 288 * MiB, WS_WOI = 296 * MiB, WS_WOO = 316 * MiB;
constexpr size_t WS_X = 324 * MiB;
constexpr size_t WS_HN = 468 * MiB;
constexpr size_t WS_ACT = 540 * MiB;
constexpr size_t WS_Z = 738 * MiB;
constexpr size_t WS_MIX = 918 * MiB;
constexpr size_t WS_VT = 990 * MiB;
constexpr size_t WS_HF = 1026 * MiB;
constexpr size_t WS_END = 1090 * MiB;
constexpr int CW_BAR = 4096;

constexpr int RING_BYTES = 131072;
constexpr int LDS_BYTES = 147456;
constexpr int MISC_OFF = LDS_BYTES - 256;

#define GAS __attribute__((address_space(1)))
#define LAS __attribute__((address_space(3)))
typedef unsigned short bf16;
typedef float f32x4 __attribute__((ext_vector_type(4)));
typedef float f32x2 __attribute__((ext_vector_type(2)));
typedef unsigned u32x4 __attribute__((ext_vector_type(4)));
typedef unsigned u32x2 __attribute__((ext_vector_type(2)));
typedef short bf16x8 __attribute__((ext_vector_type(8)));
#define LDS_WAIT() asm volatile("s_waitcnt lgkmcnt(0)" ::: "memory")
#define VM_WAIT() asm volatile("s_waitcnt vmcnt(0)" ::: "memory")
__device__ __forceinline__ unsigned f2bf(float f) { unsigned u = __builtin_bit_cast(unsigned, f); return (u + 0x7fffu + ((u >> 16) & 1u)) >> 16; }
__device__ __forceinline__ unsigned pk2(float lo, float hi) { return f2bf(lo) | (f2bf(hi) << 16); }
__device__ __forceinline__ float bf_lo(unsigned v) { return __builtin_bit_cast(float, v << 16); }
__device__ __forceinline__ float bf_hi(unsigned v) { return __builtin_bit_cast(float, v & 0xffff0000u); }
__device__ __forceinline__ float bf2f(bf16 v) { return __builtin_bit_cast(float, (unsigned)v << 16); }
__device__ __forceinline__ float fast_sigmoid(float x) { return __builtin_amdgcn_rcpf(1.0f + __builtin_amdgcn_exp2f(-1.44269504089f * x)); }
__device__ __forceinline__ float wave_sum(float v) {
#pragma unroll
    for (int o = 1; o < 64; o <<= 1) v += __shfl_xor(v, o);
    return v;
}

#define XB_TMO      128
#define XB_XCNT(j)  (256  + 64 * (j))
#define XB_XSUB(j)  (1280 + 64 * (j))
#define XB_XGEN(j)  (2304 + 64 * (j))
#define XB_TOP      3328
#define XB_TOPGEN   3392
#define XCD_BAR_WORDS 3456
#define XB_SPIN_CAP (1u << 18)

__device__ __forceinline__ unsigned xb_ld(unsigned* p)              { return __hip_atomic_load(p, __ATOMIC_RELAXED, __HIP_MEMORY_SCOPE_AGENT); }
__device__ __forceinline__ unsigned xb_add(unsigned* p, unsigned v) { return __hip_atomic_fetch_add(p, v, __ATOMIC_RELAXED, __HIP_MEMORY_SCOPE_AGENT); }
__device__ __forceinline__ unsigned xb_xcc_id() { return (unsigned)__builtin_amdgcn_s_getreg((3 << 11) | 20) & 0xFu; }
#define XB_SPIN(cond, bar) do { unsigned _sp = 0; while (cond) { __builtin_amdgcn_s_sleep(1); \
    if ((++_sp & 255u) == 0u) { if (xb_ld(&(bar)[XB_TMO])) break; if (_sp > XB_SPIN_CAP) { atomicAdd(&(bar)[XB_TMO], 1u); break; } } } } while (0)

struct XcdBarrier {
    unsigned* bar; unsigned x;
    volatile LAS unsigned* st;
};

__device__ __forceinline__ XcdBarrier xcd_barrier_post(unsigned* bar, volatile LAS unsigned* st) {
    XcdBarrier b; b.bar = bar; b.x = xb_xcc_id(); b.st = st;
    if (threadIdx.x == 0) (void)xb_add(&bar[XB_XCNT(b.x)], 1u);
    return b;
}
__device__ __forceinline__ void xcd_barrier_complete(unsigned* bar, unsigned x, unsigned& nloc, unsigned& nx) {
    const unsigned G = gridDim.x * gridDim.y * gridDim.z;
    unsigned sum, cnt, mine, sp = 0u;
    for (;;) {
        sum = 0u; cnt = 0u; mine = 0u;
#pragma unroll
        for (unsigned j = 0; j < 16; ++j) { const unsigned c = xb_ld(&bar[XB_XCNT(j)]); sum += c; cnt += (c > 0u) ? 1u : 0u; mine = (j == x) ? c : mine; }
        if (sum == G) break;
        __builtin_amdgcn_s_sleep(1);
        if ((++sp & 255u) == 0u) { if (xb_ld(&bar[XB_TMO])) break; if (sp > XB_SPIN_CAP) { atomicAdd(&bar[XB_TMO], 1u); break; } }
    }
    nloc = mine > 0u ? mine : 1u; nx = cnt > 0u ? cnt : 1u;
}

__device__ __forceinline__ void xcd_barrier(const XcdBarrier& b) {
    asm volatile("s_waitcnt vmcnt(0)" ::: "memory");
    __syncthreads();
    if (threadIdx.x == 0) {
        unsigned* bar = b.bar;
        __builtin_amdgcn_s_waitcnt(0);
        unsigned nloc = b.st[0], nx = b.st[1];
        if (nloc == 0u) { xcd_barrier_complete(bar, b.x, nloc, nx); b.st[0] = nloc; b.st[1] = nx; }
        const unsigned old = xb_add(&bar[XB_XSUB(b.x)], 1u);
        const unsigned gen = old / nloc;
        if (old + 1u == (gen + 1u) * nloc) {
            __builtin_amdgcn_fence(__ATOMIC_RELEASE, "agent");
            asm volatile("s_waitcnt vmcnt(0)" ::: "memory");
            const unsigned og = xb_add(&bar[XB_TOP], 1u);
            const unsigned tg = og / nx;
            if (og + 1u == (tg + 1u) * nx) xb_add(&bar[XB_TOPGEN], 1u);
            else XB_SPIN(xb_ld(&bar[XB_TOPGEN]) == tg, bar);
            __builtin_amdgcn_fence(__ATOMIC_ACQUIRE, "agent");
            xb_add(&bar[XB_XGEN(b.x)], 1u);
            asm volatile("s_waitcnt vmcnt(0)" ::: "memory");
        } else {
            XB_SPIN(xb_ld(&bar[XB_XGEN(b.x)]) == gen, bar);
            __builtin_amdgcn_fence(__ATOMIC_ACQUIRE, "agent");
            asm volatile("s_waitcnt vmcnt(0)" ::: "memory");
        }
    }
    __syncthreads();
}

struct Params {
    const float* in[27];
    float* out;
    unsigned char* ws;
    int ph_lo, ph_hi;
};
enum { IN_X = 0, IN_C, IN_CTX, IN_CCTX, IN_WMOD, IN_BMOD, IN_NORMG, IN_FWI, IN_FWO, IN_EWI, IN_SCW, IN_SCB, IN_CCW, IN_CCB, IN_LNG, IN_LNB, IN_EWO,
       IN_OWI, IN_QG, IN_KG, IN_RPB, IN_LCW, IN_LCB, IN_LGW, IN_LGB, IN_LAM, IN_OWO };

struct SchedStd {
    const char* A; const char* Bt; size_t tstep; int nM, nN, G, c;
    __device__ __forceinline__ bool next(int i, pg8::Unit& u) const {
        const long L = (long)i * G + c; if (L >= (long)nM * nN) return false;
        pg8::tile_map((int)L, nM, nN, u.pm, u.pn); u.kind = 0; return true;
    }
    __device__ __forceinline__ const char* a_base(const pg8::Unit& u) const { return A + (size_t)u.pm * tstep; }
    __device__ __forceinline__ const char* b_base(const pg8::Unit& u) const { return Bt + (size_t)u.pn * tstep; }
};
struct SchedOdIn {
    const char* HN; const char* W; size_t tstep; int G, c;
    __device__ __forceinline__ bool next(int i, pg8::Unit& u) const {
        const long L = (long)i * G + c;
        if (L < 72 * 16) { int pm, pnv; pg8::tile_map((int)L, 72, 16, pm, pnv); u.pm = pm; u.pn = pnv < 8 ? pnv : pnv + 4; u.kind = 0; return true; }
        if (L < 72 * 16 + 4 * 72) { int pm, pn; pg8::tile_map((int)L - 72 * 16, 4, 72, pm, pn); u.pm = pm; u.pn = pn; u.kind = 1; return true; }
        return false;
    }
    __device__ __forceinline__ const char* a_base(const pg8::Unit& u) const { return u.kind == 0 ? HN + (size_t)u.pm * tstep : W + (size_t)(8 + u.pm) * tstep; }
    __device__ __forceinline__ const char* b_base(const pg8::Unit& u) const { return u.kind == 0 ? W + (size_t)u.pn * tstep : HN + (size_t)u.pn * tstep; }
};

struct EpiSwiGLU {
    static constexpr bool PERM = true;
    bf16* O;
    __device__ __forceinline__ void operator()(const f32x4 (&acc)[2][2][4][2], const pg8::Unit& u, int wr, int wc, int fr, int fq) const {
        const int row0 = u.pm * 256 + wr * 64 + fr, col0 = u.pn * 128 + wc * 32 + 8 * fq;
#pragma unroll
        for (int ai = 0; ai < 2; ++ai)
#pragma unroll
            for (int m = 0; m < 4; ++m) {
                bf16* rowp = O + (size_t)(row0 + ai * 128 + m * 16) * DFF + col0;
                float v[8];
#pragma unroll
                for (int n = 0; n < 2; ++n)
#pragma unroll
                    for (int j = 0; j < 4; ++j) { const float g = acc[ai][0][m][n][j], up = acc[ai][1][m][n][j]; v[4 * n + j] = g * fast_sigmoid(g) * up; }
                u32x4 w; w.x = pg8::cvt_pk_bf16(v[0], v[1]); w.y = pg8::cvt_pk_bf16(v[2], v[3]); w.z = pg8::cvt_pk_bf16(v[4], v[5]); w.w = pg8::cvt_pk_bf16(v[6], v[7]);
                *(u32x4*)rowp = w;
            }
    }
};
struct EpiResid {
    static constexpr bool PERM = false;
    const float* base_lat; const float* base_ctx; float* out; const float* gate; float coef;
    __device__ __forceinline__ void operator()(const f32x4 (&acc)[2][2][4][2], const pg8::Unit& u, int wr, int wc, int fr, int fq) const {
        const int row0 = u.pm * 256 + wr * 64 + fr, col0 = u.pn * 256 + wc * 32 + 4 * fq;
        const int r = u.pm < 64 ? (u.pm >> 3) : 8;
        const float* gv = gate + (size_t)r * DMODW + col0;
        const float* bp = u.pm < 64 ? base_lat + (size_t)row0 * D + col0 : base_ctx + (size_t)(row0 - M_LAT) * D + col0;
        float* op = out + (size_t)row0 * D + col0;
        f32x4 gvv[2][2];
#pragma unroll
        for (int bj = 0; bj < 2; ++bj)
#pragma unroll
            for (int n = 0; n < 2; ++n) gvv[bj][n] = *(const f32x4*)(gv + bj * 128 + n * 16) * coef;
#pragma unroll
        for (int ai = 0; ai < 2; ++ai)
#pragma unroll
            for (int m = 0; m < 4; ++m) {
                const size_t ro = (size_t)(ai * 128 + m * 16) * D;
#pragma unroll
                for (int bj = 0; bj < 2; ++bj)
#pragma unroll
                    for (int n = 0; n < 2; ++n) { const f32x4 b = *(const f32x4*)(bp + ro + bj * 128 + n * 16); *(f32x4*)(op + ro + bj * 128 + n * 16) = b + gvv[bj][n] * acc[ai][bj][m][n]; }
                asm volatile("" ::: "memory");
            }
    }
};
struct EpiEvIn {
    static constexpr bool PERM = true;
    bf16* O;
    __device__ __forceinline__ void operator()(const f32x4 (&acc)[2][2][4][2], const pg8::Unit& u, int wr, int wc, int fr, int fq) const {
        const int row0 = u.pm * 256 + wr * 64 + fr;
        if (u.pn < 4) {
            const int col0 = u.pn * 256 + wc * 32 + 8 * fq;
#pragma unroll
            for (int ai = 0; ai < 2; ++ai)
#pragma unroll
                for (int m = 0; m < 4; ++m) { bf16* rowp = O + (size_t)(row0 + ai * 128 + m * 16) * ZE_LD + col0;
#pragma unroll
                    for (int bj = 0; bj < 2; ++bj) { const f32x4 v0 = acc[ai][bj][m][0], v1 = acc[ai][bj][m][1];
                        u32x4 w; w.x = pg8::cvt_pk_bf16(v0[0], v0[1]); w.y = pg8::cvt_pk_bf16(v0[2], v0[3]); w.z = pg8::cvt_pk_bf16(v1[0], v1[1]); w.w = pg8::cvt_pk_bf16(v1[2], v1[3]);
                        *(u32x4*)(rowp + bj * 128) = w; } }
        } else {
            const bool glu = u.pn >= 12;
            const int col0 = (glu ? 2048 + (u.pn - 12) * 128 : 1024 + (u.pn - 4) * 128) + wc * 32 + 8 * fq;
#pragma unroll
            for (int ai = 0; ai < 2; ++ai)
#pragma unroll
                for (int m = 0; m < 4; ++m) { bf16* rowp = O + (size_t)(row0 + ai * 128 + m * 16) * ZE_LD + col0;
                    float v[8];
#pragma unroll
                    for (int n = 0; n < 2; ++n)
#pragma unroll
                        for (int j = 0; j < 4; ++j) { const float a = acc[ai][0][m][n][j], b = acc[ai][1][m][n][j]; v[4 * n + j] = glu ? a * fast_sigmoid(b) : a * b; }
                    u32x4 w; w.x = pg8::cvt_pk_bf16(v[0], v[1]); w.y = pg8::cvt_pk_bf16(v[2], v[3]); w.z = pg8::cvt_pk_bf16(v[4], v[5]); w.w = pg8::cvt_pk_bf16(v[6], v[7]);
                    *(u32x4*)rowp = w; }
        }
    }
};
struct EpiOdIn {
    static constexpr bool PERM = true;
    bf16* ZO; bf16* VT;
    __device__ __forceinline__ void operator()(const f32x4 (&acc)[2][2][4][2], const pg8::Unit& u, int wr, int wc, int fr, int fq) const {
        const int row0 = u.pm * 256 + wr * 64 + fr, col0 = u.pn * 256 + wc * 32 + 8 * fq;
        bf16* base = u.kind == 0 ? ZO : VT; const size_t ld = u.kind == 0 ? (size_t)ZO_LD : (size_t)M_ALL;
#pragma unroll
        for (int ai = 0; ai < 2; ++ai)
#pragma unroll
            for (int m = 0; m < 4; ++m) { bf16* rowp = base + (size_t)(row0 + ai * 128 + m * 16) * ld + col0;
#pragma unroll
                for (int bj = 0; bj < 2; ++bj) { const f32x4 v0 = acc[ai][bj][m][0], v1 = acc[ai][bj][m][1];
                    u32x4 w; w.x = pg8::cvt_pk_bf16(v0[0], v0[1]); w.y = pg8::cvt_pk_bf16(v0[2], v0[3]); w.z = pg8::cvt_pk_bf16(v1[0], v1[1]); w.w = pg8::cvt_pk_bf16(v1[2], v1[3]);
                    *(u32x4*)(rowp + bj * 128) = w; } }
    }
};

__device__ __forceinline__ void p0_modvec(const Params& p, LAS unsigned char* lds, int tid, int lane, int wave) {
    LAS float* sv = (LAS float*)lds;
    LAS float* red = (LAS float*)(lds + 9 * 2048 * 4);
    const float* c = p.in[IN_C]; const float* cc = p.in[IN_CCTX];
    for (int i = tid; i < 9 * 2048; i += 512) { const float v = i < 8 * 2048 ? c[i] : cc[i - 8 * 2048]; sv[i] = v / (1.0f + __expf(-v)); }
    __syncthreads();
    float* MOD = (float*)(p.ws + WS_MOD);
    for (int item = blockIdx.x; item < 2 * 288; item += gridDim.x) {
        const int l = item / 288, col0 = (item % 288) * 64;
        const float* W = p.in[IN_WMOD] + (size_t)l * D * DMODW + col0 + lane;
        float acc[9];
#pragma unroll
        for (int r = 0; r < 9; ++r) acc[r] = 0.f;
        const int kb = wave * 256;
#pragma unroll 2
        for (int k4 = 0; k4 < 64; ++k4) {
            const int k = kb + 4 * k4;
            const float w0 = W[(size_t)(k + 0) * DMODW], w1 = W[(size_t)(k + 1) * DMODW], w2 = W[(size_t)(k + 2) * DMODW], w3 = W[(size_t)(k + 3) * DMODW];
#pragma unroll
            for (int r = 0; r < 9; ++r) { const f32x4 s = *(const LAS f32x4*)(sv + r * 2048 + k); acc[r] += s[0] * w0 + s[1] * w1 + s[2] * w2 + s[3] * w3; }
        }
#pragma unroll
        for (int r = 0; r < 9; ++r) red[(wave * 9 + r) * 64 + lane] = acc[r];
        __syncthreads();
        for (int o = tid; o < 9 * 64; o += 512) {
            const int r = o >> 6, ln = o & 63; float s = 0.f;
#pragma unroll
            for (int w = 0; w < 8; ++w) s += red[(w * 9 + r) * 64 + ln];
            MOD[((size_t)l * 9 + r) * DMODW + col0 + ln] = s + p.in[IN_BMOD][(size_t)l * DMODW + col0 + ln];
        }
        __syncthreads();
    }
}
__device__ __forceinline__ int srccol(int map, int n) {
    if (map == 0) return n;
    const int pn = n >> 8, bj = (n >> 7) & 1, i = n & 127;
    if (map == 1) return bj * DFF + 128 * pn + i;
    if (pn < 4) return n;
    if (pn < 12) return 1024 + bj * 1024 + 128 * (pn - 4) + i;
    return 3072 + bj * 1024 + 128 * (pn - 12) + i;
}
__device__ __forceinline__ void p0_transpose_item(const float* W, int K, int N, bf16* WT, int map, LAS float* scr, int item, int lane) {
    const int nblk = N / 64, kb = item / nblk, nb = item % nblk, k0 = 64 * kb, n0 = 64 * nb, s0 = srccol(map, n0);
    const float* src = W + (size_t)k0 * N + s0 + lane;
#pragma unroll 16
    for (int i = 0; i < 64; ++i) scr[i * 65 + lane] = src[(size_t)i * N];
    LDS_WAIT(); asm volatile("" ::: "memory");
    const int c = lane & 7;
#pragma unroll
    for (int j = 0; j < 8; ++j) { const int n = (lane >> 3) + 8 * j; const LAS float* s = scr + (8 * c) * 65 + n;
        u32x4 o; o.x = pk2(s[0 * 65], s[1 * 65]); o.y = pk2(s[2 * 65], s[3 * 65]); o.z = pk2(s[4 * 65], s[5 * 65]); o.w = pk2(s[6 * 65], s[7 * 65]);
        *(u32x4*)(WT + (size_t)(n0 + n) * K + k0 + 8 * c) = o; }
    LDS_WAIT(); asm volatile("" ::: "memory");
}
__device__ __forceinline__ void p0_weights(const Params& p, LAS unsigned char* lds, int lane, int wave) {
    LAS float* scr = (LAS float*)(lds + wave * (64 * 65 * 4));
    const int gw = blockIdx.x * 8 + wave, NGW = gridDim.x * 8;
    constexpr int I_FI = (D / 64) * (2 * DFF / 64), I_FO = (DFF / 64) * (D / 64), I_IN = (D / 64) * (D_EIN / 64), I_OUT = (D / 64) * (D / 64);
    constexpr int NITEMS = 4 * I_FI + 4 * I_FO + 2 * I_IN + 2 * I_OUT;
    for (int it = gw; it < NITEMS; it += NGW) {
        int r = it;
        if (r < 4 * I_FI) { const int q = r / I_FI; p0_transpose_item(p.in[IN_FWI] + (size_t)q * D * 2 * DFF, D, 2 * DFF, (bf16*)(p.ws + WS_WFI + q * WFI_STRIDE), 1, scr, r % I_FI, lane); continue; } r -= 4 * I_FI;
        if (r < 4 * I_FO) { const int q = r / I_FO; p0_transpose_item(p.in[IN_FWO] + (size_t)q * DFF * D, DFF, D, (bf16*)(p.ws + WS_WFO + q * WFO_STRIDE), 0, scr, r % I_FO, lane); continue; } r -= 4 * I_FO;
        if (r < I_IN) { p0_transpose_item(p.in[IN_EWI], D, D_EIN, (bf16*)(p.ws + WS_WEI), 2, scr, r, lane); continue; } r -= I_IN;
        if (r < I_IN) { p0_transpose_item(p.in[IN_OWI], D, D_OIN, (bf16*)(p.ws + WS_WOI), 0, scr, r, lane); continue; } r -= I_IN;
        if (r < I_OUT) { p0_transpose_item(p.in[IN_EWO], D, D, (bf16*)(p.ws + WS_WEO), 0, scr, r, lane); continue; } r -= I_OUT;
        p0_transpose_item(p.in[IN_OWO], D, D, (bf16*)(p.ws + WS_WOO), 0, scr, r, lane);
    }
}

__device__ __forceinline__ void norm_phase(const float* src_lat, const float* src_ctx, int nrows, const float* g, const float* modl, int shift_idx, int scale_idx, bf16* HN, int lane, int wave) {
    const int gw = blockIdx.x * 8 + wave, NGW = gridDim.x * 8;
    for (int row = gw; row < nrows; row += NGW) {
        const float* xr = row < M_LAT ? src_lat + (size_t)row * D : src_ctx + (size_t)(row - M_LAT) * D;
        const int r = row < M_LAT ? (row >> 11) : 8;
        const float* sh = modl + (size_t)r * DMODW + shift_idx * D; const float* sc = modl + (size_t)r * DMODW + scale_idx * D;
        f32x4 v[8]; float ss = 0.f;
#pragma unroll
        for (int j = 0; j < 8; ++j) { v[j] = *(const f32x4*)(xr + 4 * lane + 256 * j); ss += (v[j][0] * v[j][0] + v[j][1] * v[j][1]) + (v[j][2] * v[j][2] + v[j][3] * v[j][3]); }
        const float rstd = 1.0f / sqrtf(wave_sum(ss) * (1.0f / D) + EPS);
        bf16* o = HN + (size_t)row * D;
#pragma unroll
        for (int j = 0; j < 8; ++j) { const int c = 4 * lane + 256 * j; const f32x4 gg = *(const f32x4*)(g + c), s1 = *(const f32x4*)(sc + c), s0 = *(const f32x4*)(sh + c);
            const f32x4 y = (v[j] * rstd) * gg * (1.0f + s1) + s0;
            u32x2 w; w.x = pk2(y[0], y[1]); w.y = pk2(y[2], y[3]); *(u32x2*)(o + c) = w; }
    }
}

__device__ __forceinline__ void even_conv_phase(const Params& p, LAS unsigned char* lds, int tid, int lane, int wave) {
    const bf16* Z3 = (const bf16*)(p.ws + WS_Z); bf16* MIX = (bf16*)(p.ws + WS_MIX);
    LAS unsigned* tile = (LAS unsigned*)lds;
    LAS float* red = (LAS float*)(lds + 62 * 2048);
    LAS float* stat = red + 256;
    const float* ccw = p.in[IN_CCW]; const float* ccb = p.in[IN_CCB]; const float* lng = p.in[IN_LNG]; const float* lnb = p.in[IN_LNB];
    const float* scw = p.in[IN_SCW]; const float* scb = p.in[IN_SCB];
    for (int u = blockIdx.x; u < 576; u += gridDim.x) {
        int base, T, t0;
        if (u < 512) { base = (u >> 6) * SEQ; T = SEQ; t0 = (u & 63) * 32; } else { const int v = u - 512; base = M_LAT + (v >> 3) * CTXL; T = CTXL; t0 = (v & 7) * 32; }
        for (int ch = tid; ch < 62 * 128; ch += 512) {
            const int rr = ch >> 7, cc = ch & 127, t = t0 - 15 + rr;
            u32x4 v = (u32x4){0u, 0u, 0u, 0u};
            if (t >= 0 && t < T) v = *(const u32x4*)(Z3 + (size_t)(base + t) * ZE_LD + 2048 + cc * 8);
            *(LAS u32x4*)(tile + rr * 512 + cc * 4) = v;
        }
        __syncthreads();
        float acc[32][2];
#pragma unroll
        for (int i = 0; i < 32; ++i) { acc[i][0] = 0.f; acc[i][1] = 0.f; }
        for (int k = 0; k < 31; ++k) {
            const f32x2 w = *(const f32x2*)(ccw + (size_t)k * 1024 + 2 * tid);
            const LAS unsigned* tp = tile + k * 512 + tid;
#pragma unroll
            for (int i = 0; i < 32; ++i) { const unsigned v = tp[i * 512]; acc[i][0] += w[0] * bf_lo(v); acc[i][1] += w[1] * bf_hi(v); }
        }
        { const f32x2 b = *(const f32x2*)(ccb + 2 * tid);
#pragma unroll
          for (int i = 0; i < 32; ++i) { acc[i][0] += b[0]; acc[i][1] += b[1]; } }
#pragma unroll
        for (int i = 0; i < 32; ++i) { const float s = wave_sum(acc[i][0] + acc[i][1]); if (lane == 0) red[wave * 32 + i] = s; }
        __syncthreads();
        if (tid < 32) { float s = 0.f;
#pragma unroll
            for (int w = 0; w < 8; ++w) s += red[w * 32 + tid]; stat[tid] = s * (1.0f / 1024.0f); }
        __syncthreads();
#pragma unroll
        for (int i = 0; i < 32; ++i) { const float mu = stat[i]; acc[i][0] -= mu; acc[i][1] -= mu; }
        __syncthreads();
#pragma unroll
        for (int i = 0; i < 32; ++i) { const float s = wave_sum(acc[i][0] * acc[i][0] + acc[i][1] * acc[i][1]); if (lane == 0) red[wave * 32 + i] = s; }
        __syncthreads();
        if (tid < 32) { float s = 0.f;
#pragma unroll
            for (int w = 0; w < 8; ++w) s += red[w * 32 + tid]; stat[tid] = 1.0f / sqrtf(s * (1.0f / 1024.0f) + EPS); }
        __syncthreads();
        { const f32x2 g = *(const f32x2*)(lng + 2 * tid), b = *(const f32x2*)(lnb + 2 * tid);
#pragma unroll
          for (int i = 0; i < 32; ++i) { const float rs = stat[i]; const float y0 = acc[i][0] * rs * g[0] + b[0], y1 = acc[i][1] * rs * g[1] + b[1];
              const float o0 = y0 / (1.0f + __expf(-y0)), o1 = y1 / (1.0f + __expf(-y1));
              *(unsigned*)(MIX + (size_t)(base + t0 + i) * D + 1024 + 2 * tid) = pk2(o0, o1); } }
        { const f32x2 w0 = *(const f32x2*)(scw + 2 * tid), w1 = *(const f32x2*)(scw + 1024 + 2 * tid), w2 = *(const f32x2*)(scw + 2048 + 2 * tid), b = *(const f32x2*)(scb + 2 * tid);
          unsigned pv[34];
#pragma unroll
          for (int i = 0; i < 34; ++i) { const int t = t0 - 1 + i; pv[i] = (t >= 0 && t < T) ? *(const unsigned*)(Z3 + (size_t)(base + t) * ZE_LD + 1024 + 2 * tid) : 0u; }
#pragma unroll
          for (int i = 0; i < 32; ++i) { const unsigned bg = *(const unsigned*)(Z3 + (size_t)(base + t0 + i) * ZE_LD + 2 * tid);
              const float c0 = w0[0] * bf_lo(pv[i]) + w1[0] * bf_lo(pv[i + 1]) + w2[0] * bf_lo(pv[i + 2]) + b[0];
              const float c1 = w0[1] * bf_hi(pv[i]) + w1[1] * bf_hi(pv[i + 1]) + w2[1] * bf_hi(pv[i + 2]) + b[1];
              *(unsigned*)(MIX + (size_t)(base + t0 + i) * D + 2 * tid) = pk2(bf_lo(bg) * c0, bf_hi(bg) * c1); } }
        __syncthreads();
    }
}

__device__ __forceinline__ void attn_wave_unit(const Params& p, int b, int h, int r, int qg, int lane) {
    const bf16* ZO = (const bf16*)(p.ws + WS_Z); const bf16* VT = (const bf16*)(p.ws + WS_VT); bf16* MIX = (bf16*)(p.ws + WS_MIX);
    const float* qgain = p.in[IN_QG]; const float* kgain = p.in[IN_KG]; const float* rpb = p.in[IN_RPB] + (size_t)h * 15 * 31;
    const int l15 = lane & 15, g = lane >> 4;
    const int c0 = 16 * qg, qc = c0 + l15, qrow = b * SEQ + r * GW + qc;
    const int r0 = min(max(r - WIN_R / 2, 0), GROWS - WIN_R);
    const int kb = qg == 0 ? 0 : (qg == 1 ? 8 : (qg == 2 ? 24 : 32));
    const int cs = min(max(qc - WIN_C / 2, 0), GW - WIN_C);
    float kg[16];
    bf16x8 qf[2];
    {
        float qv[16]; float ss = 0.f;
#pragma unroll
        for (int kk = 0; kk < 2; ++kk) { const u32x4 raw = *(const u32x4*)(ZO + (size_t)qrow * ZO_LD + h * HD + 8 * g + 32 * kk);
#pragma unroll
            for (int e = 0; e < 4; ++e) { qv[8 * kk + 2 * e] = bf_lo(raw[e]); qv[8 * kk + 2 * e + 1] = bf_hi(raw[e]); } }
#pragma unroll
        for (int e = 0; e < 16; ++e) ss += qv[e] * qv[e];
        ss += __shfl_xor(ss, 16); ss += __shfl_xor(ss, 32);
        const float rs = 0.125f / sqrtf(ss * (1.0f / HD) + EPS);
#pragma unroll
        for (int kk = 0; kk < 2; ++kk) {
            const f32x4 g0 = *(const f32x4*)(qgain + 8 * g + 32 * kk), g1 = *(const f32x4*)(qgain + 8 * g + 32 * kk + 4);
            const f32x4 k0 = *(const f32x4*)(kgain + 8 * g + 32 * kk), k1 = *(const f32x4*)(kgain + 8 * g + 32 * kk + 4);
#pragma unroll
            for (int e = 0; e < 4; ++e) { kg[8 * kk + e] = k0[e]; kg[8 * kk + 4 + e] = k1[e]; }
            u32x4 w;
            w.x = pk2(qv[8 * kk + 0] * rs * g0[0], qv[8 * kk + 1] * rs * g0[1]); w.y = pk2(qv[8 * kk + 2] * rs * g0[2], qv[8 * kk + 3] * rs * g0[3]);
            w.z = pk2(qv[8 * kk + 4] * rs * g1[0], qv[8 * kk + 5] * rs * g1[1]); w.w = pk2(qv[8 * kk + 6] * rs * g1[2], qv[8 * kk + 7] * rs * g1[3]);
            qf[kk] = __builtin_bit_cast(bf16x8, w);
        }
    }
    f32x4 o[4];
#pragma unroll
    for (int d = 0; d < 4; ++d) o[d] = (f32x4){0.f, 0.f, 0.f, 0.f};
    float mrun = -1e30f, lsum = 0.f;
    const bf16* vbase = VT + (size_t)(h * HD + l15) * M_ALL + 4 * g;
    for (int ch = 0; ch < 16; ++ch) {
        const bool loc = ch >= 8;
        const int tok0 = loc ? b * SEQ + (r0 + (ch - 8)) * GW + kb : M_LAT + b * CTXL + 32 * ch;
        f32x4 s[2];
#pragma unroll
        for (int a = 0; a < 2; ++a) {
            const bf16* kp = ZO + (size_t)(tok0 + 16 * a + l15) * ZO_LD + 1024 + h * HD + 8 * g;
            const u32x4 r0v = *(const u32x4*)kp, r1v = *(const u32x4*)(kp + 32);
            float kv[16];
#pragma unroll
            for (int e = 0; e < 4; ++e) { kv[2 * e] = bf_lo(r0v[e]); kv[2 * e + 1] = bf_hi(r0v[e]); kv[8 + 2 * e] = bf_lo(r1v[e]); kv[8 + 2 * e + 1] = bf_hi(r1v[e]); }
            float ss = 0.f;
#pragma unroll
            for (int e = 0; e < 16; ++e) ss += kv[e] * kv[e];
            ss += __shfl_xor(ss, 16); ss += __shfl_xor(ss, 32);
            const float rs = 1.0f / sqrtf(ss * (1.0f / HD) + EPS);
            u32x4 w0, w1;
            w0.x = pk2(kv[0] * rs * kg[0], kv[1] * rs * kg[1]); w0.y = pk2(kv[2] * rs * kg[2], kv[3] * rs * kg[3]); w0.z = pk2(kv[4] * rs * kg[4], kv[5] * rs * kg[5]); w0.w = pk2(kv[6] * rs * kg[6], kv[7] * rs * kg[7]);
            w1.x = pk2(kv[8] * rs * kg[8], kv[9] * rs * kg[9]); w1.y = pk2(kv[10] * rs * kg[10], kv[11] * rs * kg[11]); w1.z = pk2(kv[12] * rs * kg[12], kv[13] * rs * kg[13]); w1.w = pk2(kv[14] * rs * kg[14], kv[15] * rs * kg[15]);
            f32x4 acc = (f32x4){0.f, 0.f, 0.f, 0.f};
            acc = __builtin_amdgcn_mfma_f32_16x16x32_bf16(__builtin_bit_cast(bf16x8, w0), qf[0], acc, 0, 0, 0);
            acc = __builtin_amdgcn_mfma_f32_16x16x32_bf16(__builtin_bit_cast(bf16x8, w1), qf[1], acc, 0, 0, 0);
            s[a] = acc;
        }
        if (loc) {
            const int drow = (r0 + (ch - 8)) - r + WIN_R - 1;
            const float* bp = rpb + drow * 31;
#pragma unroll
            for (int a = 0; a < 2; ++a)
#pragma unroll
                for (int e = 0; e < 4; ++e) { const int kc = kb + 16 * a + 4 * g + e; const bool ok = (kc >= cs) && (kc < cs + WIN_C);
                    const int dc = min(max(kc - qc + WIN_C - 1, 0), 2 * WIN_C - 2);
                    s[a][e] = ok ? s[a][e] + bp[dc] : -1e30f; }
        }
        float mx = fmaxf(fmaxf(fmaxf(s[0][0], s[0][1]), fmaxf(s[0][2], s[0][3])), fmaxf(fmaxf(s[1][0], s[1][1]), fmaxf(s[1][2], s[1][3])));
        mx = fmaxf(mx, __shfl_xor(mx, 16)); mx = fmaxf(mx, __shfl_xor(mx, 32));
        const float mnew = fmaxf(mrun, mx), alpha = __expf(mrun - mnew);
        mrun = mnew;
        float pe[8]; float ps = 0.f;
#pragma unroll
        for (int a = 0; a < 2; ++a)
#pragma unroll
            for (int e = 0; e < 4; ++e) { pe[4 * a + e] = __expf(s[a][e] - mnew); ps += pe[4 * a + e]; }
        lsum = lsum * alpha + ps;
        u32x4 pw; pw.x = pk2(pe[0], pe[1]); pw.y = pk2(pe[2], pe[3]); pw.z = pk2(pe[4], pe[5]); pw.w = pk2(pe[6], pe[7]);
        const bf16x8 pf = __builtin_bit_cast(bf16x8, pw);
#pragma unroll
        for (int d = 0; d < 4; ++d) {
            const bf16* vp = vbase + (size_t)(16 * d) * M_ALL + tok0;
            const u32x2 v0 = *(const u32x2*)vp, v1 = *(const u32x2*)(vp + 16);
            u32x4 vw; vw.x = v0.x; vw.y = v0.y; vw.z = v1.x; vw.w = v1.y;
            o[d] = o[d] * alpha;
            o[d] = __builtin_amdgcn_mfma_f32_16x16x32_bf16(__builtin_bit_cast(bf16x8, vw), pf, o[d], 0, 0, 0);
        }
    }
    lsum += __shfl_xor(lsum, 16); lsum += __shfl_xor(lsum, 32);
    const float inv = 1.0f / lsum;
#pragma unroll
    for (int d = 0; d < 4; ++d) { u32x2 w; w.x = pk2(o[d][0] * inv, o[d][1] * inv); w.y = pk2(o[d][2] * inv, o[d][3] * inv);
        *(u32x2*)(MIX + (size_t)qrow * D + h * HD + 16 * d + 4 * g) = w; }
}
__device__ __forceinline__ void attn_phase(const Params& p, int lane, int wave) {
    const int cls = blockIdx.x & 7, wgi = blockIdx.x >> 3, ncl = (gridDim.x - cls + 7) >> 3, nW = ncl * 8;
    if (gridDim.x >= 8) {
        for (int v = wgi * 8 + wave; v < NH * GROWS * 4; v += nW) { const int h = v >> 7, rem = v & 127; attn_wave_unit(p, cls, h, rem >> 2, rem & 3, lane); }
    } else {
        for (int v = blockIdx.x * 8 + wave; v < NBATCH * NH * GROWS * 4; v += gridDim.x * 8) { const int b = v >> 11, w = v & 2047, h = w >> 7, rem = w & 127; attn_wave_unit(p, b, h, rem >> 2, rem & 3, lane); }
    }
}

__device__ __forceinline__ float gelu_tanh(float x) { const float z = 0.7978845608028654f * (x + 0.044715f * x * x * x); return x / (1.0f + __expf(-2.0f * z)); }
__device__ __forceinline__ void lru_item(const Params& p, LAS unsigned char* lds, int item, int tid, int lane, int wave) {
    const bf16* ZO = (const bf16*)(p.ws + WS_Z); float* HF = (float*)(p.ws + WS_HF); bf16* MIX = (bf16*)(p.ws + WS_MIX);
    const int b = item >> 5, n = (item >> 1) & 15, half = item & 1, j0 = half * 32;
    LAS float* xcf = (LAS float*)lds;
    LAS bf16* xcb = (LAS bf16*)(lds + 64 * 65 * 4);
    LAS float* As = (LAS float*)(lds + 64 * 65 * 4 + 64 * 72 * 2);
    LAS float* Us = As + 64 * 33;
    LAS float* segA = Us + 64 * 33;
    LAS float* segH = segA + 16 * 32;
    const int ci = tid & 63, tq = tid >> 6, cch = n * 64 + ci;
    const float* lcw = p.in[IN_LCW]; const float cw0 = lcw[cch], cw1 = lcw[1024 + cch], cw2 = lcw[2048 + cch], cw3 = lcw[3072 + cch], cb = p.in[IN_LCB][cch];
    const int jb = wave & 1, tb = wave >> 1, l15 = lane & 15, g = lane >> 4, jl = 16 * jb + l15, gch = n * 64 + j0 + jl;
    const int sc = tid & 31, sg = tid >> 5, och = n * 64 + j0 + sc;
    for (int dir = 0; dir < 2; ++dir) {
        bf16x8 Bg[2][2];
        {
            const float* gw = p.in[IN_LGW] + (size_t)((dir * 2) * 16 + n) * 4096;
#pragma unroll
            for (int gt = 0; gt < 2; ++gt)
#pragma unroll
                for (int kk = 0; kk < 2; ++kk) { const float* wp = gw + (size_t)gt * 16 * 4096 + (size_t)(8 * g + 32 * kk) * 64 + j0 + jl;
                    u32x4 w; w.x = pk2(wp[0], wp[64]); w.y = pk2(wp[128], wp[192]); w.z = pk2(wp[256], wp[320]); w.w = pk2(wp[384], wp[448]); Bg[gt][kk] = __builtin_bit_cast(bf16x8, w); }
        }
        const float br = p.in[IN_LGB][(dir * 2 + 0) * 1024 + gch], bi = p.in[IN_LGB][(dir * 2 + 1) * 1024 + gch];
        const float lam = p.in[IN_LAM][dir * 1024 + gch];
        const float sp8 = -8.0f * log1pf(expf(-lam));
        float carry = 0.f;
        for (int cidx = 0; cidx < 36; ++cidx) {
            const bool isctx = cidx < 4;
            const int cc = isctx ? cidx : cidx - 4, ncs = isctx ? 4 : 32, cpos = dir == 0 ? cc : ncs - 1 - cc;
            const int base = isctx ? M_LAT + b * CTXL : b * SEQ, T = isctx ? CTXL : SEQ, t0 = cpos * 64;
            {
                float xw[11];
#pragma unroll
                for (int e = 0; e < 11; ++e) { const int t = t0 + 8 * tq - 1 + e; xw[e] = (t >= 0 && t < T) ? bf2f(ZO[(size_t)(base + t) * ZO_LD + 3072 + cch]) : 0.f; }
#pragma unroll
                for (int e = 0; e < 8; ++e) { const float y = cw0 * xw[e] + cw1 * xw[e + 1] + cw2 * xw[e + 2] + cw3 * xw[e + 3] + cb;
                    xcf[(8 * tq + e) * 65 + ci] = y; xcb[(8 * tq + e) * 72 + ci] = (bf16)f2bf(y); }
            }
            __syncthreads();
            {
                const bf16x8 a0 = *(const LAS bf16x8*)(xcb + (16 * tb + l15) * 72 + 8 * g), a1 = *(const LAS bf16x8*)(xcb + (16 * tb + l15) * 72 + 8 * g + 32);
                f32x4 gr_ = (f32x4){0.f, 0.f, 0.f, 0.f}, gi_ = (f32x4){0.f, 0.f, 0.f, 0.f};
                gr_ = __builtin_amdgcn_mfma_f32_16x16x32_bf16(a0, Bg[0][0], gr_, 0, 0, 0); gr_ = __builtin_amdgcn_mfma_f32_16x16x32_bf16(a1, Bg[0][1], gr_, 0, 0, 0);
                gi_ = __builtin_amdgcn_mfma_f32_16x16x32_bf16(a0, Bg[1][0], gi_, 0, 0, 0); gi_ = __builtin_amdgcn_mfma_f32_16x16x32_bf16(a1, Bg[1][1], gi_, 0, 0, 0);
#pragma unroll
                for (int e = 0; e < 4; ++e) {
                    const int tl = 16 * tb + 4 * g + e;
                    const float rg = 1.0f / (1.0f + expf(-(gr_[e] + br))), ig = 1.0f / (1.0f + expf(-(gi_[e] + bi)));
                    const float la = sp8 * rg, a = expf(la), mult = sqrtf(-expm1f(2.0f * la));
                    As[tl * 33 + jl] = a; Us[tl * 33 + jl] = mult * ig * xcf[tl * 65 + j0 + jl];
                }
            }
            __syncthreads();
            float av[4], uv[4];
            {
                float A = 1.f, H = 0.f;
#pragma unroll
                for (int e = 0; e < 4; ++e) { const int q = 4 * sg + e, tl = dir ? 63 - q : q; av[e] = As[tl * 33 + sc]; uv[e] = Us[tl * 33 + sc]; H = av[e] * H + uv[e]; A *= av[e]; }
                segA[sg * 32 + sc] = A; segH[sg * 32 + sc] = H;
            }
            __syncthreads();
            {
                float hin = carry, mine = 0.f;
#pragma unroll
                for (int s2 = 0; s2 < 16; ++s2) { if (s2 == sg) mine = hin; hin = segA[s2 * 32 + sc] * hin + segH[s2 * 32 + sc]; }
                carry = hin;
                if (!isctx) {
                    float hcur = mine;
#pragma unroll
                    for (int e = 0; e < 4; ++e) {
                        const int q = 4 * sg + e, tl = dir ? 63 - q : q; const size_t row = (size_t)(base + t0 + tl);
                        hcur = av[e] * hcur + uv[e];
                        if (dir == 0) HF[row * 1024 + och] = hcur;
                        else { const float hf = HF[row * 1024 + och]; const float gr = bf2f(ZO[row * ZO_LD + 4096 + och]);
                               MIX[row * D + 1024 + och] = (bf16)f2bf((hf + hcur) * gelu_tanh(gr)); }
                    }
                }
            }
        }
        VM_WAIT(); __syncthreads();
    }
}


#if MK_SPLIT
#define GRID_BAR() do { } while (0)
#else
#define GRID_BAR() xcd_barrier(bar)
#endif
#define IN(k) (lo <= (k) && (k) < hi)
#define SEAM(k) do { if (IN(k) && IN((k) + 1)) GRID_BAR(); } while (0)

template <int L>
__device__ __forceinline__ void layer_body(const Params& p, LAS unsigned char* lds, const XcdBarrier& bar, const int lo, const int hi) {
    constexpr int l = L;
    const int tid = threadIdx.x, lane = tid & 63, wave = __builtin_amdgcn_readfirstlane(tid >> 6);
    const int G = gridDim.x;
    float* MOD = (float*)(p.ws + WS_MOD);
    float* X = (float*)(p.ws + WS_X);
    bf16* HN = (bf16*)(p.ws + WS_HN);
    bf16* ACT = (bf16*)(p.ws + WS_ACT);
    bf16* Z = (bf16*)(p.ws + WS_Z);
    bf16* MIX = (bf16*)(p.ws + WS_MIX);
        const int pb = 1 + 10 * l;
        const float* modl = MOD + (size_t)l * 9 * DMODW;
        const float* ng = p.in[IN_NORMG] + (size_t)l * 3 * D;
        constexpr bool first = (l == 0);
        const float* xs_lat = first ? p.in[IN_X] : X; const float* xs_ctx = first ? p.in[IN_CTX] : X + (size_t)M_LAT * D;

        if (IN(pb + 0)) norm_phase(xs_lat, xs_ctx, M_ALL, ng + 0 * D, modl, 0, 1, HN, lane, wave);
        SEAM(pb + 0);
        if (IN(pb + 1)) {
            SchedStd S{(const char*)HN, (const char*)(p.ws + WS_WFI + (size_t)(l * 2 + 0) * WFI_STRIDE), (size_t)256 * D * 2, M_ALL / 256, 2 * DFF / 256, G, (int)blockIdx.x};
            EpiSwiGLU E{ACT};
            pg8::gemm_phase<EpiSwiGLU, SchedStd>(lds, D, S, E);
        }
        SEAM(pb + 1);
        if (IN(pb + 2)) {
            SchedStd S{(const char*)ACT, (const char*)(p.ws + WS_WFO + (size_t)(l * 2 + 0) * WFO_STRIDE), (size_t)256 * DFF * 2, M_ALL / 256, D / 256, G, (int)blockIdx.x};
            EpiResid E{xs_lat, xs_ctx, X, modl + 2 * D, 0.5f};
            pg8::gemm_phase<EpiResid, SchedStd>(lds, DFF, S, E);
        }
        SEAM(pb + 2);
        if (IN(pb + 3)) norm_phase(X, X + (size_t)M_LAT * D, M_ALL, ng + 1 * D, modl, 3, 4, HN, lane, wave);
        SEAM(pb + 3);
        if constexpr (first) {
            if (IN(pb + 4)) {
                SchedStd S{(const char*)HN, (const char*)(p.ws + WS_WEI), (size_t)256 * D * 2, M_ALL / 256, D_EIN / 256, G, (int)blockIdx.x};
                EpiEvIn E{Z};
                pg8::gemm_phase<EpiEvIn, SchedStd>(lds, D, S, E);
            }
            SEAM(pb + 4);
            if (IN(pb + 5)) even_conv_phase(p, lds, tid, lane, wave);
            SEAM(pb + 5);
            if (IN(pb + 6)) {
                SchedStd S{(const char*)MIX, (const char*)(p.ws + WS_WEO), (size_t)256 * D * 2, M_ALL / 256, D / 256, G, (int)blockIdx.x};
                EpiResid E{X, X + (size_t)M_LAT * D, X, modl + 5 * D, 1.0f};
                pg8::gemm_phase<EpiResid, SchedStd>(lds, D, S, E);
            }
            SEAM(pb + 6);
        } else {
            if (IN(pb + 4)) {
                SchedOdIn S{(const char*)HN, (const char*)(p.ws + WS_WOI), (size_t)256 * D * 2, G, (int)blockIdx.x};
                EpiOdIn E{Z, (bf16*)(p.ws + WS_VT)};
                pg8::gemm_phase<EpiOdIn, SchedOdIn>(lds, D, S, E);
            }
            SEAM(pb + 4);
            if (IN(pb + 5)) {
                for (int item = blockIdx.x; item < 256; item += G) lru_item(p, lds, item, tid, lane, wave);
                attn_phase(p, lane, wave);
            }
            SEAM(pb + 5);
            if (IN(pb + 6)) {
                SchedStd S{(const char*)MIX, (const char*)(p.ws + WS_WOO), (size_t)256 * D * 2, M_LAT / 256, D / 256, G, (int)blockIdx.x};
                EpiResid E{X, X + (size_t)M_LAT * D, X, modl + 5 * D, 1.0f};
                pg8::gemm_phase<EpiResid, SchedStd>(lds, D, S, E);
            }
            SEAM(pb + 6);
        }
        const int nrows2 = first ? M_ALL : M_LAT;
        if (IN(pb + 7)) norm_phase(X, X + (size_t)M_LAT * D, nrows2, ng + 2 * D, modl, 6, 7, HN, lane, wave);
        SEAM(pb + 7);
        if (IN(pb + 8)) {
            SchedStd S{(const char*)HN, (const char*)(p.ws + WS_WFI + (size_t)(l * 2 + 1) * WFI_STRIDE), (size_t)256 * D * 2, nrows2 / 256, 2 * DFF / 256, G, (int)blockIdx.x};
            EpiSwiGLU E{ACT};
            pg8::gemm_phase<EpiSwiGLU, SchedStd>(lds, D, S, E);
        }
        SEAM(pb + 8);
        if (IN(pb + 9)) {
            SchedStd S{(const char*)ACT, (const char*)(p.ws + WS_WFO + (size_t)(l * 2 + 1) * WFO_STRIDE), (size_t)256 * DFF * 2, nrows2 / 256, D / 256, G, (int)blockIdx.x};
            EpiResid E{X, X + (size_t)M_LAT * D, first ? X : p.out, modl + 8 * D, 0.5f};
            pg8::gemm_phase<EpiResid, SchedStd>(lds, DFF, S, E);
        }
        SEAM(pb + 9);
}
__global__ void __launch_bounds__(512, 2) mega_fwd(Params p) {
    extern __shared__ __attribute__((aligned(16))) unsigned char lds_raw[];
    LAS unsigned char* lds = (LAS unsigned char*)lds_raw;
    volatile LAS unsigned* MISC = (volatile LAS unsigned*)(lds + MISC_OFF);
    const int tid = threadIdx.x, lane = tid & 63, wave = __builtin_amdgcn_readfirstlane(tid >> 6);
    const int G = gridDim.x;
    if (tid < 64) MISC[tid] = 0u;
    __syncthreads();
    unsigned* ctl = (unsigned*)(p.ws + WS_CTL);
#if MK_SPLIT
    XcdBarrier bar; bar.bar = ctl + CW_BAR; bar.x = 0; bar.st = MISC + 8;
#else
    XcdBarrier bar = xcd_barrier_post(ctl + CW_BAR, MISC + 8);
#endif
    const int lo = p.ph_lo, hi = p.ph_hi;

    float* MOD = (float*)(p.ws + WS_MOD);
    float* X = (float*)(p.ws + WS_X);
    bf16* HN = (bf16*)(p.ws + WS_HN);
    bf16* ACT = (bf16*)(p.ws + WS_ACT);
    bf16* Z = (bf16*)(p.ws + WS_Z);
    bf16* MIX = (bf16*)(p.ws + WS_MIX);

    if (IN(0)) { p0_modvec(p, lds, tid, lane, wave); __syncthreads(); p0_weights(p, lds, lane, wave); __syncthreads(); }
    SEAM(0);

    layer_body<0>(p, lds, bar, lo, hi);
    layer_body<1>(p, lds, bar, lo, hi);
#undef IN
#undef SEAM
#undef GRID_BAR
}

extern "C" void kernel_launch(void* const* d_in, const int* in_sizes, int n_in, void* d_out, int out_size, void* d_ws, size_t ws_size, hipStream_t stream) {
    static int grid = 0;
    if (grid == 0) {
        if (n_in != 27 || in_sizes[0] != M_LAT * D || out_size != M_LAT * D || ws_size < WS_END) {
            fprintf(stderr, "kernel_launch: unexpected shapes (n_in %d, in0 %d, out %d, ws %zu; need ws >= %zu); nothing launched\n", n_in, n_in > 0 ? in_sizes[0] : -1, out_size, ws_size, (size_t)WS_END); grid = -1; return; }
        int dev = 0, cus = 0, per_cu = 0;
        if (hipGetDevice(&dev) != hipSuccess || hipDeviceGetAttribute(&cus, hipDeviceAttributeMultiprocessorCount, dev) != hipSuccess) { fprintf(stderr, "kernel_launch: device query failed\n"); grid = -1; return; }
        if (hipFuncSetAttribute((const void*)mega_fwd, hipFuncAttributeMaxDynamicSharedMemorySize, LDS_BYTES) != hipSuccess) { fprintf(stderr, "kernel_launch: hipFuncSetAttribute failed\n"); grid = -1; return; }
        if (hipOccupancyMaxActiveBlocksPerMultiprocessor(&per_cu, (const void*)mega_fwd, 512, LDS_BYTES) != hipSuccess || per_cu < 1) {
            fprintf(stderr, "kernel_launch: occupancy query reports %d workgroups per CU\n", per_cu); }
        (void)hipGetLastError();
        grid = cus;
    }
    if (grid < 0) return;
    if (hipMemsetAsync((char*)d_ws + WS_CTL, 0, CTL_ZERO_BYTES, stream) != hipSuccess) { fprintf(stderr, "kernel_launch: memset failed\n"); return; }
    Params a{};
    for (int i = 0; i < 27; ++i) a.in[i] = (const float*)d_in[i];
    a.out = (float*)d_out; a.ws = (unsigned char*)d_ws;
#if MK_SPLIT
    for (int ph = 0; ph < NPHASE; ++ph) { a.ph_lo = ph; a.ph_hi = ph + 1; hipLaunchKernelGGL(mega_fwd, dim3(grid), dim3(512), LDS_BYTES, stream, a); }
#else
    a.ph_lo = 0; a.ph_hi = NPHASE;
    hipLaunchKernelGGL(mega_fwd, dim3(grid), dim3(512), LDS_BYTES, stream, a);
#endif
    const hipError_t le = hipPeekAtLastError();
    if (le != hipSuccess) fprintf(stderr, "kernel_launch: launch failed: %s\n", hipGetErrorName(le));
}
```

```cpp
#include <hip/hip_runtime.h>
#include <cstdio>
#include <cstdint>

#ifndef MK_SPLIT
#define MK_SPLIT 0
#endif

namespace pg8 {
#define PG8_LAS __attribute__((address_space(3)))
typedef unsigned short bf16_t;
typedef short bf16x8 __attribute__((ext_vector_type(8)));
typedef float f32x4 __attribute__((ext_vector_type(4)));
typedef unsigned u32x4 __attribute__((ext_vector_type(4)));
typedef unsigned u32x2 __attribute__((ext_vector_type(2)));
constexpr int BM = 256, BK = 64, HALF = 128, HTB = HALF * BK * 2  , STAGE_BYTES = 8 * HTB, NXCD = 8, WGM = 8;

__host__ __device__ __forceinline__ int lds_byte(int r, int c) { const int st = (r >> 4) * 2 + (c >> 5), rr = r & 15, cc = c & 31, ob = rr * 64 + cc * 2; return st * 1024 + (ob ^ (((ob >> 9) & 1) << 5)); }
__host__ __device__ __forceinline__ void stage_rc(int b, int& R, int& C) { const int st = b / 1024, sb = b % 1024, swz = sb ^ (((sb >> 9) & 1) << 5); R = (st >> 1) * 16 + swz / 64; C = (st & 1) * 32 + (swz % 64) / 2; }
__host__ __device__ __forceinline__ int perm32(int rho) { const int n = rho >> 4, i = rho & 15; return 8 * (i >> 2) + 4 * n + (i & 3); }

struct Unit { int pm, pn, kind; };

__host__ __device__ __forceinline__ void tile_map(int wgid, int nM, int nN, int& pm, int& pn) {
    const int nwg = nM * nN;
    { const int q = nwg / NXCD, r = nwg % NXCD, xcd = wgid % NXCD, off = wgid / NXCD; wgid = (xcd < r ? xcd * (q + 1) : r * (q + 1) + (xcd - r) * q) + off; }
    const int nig = WGM * nN, gid = wgid / nig, fm = gid * WGM, gsz = (nM - fm) < WGM ? (nM - fm) : WGM;
    pm = fm + ((wgid % nig) % gsz); pn = (wgid % nig) / gsz;
}

__device__ __forceinline__ unsigned cvt_pk_bf16(float lo, float hi) { unsigned r; asm volatile("v_cvt_pk_bf16_f32 %0, %1, %2" : "=v"(r) : "v"(lo), "v"(hi)); return r; }

template <class Epi, class Sched, bool ALIGN_EPI = true, bool SP2 = true>
__device__ __forceinline__ void gemm_phase(PG8_LAS unsigned char* lds, const int K  , const Sched& S, const Epi& E) {
    const int tid = threadIdx.x, wid = __builtin_amdgcn_readfirstlane(tid >> 6), lane = tid & 63, wr = wid >> 2, wc = wid & 3, fr = lane & 15, fq = lane >> 4;
    unsigned voffA[2], voffB[2];
#pragma unroll
    for (int i = 0; i < 2; ++i) { int R, C; stage_rc(tid * 16 + i * 8192, R, C); const int Rb = Epi::PERM ? ((R & ~31) + perm32(R & 31)) : R;
        voffA[i] = (unsigned)(R * K + C) * 2u; voffB[i] = (unsigned)(Rb * K + C) * 2u; }
    const size_t kstep = (size_t)(BK * 2);
    const size_t hstep = (size_t)HALF * K * 2;
    const unsigned ldsw = (unsigned)wid * 1024u;
    const int aoff = lds_byte(wr * 64 + fr, fq * 8), boff = lds_byte(wc * 32 + fr, fq * 8);
#define PG8_SA(b, h) (((b) * 2 + (h)) * HTB)
#define PG8_SB(b, h) ((4 + (b) * 2 + (h)) * HTB)
#define PG8_STAGE(bufoff, gbase, voff) do { _Pragma("unroll") for (int _i = 0; _i < 2; ++_i) \
        __builtin_amdgcn_global_load_lds((const unsigned*)((const char*)(gbase) + (voff)[_i]), (PG8_LAS unsigned*)(lds + (bufoff) + ldsw + _i * 8192), 16, 0, 0); } while (0)
#define PG8_LDA(dst, b, h) do { _Pragma("unroll") for (int m = 0; m < 4; ++m) _Pragma("unroll") for (int k = 0; k < 2; ++k) dst[m][k] = *(const PG8_LAS bf16x8*)(lds + PG8_SA(b, h) + aoff + m * 2048 + k * 1024); } while (0)
#define PG8_LDB(dst, b, h) do { _Pragma("unroll") for (int n = 0; n < 2; ++n) _Pragma("unroll") for (int k = 0; k < 2; ++k) dst[n][k] = *(const PG8_LAS bf16x8*)(lds + PG8_SB(b, h) + boff + n * 2048 + k * 1024); } while (0)
#define PG8_MMA(ai, bj, At, Bt) do { __builtin_amdgcn_s_setprio(1); _Pragma("unroll") for (int m = 0; m < 4; ++m) _Pragma("unroll") for (int n = 0; n < 2; ++n) _Pragma("unroll") for (int k = 0; k < 2; ++k) \
        acc[ai][bj][m][n] = __builtin_amdgcn_mfma_f32_16x16x32_bf16(Bt[n][k], At[m][k], acc[ai][bj][m][n], 0, 0, 0); __builtin_amdgcn_s_setprio(0); } while (0)
#define PG8_WAIT_V(n) asm volatile("s_waitcnt vmcnt(" #n ")" ::: "memory")
#define PG8_WAIT_L(n) asm volatile("s_waitcnt lgkmcnt(" #n ")" ::: "memory")
#define PG8_BAR __builtin_amdgcn_s_barrier()
#define PG8_SCHED __builtin_amdgcn_sched_barrier(0)
    Unit cur, nxt; int ui = 0;
    if (!S.next(0, cur)) return;
    f32x4 acc[2][2][4][2];
#pragma unroll
    for (int a = 0; a < 2; ++a)
#pragma unroll
        for (int b = 0; b < 2; ++b)
#pragma unroll
            for (int m = 0; m < 4; ++m)
#pragma unroll
                for (int n = 0; n < 2; ++n) acc[a][b][m][n] = (f32x4){0.f, 0.f, 0.f, 0.f};
    bf16x8 At[4][2], B0[2][2], B1[2][2];
    const char* cA = S.a_base(cur); const char* cB = S.b_base(cur);
    if constexpr (SP2) {
        PG8_STAGE(PG8_SB(0, 0), cB, voffB); PG8_STAGE(PG8_SB(0, 1), cB + hstep, voffB); PG8_STAGE(PG8_SA(0, 0), cA, voffA); PG8_STAGE(PG8_SA(0, 1), cA + hstep, voffA);
        if (wr == 1) PG8_BAR;
        PG8_WAIT_V(2); PG8_BAR;
        PG8_STAGE(PG8_SB(1, 0), cB + kstep, voffB); PG8_STAGE(PG8_SA(1, 0), cA + kstep, voffA); PG8_STAGE(PG8_SB(1, 1), cB + hstep + kstep, voffB);
        PG8_WAIT_V(6); PG8_BAR;
    } else {
        PG8_STAGE(PG8_SB(0, 0), cB, voffB); PG8_STAGE(PG8_SA(0, 0), cA, voffA); PG8_STAGE(PG8_SB(0, 1), cB + hstep, voffB); PG8_STAGE(PG8_SA(0, 1), cA + hstep, voffA);
        if (wr == 1) PG8_BAR;
        PG8_WAIT_V(4); PG8_BAR;
        PG8_STAGE(PG8_SB(1, 0), cB + kstep, voffB); PG8_STAGE(PG8_SA(1, 0), cA + kstep, voffA); PG8_STAGE(PG8_SB(1, 1), cB + hstep + kstep, voffB);
        PG8_WAIT_V(6); PG8_BAR;
    }
    for (;;) {
        const bool has_next = S.next(ui + 1, nxt);
        const int nt = S.nt(cur);
        const char* nA = has_next ? S.a_base(nxt) : cA; const char* nB = has_next ? S.b_base(nxt) : cB;
        for (int t = 0; t < nt; t += 2) {
            const bool last = (t == nt - 2);
            const char* a1 = cA + (size_t)(t + 1) * kstep;
            const char* a2 = last ? nA : cA + (size_t)(t + 2) * kstep; const char* b2 = last ? nB : cB + (size_t)(t + 2) * kstep;
            const char* a3 = a2 + kstep; const char* b3 = b2 + kstep;
            if constexpr (SP2) {
            PG8_LDB(B0, 0, 0); PG8_LDB(B1, 0, 1); PG8_SCHED; PG8_LDA(At, 0, 0); PG8_STAGE(PG8_SA(1, 1), a1 + hstep, voffA);
            PG8_WAIT_V(8); PG8_WAIT_L(0); PG8_BAR; PG8_MMA(0, 0, At, B0); PG8_MMA(0, 1, At, B1); PG8_BAR; PG8_SCHED;
            PG8_LDA(At, 0, 1); PG8_STAGE(PG8_SB(0, 0), b2, voffB); PG8_STAGE(PG8_SB(0, 1), b2 + hstep, voffB); PG8_STAGE(PG8_SA(0, 0), a2, voffA);
            PG8_WAIT_V(8); PG8_WAIT_L(0); PG8_BAR; PG8_MMA(1, 0, At, B0); PG8_MMA(1, 1, At, B1); PG8_BAR; PG8_SCHED;
            PG8_LDB(B0, 1, 0); PG8_LDB(B1, 1, 1); PG8_SCHED; PG8_LDA(At, 1, 0); PG8_STAGE(PG8_SA(0, 1), a2 + hstep, voffA);
            PG8_WAIT_V(8); PG8_WAIT_L(0); PG8_BAR; PG8_MMA(0, 0, At, B0); PG8_MMA(0, 1, At, B1); PG8_BAR; PG8_SCHED;
            PG8_LDA(At, 1, 1); PG8_STAGE(PG8_SB(1, 0), b3, voffB); PG8_STAGE(PG8_SB(1, 1), b3 + hstep, voffB); PG8_STAGE(PG8_SA(1, 0), a3, voffA);
            PG8_WAIT_V(8); PG8_WAIT_L(0); PG8_BAR; PG8_MMA(1, 0, At, B0); PG8_MMA(1, 1, At, B1); PG8_BAR; PG8_SCHED;
            } else {
            PG8_LDB(B0, 0, 0); PG8_SCHED; PG8_LDA(At, 0, 0); PG8_STAGE(PG8_SA(1, 1), a1 + hstep, voffA);
            PG8_WAIT_L(8); PG8_BAR; PG8_WAIT_L(0); PG8_MMA(0, 0, At, B0); PG8_BAR; PG8_SCHED;
            PG8_LDB(B1, 0, 1); PG8_STAGE(PG8_SB(0, 0), b2, voffB);
            PG8_BAR; PG8_WAIT_L(0); PG8_MMA(0, 1, At, B1); PG8_BAR;
            PG8_LDA(At, 0, 1); PG8_STAGE(PG8_SA(0, 0), a2, voffA);
            PG8_BAR; PG8_WAIT_L(0); PG8_MMA(1, 0, At, B0); PG8_BAR; PG8_SCHED;
            PG8_STAGE(PG8_SB(0, 1), b2 + hstep, voffB);
            PG8_WAIT_V(6); PG8_BAR; PG8_MMA(1, 1, At, B1); PG8_BAR;
            PG8_LDB(B0, 1, 0); PG8_SCHED; PG8_LDA(At, 1, 0); PG8_STAGE(PG8_SA(0, 1), a2 + hstep, voffA);
            PG8_WAIT_L(8); PG8_BAR; PG8_WAIT_L(0); PG8_MMA(0, 0, At, B0); PG8_BAR; PG8_SCHED;
            PG8_LDB(B1, 1, 1); PG8_STAGE(PG8_SB(1, 0), b3, voffB);
            PG8_BAR; PG8_WAIT_L(0); PG8_MMA(0, 1, At, B1); PG8_BAR;
            PG8_LDA(At, 1, 1); PG8_STAGE(PG8_SA(1, 0), a3, voffA);
            PG8_BAR; PG8_WAIT_L(0); PG8_MMA(1, 0, At, B0); PG8_BAR; PG8_SCHED;
            PG8_STAGE(PG8_SB(1, 1), b3 + hstep, voffB);
            PG8_WAIT_V(6); PG8_BAR; PG8_MMA(1, 1, At, B1); PG8_BAR;
            }
        }
        if constexpr (ALIGN_EPI) { if (wr == 0) PG8_BAR; }
        E(acc, cur, wr, wc, fr, fq);
        if (!has_next) break;
#pragma unroll
        for (int a = 0; a < 2; ++a)
#pragma unroll
            for (int b = 0; b < 2; ++b)
#pragma unroll
                for (int m = 0; m < 4; ++m)
#pragma unroll
                    for (int n = 0; n < 2; ++n) acc[a][b][m][n] = (f32x4){0.f, 0.f, 0.f, 0.f};
        cur = nxt; cA = nA; cB = nB; ++ui;
        if constexpr (ALIGN_EPI) { if (wr == 1) PG8_BAR; }
    }
    PG8_WAIT_V(0);
    if constexpr (!ALIGN_EPI) { if (wr == 0) PG8_BAR; }
    PG8_BAR;
#undef PG8_SA
#undef PG8_SB
#undef PG8_STAGE
#undef PG8_LDA
#undef PG8_LDB
#undef PG8_MMA
#undef PG8_WAIT_V
#undef PG8_WAIT_L
#undef PG8_BAR
#undef PG8_SCHED
}
}

constexpr int D = 2048, NBATCH = 8, SEQ = 2048, CTXL = 256, DFF = 5632, NMODV = 9, DMODW = NMODV * D  ;
constexpr int M_LAT = NBATCH * SEQ  , M_CTX = NBATCH * CTXL  , M_ALL = M_LAT + M_CTX  ;
constexpr int NH = 16, HD = 64, GW = 64  , GROWS = SEQ / GW  , WIN_R = 8, WIN_C = 16;
constexpr int D_EIN = 5120, D_OIN = 5120, ZE_LD = 3072  , ZO_LD = 5120;
constexpr float EPS = 1e-6f;
constexpr int NPHASE = 21;

constexpr size_t MiB = 1u << 20;
constexpr size_t WS_CTL = 0, CTL_ZERO_BYTES = 1 * MiB;
constexpr size_t WS_MOD = 1 * MiB;
constexpr size_t WS_WFI = 4 * MiB, WFI_STRIDE = 44 * MiB;
constexpr size_t WS_WFO = 180 * MiB, WFO_STRIDE = 22 * MiB;
constexpr size_t WS_WEI = 268 * MiB, WS_WEO = 288 * MiB, WS_WOI = 296 * MiB, WS_WOO = 316 * MiB;
constexpr size_t WS_X = 324 * MiB;
constexpr size_t WS_HN = 468 * MiB;
constexpr size_t WS_ACT = 540 * MiB;
constexpr size_t WS_Z = 738 * MiB;
constexpr size_t WS_MIX = 918 * MiB;
constexpr size_t WS_VT = 990 * MiB;
constexpr size_t WS_HF = 1026 * MiB;
constexpr size_t WS_PART = 1090 * MiB, PART_STRIDE = 16 * MiB;
constexpr size_t WS_END = 1138 * MiB;
constexpr int CW_BAR = 4096;
constexpr int CW_Q = 8192;

constexpr int RING_BYTES = 131072;
constexpr int LDS_BYTES = 147456;
constexpr int MISC_OFF = LDS_BYTES - 256;

#define GAS __attribute__((address_space(1)))
#define LAS __attribute__((address_space(3)))
typedef unsigned short bf16;
typedef float f32x4 __attribute__((ext_vector_type(4)));
typedef float f32x2 __attribute__((ext_vector_type(2)));
typedef unsigned u32x4 __attribute__((ext_vector_type(4)));
typedef unsigned u32x2 __attribute__((ext_vector_type(2)));
typedef short bf16x8 __attribute__((ext_vector_type(8)));
#define LDS_WAIT() asm volatile("s_waitcnt lgkmcnt(0)" ::: "memory")
#define VM_WAIT() asm volatile("s_waitcnt vmcnt(0)" ::: "memory")
__device__ __forceinline__ unsigned f2bf(float f) { unsigned u = __builtin_bit_cast(unsigned, f); return (u + 0x7fffu + ((u >> 16) & 1u)) >> 16; }
__device__ __forceinline__ unsigned pk2(float lo, float hi) { return f2bf(lo) | (f2bf(hi) << 16); }
__device__ __forceinline__ float bf_lo(unsigned v) { return __builtin_bit_cast(float, v << 16); }
__device__ __forceinline__ float bf_hi(unsigned v) { return __builtin_bit_cast(float, v & 0xffff0000u); }
__device__ __forceinline__ float bf2f(bf16 v) { return __builtin_bit_cast(float, (unsigned)v << 16); }
__device__ __forceinline__ float fast_sigmoid(float x) { return __builtin_amdgcn_rcpf(1.0f + __builtin_amdgcn_exp2f(-1.44269504089f * x)); }
__device__ __forceinline__ float wave_sum(float v) {
#pragma unroll
    for (int o = 1; o < 64; o <<= 1) v += __shfl_xor(v, o);
    return v;
}

#define XB_TMO      128
#define XB_XCNT(j)  (256  + 64 * (j))
#define XB_XSUB(j)  (1280 + 64 * (j))
#define XB_XGEN(j)  (2304 + 64 * (j))
#define XB_TOP      3328
#define XB_TOPGEN   3392
#define XCD_BAR_WORDS 3456
#define XB_SPIN_CAP (1u << 18)

__device__ __forceinline__ unsigned xb_ld(unsigned* p)              { return __hip_atomic_load(p, __ATOMIC_RELAXED, __HIP_MEMORY_SCOPE_AGENT); }
__device__ __forceinline__ unsigned xb_add(unsigned* p, unsigned v) { return __hip_atomic_fetch_add(p, v, __ATOMIC_RELAXED, __HIP_MEMORY_SCOPE_AGENT); }
__device__ __forceinline__ unsigned xb_xcc_id() { return (unsigned)__builtin_amdgcn_s_getreg((3 << 11) | 20) & 0xFu; }
#define XB_SPIN(cond, bar) do { unsigned _sp = 0; while (cond) { __builtin_amdgcn_s_sleep(1); \
    if ((++_sp & 255u) == 0u) { if (xb_ld(&(bar)[XB_TMO])) break; if (_sp > XB_SPIN_CAP) { atomicAdd(&(bar)[XB_TMO], 1u); break; } } } } while (0)

struct XcdBarrier {
    unsigned* bar; unsigned x;
    volatile LAS unsigned* st;
};

__device__ __forceinline__ XcdBarrier xcd_barrier_post(unsigned* bar, volatile LAS unsigned* st) {
    XcdBarrier b; b.bar = bar; b.x = xb_xcc_id(); b.st = st;
    if (threadIdx.x == 0) (void)xb_add(&bar[XB_XCNT(b.x)], 1u);
    return b;
}
__device__ __forceinline__ void xcd_barrier_complete(unsigned* bar, unsigned x, unsigned& nloc, unsigned& nx) {
    const unsigned G = gridDim.x * gridDim.y * gridDim.z;
    unsigned sum, cnt, mine, sp = 0u;
    for (;;) {
        sum = 0u; cnt = 0u; mine = 0u;
#pragma unroll
        for (unsigned j = 0; j < 16; ++j) { const unsigned c = xb_ld(&bar[XB_XCNT(j)]); sum += c; cnt += (c > 0u) ? 1u : 0u; mine = (j == x) ? c : mine; }
        if (sum == G) break;
        __builtin_amdgcn_s_sleep(1);
        if ((++sp & 255u) == 0u) { if (xb_ld(&bar[XB_TMO])) break; if (sp > XB_SPIN_CAP) { atomicAdd(&bar[XB_TMO], 1u); break; } }
    }
    nloc = mine > 0u ? mine : 1u; nx = cnt > 0u ? cnt : 1u;
}

__device__ __forceinline__ void xcd_barrier(const XcdBarrier& b) {
    asm volatile("s_waitcnt vmcnt(0)" ::: "memory");
    __syncthreads();
    if (threadIdx.x == 0) {
        unsigned* bar = b.bar;
        __builtin_amdgcn_s_waitcnt(0);
        unsigned nloc = b.st[0], nx = b.st[1];
        if (nloc == 0u) { xcd_barrier_complete(bar, b.x, nloc, nx); b.st[0] = nloc; b.st[1] = nx; }
        const unsigned old = xb_add(&bar[XB_XSUB(b.x)], 1u);
        const unsigned gen = old / nloc;
        if (old + 1u == (gen + 1u) * nloc) {
            __builtin_amdgcn_fence(__ATOMIC_RELEASE, "agent");
            asm volatile("s_waitcnt vmcnt(0)" ::: "memory");
            const unsigned og = xb_add(&bar[XB_TOP], 1u);
            const unsigned tg = og / nx;
            if (og + 1u == (tg + 1u) * nx) xb_add(&bar[XB_TOPGEN], 1u);
            else XB_SPIN(xb_ld(&bar[XB_TOPGEN]) == tg, bar);
            __builtin_amdgcn_fence(__ATOMIC_ACQUIRE, "agent");
            xb_add(&bar[XB_XGEN(b.x)], 1u);
            asm volatile("s_waitcnt vmcnt(0)" ::: "memory");
        } else {
            XB_SPIN(xb_ld(&bar[XB_XGEN(b.x)]) == gen, bar);
            __builtin_amdgcn_fence(__ATOMIC_ACQUIRE, "agent");
            asm volatile("s_waitcnt vmcnt(0)" ::: "memory");
        }
    }
    __syncthreads();
}

struct Params {
    const float* in[27];
    float* out;
    unsigned char* ws;
    int ph_lo, ph_hi;
};
enum { IN_X = 0, IN_C, IN_CTX, IN_CCTX, IN_WMOD, IN_BMOD, IN_NORMG, IN_FWI, IN_FWO, IN_EWI, IN_SCW, IN_SCB, IN_CCW, IN_CCB, IN_LNG, IN_LNB, IN_EWO,
       IN_OWI, IN_QG, IN_KG, IN_RPB, IN_LCW, IN_LCB, IN_LGW, IN_LGB, IN_LAM, IN_OWO };

struct SchedStd {
    const char* A; const char* Bt; size_t tstep; int nM, nN, G, c, ntiles;
    __device__ __forceinline__ int nt(const pg8::Unit&) const { return ntiles; }
    __device__ __forceinline__ bool next(int i, pg8::Unit& u) const {
        const long L = (long)i * G + c; if (L >= (long)nM * nN) return false;
        pg8::tile_map((int)L, nM, nN, u.pm, u.pn); u.kind = 0; return true;
    }
    __device__ __forceinline__ const char* a_base(const pg8::Unit& u) const { return A + (size_t)u.pm * tstep; }
    __device__ __forceinline__ const char* b_base(const pg8::Unit& u) const { return Bt + (size_t)u.pn * tstep; }
};

struct SchedDown {
    const char* A; const char* Bt; size_t tstep; int G, c, ntiles;
    __device__ __forceinline__ bool next(int i, pg8::Unit& u) const {
        const long L = (long)i * G + c;
        if (L < 512) { pg8::tile_map((int)L, 64, 8, u.pm, u.pn); u.kind = 0; return true; }
        if (L < 768) { const int q = (int)L - 512, t = q & 63; u.pm = 64 + (t >> 3); u.pn = t & 7; u.kind = 1 + (q >> 6); return true; }
        return false;
    }
    __device__ __forceinline__ int nt(const pg8::Unit& u) const { return u.kind == 0 ? ntiles : ntiles / 4; }
    __device__ __forceinline__ const char* a_base(const pg8::Unit& u) const { return A + (size_t)u.pm * tstep + (u.kind > 1 ? (size_t)(u.kind - 1) * (ntiles / 4) * 128 : 0); }
    __device__ __forceinline__ const char* b_base(const pg8::Unit& u) const { return Bt + (size_t)u.pn * tstep + (u.kind > 1 ? (size_t)(u.kind - 1) * (ntiles / 4) * 128 : 0); }
};
struct SchedOdIn {
    const char* HN; const char* W; size_t tstep; int G, c;
    __device__ __forceinline__ int nt(const pg8::Unit&) const { return D / 64; }
    __device__ __forceinline__ bool next(int i, pg8::Unit& u) const {
        const long L = (long)i * G + c;
        if (L < 72 * 16) { int pm, pnv; pg8::tile_map((int)L, 72, 16, pm, pnv); u.pm = pm; u.pn = pnv < 8 ? pnv : pnv + 4; u.kind = 0; return true; }
        if (L < 72 * 16 + 4 * 72) { int pm, pn; pg8::tile_map((int)L - 72 * 16, 4, 72, pm, pn); u.pm = pm; u.pn = pn; u.kind = 1; return true; }
        return false;
    }
    __device__ __forceinline__ const char* a_base(const pg8::Unit& u) const { return u.kind == 0 ? HN + (size_t)u.pm * tstep : W + (size_t)(8 + u.pm) * tstep; }
    __device__ __forceinline__ const char* b_base(const pg8::Unit& u) const { return u.kind == 0 ? W + (size_t)u.pn * tstep : HN + (size_t)u.pn * tstep; }
};

struct EpiSwiGLU {
    static constexpr bool PERM = true;
    bf16* O;
    __device__ __forceinline__ void operator()(const f32x4 (&acc)[2][2][4][2], const pg8::Unit& u, int wr, int wc, int fr, int fq) const {
        const int row0 = u.pm * 256 + wr * 64 + fr, col0 = u.pn * 128 + wc * 32 + 8 * fq;
#pragma unroll
        for (int ai = 0; ai < 2; ++ai)
#pragma unroll
            for (int m = 0; m < 4; ++m) {
                bf16* rowp = O + (size_t)(row0 + ai * 128 + m * 16) * DFF + col0;
                float v[8];
#pragma unroll
                for (int n = 0; n < 2; ++n)
#pragma unroll
                    for (int j = 0; j < 4; ++j) { const float g = acc[ai][0][m][n][j], up = acc[ai][1][m][n][j]; v[4 * n + j] = g * fast_sigmoid(g) * up; }
                u32x4 w; w.x = pg8::cvt_pk_bf16(v[0], v[1]); w.y = pg8::cvt_pk_bf16(v[2], v[3]); w.z = pg8::cvt_pk_bf16(v[4], v[5]); w.w = pg8::cvt_pk_bf16(v[6], v[7]);
                *(u32x4*)rowp = w;
            }
    }
};
struct EpiResid {
    static constexpr bool PERM = false;
    const float* base_lat; const float* base_ctx; float* out; const float* gate; float coef; float* part;
    __device__ __forceinline__ void operator()(const f32x4 (&acc)[2][2][4][2], const pg8::Unit& u, int wr, int wc, int fr, int fq) const {
        const float coef = __builtin_bit_cast(float, __builtin_amdgcn_readfirstlane(__builtin_bit_cast(int, this->coef)));
        float* const part = (float*)(((unsigned long long)(unsigned)__builtin_amdgcn_readfirstlane((int)((unsigned long long)this->part >> 32)) << 32) | (unsigned)__builtin_amdgcn_readfirstlane((int)(unsigned long long)this->part));
        const int row0 = u.pm * 256 + wr * 64 + fr, col0 = u.pn * 256 + wc * 32 + 4 * fq;
        const int r = u.pm < 64 ? (u.pm >> 3) : 8;
        const float* gv = gate + (size_t)r * DMODW + col0;
        f32x4 gvv[2][2];
#pragma unroll
        for (int bj = 0; bj < 2; ++bj)
#pragma unroll
            for (int n = 0; n < 2; ++n) gvv[bj][n] = *(const f32x4*)(gv + bj * 128 + n * 16) * coef;
        if (u.kind >= 2) {
            float* op = part + (size_t)(u.kind - 2) * (PART_STRIDE / 4) + (size_t)(row0 - M_LAT) * D + col0;
#pragma unroll
            for (int ai = 0; ai < 2; ++ai)
#pragma unroll
                for (int m = 0; m < 4; ++m) { const size_t ro = (size_t)(ai * 128 + m * 16) * D;
#pragma unroll
                    for (int bj = 0; bj < 2; ++bj)
#pragma unroll
                        for (int n = 0; n < 2; ++n) *(f32x4*)(op + ro + bj * 128 + n * 16) = gvv[bj][n] * acc[ai][bj][m][n]; }
            return;
        }
        const float* bp = u.pm < 64 ? base_lat + (size_t)row0 * D + col0 : base_ctx + (size_t)(row0 - M_LAT) * D + col0;
        float* op = out + (size_t)row0 * D + col0;
#pragma unroll
        for (int ai = 0; ai < 2; ++ai)
#pragma unroll
            for (int mh = 0; mh < 2; ++mh) {
                f32x4 b[2][2][2];
#pragma unroll
                for (int mm = 0; mm < 2; ++mm)
#pragma unroll
                    for (int bj = 0; bj < 2; ++bj)
#pragma unroll
                        for (int n = 0; n < 2; ++n) b[mm][bj][n] = *(const f32x4*)(bp + (size_t)(ai * 128 + (2 * mh + mm) * 16) * D + bj * 128 + n * 16);
#pragma unroll
                for (int mm = 0; mm < 2; ++mm)
#pragma unroll
                    for (int bj = 0; bj < 2; ++bj)
#pragma unroll
                        for (int n = 0; n < 2; ++n) *(f32x4*)(op + (size_t)(ai * 128 + (2 * mh + mm) * 16) * D + bj * 128 + n * 16) = b[mm][bj][n] + gvv[bj][n] * acc[ai][bj][2 * mh + mm][n];
                asm volatile("" ::: "memory");
            }
    }
};
struct EpiEvIn {
    static constexpr bool PERM = true;
    bf16* O;
    __device__ __forceinline__ void operator()(const f32x4 (&acc)[2][2][4][2], const pg8::Unit& u, int wr, int wc, int fr, int fq) const {
        const int row0 = u.pm * 256 + wr * 64 + fr;
        if (u.pn < 4) {
            const int col0 = u.pn * 256 + wc * 32 + 8 * fq;
#pragma unroll
            for (int ai = 0; ai < 2; ++ai)
#pragma unroll
                for (int m = 0; m < 4; ++m) { bf16* rowp = O + (size_t)(row0 + ai * 128 + m * 16) * ZE_LD + col0;
#pragma unroll
                    for (int bj = 0; bj < 2; ++bj) { const f32x4 v0 = acc[ai][bj][m][0], v1 = acc[ai][bj][m][1];
                        u32x4 w; w.x = pg8::cvt_pk_bf16(v0[0], v0[1]); w.y = pg8::cvt_pk_bf16(v0[2], v0[3]); w.z = pg8::cvt_pk_bf16(v1[0], v1[1]); w.w = pg8::cvt_pk_bf16(v1[2], v1[3]);
                        *(u32x4*)(rowp + bj * 128) = w; } }
        } else {
            const bool glu = u.pn >= 12;
            const int col0 = (glu ? 2048 + (u.pn - 12) * 128 : 1024 + (u.pn - 4) * 128) + wc * 32 + 8 * fq;
#pragma unroll
            for (int ai = 0; ai < 2; ++ai)
#pragma unroll
                for (int m = 0; m < 4; ++m) { bf16* rowp = O + (size_t)(row0 + ai * 128 + m * 16) * ZE_LD + col0;
                    float v[8];
#pragma unroll
                    for (int n = 0; n < 2; ++n)
#pragma unroll
                        for (int j = 0; j < 4; ++j) { const float a = acc[ai][0][m][n][j], b = acc[ai][1][m][n][j]; v[4 * n + j] = glu ? a * fast_sigmoid(b) : a * b; }
                    u32x4 w; w.x = pg8::cvt_pk_bf16(v[0], v[1]); w.y = pg8::cvt_pk_bf16(v[2], v[3]); w.z = pg8::cvt_pk_bf16(v[4], v[5]); w.w = pg8::cvt_pk_bf16(v[6], v[7]);
                    *(u32x4*)rowp = w; }
        }
    }
};
struct EpiOdIn {
    static constexpr bool PERM = true;
    bf16* ZO; bf16* VT; const float* qg; const float* kg;
    __device__ __forceinline__ void operator()(const f32x4 (&acc)[2][2][4][2], const pg8::Unit& u, int wr, int wc, int fr, int fq) const {
        const int row0 = u.pm * 256 + wr * 64 + fr;
        if (u.kind == 0 && u.pn < 8) {
            const bool isq = u.pn < 4;
            const float* gp = (isq ? qg : kg) + 8 * fq;
            f32x4 gn[2][2];
#pragma unroll
            for (int bj = 0; bj < 2; ++bj)
#pragma unroll
                for (int n = 0; n < 2; ++n) gn[bj][n] = *(const f32x4*)(gp + 32 * bj + 4 * n);
            const float sc = isq ? 0.125f : 1.0f;
            const int col0 = u.pn * 256 + wc * 64 + 8 * fq;
#pragma unroll
            for (int ai = 0; ai < 2; ++ai)
#pragma unroll
                for (int m = 0; m < 4; ++m) {
                    float ss = 0.f;
#pragma unroll
                    for (int bj = 0; bj < 2; ++bj)
#pragma unroll
                        for (int n = 0; n < 2; ++n) { const f32x4 v = acc[ai][bj][m][n]; ss += (v[0] * v[0] + v[1] * v[1]) + (v[2] * v[2] + v[3] * v[3]); }
                    ss += __shfl_xor(ss, 16); ss += __shfl_xor(ss, 32);
                    const float rs = sc / sqrtf(ss * (1.0f / HD) + EPS);
                    bf16* rowp = ZO + (size_t)(row0 + ai * 128 + m * 16) * ZO_LD + col0;
#pragma unroll
                    for (int bj = 0; bj < 2; ++bj) { const f32x4 v0 = acc[ai][bj][m][0] * rs * gn[bj][0], v1 = acc[ai][bj][m][1] * rs * gn[bj][1];
                        u32x4 w; w.x = pg8::cvt_pk_bf16(v0[0], v0[1]); w.y = pg8::cvt_pk_bf16(v0[2], v0[3]); w.z = pg8::cvt_pk_bf16(v1[0], v1[1]); w.w = pg8::cvt_pk_bf16(v1[2], v1[3]);
                        *(u32x4*)(rowp + bj * 32) = w; }
                }
            return;
        }
        const int col0 = u.pn * 256 + wc * 32 + 8 * fq;
        bf16* base = u.kind == 0 ? ZO : VT; const size_t ld = u.kind == 0 ? (size_t)ZO_LD : (size_t)M_ALL;
#pragma unroll
        for (int ai = 0; ai < 2; ++ai)
#pragma unroll
            for (int m = 0; m < 4; ++m) { bf16* rowp = base + (size_t)(row0 + ai * 128 + m * 16) * ld + col0;
#pragma unroll
                for (int bj = 0; bj < 2; ++bj) { const f32x4 v0 = acc[ai][bj][m][0], v1 = acc[ai][bj][m][1];
                    u32x4 w; w.x = pg8::cvt_pk_bf16(v0[0], v0[1]); w.y = pg8::cvt_pk_bf16(v0[2], v0[3]); w.z = pg8::cvt_pk_bf16(v1[0], v1[1]); w.w = pg8::cvt_pk_bf16(v1[2], v1[3]);
                    *(u32x4*)(rowp + bj * 128) = w; } }
    }
};

__device__ __forceinline__ int srccol(int map, int n) {
    if (map == 0) return n;
    const int pn = n >> 8, bj = (n >> 7) & 1, i = n & 127;
    if (map == 1) return bj * DFF + 128 * pn + i;
    if (map == 2) {
        if (pn < 4) return n;
        if (pn < 12) return 1024 + bj * 1024 + 128 * (pn - 4) + i;
        return 3072 + bj * 1024 + 128 * (pn - 12) + i;
    }
    if (pn < 8) return 256 * pn + 64 * ((n >> 5) & 3) + 32 * bj + (n & 31);
    return n;
}
__device__ __forceinline__ void p0_transpose_item(const float* W, int K, int N, bf16* WT, int map, LAS float* scr, int item, int lane) {
    const int nblk = N / 64, kb = item / nblk, nb = item % nblk, k0 = 64 * kb, n0 = 64 * nb;
    const float* src = W + (size_t)k0 * N + srccol(map, n0 + lane);
#pragma unroll 16
    for (int i = 0; i < 64; ++i) scr[i * 65 + lane] = src[(size_t)i * N];
    LDS_WAIT(); asm volatile("" ::: "memory");
    const int c = lane & 7;
#pragma unroll
    for (int j = 0; j < 8; ++j) { const int n = (lane >> 3) + 8 * j; const LAS float* s = scr + (8 * c) * 65 + n;
        u32x4 o; o.x = pk2(s[0 * 65], s[1 * 65]); o.y = pk2(s[2 * 65], s[3 * 65]); o.z = pk2(s[4 * 65], s[5 * 65]); o.w = pk2(s[6 * 65], s[7 * 65]);
        *(u32x4*)(WT + (size_t)(n0 + n) * K + k0 + 8 * c) = o; }
    LDS_WAIT(); asm volatile("" ::: "memory");
}
__device__ __forceinline__ void p0_weights(const Params& p, LAS unsigned char* lds, int lane, int wave) {
    LAS float* scr = (LAS float*)(lds + wave * (64 * 65 * 4));
    const int gw = blockIdx.x * 8 + wave, NGW = gridDim.x * 8;
    constexpr int I_FI = (D / 64) * (2 * DFF / 64), I_FO = (DFF / 64) * (D / 64), I_IN = (D / 64) * (D_EIN / 64), I_OUT = (D / 64) * (D / 64);
    constexpr int NITEMS = 4 * I_FI + 4 * I_FO + 2 * I_IN + 2 * I_OUT;
    for (int it = gw; it < NITEMS; it += NGW) {
        int r = it;
        if (r < 4 * I_FI) { const int q = r / I_FI; p0_transpose_item(p.in[IN_FWI] + (size_t)q * D * 2 * DFF, D, 2 * DFF, (bf16*)(p.ws + WS_WFI + q * WFI_STRIDE), 1, scr, r % I_FI, lane); continue; } r -= 4 * I_FI;
        if (r < 4 * I_FO) { const int q = r / I_FO; p0_transpose_item(p.in[IN_FWO] + (size_t)q * DFF * D, DFF, D, (bf16*)(p.ws + WS_WFO + q * WFO_STRIDE), 0, scr, r % I_FO, lane); continue; } r -= 4 * I_FO;
        if (r < I_IN) { p0_transpose_item(p.in[IN_EWI], D, D_EIN, (bf16*)(p.ws + WS_WEI), 2, scr, r, lane); continue; } r -= I_IN;
        if (r < I_IN) { p0_transpose_item(p.in[IN_OWI], D, D_OIN, (bf16*)(p.ws + WS_WOI), 3, scr, r, lane); continue; } r -= I_IN;
        if (r < I_OUT) { p0_transpose_item(p.in[IN_EWO], D, D, (bf16*)(p.ws + WS_WEO), 0, scr, r, lane); continue; } r -= I_OUT;
        p0_transpose_item(p.in[IN_OWO], D, D, (bf16*)(p.ws + WS_WOO), 0, scr, r, lane);
    }
}
__device__ __forceinline__ void p0_modvec(const Params& p, LAS unsigned char* lds, int tid, int lane, int wave) {
    LAS float* sv = (LAS float*)lds;
    LAS float* red = (LAS float*)(lds + 9 * 2048 * 4);
    volatile LAS int* qslot = (volatile LAS int*)(lds + 9 * 2048 * 4 + 8 * 9 * 64 * 4);
    const float* c = p.in[IN_C]; const float* cc = p.in[IN_CCTX];
    for (int i = tid; i < 9 * 2048; i += 512) { const float v = i < 8 * 2048 ? c[i] : cc[i - 8 * 2048]; sv[i] = v / (1.0f + __expf(-v)); }
    float* MOD = (float*)(p.ws + WS_MOD);
    unsigned* qhead = (unsigned*)(p.ws + WS_CTL) + CW_Q;
    for (;;) {
        __syncthreads();
        if (tid == 0) *qslot = (int)__hip_atomic_fetch_add(qhead, 1u, __ATOMIC_RELAXED, __HIP_MEMORY_SCOPE_AGENT);
        __syncthreads();
        const int item = *qslot;
        if (item >= 2 * 288) break;
        const int l = item / 288, col0 = (item % 288) * 64;
        const float* W = p.in[IN_WMOD] + (size_t)l * D * DMODW + col0 + lane + (size_t)(wave * 256) * DMODW;
        float acc[9];
#pragma unroll
        for (int r = 0; r < 9; ++r) acc[r] = 0.f;
#define MV_LOAD(w, k16) do { _Pragma("unroll") for (int e = 0; e < 16; ++e) w[e] = W[(size_t)(16 * (k16) + e) * DMODW]; } while (0)
#define MV_COMP(w, k16) do { _Pragma("unroll") for (int e4 = 0; e4 < 4; ++e4) { _Pragma("unroll") for (int r = 0; r < 9; ++r) { \
            const f32x4 s = *(const LAS f32x4*)(sv + r * 2048 + wave * 256 + 16 * (k16) + 4 * e4); \
            acc[r] += (s[0] * w[4 * e4] + s[1] * w[4 * e4 + 1]) + (s[2] * w[4 * e4 + 2] + s[3] * w[4 * e4 + 3]); } } } while (0)
        float wa[16], wb[16];
        MV_LOAD(wa, 0);
#pragma unroll 1
        for (int k16 = 0; k16 < 16; k16 += 2) {
            MV_LOAD(wb, k16 + 1);
            MV_COMP(wa, k16);
            if (k16 + 2 < 16) MV_LOAD(wa, k16 + 2);
            MV_COMP(wb, k16 + 1);
        }
#undef MV_LOAD
#undef MV_COMP
#pragma unroll
        for (int r = 0; r < 9; ++r) red[(wave * 9 + r) * 64 + lane] = acc[r];
        __syncthreads();
        for (int o = tid; o < 9 * 64; o += 512) {
            const int r = o >> 6, ln = o & 63; float s = 0.f;
#pragma unroll
            for (int w = 0; w < 8; ++w) s += red[(w * 9 + r) * 64 + ln];
            MOD[((size_t)l * 9 + r) * DMODW + col0 + ln] = s + p.in[IN_BMOD][(size_t)l * DMODW + col0 + ln];
        }
    }
}

template <bool COMBINE>
__device__ __forceinline__ void norm_phase(const float* src_lat, const float* src_ctx, float* xw_ctx, const float* part, int nrows, const float* g, const float* modl, int shift_idx, int scale_idx, bf16* HN, int lane, int wave) {
    const int gw = blockIdx.x * 8 + wave, NGW = gridDim.x * 8, rpw = (nrows + NGW - 1) / NGW;
    const int rbeg = gw * rpw, rend = min(rbeg + rpw, nrows);
    if (rbeg >= rend) return;
    f32x4 v[8], nv[8];
#define NORM_LOAD(dst, row) do { const int row_ = (row); const float* xr_ = row_ < M_LAT ? src_lat + (size_t)row_ * D : src_ctx + (size_t)(row_ - M_LAT) * D; \
        _Pragma("unroll") for (int j = 0; j < 8; ++j) dst[j] = *(const f32x4*)(xr_ + 4 * lane + 256 * j); \
        if (COMBINE && row_ >= M_LAT) { _Pragma("unroll") for (int q = 0; q < 3; ++q) { const float* pr_ = part + (size_t)q * (PART_STRIDE / 4) + (size_t)(row_ - M_LAT) * D; \
            _Pragma("unroll") for (int j = 0; j < 8; ++j) dst[j] += *(const f32x4*)(pr_ + 4 * lane + 256 * j); } } } while (0)
    NORM_LOAD(v, rbeg);
    for (int row = rbeg; row < rend; ++row) {
        if (row + 1 < rend) NORM_LOAD(nv, row + 1);
        const int r = row < M_LAT ? (row >> 11) : 8;
        const float* sh = modl + (size_t)r * DMODW + shift_idx * D; const float* sc = modl + (size_t)r * DMODW + scale_idx * D;
        float ss = 0.f;
#pragma unroll
        for (int j = 0; j < 8; ++j) ss += (v[j][0] * v[j][0] + v[j][1] * v[j][1]) + (v[j][2] * v[j][2] + v[j][3] * v[j][3]);
        const float rstd = 1.0f / sqrtf(wave_sum(ss) * (1.0f / D) + EPS);
        bf16* o = HN + (size_t)row * D;
#pragma unroll
        for (int j = 0; j < 8; ++j) { const int c = 4 * lane + 256 * j; const f32x4 gg = *(const f32x4*)(g + c), s1 = *(const f32x4*)(sc + c), s0 = *(const f32x4*)(sh + c);
            const f32x4 y = (v[j] * rstd) * gg * (1.0f + s1) + s0;
            u32x2 w; w.x = pg8::cvt_pk_bf16(y[0], y[1]); w.y = pg8::cvt_pk_bf16(y[2], y[3]); *(u32x2*)(o + c) = w;
            if (COMBINE && row >= M_LAT) *(f32x4*)(xw_ctx + (size_t)(row - M_LAT) * D + c) = v[j]; }
#pragma unroll
        for (int j = 0; j < 8; ++j) v[j] = nv[j];
    }
#undef NORM_LOAD
}

__device__ __forceinline__ void even_conv_phase(const Params& p, LAS unsigned char* lds, int tid, int lane, int wave) {
    const bf16* Z3 = (const bf16*)(p.ws + WS_Z); bf16* MIX = (bf16*)(p.ws + WS_MIX);
    LAS unsigned* tile = (LAS unsigned*)lds;
    LAS float* red = (LAS float*)(lds + 62 * 2048);
    LAS float* stat = red + 256;
    const float* ccw = p.in[IN_CCW]; const float* ccb = p.in[IN_CCB]; const float* lng = p.in[IN_LNG]; const float* lnb = p.in[IN_LNB];
    const float* scw = p.in[IN_SCW]; const float* scb = p.in[IN_SCB];
    for (int u = blockIdx.x; u < 576; u += gridDim.x) {
        int base, T, t0;
        if (u < 512) { base = (u >> 6) * SEQ; T = SEQ; t0 = (u & 63) * 32; } else { const int v = u - 512; base = M_LAT + (v >> 3) * CTXL; T = CTXL; t0 = (v & 7) * 32; }
        {
            u32x4 sv[16];
#pragma unroll
            for (int q = 0; q < 16; ++q) { const int ch = tid + 512 * q, rr = min(ch >> 7, 61), cc = ch & 127, t = t0 - 15 + rr, tc = min(max(t, 0), T - 1);
                const unsigned msk = (t == tc) ? 0xffffffffu : 0u;
                sv[q] = *(const u32x4*)(Z3 + (size_t)(base + tc) * ZE_LD + 2048 + cc * 8) & msk; }
#pragma unroll
            for (int q = 0; q < 16; ++q) { const int ch = tid + 512 * q, rr = ch >> 7, cc = ch & 127; if (rr < 62) *(LAS u32x4*)(tile + rr * 512 + cc * 4) = sv[q]; }
        }
        unsigned pv[34], bgv[32];
#pragma unroll
        for (int i = 0; i < 34; ++i) { const int t = t0 - 1 + i, tc = min(max(t, 0), T - 1); const unsigned msk = (t == tc) ? 0xffffffffu : 0u; pv[i] = *(const unsigned*)(Z3 + (size_t)(base + tc) * ZE_LD + 1024 + 2 * tid) & msk; }
#pragma unroll
        for (int i = 0; i < 32; ++i) bgv[i] = *(const unsigned*)(Z3 + (size_t)(base + t0 + i) * ZE_LD + 2 * tid);
        __syncthreads();
        { const f32x2 w0 = *(const f32x2*)(scw + 2 * tid), w1 = *(const f32x2*)(scw + 1024 + 2 * tid), w2 = *(const f32x2*)(scw + 2048 + 2 * tid), b = *(const f32x2*)(scb + 2 * tid);
#pragma unroll
          for (int i = 0; i < 32; ++i) {
              const float c0 = w0[0] * bf_lo(pv[i]) + w1[0] * bf_lo(pv[i + 1]) + w2[0] * bf_lo(pv[i + 2]) + b[0];
              const float c1 = w0[1] * bf_hi(pv[i]) + w1[1] * bf_hi(pv[i + 1]) + w2[1] * bf_hi(pv[i + 2]) + b[1];
              *(unsigned*)(MIX + (size_t)(base + t0 + i) * D + 2 * tid) = pg8::cvt_pk_bf16(bf_lo(bgv[i]) * c0, bf_hi(bgv[i]) * c1); } }
        float acc[32][2];
#pragma unroll
        for (int i = 0; i < 32; ++i) { acc[i][0] = 0.f; acc[i][1] = 0.f; }
#pragma unroll 1
        for (int k = 0; k < 31; ++k) {
            const f32x2 w = *(const f32x2*)(ccw + (size_t)k * 1024 + 2 * tid);
            const LAS unsigned* tp = tile + k * 512 + tid;
#pragma unroll
            for (int i = 0; i < 32; ++i) { const unsigned v = tp[i * 512]; acc[i][0] += w[0] * bf_lo(v); acc[i][1] += w[1] * bf_hi(v); }
        }
        { const f32x2 b = *(const f32x2*)(ccb + 2 * tid);
#pragma unroll
          for (int i = 0; i < 32; ++i) { acc[i][0] += b[0]; acc[i][1] += b[1]; } }
#pragma unroll
        for (int i = 0; i < 32; ++i) { const float s = wave_sum(acc[i][0] + acc[i][1]); if (lane == 0) red[wave * 32 + i] = s; }
        __syncthreads();
        if (tid < 32) { float s = 0.f;
#pragma unroll
            for (int w = 0; w < 8; ++w) s += red[w * 32 + tid]; stat[tid] = s * (1.0f / 1024.0f); }
        __syncthreads();
#pragma unroll
        for (int i = 0; i < 32; ++i) { const float mu = stat[i]; acc[i][0] -= mu; acc[i][1] -= mu; }
        __syncthreads();
#pragma unroll
        for (int i = 0; i < 32; ++i) { const float s = wave_sum(acc[i][0] * acc[i][0] + acc[i][1] * acc[i][1]); if (lane == 0) red[wave * 32 + i] = s; }
        __syncthreads();
        if (tid < 32) { float s = 0.f;
#pragma unroll
            for (int w = 0; w < 8; ++w) s += red[w * 32 + tid]; stat[tid] = 1.0f / sqrtf(s * (1.0f / 1024.0f) + EPS); }
        __syncthreads();
        { const f32x2 g = *(const f32x2*)(lng + 2 * tid), b = *(const f32x2*)(lnb + 2 * tid);
#pragma unroll
          for (int i = 0; i < 32; ++i) { const float rs = stat[i]; const float y0 = acc[i][0] * rs * g[0] + b[0], y1 = acc[i][1] * rs * g[1] + b[1];
              *(unsigned*)(MIX + (size_t)(base + t0 + i) * D + 1024 + 2 * tid) = pg8::cvt_pk_bf16(y0 * fast_sigmoid(y0), y1 * fast_sigmoid(y1)); } }
        __syncthreads();
    }
}

struct AttnChunk { u32x4 k[2][2]; u32x2 v[4][2]; float bias[8]; };
__device__ __forceinline__ void attn_wave_unit(const Params& p, int b, int h, int r, int qg, int lane) {
    const bf16* ZO = (const bf16*)(p.ws + WS_Z); const bf16* VT = (const bf16*)(p.ws + WS_VT); bf16* MIX = (bf16*)(p.ws + WS_MIX);
    const float* rpb = p.in[IN_RPB] + (size_t)h * 15 * 31;
    const int l15 = lane & 15, g = lane >> 4;
    const int c0 = 16 * qg, qc = c0 + l15, qrow = b * SEQ + r * GW + qc;
    const int r0 = min(max(r - WIN_R / 2, 0), GROWS - WIN_R);
    const int kb = qg == 0 ? 0 : (qg == 1 ? 8 : (qg == 2 ? 24 : 32));
    const int cs = min(max(qc - WIN_C / 2, 0), GW - WIN_C);
    bf16x8 qf[2];
#pragma unroll
    for (int kk = 0; kk < 2; ++kk) qf[kk] = __builtin_bit_cast(bf16x8, *(const u32x4*)(ZO + (size_t)qrow * ZO_LD + h * HD + 8 * g + 32 * kk));
    const bf16* kbase = ZO + (size_t)l15 * ZO_LD + 1024 + h * HD + 8 * g;
    const bf16* vbase = VT + (size_t)(h * HD + l15) * M_ALL + 4 * g;
    int dcol[8]; bool okk[8];
#pragma unroll
    for (int a = 0; a < 2; ++a)
#pragma unroll
        for (int e = 0; e < 4; ++e) { const int kc = kb + 16 * a + 4 * g + e; okk[4 * a + e] = (kc >= cs) && (kc < cs + WIN_C); dcol[4 * a + e] = min(max(kc - qc + WIN_C - 1, 0), 2 * WIN_C - 2); }
#define ATT_LOAD(C, ch) do { const int ch_ = (ch); const bool loc_ = ch_ >= 8; \
        const int tok_ = loc_ ? b * SEQ + (r0 + (ch_ - 8)) * GW + kb : M_LAT + b * CTXL + 32 * ch_; \
        _Pragma("unroll") for (int a = 0; a < 2; ++a) { const bf16* kp_ = kbase + (size_t)(tok_ + 16 * a) * ZO_LD; C.k[a][0] = *(const u32x4*)kp_; C.k[a][1] = *(const u32x4*)(kp_ + 32); } \
        _Pragma("unroll") for (int d = 0; d < 4; ++d) { const bf16* vp_ = vbase + (size_t)(16 * d) * M_ALL + tok_; C.v[d][0] = *(const u32x2*)vp_; C.v[d][1] = *(const u32x2*)(vp_ + 16); } \
        if (loc_) { const float* bp_ = rpb + ((r0 + (ch_ - 8)) - r + WIN_R - 1) * 31; _Pragma("unroll") for (int e = 0; e < 8; ++e) C.bias[e] = bp_[dcol[e]]; } } while (0)
    f32x4 o[4];
#pragma unroll
    for (int d = 0; d < 4; ++d) o[d] = (f32x4){0.f, 0.f, 0.f, 0.f};
    float mrun = -1e30f, lsum = 0.f;
#define ATT_COMPUTE(C, ch) do { const bool loc_ = (ch) >= 8; f32x4 s[2]; \
        _Pragma("unroll") for (int a = 0; a < 2; ++a) { f32x4 acc_ = (f32x4){0.f, 0.f, 0.f, 0.f}; \
            acc_ = __builtin_amdgcn_mfma_f32_16x16x32_bf16(__builtin_bit_cast(bf16x8, C.k[a][0]), qf[0], acc_, 0, 0, 0); \
            acc_ = __builtin_amdgcn_mfma_f32_16x16x32_bf16(__builtin_bit_cast(bf16x8, C.k[a][1]), qf[1], acc_, 0, 0, 0); s[a] = acc_; } \
        if (loc_) { _Pragma("unroll") for (int a = 0; a < 2; ++a) _Pragma("unroll") for (int e = 0; e < 4; ++e) s[a][e] = okk[4 * a + e] ? s[a][e] + C.bias[4 * a + e] : -1e30f; } \
        float mx_ = fmaxf(fmaxf(fmaxf(s[0][0], s[0][1]), fmaxf(s[0][2], s[0][3])), fmaxf(fmaxf(s[1][0], s[1][1]), fmaxf(s[1][2], s[1][3]))); \
        mx_ = fmaxf(mx_, __shfl_xor(mx_, 16)); mx_ = fmaxf(mx_, __shfl_xor(mx_, 32)); \
        const float mnew_ = fmaxf(mrun, mx_), alpha_ = __builtin_amdgcn_exp2f((mrun - mnew_) * 1.44269504089f); mrun = mnew_; \
        float pe_[8]; float ps_ = 0.f; \
        _Pragma("unroll") for (int a = 0; a < 2; ++a) _Pragma("unroll") for (int e = 0; e < 4; ++e) { pe_[4 * a + e] = __builtin_amdgcn_exp2f((s[a][e] - mnew_) * 1.44269504089f); ps_ += pe_[4 * a + e]; } \
        lsum = lsum * alpha_ + ps_; \
        u32x4 pw_; pw_.x = pg8::cvt_pk_bf16(pe_[0], pe_[1]); pw_.y = pg8::cvt_pk_bf16(pe_[2], pe_[3]); pw_.z = pg8::cvt_pk_bf16(pe_[4], pe_[5]); pw_.w = pg8::cvt_pk_bf16(pe_[6], pe_[7]); \
        const bf16x8 pf_ = __builtin_bit_cast(bf16x8, pw_); \
        _Pragma("unroll") for (int d = 0; d < 4; ++d) { u32x4 vw_; vw_.x = C.v[d][0].x; vw_.y = C.v[d][0].y; vw_.z = C.v[d][1].x; vw_.w = C.v[d][1].y; \
            o[d] = o[d] * alpha_; o[d] = __builtin_amdgcn_mfma_f32_16x16x32_bf16(__builtin_bit_cast(bf16x8, vw_), pf_, o[d], 0, 0, 0); } } while (0)
    AttnChunk A, B;
    ATT_LOAD(A, 0);
#pragma unroll 1
    for (int ch = 0; ch < 16; ch += 2) {
        ATT_LOAD(B, ch + 1);
        ATT_COMPUTE(A, ch);
        if (ch + 2 < 16) ATT_LOAD(A, ch + 2);
        ATT_COMPUTE(B, ch + 1);
    }
#undef ATT_LOAD
#undef ATT_COMPUTE
    lsum += __shfl_xor(lsum, 16); lsum += __shfl_xor(lsum, 32);
    const float inv = 1.0f / lsum;
#pragma unroll
    for (int d = 0; d < 4; ++d) { u32x2 w; w.x = pg8::cvt_pk_bf16(o[d][0] * inv, o[d][1] * inv); w.y = pg8::cvt_pk_bf16(o[d][2] * inv, o[d][3] * inv);
        *(u32x2*)(MIX + (size_t)qrow * D + h * HD + 16 * d + 4 * g) = w; }
}
__device__ __forceinline__ void attn_phase(const Params& p, int lane, int wave) {
    const int cls = blockIdx.x & 7, wgi = blockIdx.x >> 3, ncl = (gridDim.x - cls + 7) >> 3, nW = ncl * 8;
    if (gridDim.x >= 8) {
        for (int v = wgi * 8 + wave; v < NH * GROWS * 4; v += nW) { const int h = v >> 7, rem = v & 127; attn_wave_unit(p, cls, h, rem >> 2, rem & 3, lane); }
    } else {
        for (int v = blockIdx.x * 8 + wave; v < NBATCH * NH * GROWS * 4; v += gridDim.x * 8) { const int b = v >> 11, w = v & 2047, h = w >> 7, rem = w & 127; attn_wave_unit(p, b, h, rem >> 2, rem & 3, lane); }
    }
}

__device__ __forceinline__ float gelu_tanh(float x) { const float z = 0.7978845608028654f * (x + 0.044715f * x * x * x); return x * fast_sigmoid(2.0f * z); }
constexpr int LCH = 256;
__device__ __forceinline__ void lru_item(const Params& p, LAS unsigned char* lds, int item, int tid, int lane, int wave) {
    const bf16* ZO = (const bf16*)(p.ws + WS_Z); float* HF = (float*)(p.ws + WS_HF); bf16* MIX = (bf16*)(p.ws + WS_MIX);
    const int b = item >> 5, n = (item >> 1) & 15, half = item & 1, j0 = half * 32;
    LAS float* xcf = (LAS float*)lds;
    LAS bf16* xcb = (LAS bf16*)(lds + LCH * 33 * 4);
    LAS float* As = (LAS float*)(lds + LCH * 33 * 4 + LCH * 72 * 2);
    LAS float* Us = As + LCH * 33;
    LAS float* segA = Us + LCH * 33;
    LAS float* segH = segA + 16 * 32;
    const int ci = lane, cch = n * 64 + ci;
    const float* lcw = p.in[IN_LCW]; const float cw0 = lcw[cch], cw1 = lcw[1024 + cch], cw2 = lcw[2048 + cch], cw3 = lcw[3072 + cch], cb = p.in[IN_LCB][cch];
    const bool own = (ci >> 5) == half;
    const int jb = wave & 1, tb0 = (wave >> 1) * 4, l15 = lane & 15, g = lane >> 4, jl = 16 * jb + l15, gch = n * 64 + j0 + jl;
    const int sc = lane & 31, hi = lane >> 5, sg = 2 * wave + hi;
    const unsigned och = (unsigned)(n * 64 + j0 + sc);
    for (int dir = 0; dir < 2; ++dir) {
        bf16x8 Bg[2][2];
        {
            const float* gw = p.in[IN_LGW] + (size_t)((dir * 2) * 16 + n) * 4096;
#pragma unroll
            for (int gt = 0; gt < 2; ++gt)
#pragma unroll
                for (int kk = 0; kk < 2; ++kk) { const float* wp = gw + (size_t)gt * 16 * 4096 + (size_t)(8 * g + 32 * kk) * 64 + j0 + jl;
                    u32x4 w; w.x = pk2(wp[0], wp[64]); w.y = pk2(wp[128], wp[192]); w.z = pk2(wp[256], wp[320]); w.w = pk2(wp[384], wp[448]); Bg[gt][kk] = __builtin_bit_cast(bf16x8, w); }
        }
        const float br = p.in[IN_LGB][(dir * 2 + 0) * 1024 + gch], bi = p.in[IN_LGB][(dir * 2 + 1) * 1024 + gch];
        const float lam = p.in[IN_LAM][dir * 1024 + gch];
        const float sp8 = -8.0f * log1pf(expf(-lam)) * 1.44269504089f;
        float carry = 0.f;
        const unsigned hoff = (unsigned)((dir == 0 ? 16 * hi : 16 * (1 - hi)) * 1024) + och;
        const unsigned moff = (unsigned)((dir == 0 ? 16 * hi : 16 * (1 - hi)) * D) + 1024u + och;
        const unsigned goff = (unsigned)((dir == 0 ? 16 * hi : 16 * (1 - hi)) * ZO_LD) + 4096u + och;
        u32x4 xraw[5];
#define LRU_LOADX(cidx_) do { const int ci_ = (cidx_); const bool isctx_ = ci_ < 1; const int cc_ = isctx_ ? 0 : ci_ - 1, ncs_ = isctx_ ? 1 : 8, cpos_ = dir == 0 ? cc_ : ncs_ - 1 - cc_; \
        const int base_ = isctx_ ? M_LAT + b * CTXL : b * SEQ, T_ = isctx_ ? CTXL : SEQ, ts_ = cpos_ * LCH - 1; \
        _Pragma("unroll") for (int q = 0; q < 5; ++q) { const int pc = min(q * 512 + tid, 2071), t = ts_ + (pc >> 3), tc = min(max(t, 0), T_ - 1); const unsigned msk = (t == tc) ? 0xffffffffu : 0u; \
            xraw[q] = *(const u32x4*)(ZO + (size_t)(base_ + tc) * ZO_LD + 3072 + n * 64 + (pc & 7) * 8) & msk; } } while (0)
        LRU_LOADX(0);
        LAS unsigned char* rawt = (LAS unsigned char*)As;
#pragma unroll 1
        for (int cidx = 0; cidx < 9; ++cidx) {
            const bool isctx = cidx < 1;
            const int cc = isctx ? 0 : cidx - 1, ncs = isctx ? 1 : 8, cpos = dir == 0 ? cc : ncs - 1 - cc;
            const int base = isctx ? M_LAT + b * CTXL : b * SEQ, t0 = cpos * LCH;
#pragma unroll
            for (int q = 0; q < 5; ++q) { const int pc = q * 512 + tid; if (pc < 2072) *(LAS u32x4*)(rawt + pc * 16) = xraw[q]; }
            __syncthreads();
            {
                float xf[35];
                const LAS unsigned short* rp_ = (const LAS unsigned short*)(rawt + (32 * wave) * 128) + ci;
#pragma unroll
                for (int e = 0; e < 35; ++e) xf[e] = __builtin_bit_cast(float, (unsigned)rp_[e * 64] << 16);
                LAS bf16* xb_ = xcb + (32 * wave) * 72 + ci; LAS float* xf_ = xcf + (32 * wave) * 33 + (ci & 31);
#pragma unroll
                for (int e = 0; e < 32; ++e) { const float y = cw0 * xf[e] + cw1 * xf[e + 1] + cw2 * xf[e + 2] + cw3 * xf[e + 3] + cb;
                    xb_[e * 72] = (bf16)f2bf(y); if (own) xf_[e * 33] = y; }
            }
            if (cidx + 1 < 9) LRU_LOADX(cidx + 1);
            __syncthreads();
#pragma unroll 1
            for (int q = 0; q < 4; ++q) {
                const int tb = tb0 + q;
                const bf16x8 a0 = *(const LAS bf16x8*)(xcb + (16 * tb + l15) * 72 + 8 * g), a1 = *(const LAS bf16x8*)(xcb + (16 * tb + l15) * 72 + 8 * g + 32);
                f32x4 gr_ = (f32x4){0.f, 0.f, 0.f, 0.f}, gi_ = (f32x4){0.f, 0.f, 0.f, 0.f};
                gr_ = __builtin_amdgcn_mfma_f32_16x16x32_bf16(a0, Bg[0][0], gr_, 0, 0, 0); gr_ = __builtin_amdgcn_mfma_f32_16x16x32_bf16(a1, Bg[0][1], gr_, 0, 0, 0);
                gi_ = __builtin_amdgcn_mfma_f32_16x16x32_bf16(a0, Bg[1][0], gi_, 0, 0, 0); gi_ = __builtin_amdgcn_mfma_f32_16x16x32_bf16(a1, Bg[1][1], gi_, 0, 0, 0);
#pragma unroll
                for (int e = 0; e < 4; ++e) {
                    const int tl = 16 * tb + 4 * g + e;
                    const float rg = fast_sigmoid(gr_[e] + br), ig = fast_sigmoid(gi_[e] + bi);
                    const float la2 = sp8 * rg, a = __builtin_amdgcn_exp2f(la2);
                    const float x2 = la2 * 1.38629436112f;
                    const float em = x2 > -0.25f ? -x2 * (1.0f + x2 * (0.5f + x2 * (0.16666667f + x2 * (0.041666668f + x2 * 0.0083333338f)))) : 1.0f - a * a;
                    As[tl * 33 + jl] = a; Us[tl * 33 + jl] = sqrtf(em) * ig * xcf[tl * 33 + jl];
                }
            }
            __syncthreads();
            float av[16], uv[16];
            {
                float A = 1.f, H = 0.f;
                const LAS float* ap_ = As + (dir ? (LCH - 1 - 16 * sg) : 16 * sg) * 33 + sc; const LAS float* up_ = Us + (dir ? (LCH - 1 - 16 * sg) : 16 * sg) * 33 + sc;
#pragma unroll
                for (int e = 0; e < 16; ++e) { av[e] = dir ? ap_[-e * 33] : ap_[e * 33]; uv[e] = dir ? up_[-e * 33] : up_[e * 33]; H = av[e] * H + uv[e]; A *= av[e]; }
                segA[sg * 32 + sc] = A; segH[sg * 32 + sc] = H;
            }
            const int rbase = dir == 0 ? base + t0 + 32 * wave : base + t0 + LCH - 1 - 32 * wave - 16;
            float hfv[16]; unsigned grv[16];
            if (!isctx && dir == 1) {
                const float* hp_ = HF + (size_t)rbase * 1024; const bf16* gp_ = ZO + (size_t)rbase * ZO_LD;
#pragma unroll
                for (int e = 0; e < 16; ++e) { hfv[e] = (hp_ - (size_t)e * 1024)[hoff]; grv[e] = (unsigned)(gp_ - (size_t)e * ZO_LD)[goff]; }
            }
            __syncthreads();
            {
                float hin = carry, mine = 0.f;
#pragma unroll
                for (int s2 = 0; s2 < 16; ++s2) { if (s2 == sg) mine = hin; hin = segA[s2 * 32 + sc] * hin + segH[s2 * 32 + sc]; }
                carry = hin;
                if (!isctx) {
                    float hcur = mine;
                    if (dir == 0) {
                        float* hp_ = HF + (size_t)rbase * 1024;
#pragma unroll
                        for (int e = 0; e < 16; ++e) { hcur = av[e] * hcur + uv[e]; (hp_ + (size_t)e * 1024)[hoff] = hcur; }
                    } else {
                        bf16* mp_ = MIX + (size_t)rbase * D;
#pragma unroll
                        for (int e = 0; e < 16; ++e) { hcur = av[e] * hcur + uv[e];
                            (mp_ - (size_t)e * D)[moff] = (bf16)f2bf((hfv[e] + hcur) * gelu_tanh(__builtin_bit_cast(float, grv[e] << 16))); }
                    }
                }
            }
        }
#undef LRU_LOADX
        VM_WAIT(); __syncthreads();
    }
}


#if MK_SPLIT
#define GRID_BAR() do { } while (0)
#else
#define GRID_BAR() xcd_barrier(bar)
#endif
#ifndef PH_MASK
#define PH_MASK 0xffffffffu
#endif
#define IN(k) (lo <= (k) && (k) < hi && ((PH_MASK >> (k)) & 1u))
#ifndef PROBE_MASK
#define PROBE_MASK 0u
#endif
#ifndef PROBE_MULT
#define PROBE_MULT 4
#endif
#if PROBE_MASK
#define PROBE_STAMP(k) do { if (blockIdx.x == 0 && threadIdx.x == 0) { volatile LAS unsigned long long* pw = (volatile LAS unsigned long long*)(lds + MISC_OFF + 128); \
        const unsigned long long t_ = __builtin_amdgcn_s_memrealtime(); if ((PROBE_MASK >> (k)) & 1u) pw[1] += t_ - pw[0]; pw[0] = t_; } } while (0)
#else
#define PROBE_STAMP(k) do { } while (0)
#endif
#define SEAM(k) do { if (IN(k) && IN((k) + 1)) GRID_BAR(); PROBE_STAMP(k); } while (0)

template <int L>
__device__ __forceinline__ void layer_body(const Params& p, LAS unsigned char* lds, const XcdBarrier& bar, const int lo, const int hi) {
    constexpr int l = L;
    const int tid = threadIdx.x, lane = tid & 63, wave = __builtin_amdgcn_readfirstlane(tid >> 6);
    const int G = gridDim.x;
    float* MOD = (float*)(p.ws + WS_MOD);
    float* X = (float*)(p.ws + WS_X);
    bf16* HN = (bf16*)(p.ws + WS_HN);
    bf16* ACT = (bf16*)(p.ws + WS_ACT);
    bf16* Z = (bf16*)(p.ws + WS_Z);
    bf16* MIX = (bf16*)(p.ws + WS_MIX);
    float* PART = (float*)(p.ws + WS_PART);
        const int pb = 1 + 10 * l;
        const float* modl = MOD + (size_t)l * 9 * DMODW;
        const float* ng = p.in[IN_NORMG] + (size_t)l * 3 * D;
        constexpr bool first = (l == 0);
        const float* xs_lat = first ? p.in[IN_X] : X; const float* xs_ctx = first ? p.in[IN_CTX] : X + (size_t)M_LAT * D;

        if (IN(pb + 0)) norm_phase<!first>(xs_lat, xs_ctx, X + (size_t)M_LAT * D, PART, M_ALL, ng + 0 * D, modl, 0, 1, HN, lane, wave);
        SEAM(pb + 0);
        if (IN(pb + 1)) {
            SchedStd S{(const char*)HN, (const char*)(p.ws + WS_WFI + (size_t)(l * 2 + 0) * WFI_STRIDE), (size_t)256 * D * 2, M_ALL / 256, 2 * DFF / 256, G, (int)blockIdx.x, D / 64};
            EpiSwiGLU E{ACT};
            pg8::gemm_phase<EpiSwiGLU, SchedStd>(lds, D, S, E);
        }
        SEAM(pb + 1);
        if (IN(pb + 2)) {
            SchedDown S{(const char*)ACT, (const char*)(p.ws + WS_WFO + (size_t)(l * 2 + 0) * WFO_STRIDE), (size_t)256 * DFF * 2, G, (int)blockIdx.x, DFF / 64};
            EpiResid E{xs_lat, xs_ctx, X, modl + 2 * D, 0.5f, PART};
            pg8::gemm_phase<EpiResid, SchedDown>(lds, DFF, S, E);
        }
        SEAM(pb + 2);
        if (IN(pb + 3)) norm_phase<true>(X, X + (size_t)M_LAT * D, X + (size_t)M_LAT * D, PART, M_ALL, ng + 1 * D, modl, 3, 4, HN, lane, wave);
        SEAM(pb + 3);
        if constexpr (first) {
            if (IN(pb + 4)) {
                SchedStd S{(const char*)HN, (const char*)(p.ws + WS_WEI), (size_t)256 * D * 2, M_ALL / 256, D_EIN / 256, G, (int)blockIdx.x, D / 64};
                EpiEvIn E{Z};
                pg8::gemm_phase<EpiEvIn, SchedStd>(lds, D, S, E);
            }
            SEAM(pb + 4);
            if (IN(pb + 5)) even_conv_phase(p, lds, tid, lane, wave);
            SEAM(pb + 5);
            if (IN(pb + 6)) {
                SchedDown S{(const char*)MIX, (const char*)(p.ws + WS_WEO), (size_t)256 * D * 2, G, (int)blockIdx.x, D / 64};
                EpiResid E{X, X + (size_t)M_LAT * D, X, modl + 5 * D, 1.0f, PART};
                pg8::gemm_phase<EpiResid, SchedDown>(lds, D, S, E);
            }
            SEAM(pb + 6);
        } else {
            if (IN(pb + 4)) {
                SchedOdIn S{(const char*)HN, (const char*)(p.ws + WS_WOI), (size_t)256 * D * 2, G, (int)blockIdx.x};
                EpiOdIn E{Z, (bf16*)(p.ws + WS_VT), p.in[IN_QG], p.in[IN_KG]};
                pg8::gemm_phase<EpiOdIn, SchedOdIn>(lds, D, S, E);
            }
            SEAM(pb + 4);
            if (IN(pb + 5)) {
#ifndef NO_LRU
                for (int item = blockIdx.x; item < 256; item += G) lru_item(p, lds, item, tid, lane, wave);
#endif
#ifndef NO_ATTN
                attn_phase(p, lane, wave);
#endif
            }
            SEAM(pb + 5);
            if (IN(pb + 6)) {
                SchedStd S{(const char*)MIX, (const char*)(p.ws + WS_WOO), (size_t)256 * D * 2, M_LAT / 256, D / 256, G, (int)blockIdx.x, D / 64};
                EpiResid E{X, X + (size_t)M_LAT * D, X, modl + 5 * D, 1.0f, PART};
                pg8::gemm_phase<EpiResid, SchedStd>(lds, D, S, E);
            }
            SEAM(pb + 6);
        }
        const int nrows2 = first ? M_ALL : M_LAT;
        if (IN(pb + 7)) norm_phase<first>(X, X + (size_t)M_LAT * D, X + (size_t)M_LAT * D, PART, nrows2, ng + 2 * D, modl, 6, 7, HN, lane, wave);
        SEAM(pb + 7);
        if (IN(pb + 8)) {
            SchedStd S{(const char*)HN, (const char*)(p.ws + WS_WFI + (size_t)(l * 2 + 1) * WFI_STRIDE), (size_t)256 * D * 2, nrows2 / 256, 2 * DFF / 256, G, (int)blockIdx.x, D / 64};
            EpiSwiGLU E{ACT};
            pg8::gemm_phase<EpiSwiGLU, SchedStd>(lds, D, S, E);
        }
        SEAM(pb + 8);
        if (IN(pb + 9)) {
            if constexpr (first) {
                SchedDown S{(const char*)ACT, (const char*)(p.ws + WS_WFO + (size_t)(l * 2 + 1) * WFO_STRIDE), (size_t)256 * DFF * 2, G, (int)blockIdx.x, DFF / 64};
                EpiResid E{X, X + (size_t)M_LAT * D, X, modl + 8 * D, 0.5f, PART};
                pg8::gemm_phase<EpiResid, SchedDown>(lds, DFF, S, E);
            } else {
                SchedStd S{(const char*)ACT, (const char*)(p.ws + WS_WFO + (size_t)(l * 2 + 1) * WFO_STRIDE), (size_t)256 * DFF * 2, M_LAT / 256, D / 256, G, (int)blockIdx.x, DFF / 64};
                EpiResid E{X, X + (size_t)M_LAT * D, p.out, modl + 8 * D, 0.5f, PART};
                pg8::gemm_phase<EpiResid, SchedStd>(lds, DFF, S, E);
            }
        }
        SEAM(pb + 9);
}
__global__ void __launch_bounds__(512, 2) mega_fwd(Params p) {
    extern __shared__ __attribute__((aligned(16))) unsigned char lds_raw[];
    LAS unsigned char* lds = (LAS unsigned char*)lds_raw;
    volatile LAS unsigned* MISC = (volatile LAS unsigned*)(lds + MISC_OFF);
    const int tid = threadIdx.x, lane = tid & 63, wave = __builtin_amdgcn_readfirstlane(tid >> 6);
    const int G = gridDim.x;
    if (tid < 64) MISC[tid] = 0u;
    __syncthreads();
    unsigned* ctl = (unsigned*)(p.ws + WS_CTL);
#if MK_SPLIT
    XcdBarrier bar; bar.bar = ctl + CW_BAR; bar.x = 0; bar.st = MISC + 8;
#else
    XcdBarrier bar = xcd_barrier_post(ctl + CW_BAR, MISC + 8);
#endif
    const int lo = p.ph_lo, hi = p.ph_hi;
#if PROBE_MASK
    if (blockIdx.x == 0 && tid == 0) { volatile LAS unsigned long long* pw = (volatile LAS unsigned long long*)(lds + MISC_OFF + 128); pw[0] = __builtin_amdgcn_s_memrealtime(); pw[1] = 0ull; }
#endif

    float* MOD = (float*)(p.ws + WS_MOD);
    float* X = (float*)(p.ws + WS_X);
    bf16* HN = (bf16*)(p.ws + WS_HN);
    bf16* ACT = (bf16*)(p.ws + WS_ACT);
    bf16* Z = (bf16*)(p.ws + WS_Z);
    bf16* MIX = (bf16*)(p.ws + WS_MIX);

    if (IN(0)) {
#ifndef NO_WEIGHTS
        p0_weights(p, lds, lane, wave); __syncthreads();
#endif
#ifndef NO_MODVEC
        p0_modvec(p, lds, tid, lane, wave); __syncthreads();
#endif
    }
    SEAM(0);

    layer_body<0>(p, lds, bar, lo, hi);
    layer_body<1>(p, lds, bar, lo, hi);
#if PROBE_MASK
    if (blockIdx.x == 0 && tid == 0) { volatile LAS unsigned long long* pw = (volatile LAS unsigned long long*)(lds + MISC_OFF + 128); const unsigned long long t0 = __builtin_amdgcn_s_memrealtime(), dt = (unsigned long long)PROBE_MULT * pw[1];
        while (__builtin_amdgcn_s_memrealtime() - t0 < dt) __builtin_amdgcn_s_sleep(8); }
#endif
#undef IN
#undef SEAM
#undef GRID_BAR
}

extern "C" void kernel_launch(void* const* d_in, const int* in_sizes, int n_in, void* d_out, int out_size, void* d_ws, size_t ws_size, hipStream_t stream) {
    static int grid = 0;
    if (grid == 0) {
        if (n_in != 27 || in_sizes[0] != M_LAT * D || out_size != M_LAT * D || ws_size < WS_END) {
            fprintf(stderr, "kernel_launch: unexpected shapes (n_in %d, in0 %d, out %d, ws %zu; need ws >= %zu); nothing launched\n", n_in, n_in > 0 ? in_sizes[0] : -1, out_size, ws_size, (size_t)WS_END); grid = -1; return; }
        int dev = 0, cus = 0, per_cu = 0;
        if (hipGetDevice(&dev) != hipSuccess || hipDeviceGetAttribute(&cus, hipDeviceAttributeMultiprocessorCount, dev) != hipSuccess) { fprintf(stderr, "kernel_launch: device query failed\n"); grid = -1; return; }
        if (hipFuncSetAttribute((const void*)mega_fwd, hipFuncAttributeMaxDynamicSharedMemorySize, LDS_BYTES) != hipSuccess) { fprintf(stderr, "kernel_launch: hipFuncSetAttribute failed\n"); grid = -1; return; }
        if (hipOccupancyMaxActiveBlocksPerMultiprocessor(&per_cu, (const void*)mega_fwd, 512, LDS_BYTES) != hipSuccess || per_cu < 1) {
            fprintf(stderr, "kernel_launch: occupancy query reports %d workgroups per CU\n", per_cu); }
        (void)hipGetLastError();
        grid = cus;
    }
    if (grid < 0) return;
    if (hipMemsetAsync((char*)d_ws + WS_CTL, 0, CTL_ZERO_BYTES, stream) != hipSuccess) { fprintf(stderr, "kernel_launch: memset failed\n"); return; }
    Params a{};
    for (int i = 0; i < 27; ++i) a.in[i] = (const float*)d_in[i];
    a.out = (float*)d_out; a.ws = (unsigned char*)d_ws;
#if MK_SPLIT
    for (int ph = 0; ph < NPHASE; ++ph) { a.ph_lo = ph; a.ph_hi = ph + 1; hipLaunchKernelGGL(mega_fwd, dim3(grid), dim3(512), LDS_BYTES, stream, a); }
#else
    a.ph_lo = 0; a.ph_hi = NPHASE;
    hipLaunchKernelGGL(mega_fwd, dim3(grid), dim3(512), LDS_BYTES, stream, a);
#endif
    const hipError_t le = hipPeekAtLastError();
    if (le != hipSuccess) fprintf(stderr, "kernel_launch: launch failed: %s\n", hipGetErrorName(le));
}
```

```cpp
#include <hip/hip_runtime.h>
#include <cstdio>
#include <cstdint>

#ifndef MK_SPLIT
#define MK_SPLIT 0
#endif

namespace pg8 {
#define PG8_LAS __attribute__((address_space(3)))
typedef unsigned short bf16_t;
typedef short bf16x8 __attribute__((ext_vector_type(8)));
typedef float f32x4 __attribute__((ext_vector_type(4)));
typedef unsigned u32x4 __attribute__((ext_vector_type(4)));
typedef unsigned u32x2 __attribute__((ext_vector_type(2)));
constexpr int BM = 256, BK = 64, HALF = 128, HTB = HALF * BK * 2  , STAGE_BYTES = 8 * HTB, NXCD = 8, WGM = 8;

__host__ __device__ __forceinline__ int lds_byte(int r, int c) { const int st = (r >> 4) * 2 + (c >> 5), rr = r & 15, cc = c & 31, ob = rr * 64 + cc * 2; return st * 1024 + (ob ^ (((ob >> 9) & 1) << 5)); }
__host__ __device__ __forceinline__ void stage_rc(int b, int& R, int& C) { const int st = b / 1024, sb = b % 1024, swz = sb ^ (((sb >> 9) & 1) << 5); R = (st >> 1) * 16 + swz / 64; C = (st & 1) * 32 + (swz % 64) / 2; }
__host__ __device__ __forceinline__ int perm32(int rho) { const int n = rho >> 4, i = rho & 15; return 8 * (i >> 2) + 4 * n + (i & 3); }

struct Unit { int pm, pn, kind; };

__host__ __device__ __forceinline__ void tile_map(int wgid, int nM, int nN, int& pm, int& pn) {
    const int nwg = nM * nN;
    { const int q = nwg / NXCD, r = nwg % NXCD, xcd = wgid % NXCD, off = wgid / NXCD; wgid = (xcd < r ? xcd * (q + 1) : r * (q + 1) + (xcd - r) * q) + off; }
    const int nig = WGM * nN, gid = wgid / nig, fm = gid * WGM, gsz = (nM - fm) < WGM ? (nM - fm) : WGM;
    pm = fm + ((wgid % nig) % gsz); pn = (wgid % nig) / gsz;
}

__device__ __forceinline__ unsigned cvt_pk_bf16(float lo, float hi) { unsigned r; asm volatile("v_cvt_pk_bf16_f32 %0, %1, %2" : "=v"(r) : "v"(lo), "v"(hi)); return r; }

template <class Epi, class Sched, bool ALIGN_EPI = true, bool SP2 = true>
__device__ __forceinline__ void gemm_phase(PG8_LAS unsigned char* lds, const int K  , const Sched& S, const Epi& E) {
    const int tid = threadIdx.x, wid = __builtin_amdgcn_readfirstlane(tid >> 6), lane = tid & 63, wr = wid >> 2, wc = wid & 3, fr = lane & 15, fq = lane >> 4;
    unsigned voffA[2], voffB[2];
#pragma unroll
    for (int i = 0; i < 2; ++i) { int R, C; stage_rc(tid * 16 + i * 8192, R, C); const int Rb = Epi::PERM ? ((R & ~31) + perm32(R & 31)) : R;
        voffA[i] = (unsigned)(R * K + C) * 2u; voffB[i] = (unsigned)(Rb * K + C) * 2u; }
    const size_t kstep = (size_t)(BK * 2);
    const size_t hstep = (size_t)HALF * K * 2;
    const unsigned ldsw = (unsigned)wid * 1024u;
    const int aoff = lds_byte(wr * 64 + fr, fq * 8), boff = lds_byte(wc * 32 + fr, fq * 8);
#define PG8_SA(b, h) (((b) * 2 + (h)) * HTB)
#define PG8_SB(b, h) ((4 + (b) * 2 + (h)) * HTB)
#define PG8_STAGE(bufoff, gbase, voff) do { _Pragma("unroll") for (int _i = 0; _i < 2; ++_i) \
        __builtin_amdgcn_global_load_lds((const unsigned*)((const char*)(gbase) + (voff)[_i]), (PG8_LAS unsigned*)(lds + (bufoff) + ldsw + _i * 8192), 16, 0, 0); } while (0)
#define PG8_LDA(dst, b, h) do { _Pragma("unroll") for (int m = 0; m < 4; ++m) _Pragma("unroll") for (int k = 0; k < 2; ++k) dst[m][k] = *(const PG8_LAS bf16x8*)(lds + PG8_SA(b, h) + aoff + m * 2048 + k * 1024); } while (0)
#define PG8_LDB(dst, b, h) do { _Pragma("unroll") for (int n = 0; n < 2; ++n) _Pragma("unroll") for (int k = 0; k < 2; ++k) dst[n][k] = *(const PG8_LAS bf16x8*)(lds + PG8_SB(b, h) + boff + n * 2048 + k * 1024); } while (0)
#define PG8_MMA(ai, bj, At, Bt) do { __builtin_amdgcn_s_setprio(1); _Pragma("unroll") for (int m = 0; m < 4; ++m) _Pragma("unroll") for (int n = 0; n < 2; ++n) _Pragma("unroll") for (int k = 0; k < 2; ++k) \
        acc[ai][bj][m][n] = __builtin_amdgcn_mfma_f32_16x16x32_bf16(Bt[n][k], At[m][k], acc[ai][bj][m][n], 0, 0, 0); __builtin_amdgcn_s_setprio(0); } while (0)
#define PG8_WAIT_V(n) asm volatile("s_waitcnt vmcnt(" #n ")" ::: "memory")
#define PG8_WAIT_L(n) asm volatile("s_waitcnt lgkmcnt(" #n ")" ::: "memory")
#define PG8_BAR __builtin_amdgcn_s_barrier()
#define PG8_SCHED __builtin_amdgcn_sched_barrier(0)
    Unit cur, nxt; int ui = 0;
    if (!S.next(0, cur)) return;
    f32x4 acc[2][2][4][2];
#pragma unroll
    for (int a = 0; a < 2; ++a)
#pragma unroll
        for (int b = 0; b < 2; ++b)
#pragma unroll
            for (int m = 0; m < 4; ++m)
#pragma unroll
                for (int n = 0; n < 2; ++n) acc[a][b][m][n] = (f32x4){0.f, 0.f, 0.f, 0.f};
    bf16x8 At[4][2], B0[2][2], B1[2][2];
    const char* cA = S.a_base(cur); const char* cB = S.b_base(cur);
    if constexpr (SP2) {
        PG8_STAGE(PG8_SB(0, 0), cB, voffB); PG8_STAGE(PG8_SB(0, 1), cB + hstep, voffB); PG8_STAGE(PG8_SA(0, 0), cA, voffA); PG8_STAGE(PG8_SA(0, 1), cA + hstep, voffA);
        if (wr == 1) PG8_BAR;
        PG8_WAIT_V(2); PG8_BAR;
        PG8_STAGE(PG8_SB(1, 0), cB + kstep, voffB); PG8_STAGE(PG8_SA(1, 0), cA + kstep, voffA); PG8_STAGE(PG8_SB(1, 1), cB + hstep + kstep, voffB);
        PG8_WAIT_V(6); PG8_BAR;
    } else {
        PG8_STAGE(PG8_SB(0, 0), cB, voffB); PG8_STAGE(PG8_SA(0, 0), cA, voffA); PG8_STAGE(PG8_SB(0, 1), cB + hstep, voffB); PG8_STAGE(PG8_SA(0, 1), cA + hstep, voffA);
        if (wr == 1) PG8_BAR;
        PG8_WAIT_V(4); PG8_BAR;
        PG8_STAGE(PG8_SB(1, 0), cB + kstep, voffB); PG8_STAGE(PG8_SA(1, 0), cA + kstep, voffA); PG8_STAGE(PG8_SB(1, 1), cB + hstep + kstep, voffB);
        PG8_WAIT_V(6); PG8_BAR;
    }
    for (;;) {
        const bool has_next = S.next(ui + 1, nxt);
        const int nt = S.nt(cur);
        const char* nA = has_next ? S.a_base(nxt) : cA; const char* nB = has_next ? S.b_base(nxt) : cB;
        for (int t = 0; t < nt; t += 2) {
            const bool last = (t == nt - 2);
            const char* a1 = cA + (size_t)(t + 1) * kstep;
            const char* a2 = last ? nA : cA + (size_t)(t + 2) * kstep; const char* b2 = last ? nB : cB + (size_t)(t + 2) * kstep;
            const char* a3 = a2 + kstep; const char* b3 = b2 + kstep;
            if constexpr (SP2) {
            PG8_LDB(B0, 0, 0); PG8_LDB(B1, 0, 1); PG8_SCHED; PG8_LDA(At, 0, 0); PG8_STAGE(PG8_SA(1, 1), a1 + hstep, voffA);
            PG8_WAIT_V(8); PG8_WAIT_L(0); PG8_BAR; PG8_MMA(0, 0, At, B0); PG8_MMA(0, 1, At, B1); PG8_BAR; PG8_SCHED;
            PG8_LDA(At, 0, 1); PG8_STAGE(PG8_SB(0, 0), b2, voffB); PG8_STAGE(PG8_SB(0, 1), b2 + hstep, voffB); PG8_STAGE(PG8_SA(0, 0), a2, voffA);
            PG8_WAIT_V(8); PG8_WAIT_L(0); PG8_BAR; PG8_MMA(1, 0, At, B0); PG8_MMA(1, 1, At, B1); PG8_BAR; PG8_SCHED;
            PG8_LDB(B0, 1, 0); PG8_LDB(B1, 1, 1); PG8_SCHED; PG8_LDA(At, 1, 0); PG8_STAGE(PG8_SA(0, 1), a2 + hstep, voffA);
            PG8_WAIT_V(8); PG8_WAIT_L(0); PG8_BAR; PG8_MMA(0, 0, At, B0); PG8_MMA(0, 1, At, B1); PG8_BAR; PG8_SCHED;
            PG8_LDA(At, 1, 1); PG8_STAGE(PG8_SB(1, 0), b3, voffB); PG8_STAGE(PG8_SB(1, 1), b3 + hstep, voffB); PG8_STAGE(PG8_SA(1, 0), a3, voffA);
            PG8_WAIT_V(8); PG8_WAIT_L(0); PG8_BAR; PG8_MMA(1, 0, At, B0); PG8_MMA(1, 1, At, B1); PG8_BAR; PG8_SCHED;
            } else {
            PG8_LDB(B0, 0, 0); PG8_SCHED; PG8_LDA(At, 0, 0); PG8_STAGE(PG8_SA(1, 1), a1 + hstep, voffA);
            PG8_WAIT_L(8); PG8_BAR; PG8_WAIT_L(0); PG8_MMA(0, 0, At, B0); PG8_BAR; PG8_SCHED;
            PG8_LDB(B1, 0, 1); PG8_STAGE(PG8_SB(0, 0), b2, voffB);
            PG8_BAR; PG8_WAIT_L(0); PG8_MMA(0, 1, At, B1); PG8_BAR;
            PG8_LDA(At, 0, 1); PG8_STAGE(PG8_SA(0, 0), a2, voffA);
            PG8_BAR; PG8_WAIT_L(0); PG8_MMA(1, 0, At, B0); PG8_BAR; PG8_SCHED;
            PG8_STAGE(PG8_SB(0, 1), b2 + hstep, voffB);
            PG8_WAIT_V(6); PG8_BAR; PG8_MMA(1, 1, At, B1); PG8_BAR;
            PG8_LDB(B0, 1, 0); PG8_SCHED; PG8_LDA(At, 1, 0); PG8_STAGE(PG8_SA(0, 1), a2 + hstep, voffA);
            PG8_WAIT_L(8); PG8_BAR; PG8_WAIT_L(0); PG8_MMA(0, 0, At, B0); PG8_BAR; PG8_SCHED;
            PG8_LDB(B1, 1, 1); PG8_STAGE(PG8_SB(1, 0), b3, voffB);
            PG8_BAR; PG8_WAIT_L(0); PG8_MMA(0, 1, At, B1); PG8_BAR;
            PG8_LDA(At, 1, 1); PG8_STAGE(PG8_SA(1, 0), a3, voffA);
            PG8_BAR; PG8_WAIT_L(0); PG8_MMA(1, 0, At, B0); PG8_BAR; PG8_SCHED;
            PG8_STAGE(PG8_SB(1, 1), b3 + hstep, voffB);
            PG8_WAIT_V(6); PG8_BAR; PG8_MMA(1, 1, At, B1); PG8_BAR;
            }
        }
        if constexpr (ALIGN_EPI) { if (wr == 0) PG8_BAR; }
        E(acc, cur, wr, wc, fr, fq);
        if (!has_next) break;
#pragma unroll
        for (int a = 0; a < 2; ++a)
#pragma unroll
            for (int b = 0; b < 2; ++b)
#pragma unroll
                for (int m = 0; m < 4; ++m)
#pragma unroll
                    for (int n = 0; n < 2; ++n) acc[a][b][m][n] = (f32x4){0.f, 0.f, 0.f, 0.f};
        cur = nxt; cA = nA; cB = nB; ++ui;
        if constexpr (ALIGN_EPI) { if (wr == 1) PG8_BAR; }
    }
    PG8_WAIT_V(0);
    if constexpr (!ALIGN_EPI) { if (wr == 0) PG8_BAR; }
    PG8_BAR;
#undef PG8_SA
#undef PG8_SB
#undef PG8_STAGE
#undef PG8_LDA
#undef PG8_LDB
#undef PG8_MMA
#undef PG8_WAIT_V
#undef PG8_WAIT_L
#undef PG8_BAR
#undef PG8_SCHED
}
}

constexpr int D = 2048, NBATCH = 8, SEQ = 2048, CTXL = 256, DFF = 5632, NMODV = 9, DMODW = NMODV * D  ;
constexpr int M_LAT = NBATCH * SEQ  , M_CTX = NBATCH * CTXL  , M_ALL = M_LAT + M_CTX  ;
constexpr int NH = 16, HD = 64, GW = 64  , GROWS = SEQ / GW  , WIN_R = 8, WIN_C = 16;
constexpr int D_EIN = 5120, D_OIN = 5120, ZE_LD = 3072  , ZO_LD = 5120;
constexpr float EPS = 1e-6f;
constexpr int NPHASE = 21;

constexpr size_t MiB = 1u << 20;
constexpr size_t WS_CTL = 0, CTL_ZERO_BYTES = 1 * MiB;
constexpr size_t WS_MOD = 1 * MiB;
constexpr size_t WS_WFI = 4 * MiB, WFI_STRIDE = 44 * MiB;
constexpr size_t WS_WFO = 180 * MiB, WFO_STRIDE = 22 * MiB;
constexpr size_t WS_WEI = 268 * MiB, WS_WEO = 288 * MiB, WS_WOI = 296 * MiB, WS_WOO = 316 * MiB;
constexpr size_t WS_X = 324 * MiB;
constexpr size_t WS_HN = 468 * MiB;
constexpr size_t WS_ACT = 540 * MiB;
constexpr size_t WS_Z = 738 * MiB;
constexpr size_t WS_MIX = 918 * MiB;
constexpr size_t WS_VT = 990 * MiB;
constexpr size_t WS_HF = 1026 * MiB;
constexpr size_t WS_PART = 1090 * MiB, PART_STRIDE = 16 * MiB;
constexpr size_t WS_KF = 1138 * MiB;
constexpr size_t WS_END = 1174 * MiB;
constexpr int CW_BAR = 4096;
constexpr int CW_Q = 8192;

constexpr int RING_BYTES = 131072;
constexpr int LDS_BYTES = 147456;
constexpr int MISC_OFF = LDS_BYTES - 256;

#define GAS __attribute__((address_space(1)))
#define LAS __attribute__((address_space(3)))
typedef unsigned short bf16;
typedef float f32x4 __attribute__((ext_vector_type(4)));
typedef float f32x2 __attribute__((ext_vector_type(2)));
typedef unsigned u32x4 __attribute__((ext_vector_type(4)));
typedef unsigned u32x2 __attribute__((ext_vector_type(2)));
typedef short bf16x8 __attribute__((ext_vector_type(8)));
#define LDS_WAIT() asm volatile("s_waitcnt lgkmcnt(0)" ::: "memory")
#define VM_WAIT() asm volatile("s_waitcnt vmcnt(0)" ::: "memory")
__device__ __forceinline__ unsigned f2bf(float f) { unsigned u = __builtin_bit_cast(unsigned, f); return (u + 0x7fffu + ((u >> 16) & 1u)) >> 16; }
__device__ __forceinline__ unsigned pk2(float lo, float hi) { return f2bf(lo) | (f2bf(hi) << 16); }
__device__ __forceinline__ float bf_lo(unsigned v) { return __builtin_bit_cast(float, v << 16); }
__device__ __forceinline__ float bf_hi(unsigned v) { return __builtin_bit_cast(float, v & 0xffff0000u); }
__device__ __forceinline__ float bf2f(bf16 v) { return __builtin_bit_cast(float, (unsigned)v << 16); }
__device__ __forceinline__ float fast_sigmoid(float x) { return __builtin_amdgcn_rcpf(1.0f + __builtin_amdgcn_exp2f(-1.44269504089f * x)); }
__device__ __forceinline__ float wave_sum(float v) {
#pragma unroll
    for (int o = 1; o < 64; o <<= 1) v += __shfl_xor(v, o);
    return v;
}

#define XB_TMO      128
#define XB_XCNT(j)  (256  + 64 * (j))
#define XB_XSUB(j)  (1280 + 64 * (j))
#define XB_XGEN(j)  (2304 + 64 * (j))
#define XB_TOP      3328
#define XB_TOPGEN   3392
#define XCD_BAR_WORDS 3456
#define XB_SPIN_CAP (1u << 18)

__device__ __forceinline__ unsigned xb_ld(unsigned* p)              { return __hip_atomic_load(p, __ATOMIC_RELAXED, __HIP_MEMORY_SCOPE_AGENT); }
__device__ __forceinline__ unsigned xb_add(unsigned* p, unsigned v) { return __hip_atomic_fetch_add(p, v, __ATOMIC_RELAXED, __HIP_MEMORY_SCOPE_AGENT); }
__device__ __forceinline__ unsigned xb_xcc_id() { return (unsigned)__builtin_amdgcn_s_getreg((3 << 11) | 20) & 0xFu; }
#define XB_SPIN(cond, bar) do { unsigned _sp = 0; while (cond) { __builtin_amdgcn_s_sleep(1); \
    if ((++_sp & 255u) == 0u) { if (xb_ld(&(bar)[XB_TMO])) break; if (_sp > XB_SPIN_CAP) { atomicAdd(&(bar)[XB_TMO], 1u); break; } } } } while (0)

struct XcdBarrier {
    unsigned* bar; unsigned x;
    volatile LAS unsigned* st;
};

__device__ __forceinline__ XcdBarrier xcd_barrier_post(unsigned* bar, volatile LAS unsigned* st) {
    XcdBarrier b; b.bar = bar; b.x = xb_xcc_id(); b.st = st;
    if (threadIdx.x == 0) (void)xb_add(&bar[XB_XCNT(b.x)], 1u);
    return b;
}
__device__ __forceinline__ void xcd_barrier_complete(unsigned* bar, unsigned x, unsigned& nloc, unsigned& nx) {
    const unsigned G = gridDim.x * gridDim.y * gridDim.z;
    unsigned sum, cnt, mine, sp = 0u;
    for (;;) {
        sum = 0u; cnt = 0u; mine = 0u;
#pragma unroll
        for (unsigned j = 0; j < 16; ++j) { const unsigned c = xb_ld(&bar[XB_XCNT(j)]); sum += c; cnt += (c > 0u) ? 1u : 0u; mine = (j == x) ? c : mine; }
        if (sum == G) break;
        __builtin_amdgcn_s_sleep(1);
        if ((++sp & 255u) == 0u) { if (xb_ld(&bar[XB_TMO])) break; if (sp > XB_SPIN_CAP) { atomicAdd(&bar[XB_TMO], 1u); break; } }
    }
    nloc = mine > 0u ? mine : 1u; nx = cnt > 0u ? cnt : 1u;
}

__device__ __forceinline__ void xcd_barrier(const XcdBarrier& b) {
    asm volatile("s_waitcnt vmcnt(0)" ::: "memory");
    __syncthreads();
    if (threadIdx.x == 0) {
        unsigned* bar = b.bar;
        __builtin_amdgcn_s_waitcnt(0);
        unsigned nloc = b.st[0], nx = b.st[1];
        if (nloc == 0u) { xcd_barrier_complete(bar, b.x, nloc, nx); b.st[0] = nloc; b.st[1] = nx; }
        const unsigned old = xb_add(&bar[XB_XSUB(b.x)], 1u);
        const unsigned gen = old / nloc;
        if (old + 1u == (gen + 1u) * nloc) {
            __builtin_amdgcn_fence(__ATOMIC_RELEASE, "agent");
            asm volatile("s_waitcnt vmcnt(0)" ::: "memory");
            const unsigned og = xb_add(&bar[XB_TOP], 1u);
            const unsigned tg = og / nx;
            if (og + 1u == (tg + 1u) * nx) xb_add(&bar[XB_TOPGEN], 1u);
            else XB_SPIN(xb_ld(&bar[XB_TOPGEN]) == tg, bar);
            __builtin_amdgcn_fence(__ATOMIC_ACQUIRE, "agent");
            xb_add(&bar[XB_XGEN(b.x)], 1u);
            asm volatile("s_waitcnt vmcnt(0)" ::: "memory");
        } else {
            XB_SPIN(xb_ld(&bar[XB_XGEN(b.x)]) == gen, bar);
            __builtin_amdgcn_fence(__ATOMIC_ACQUIRE, "agent");
            asm volatile("s_waitcnt vmcnt(0)" ::: "memory");
        }
    }
    __syncthreads();
}

struct Params {
    const float* in[27];
    float* out;
    unsigned char* ws;
    int ph_lo, ph_hi;
};
enum { IN_X = 0, IN_C, IN_CTX, IN_CCTX, IN_WMOD, IN_BMOD, IN_NORMG, IN_FWI, IN_FWO, IN_EWI, IN_SCW, IN_SCB, IN_CCW, IN_CCB, IN_LNG, IN_LNB, IN_EWO,
       IN_OWI, IN_QG, IN_KG, IN_RPB, IN_LCW, IN_LCB, IN_LGW, IN_LGB, IN_LAM, IN_OWO };

struct SchedStd {
    const char* A; const char* Bt; size_t tstep; int nM, nN, G, c, ntiles;
    __device__ __forceinline__ int nt(const pg8::Unit&) const { return ntiles; }
    __device__ __forceinline__ bool next(int i, pg8::Unit& u) const {
        const long L = (long)i * G + c; if (L >= (long)nM * nN) return false;
        pg8::tile_map((int)L, nM, nN, u.pm, u.pn); u.kind = 0; return true;
    }
    __device__ __forceinline__ const char* a_base(const pg8::Unit& u) const { return A + (size_t)u.pm * tstep; }
    __device__ __forceinline__ const char* b_base(const pg8::Unit& u) const { return Bt + (size_t)u.pn * tstep; }
};

struct SchedDown {
    const char* A; const char* Bt; size_t tstep; int G, c, ntiles;
    __device__ __forceinline__ bool next(int i, pg8::Unit& u) const {
        const long L = (long)i * G + c;
        if (L < 512) { pg8::tile_map((int)L, 64, 8, u.pm, u.pn); u.kind = 0; return true; }
        if (L < 768) { const int q = (int)L - 512, t = q & 63; u.pm = 64 + (t >> 3); u.pn = t & 7; u.kind = 1 + (q >> 6); return true; }
        return false;
    }
    __device__ __forceinline__ int nt(const pg8::Unit& u) const { return u.kind == 0 ? ntiles : ntiles / 4; }
    __device__ __forceinline__ const char* a_base(const pg8::Unit& u) const { return A + (size_t)u.pm * tstep + (u.kind > 1 ? (size_t)(u.kind - 1) * (ntiles / 4) * 128 : 0); }
    __device__ __forceinline__ const char* b_base(const pg8::Unit& u) const { return Bt + (size_t)u.pn * tstep + (u.kind > 1 ? (size_t)(u.kind - 1) * (ntiles / 4) * 128 : 0); }
};
struct SchedOdIn {
    const char* HN; const char* W; size_t tstep; int G, c;
    __device__ __forceinline__ int nt(const pg8::Unit&) const { return D / 64; }
    __device__ __forceinline__ bool next(int i, pg8::Unit& u) const {
        const long L = (long)i * G + c;
        if (L < 72 * 16) { int pm, pnv; pg8::tile_map((int)L, 72, 16, pm, pnv); u.pm = pm; u.pn = pnv < 8 ? pnv : pnv + 4; u.kind = 0; return true; }
        if (L < 72 * 16 + 4 * 72) { int pm, pn; pg8::tile_map((int)L - 72 * 16, 4, 72, pm, pn); u.pm = pm; u.pn = pn; u.kind = 1; return true; }
        return false;
    }
    __device__ __forceinline__ const char* a_base(const pg8::Unit& u) const { return u.kind == 0 ? HN + (size_t)u.pm * tstep : W + (size_t)(8 + u.pm) * tstep; }
    __device__ __forceinline__ const char* b_base(const pg8::Unit& u) const { return u.kind == 0 ? W + (size_t)u.pn * tstep : HN + (size_t)u.pn * tstep; }
};

struct EpiSwiGLU {
    static constexpr bool PERM = true;
    bf16* O;
    __device__ __forceinline__ void operator()(const f32x4 (&acc)[2][2][4][2], const pg8::Unit& u, int wr, int wc, int fr, int fq) const {
        const int row0 = u.pm * 256 + wr * 64 + fr, col0 = u.pn * 128 + wc * 32 + 8 * fq;
#pragma unroll
        for (int ai = 0; ai < 2; ++ai)
#pragma unroll
            for (int m = 0; m < 4; ++m) {
                bf16* rowp = O + (size_t)(row0 + ai * 128 + m * 16) * DFF + col0;
                float v[8];
#pragma unroll
                for (int n = 0; n < 2; ++n)
#pragma unroll
                    for (int j = 0; j < 4; ++j) { const float g = acc[ai][0][m][n][j], up = acc[ai][1][m][n][j]; v[4 * n + j] = g * fast_sigmoid(g) * up; }
                u32x4 w; w.x = pg8::cvt_pk_bf16(v[0], v[1]); w.y = pg8::cvt_pk_bf16(v[2], v[3]); w.z = pg8::cvt_pk_bf16(v[4], v[5]); w.w = pg8::cvt_pk_bf16(v[6], v[7]);
                *(u32x4*)rowp = w;
            }
    }
};
struct EpiResid {
    static constexpr bool PERM = false;
    const float* base_lat; const float* base_ctx; float* out; const float* gate; float coef; float* part;
    __device__ __forceinline__ void operator()(const f32x4 (&acc)[2][2][4][2], const pg8::Unit& u, int wr, int wc, int fr, int fq) const {
        const float coef = __builtin_bit_cast(float, __builtin_amdgcn_readfirstlane(__builtin_bit_cast(int, this->coef)));
        float* const part = (float*)(((unsigned long long)(unsigned)__builtin_amdgcn_readfirstlane((int)((unsigned long long)this->part >> 32)) << 32) | (unsigned)__builtin_amdgcn_readfirstlane((int)(unsigned long long)this->part));
        const int row0 = u.pm * 256 + wr * 64 + fr, col0 = u.pn * 256 + wc * 32 + 4 * fq;
        const int r = u.pm < 64 ? (u.pm >> 3) : 8;
        const float* gv = gate + (size_t)r * DMODW + col0;
        f32x4 gvv[2][2];
#pragma unroll
        for (int bj = 0; bj < 2; ++bj)
#pragma unroll
            for (int n = 0; n < 2; ++n) gvv[bj][n] = *(const f32x4*)(gv + bj * 128 + n * 16) * coef;
        if (u.kind >= 2) {
            float* op = part + (size_t)(u.kind - 2) * (PART_STRIDE / 4) + (size_t)(row0 - M_LAT) * D + col0;
#pragma unroll
            for (int ai = 0; ai < 2; ++ai)
#pragma unroll
                for (int m = 0; m < 4; ++m) { const size_t ro = (size_t)(ai * 128 + m * 16) * D;
#pragma unroll
                    for (int bj = 0; bj < 2; ++bj)
#pragma unroll
                        for (int n = 0; n < 2; ++n) *(f32x4*)(op + ro + bj * 128 + n * 16) = gvv[bj][n] * acc[ai][bj][m][n]; }
            return;
        }
        const float* bp = u.pm < 64 ? base_lat + (size_t)row0 * D + col0 : base_ctx + (size_t)(row0 - M_LAT) * D + col0;
        float* op = out + (size_t)row0 * D + col0;
#pragma unroll
        for (int ai = 0; ai < 2; ++ai)
#pragma unroll
            for (int mh = 0; mh < 2; ++mh) {
                f32x4 b[2][2][2];
#pragma unroll
                for (int mm = 0; mm < 2; ++mm)
#pragma unroll
                    for (int bj = 0; bj < 2; ++bj)
#pragma unroll
                        for (int n = 0; n < 2; ++n) b[mm][bj][n] = *(const f32x4*)(bp + (size_t)(ai * 128 + (2 * mh + mm) * 16) * D + bj * 128 + n * 16);
#pragma unroll
                for (int mm = 0; mm < 2; ++mm)
#pragma unroll
                    for (int bj = 0; bj < 2; ++bj)
#pragma unroll
                        for (int n = 0; n < 2; ++n) *(f32x4*)(op + (size_t)(ai * 128 + (2 * mh + mm) * 16) * D + bj * 128 + n * 16) = b[mm][bj][n] + gvv[bj][n] * acc[ai][bj][2 * mh + mm][n];
                asm volatile("" ::: "memory");
            }
    }
};
struct EpiEvIn {
    static constexpr bool PERM = true;
    bf16* O;
    __device__ __forceinline__ void operator()(const f32x4 (&acc)[2][2][4][2], const pg8::Unit& u, int wr, int wc, int fr, int fq) const {
        const int row0 = u.pm * 256 + wr * 64 + fr;
        if (u.pn < 4) {
            const int col0 = u.pn * 256 + wc * 32 + 8 * fq;
#pragma unroll
            for (int ai = 0; ai < 2; ++ai)
#pragma unroll
                for (int m = 0; m < 4; ++m) { bf16* rowp = O + (size_t)(row0 + ai * 128 + m * 16) * ZE_LD + col0;
#pragma unroll
                    for (int bj = 0; bj < 2; ++bj) { const f32x4 v0 = acc[ai][bj][m][0], v1 = acc[ai][bj][m][1];
                        u32x4 w; w.x = pg8::cvt_pk_bf16(v0[0], v0[1]); w.y = pg8::cvt_pk_bf16(v0[2], v0[3]); w.z = pg8::cvt_pk_bf16(v1[0], v1[1]); w.w = pg8::cvt_pk_bf16(v1[2], v1[3]);
                        *(u32x4*)(rowp + bj * 128) = w; } }
        } else {
            const bool glu = u.pn >= 12;
            const int col0 = (glu ? 2048 + (u.pn - 12) * 128 : 1024 + (u.pn - 4) * 128) + wc * 32 + 8 * fq;
#pragma unroll
            for (int ai = 0; ai < 2; ++ai)
#pragma unroll
                for (int m = 0; m < 4; ++m) { bf16* rowp = O + (size_t)(row0 + ai * 128 + m * 16) * ZE_LD + col0;
                    float v[8];
#pragma unroll
                    for (int n = 0; n < 2; ++n)
#pragma unroll
                        for (int j = 0; j < 4; ++j) { const float a = acc[ai][0][m][n][j], b = acc[ai][1][m][n][j]; v[4 * n + j] = glu ? a * fast_sigmoid(b) : a * b; }
                    u32x4 w; w.x = pg8::cvt_pk_bf16(v[0], v[1]); w.y = pg8::cvt_pk_bf16(v[2], v[3]); w.z = pg8::cvt_pk_bf16(v[4], v[5]); w.w = pg8::cvt_pk_bf16(v[6], v[7]);
                    *(u32x4*)rowp = w; }
        }
    }
};
struct EpiOdIn {
    static constexpr bool PERM = true;
    bf16* ZO; u32x4* KF; u32x2* VF; const float* qg; const float* kg;
    __device__ __forceinline__ void operator()(const f32x4 (&acc)[2][2][4][2], const pg8::Unit& u, int wr, int wc, int fr, int fq) const {
        const int row0 = u.pm * 256 + wr * 64 + fr;
        if (u.kind == 0 && u.pn < 8) {
            const bool isq = u.pn < 4;
            const float* gp = (isq ? qg : kg) + 8 * fq;
            f32x4 gn[2][2];
#pragma unroll
            for (int bj = 0; bj < 2; ++bj)
#pragma unroll
                for (int n = 0; n < 2; ++n) gn[bj][n] = *(const f32x4*)(gp + 32 * bj + 4 * n);
            const float sc = isq ? 0.125f : 1.0f;
            const int col0 = u.pn * 256 + wc * 64 + 8 * fq, hh = 4 * (u.pn & 3) + wc;
#pragma unroll
            for (int ai = 0; ai < 2; ++ai)
#pragma unroll
                for (int m = 0; m < 4; ++m) {
                    float ss = 0.f;
#pragma unroll
                    for (int bj = 0; bj < 2; ++bj)
#pragma unroll
                        for (int n = 0; n < 2; ++n) { const f32x4 v = acc[ai][bj][m][n]; ss += (v[0] * v[0] + v[1] * v[1]) + (v[2] * v[2] + v[3] * v[3]); }
                    ss += __shfl_xor(ss, 16); ss += __shfl_xor(ss, 32);
                    const float rs = sc / sqrtf(ss * (1.0f / HD) + EPS);
                    const int row = row0 + ai * 128 + m * 16;
                    bf16* rowp = ZO + (size_t)row * ZO_LD + col0;
                    u32x4* kfp = KF + ((size_t)((row >> 4) * 16 + hh) * 8 + fq) * 16 + (row & 15);
#pragma unroll
                    for (int bj = 0; bj < 2; ++bj) { const f32x4 v0 = acc[ai][bj][m][0] * rs * gn[bj][0], v1 = acc[ai][bj][m][1] * rs * gn[bj][1];
                        u32x4 w; w.x = pg8::cvt_pk_bf16(v0[0], v0[1]); w.y = pg8::cvt_pk_bf16(v0[2], v0[3]); w.z = pg8::cvt_pk_bf16(v1[0], v1[1]); w.w = pg8::cvt_pk_bf16(v1[2], v1[3]);
                        if (isq) *(u32x4*)(rowp + bj * 32) = w; else kfp[bj * 64] = w; }
                }
            return;
        }
        if (u.kind == 1) {
#pragma unroll
            for (int ai = 0; ai < 2; ++ai)
#pragma unroll
                for (int m = 0; m < 4; ++m) { const int ch = row0 + ai * 128 + m * 16;
#pragma unroll
                    for (int bj = 0; bj < 2; ++bj)
#pragma unroll
                        for (int n = 0; n < 2; ++n) { const int t = u.pn * 256 + bj * 128 + wc * 32 + 8 * fq + 4 * n; const f32x4 v = acc[ai][bj][m][n];
                            u32x2 w; w.x = pg8::cvt_pk_bf16(v[0], v[1]); w.y = pg8::cvt_pk_bf16(v[2], v[3]);
                            VF[((size_t)(((t >> 4) * 16 + (ch >> 6)) * 4 + ((ch >> 4) & 3)) * 4 + ((t >> 2) & 3)) * 16 + (ch & 15)] = w; } }
            return;
        }
        const int col0 = u.pn * 256 + wc * 32 + 8 * fq;
#pragma unroll
        for (int ai = 0; ai < 2; ++ai)
#pragma unroll
            for (int m = 0; m < 4; ++m) { bf16* rowp = ZO + (size_t)(row0 + ai * 128 + m * 16) * ZO_LD + col0;
#pragma unroll
                for (int bj = 0; bj < 2; ++bj) { const f32x4 v0 = acc[ai][bj][m][0], v1 = acc[ai][bj][m][1];
                    u32x4 w; w.x = pg8::cvt_pk_bf16(v0[0], v0[1]); w.y = pg8::cvt_pk_bf16(v0[2], v0[3]); w.z = pg8::cvt_pk_bf16(v1[0], v1[1]); w.w = pg8::cvt_pk_bf16(v1[2], v1[3]);
                    *(u32x4*)(rowp + bj * 128) = w; } }
    }
};

__device__ __forceinline__ int srccol(int map, int n) {
    if (map == 0) return n;
    const int pn = n >> 8, bj = (n >> 7) & 1, i = n & 127;
    if (map == 1) return bj * DFF + 128 * pn + i;
    if (map == 2) {
        if (pn < 4) return n;
        if (pn < 12) return 1024 + bj * 1024 + 128 * (pn - 4) + i;
        return 3072 + bj * 1024 + 128 * (pn - 12) + i;
    }
    if (pn < 8) return 256 * pn + 64 * ((n >> 5) & 3) + 32 * bj + (n & 31);
    return n;
}
__device__ __forceinline__ void p0_transpose_item(const float* W, int K, int N, bf16* WT, int map, LAS float* scr, int item, int lane) {
    const int nblk = N / 64, kb = item / nblk, nb = item % nblk, k0 = 64 * kb, n0 = 64 * nb;
    const float* src = W + (size_t)k0 * N + srccol(map, n0 + lane);
#pragma unroll 16
    for (int i = 0; i < 64; ++i) scr[i * 65 + lane] = src[(size_t)i * N];
    LDS_WAIT(); asm volatile("" ::: "memory");
    const int c = lane & 7;
#pragma unroll
    for (int j = 0; j < 8; ++j) { const int n = (lane >> 3) + 8 * j; const LAS float* s = scr + (8 * c) * 65 + n;
        u32x4 o; o.x = pk2(s[0 * 65], s[1 * 65]); o.y = pk2(s[2 * 65], s[3 * 65]); o.z = pk2(s[4 * 65], s[5 * 65]); o.w = pk2(s[6 * 65], s[7 * 65]);
        *(u32x4*)(WT + (size_t)(n0 + n) * K + k0 + 8 * c) = o; }
    LDS_WAIT(); asm volatile("" ::: "memory");
}
__device__ __forceinline__ void p0_weights(const Params& p, LAS unsigned char* lds, int lane, int wave) {
    LAS float* scr = (LAS float*)(lds + wave * (64 * 65 * 4));
    const int gw = blockIdx.x * 8 + wave, NGW = gridDim.x * 8;
    constexpr int I_FI = (D / 64) * (2 * DFF / 64), I_FO = (DFF / 64) * (D / 64), I_IN = (D / 64) * (D_EIN / 64), I_OUT = (D / 64) * (D / 64);
    constexpr int NITEMS = 4 * I_FI + 4 * I_FO + 2 * I_IN + 2 * I_OUT;
    for (int it = gw; it < NITEMS; it += NGW) {
        int r = it;
        if (r < 4 * I_FI) { const int q = r / I_FI; p0_transpose_item(p.in[IN_FWI] + (size_t)q * D * 2 * DFF, D, 2 * DFF, (bf16*)(p.ws + WS_WFI + q * WFI_STRIDE), 1, scr, r % I_FI, lane); continue; } r -= 4 * I_FI;
        if (r < 4 * I_FO) { const int q = r / I_FO; p0_transpose_item(p.in[IN_FWO] + (size_t)q * DFF * D, DFF, D, (bf16*)(p.ws + WS_WFO + q * WFO_STRIDE), 0, scr, r % I_FO, lane); continue; } r -= 4 * I_FO;
        if (r < I_IN) { p0_transpose_item(p.in[IN_EWI], D, D_EIN, (bf16*)(p.ws + WS_WEI), 2, scr, r, lane); continue; } r -= I_IN;
        if (r < I_IN) { p0_transpose_item(p.in[IN_OWI], D, D_OIN, (bf16*)(p.ws + WS_WOI), 3, scr, r, lane); continue; } r -= I_IN;
        if (r < I_OUT) { p0_transpose_item(p.in[IN_EWO], D, D, (bf16*)(p.ws + WS_WEO), 0, scr, r, lane); continue; } r -= I_OUT;
        p0_transpose_item(p.in[IN_OWO], D, D, (bf16*)(p.ws + WS_WOO), 0, scr, r, lane);
    }
}
__device__ __forceinline__ void p0_modvec(const Params& p, LAS unsigned char* lds, int tid, int lane, int wave) {
    LAS float* sv = (LAS float*)lds;
    LAS float* red = (LAS float*)(lds + 9 * 2048 * 4);
    volatile LAS int* qslot = (volatile LAS int*)(lds + 9 * 2048 * 4 + 8 * 9 * 64 * 4);
    const float* c = p.in[IN_C]; const float* cc = p.in[IN_CCTX];
    for (int i = tid; i < 9 * 2048; i += 512) { const float v = i < 8 * 2048 ? c[i] : cc[i - 8 * 2048]; sv[i] = v / (1.0f + __expf(-v)); }
    float* MOD = (float*)(p.ws + WS_MOD);
    unsigned* qhead = (unsigned*)(p.ws + WS_CTL) + CW_Q;
    for (;;) {
        __syncthreads();
        if (tid == 0) *qslot = (int)__hip_atomic_fetch_add(qhead, 1u, __ATOMIC_RELAXED, __HIP_MEMORY_SCOPE_AGENT);
        __syncthreads();
        const int item = *qslot;
        if (item >= 2 * 288) break;
        const int l = item / 288, col0 = (item % 288) * 64;
        const float* W = p.in[IN_WMOD] + (size_t)l * D * DMODW + col0 + lane + (size_t)(wave * 256) * DMODW;
        float acc[9];
#pragma unroll
        for (int r = 0; r < 9; ++r) acc[r] = 0.f;
#define MV_LOAD(w, k16) do { _Pragma("unroll") for (int e = 0; e < 16; ++e) w[e] = W[(size_t)(16 * (k16) + e) * DMODW]; } while (0)
#define MV_COMP(w, k16) do { _Pragma("unroll") for (int e4 = 0; e4 < 4; ++e4) { _Pragma("unroll") for (int r = 0; r < 9; ++r) { \
            const f32x4 s = *(const LAS f32x4*)(sv + r * 2048 + wave * 256 + 16 * (k16) + 4 * e4); \
            acc[r] += (s[0] * w[4 * e4] + s[1] * w[4 * e4 + 1]) + (s[2] * w[4 * e4 + 2] + s[3] * w[4 * e4 + 3]); } } } while (0)
        float wa[16], wb[16];
        MV_LOAD(wa, 0);
#pragma unroll 1
        for (int k16 = 0; k16 < 16; k16 += 2) {
            MV_LOAD(wb, k16 + 1);
            MV_COMP(wa, k16);
            if (k16 + 2 < 16) MV_LOAD(wa, k16 + 2);
            MV_COMP(wb, k16 + 1);
        }
#undef MV_LOAD
#undef MV_COMP
#pragma unroll
        for (int r = 0; r < 9; ++r) red[(wave * 9 + r) * 64 + lane] = acc[r];
        __syncthreads();
        for (int o = tid; o < 9 * 64; o += 512) {
            const int r = o >> 6, ln = o & 63; float s = 0.f;
#pragma unroll
            for (int w = 0; w < 8; ++w) s += red[(w * 9 + r) * 64 + ln];
            MOD[((size_t)l * 9 + r) * DMODW + col0 + ln] = s + p.in[IN_BMOD][(size_t)l * DMODW + col0 + ln];
        }
    }
}

template <bool COMBINE>
__device__ __forceinline__ void norm_phase(const float* src_lat, const float* src_ctx, float* xw_ctx, const float* part, int nrows, const float* g, const float* modl, int shift_idx, int scale_idx, bf16* HN, int lane, int wave) {
    const int gw = blockIdx.x * 8 + wave, NGW = gridDim.x * 8;
    if (gw >= nrows) return;
    f32x4 v[8], nv[8];
#define NORM_LOAD(dst, row) do { const int row_ = (row); const float* xr_ = row_ < M_LAT ? src_lat + (size_t)row_ * D : src_ctx + (size_t)(row_ - M_LAT) * D; \
        _Pragma("unroll") for (int j = 0; j < 8; ++j) dst[j] = *(const f32x4*)(xr_ + 4 * lane + 256 * j); \
        if (COMBINE && row_ >= M_LAT) { _Pragma("unroll") for (int q = 0; q < 3; ++q) { const float* pr_ = part + (size_t)q * (PART_STRIDE / 4) + (size_t)(row_ - M_LAT) * D; \
            _Pragma("unroll") for (int j = 0; j < 8; ++j) dst[j] += *(const f32x4*)(pr_ + 4 * lane + 256 * j); } } } while (0)
    NORM_LOAD(v, gw);
    for (int row = gw; row < nrows; row += NGW) {
        if (row + NGW < nrows) NORM_LOAD(nv, row + NGW);
        const int r = row < M_LAT ? (row >> 11) : 8;
        const float* sh = modl + (size_t)r * DMODW + shift_idx * D; const float* sc = modl + (size_t)r * DMODW + scale_idx * D;
        float ss = 0.f;
#pragma unroll
        for (int j = 0; j < 8; ++j) ss += (v[j][0] * v[j][0] + v[j][1] * v[j][1]) + (v[j][2] * v[j][2] + v[j][3] * v[j][3]);
        const float rstd = 1.0f / sqrtf(wave_sum(ss) * (1.0f / D) + EPS);
        bf16* o = HN + (size_t)row * D;
#pragma unroll
        for (int j = 0; j < 8; ++j) { const int c = 4 * lane + 256 * j; const f32x4 gg = *(const f32x4*)(g + c), s1 = *(const f32x4*)(sc + c), s0 = *(const f32x4*)(sh + c);
            const f32x4 y = (v[j] * rstd) * gg * (1.0f + s1) + s0;
            u32x2 w; w.x = pg8::cvt_pk_bf16(y[0], y[1]); w.y = pg8::cvt_pk_bf16(y[2], y[3]); *(u32x2*)(o + c) = w;
            if (COMBINE && row >= M_LAT) *(f32x4*)(xw_ctx + (size_t)(row - M_LAT) * D + c) = v[j]; }
#pragma unroll
        for (int j = 0; j < 8; ++j) v[j] = nv[j];
    }
#undef NORM_LOAD
}

__device__ __forceinline__ void even_conv_phase(const Params& p, LAS unsigned char* lds, int tid, int lane, int wave) {
    const bf16* Z3 = (const bf16*)(p.ws + WS_Z); bf16* MIX = (bf16*)(p.ws + WS_MIX);
    LAS unsigned* tile = (LAS unsigned*)lds;
    LAS float* red = (LAS float*)(lds + 62 * 2048);
    LAS float* stat = red + 256;
    const float* ccw = p.in[IN_CCW]; const float* ccb = p.in[IN_CCB]; const float* lng = p.in[IN_LNG]; const float* lnb = p.in[IN_LNB];
    const float* scw = p.in[IN_SCW]; const float* scb = p.in[IN_SCB];
    for (int u = blockIdx.x; u < 576; u += gridDim.x) {
        int base, T, t0;
        if (u < 512) { base = (u >> 6) * SEQ; T = SEQ; t0 = (u & 63) * 32; } else { const int v = u - 512; base = M_LAT + (v >> 3) * CTXL; T = CTXL; t0 = (v & 7) * 32; }
        {
            u32x4 sv[16];
#pragma unroll
            for (int q = 0; q < 16; ++q) { const int ch = tid + 512 * q, rr = min(ch >> 7, 61), cc = ch & 127, t = t0 - 15 + rr, tc = min(max(t, 0), T - 1);
                const unsigned msk = (t == tc) ? 0xffffffffu : 0u;
                sv[q] = *(const u32x4*)(Z3 + (size_t)(base + tc) * ZE_LD + 2048 + cc * 8) & msk; }
#pragma unroll
            for (int q = 0; q < 16; ++q) { const int ch = tid + 512 * q, rr = ch >> 7, cc = ch & 127; if (rr < 62) *(LAS u32x4*)(tile + rr * 512 + cc * 4) = sv[q]; }
        }
        unsigned pv[34], bgv[32];
#pragma unroll
        for (int i = 0; i < 34; ++i) { const int t = t0 - 1 + i, tc = min(max(t, 0), T - 1); const unsigned msk = (t == tc) ? 0xffffffffu : 0u; pv[i] = *(const unsigned*)(Z3 + (size_t)(base + tc) * ZE_LD + 1024 + 2 * tid) & msk; }
#pragma unroll
        for (int i = 0; i < 32; ++i) bgv[i] = *(const unsigned*)(Z3 + (size_t)(base + t0 + i) * ZE_LD + 2 * tid);
        __syncthreads();
        { const f32x2 w0 = *(const f32x2*)(scw + 2 * tid), w1 = *(const f32x2*)(scw + 1024 + 2 * tid), w2 = *(const f32x2*)(scw + 2048 + 2 * tid), b = *(const f32x2*)(scb + 2 * tid);
#pragma unroll
          for (int i = 0; i < 32; ++i) {
              const float c0 = w0[0] * bf_lo(pv[i]) + w1[0] * bf_lo(pv[i + 1]) + w2[0] * bf_lo(pv[i + 2]) + b[0];
              const float c1 = w0[1] * bf_hi(pv[i]) + w1[1] * bf_hi(pv[i + 1]) + w2[1] * bf_hi(pv[i + 2]) + b[1];
              *(unsigned*)(MIX + (size_t)(base + t0 + i) * D + 2 * tid) = pg8::cvt_pk_bf16(bf_lo(bgv[i]) * c0, bf_hi(bgv[i]) * c1); } }
        float acc[32][2];
#pragma unroll
        for (int i = 0; i < 32; ++i) { acc[i][0] = 0.f; acc[i][1] = 0.f; }
#pragma unroll 1
        for (int k = 0; k < 31; ++k) {
            const f32x2 w = *(const f32x2*)(ccw + (size_t)k * 1024 + 2 * tid);
            const LAS unsigned* tp = tile + k * 512 + tid;
#pragma unroll
            for (int i = 0; i < 32; ++i) { const unsigned v = tp[i * 512]; acc[i][0] += w[0] * bf_lo(v); acc[i][1] += w[1] * bf_hi(v); }
        }
        { const f32x2 b = *(const f32x2*)(ccb + 2 * tid);
#pragma unroll
          for (int i = 0; i < 32; ++i) { acc[i][0] += b[0]; acc[i][1] += b[1]; } }
#pragma unroll
        for (int i = 0; i < 32; ++i) { const float s = wave_sum(acc[i][0] + acc[i][1]); if (lane == 0) red[wave * 32 + i] = s; }
        __syncthreads();
        if (tid < 32) { float s = 0.f;
#pragma unroll
            for (int w = 0; w < 8; ++w) s += red[w * 32 + tid]; stat[tid] = s * (1.0f / 1024.0f); }
        __syncthreads();
#pragma unroll
        for (int i = 0; i < 32; ++i) { const float mu = stat[i]; acc[i][0] -= mu; acc[i][1] -= mu; }
        __syncthreads();
#pragma unroll
        for (int i = 0; i < 32; ++i) { const float s = wave_sum(acc[i][0] * acc[i][0] + acc[i][1] * acc[i][1]); if (lane == 0) red[wave * 32 + i] = s; }
        __syncthreads();
        if (tid < 32) { float s = 0.f;
#pragma unroll
            for (int w = 0; w < 8; ++w) s += red[w * 32 + tid]; stat[tid] = 1.0f / sqrtf(s * (1.0f / 1024.0f) + EPS); }
        __syncthreads();
        { const f32x2 g = *(const f32x2*)(lng + 2 * tid), b = *(const f32x2*)(lnb + 2 * tid);
#pragma unroll
          for (int i = 0; i < 32; ++i) { const float rs = stat[i]; const float y0 = acc[i][0] * rs * g[0] + b[0], y1 = acc[i][1] * rs * g[1] + b[1];
              *(unsigned*)(MIX + (size_t)(base + t0 + i) * D + 1024 + 2 * tid) = pg8::cvt_pk_bf16(y0 * fast_sigmoid(y0), y1 * fast_sigmoid(y1)); } }
        __syncthreads();
    }
}

__device__ __forceinline__ void attn_wave_unit(const Params& p, const LAS float* rpbL, int b, int h, int r, int qg, int lane) {
    const bf16* ZO = (const bf16*)(p.ws + WS_Z); const u32x4* KF = (const u32x4*)(p.ws + WS_KF); const u32x2* VF = (const u32x2*)(p.ws + WS_VT); bf16* MIX = (bf16*)(p.ws + WS_MIX);
    const int l15 = lane & 15, g = lane >> 4;
    const int c0 = 16 * qg, qc = c0 + l15, qrow = b * SEQ + r * GW + qc;
    const int r0 = min(max(r - WIN_R / 2, 0), GROWS - WIN_R);
    const int kb = qg == 0 ? 0 : (qg == 1 ? 8 : (qg == 2 ? 24 : 32));
    const int cs = min(max(qc - WIN_C / 2, 0), GW - WIN_C);
    bf16x8 qf[2];
#pragma unroll
    for (int kk = 0; kk < 2; ++kk) qf[kk] = __builtin_bit_cast(bf16x8, *(const u32x4*)(ZO + (size_t)qrow * ZO_LD + h * HD + 8 * g + 32 * kk));
    int dcol[8]; bool okk[8];
#pragma unroll
    for (int a = 0; a < 2; ++a)
#pragma unroll
        for (int e = 0; e < 4; ++e) { const int kc = kb + 16 * a + 4 * g + e; okk[4 * a + e] = (kc >= cs) && (kc < cs + WIN_C); dcol[4 * a + e] = min(max(kc - qc + WIN_C - 1, 0), 2 * WIN_C - 2); }
    const LAS float* rpbh = rpbL + h * 15 * 31;
    u32x4 kx[4][2][2]; u32x2 vx[4][4][2];
#define ATT_TOK0(ch) ((ch) < 8 ? M_LAT + b * CTXL + 32 * (ch) : b * SEQ + (r0 + ((ch) - 8)) * GW + kb)
#define ATT_LOADK(s) do { _Pragma("unroll") for (int c = 0; c < 4; ++c) { const int tok_ = ATT_TOK0(4 * (s) + c); \
        _Pragma("unroll") for (int a = 0; a < 2; ++a) { const int t_ = tok_ + 16 * a + l15; const u32x4* kp_ = KF + ((size_t)((t_ >> 4) * 16 + h) * 8 + g) * 16 + (t_ & 15); kx[c][a][0] = kp_[0]; kx[c][a][1] = kp_[64]; } } } while (0)
#define ATT_LOADV(s) do { _Pragma("unroll") for (int c = 0; c < 4; ++c) { const int tok_ = ATT_TOK0(4 * (s) + c); \
        _Pragma("unroll") for (int a = 0; a < 2; ++a) { const int t_ = tok_ + 16 * a + 4 * g; const u32x2* vp_ = VF + ((size_t)((t_ >> 4) * 16 + h) * 16 + ((t_ >> 2) & 3)) * 16 + l15; \
            _Pragma("unroll") for (int d = 0; d < 4; ++d) vx[c][d][a] = vp_[d * 64]; } } } while (0)
    f32x4 o[4];
#pragma unroll
    for (int d = 0; d < 4; ++d) o[d] = (f32x4){0.f, 0.f, 0.f, 0.f};
    float mrun = -1e30f, lsum = 0.f;
    ATT_LOADK(0); ATT_LOADV(0);
#pragma unroll 1
    for (int s = 0; s < 4; ++s) {
        f32x4 sc_[4][2];
#pragma unroll
        for (int c = 0; c < 4; ++c)
#pragma unroll
            for (int a = 0; a < 2; ++a) { f32x4 acc_ = (f32x4){0.f, 0.f, 0.f, 0.f};
                acc_ = __builtin_amdgcn_mfma_f32_16x16x32_bf16(__builtin_bit_cast(bf16x8, kx[c][a][0]), qf[0], acc_, 0, 0, 0);
                acc_ = __builtin_amdgcn_mfma_f32_16x16x32_bf16(__builtin_bit_cast(bf16x8, kx[c][a][1]), qf[1], acc_, 0, 0, 0); sc_[c][a] = acc_; }
        if (s < 3) ATT_LOADK(s + 1);
        if (s >= 2) {
#pragma unroll
            for (int c = 0; c < 4; ++c) { const LAS float* bp_ = rpbh + ((r0 + 4 * (s - 2) + c) - r + WIN_R - 1) * 31;
#pragma unroll
                for (int a = 0; a < 2; ++a)
#pragma unroll
                    for (int e = 0; e < 4; ++e) sc_[c][a][e] = okk[4 * a + e] ? sc_[c][a][e] + bp_[dcol[4 * a + e]] : -1e30f; }
        }
        float mx_ = -1e30f;
#pragma unroll
        for (int c = 0; c < 4; ++c)
#pragma unroll
            for (int a = 0; a < 2; ++a) mx_ = fmaxf(mx_, fmaxf(fmaxf(sc_[c][a][0], sc_[c][a][1]), fmaxf(sc_[c][a][2], sc_[c][a][3])));
        mx_ = fmaxf(mx_, __shfl_xor(mx_, 16)); mx_ = fmaxf(mx_, __shfl_xor(mx_, 32));
        const float mnew_ = fmaxf(mrun, mx_), alpha_ = __builtin_amdgcn_exp2f((mrun - mnew_) * 1.44269504089f); mrun = mnew_;
        const float mb_ = mnew_ * 1.44269504089f;
        float ps_ = 0.f; bf16x8 pf_[4];
#pragma unroll
        for (int c = 0; c < 4; ++c) { float pe_[8];
#pragma unroll
            for (int a = 0; a < 2; ++a)
#pragma unroll
                for (int e = 0; e < 4; ++e) { pe_[4 * a + e] = __builtin_amdgcn_exp2f(sc_[c][a][e] * 1.44269504089f - mb_); ps_ += pe_[4 * a + e]; }
            u32x4 pw_; pw_.x = pg8::cvt_pk_bf16(pe_[0], pe_[1]); pw_.y = pg8::cvt_pk_bf16(pe_[2], pe_[3]); pw_.z = pg8::cvt_pk_bf16(pe_[4], pe_[5]); pw_.w = pg8::cvt_pk_bf16(pe_[6], pe_[7]);
            pf_[c] = __builtin_bit_cast(bf16x8, pw_); }
        lsum = lsum * alpha_ + ps_;
#pragma unroll
        for (int d = 0; d < 4; ++d) { o[d] = o[d] * alpha_;
#pragma unroll
            for (int c = 0; c < 4; ++c) { u32x4 vw_; vw_.x = vx[c][d][0].x; vw_.y = vx[c][d][0].y; vw_.z = vx[c][d][1].x; vw_.w = vx[c][d][1].y;
                o[d] = __builtin_amdgcn_mfma_f32_16x16x32_bf16(__builtin_bit_cast(bf16x8, vw_), pf_[c], o[d], 0, 0, 0); } }
        if (s < 3) ATT_LOADV(s + 1);
    }
#undef ATT_TOK0
#undef ATT_LOADK
#undef ATT_LOADV
    lsum += __shfl_xor(lsum, 16); lsum += __shfl_xor(lsum, 32);
    const float inv = 1.0f / lsum;
#pragma unroll
    for (int d = 0; d < 4; ++d) { u32x2 w; w.x = pg8::cvt_pk_bf16(o[d][0] * inv, o[d][1] * inv); w.y = pg8::cvt_pk_bf16(o[d][2] * inv, o[d][3] * inv);
        *(u32x2*)(MIX + (size_t)qrow * D + h * HD + 16 * d + 4 * g) = w; }
}
__device__ __forceinline__ void attn_phase(const Params& p, LAS unsigned char* lds, int tid, int lane, int wave) {
    LAS float* rpbL = (LAS float*)lds;
    __syncthreads();
    for (int i = tid; i < NH * 15 * 31; i += 512) rpbL[i] = p.in[IN_RPB][i];
    __syncthreads();
    const int cls = blockIdx.x & 7, wgi = blockIdx.x >> 3, ncl = (gridDim.x - cls + 7) >> 3, nW = ncl * 8;
    if (gridDim.x >= 8) {
        for (int v = wgi * 8 + wave; v < NH * GROWS * 4; v += nW) { const int h = v >> 7, rem = v & 127; attn_wave_unit(p, rpbL, cls, h, rem >> 2, rem & 3, lane); }
    } else {
        for (int v = blockIdx.x * 8 + wave; v < NBATCH * NH * GROWS * 4; v += gridDim.x * 8) { const int b = v >> 11, w = v & 2047, h = w >> 7, rem = w & 127; attn_wave_unit(p, rpbL, b, h, rem >> 2, rem & 3, lane); }
    }
}

__device__ __forceinline__ float gelu_tanh(float x) { const float z = 0.7978845608028654f * (x + 0.044715f * x * x * x); return x * fast_sigmoid(2.0f * z); }
constexpr int LCH = 256;
__device__ __forceinline__ void lru_item(const Params& p, LAS unsigned char* lds, int item, int tid, int lane, int wave) {
    const bf16* ZO = (const bf16*)(p.ws + WS_Z); float* HF = (float*)(p.ws + WS_HF); bf16* MIX = (bf16*)(p.ws + WS_MIX);
    const int b = item >> 5, n = (item >> 1) & 15, half = item & 1, j0 = half * 32;
    LAS float* xcf = (LAS float*)lds;
    LAS bf16* xcb = (LAS bf16*)(lds + LCH * 33 * 4);
    LAS float* As = (LAS float*)(lds + LCH * 33 * 4 + LCH * 72 * 2);
    LAS float* Us = As + LCH * 33;
    LAS float* segA = Us + LCH * 33;
    LAS float* segH = segA + 16 * 32;
    const int ci = lane, cch = n * 64 + ci;
    const float* lcw = p.in[IN_LCW]; const float cw0 = lcw[cch], cw1 = lcw[1024 + cch], cw2 = lcw[2048 + cch], cw3 = lcw[3072 + cch], cb = p.in[IN_LCB][cch];
    const bool own = (ci >> 5) == half;
    const int jb = wave & 1, tb0 = (wave >> 1) * 4, l15 = lane & 15, g = lane >> 4, jl = 16 * jb + l15, gch = n * 64 + j0 + jl;
    const int sc = lane & 31, hi = lane >> 5, sg = 2 * wave + hi;
    const unsigned och = (unsigned)(n * 64 + j0 + sc);
    for (int dir = 0; dir < 2; ++dir) {
        bf16x8 Bg[2][2];
        {
            const float* gw = p.in[IN_LGW] + (size_t)((dir * 2) * 16 + n) * 4096;
#pragma unroll
            for (int gt = 0; gt < 2; ++gt)
#pragma unroll
                for (int kk = 0; kk < 2; ++kk) { const float* wp = gw + (size_t)gt * 16 * 4096 + (size_t)(8 * g + 32 * kk) * 64 + j0 + jl;
                    u32x4 w; w.x = pk2(wp[0], wp[64]); w.y = pk2(wp[128], wp[192]); w.z = pk2(wp[256], wp[320]); w.w = pk2(wp[384], wp[448]); Bg[gt][kk] = __builtin_bit_cast(bf16x8, w); }
        }
        const float br = p.in[IN_LGB][(dir * 2 + 0) * 1024 + gch], bi = p.in[IN_LGB][(dir * 2 + 1) * 1024 + gch];
        const float lam = p.in[IN_LAM][dir * 1024 + gch];
        const float sp8 = -8.0f * log1pf(expf(-lam)) * 1.44269504089f;
        float carry = 0.f;
        const unsigned hoff = (unsigned)((dir == 0 ? 16 * hi : 16 * (1 - hi)) * 1024) + och;
        const unsigned moff = (unsigned)((dir == 0 ? 16 * hi : 16 * (1 - hi)) * D) + 1024u + och;
        const unsigned goff = (unsigned)((dir == 0 ? 16 * hi : 16 * (1 - hi)) * ZO_LD) + 4096u + och;
        u32x4 xraw[5];
#define LRU_LOADX(cidx_) do { const int ci_ = (cidx_); const bool isctx_ = ci_ < 1; const int cc_ = isctx_ ? 0 : ci_ - 1, ncs_ = isctx_ ? 1 : 8, cpos_ = dir == 0 ? cc_ : ncs_ - 1 - cc_; \
        const int base_ = isctx_ ? M_LAT + b * CTXL : b * SEQ, T_ = isctx_ ? CTXL : SEQ, ts_ = cpos_ * LCH - 1; \
        _Pragma("unroll") for (int q = 0; q < 5; ++q) { const int pc = min(q * 512 + tid, 2071), t = ts_ + (pc >> 3), tc = min(max(t, 0), T_ - 1); const unsigned msk = (t == tc) ? 0xffffffffu : 0u; \
            xraw[q] = *(const u32x4*)(ZO + (size_t)(base_ + tc) * ZO_LD + 3072 + n * 64 + (pc & 7) * 8) & msk; } } while (0)
        LRU_LOADX(0);
        LAS unsigned char* rawt = (LAS unsigned char*)As;
#pragma unroll 1
        for (int cidx = 0; cidx < 9; ++cidx) {
            const bool isctx = cidx < 1;
            const int cc = isctx ? 0 : cidx - 1, ncs = isctx ? 1 : 8, cpos = dir == 0 ? cc : ncs - 1 - cc;
            const int base = isctx ? M_LAT + b * CTXL : b * SEQ, t0 = cpos * LCH;
#pragma unroll
            for (int q = 0; q < 5; ++q) { const int pc = q * 512 + tid; if (pc < 2072) *(LAS u32x4*)(rawt + pc * 16) = xraw[q]; }
            __syncthreads();
            {
                float xf[35];
                const LAS unsigned short* rp_ = (const LAS unsigned short*)(rawt + (32 * wave) * 128) + ci;
#pragma unroll
                for (int e = 0; e < 35; ++e) xf[e] = __builtin_bit_cast(float, (unsigned)rp_[e * 64] << 16);
                LAS bf16* xb_ = xcb + (32 * wave) * 72 + ci; LAS float* xf_ = xcf + (32 * wave) * 33 + (ci & 31);
#pragma unroll
                for (int e = 0; e < 32; ++e) { const float y = cw0 * xf[e] + cw1 * xf[e + 1] + cw2 * xf[e + 2] + cw3 * xf[e + 3] + cb;
                    xb_[e * 72] = (bf16)f2bf(y); if (own) xf_[e * 33] = y; }
            }
            if (cidx + 1 < 9) LRU_LOADX(cidx + 1);
            __syncthreads();
#pragma unroll 1
            for (int q = 0; q < 4; ++q) {
                const int tb = tb0 + q;
                const bf16x8 a0 = *(const LAS bf16x8*)(xcb + (16 * tb + l15) * 72 + 8 * g), a1 = *(const LAS bf16x8*)(xcb + (16 * tb + l15) * 72 + 8 * g + 32);
                f32x4 gr_ = (f32x4){0.f, 0.f, 0.f, 0.f}, gi_ = (f32x4){0.f, 0.f, 0.f, 0.f};
                gr_ = __builtin_amdgcn_mfma_f32_16x16x32_bf16(a0, Bg[0][0], gr_, 0, 0, 0); gr_ = __builtin_amdgcn_mfma_f32_16x16x32_bf16(a1, Bg[0][1], gr_, 0, 0, 0);
                gi_ = __builtin_amdgcn_mfma_f32_16x16x32_bf16(a0, Bg[1][0], gi_, 0, 0, 0); gi_ = __builtin_amdgcn_mfma_f32_16x16x32_bf16(a1, Bg[1][1], gi_, 0, 0, 0);
#pragma unroll
                for (int e = 0; e < 4; ++e) {
                    const int tl = 16 * tb + 4 * g + e;
                    const float rg = fast_sigmoid(gr_[e] + br), ig = fast_sigmoid(gi_[e] + bi);
                    const float la2 = sp8 * rg, a = __builtin_amdgcn_exp2f(la2);
                    const float x2 = la2 * 1.38629436112f;
                    const float em = x2 > -0.25f ? -x2 * (1.0f + x2 * (0.5f + x2 * (0.16666667f + x2 * (0.041666668f + x2 * 0.0083333338f)))) : 1.0f - a * a;
                    As[tl * 33 + jl] = a; Us[tl * 33 + jl] = sqrtf(em) * ig * xcf[tl * 33 + jl];
                }
            }
            __syncthreads();
            float av[16], uv[16];
            {
                float A = 1.f, H = 0.f;
                const LAS float* ap_ = As + (dir ? (LCH - 1 - 16 * sg) : 16 * sg) * 33 + sc; const LAS float* up_ = Us + (dir ? (LCH - 1 - 16 * sg) : 16 * sg) * 33 + sc;
#pragma unroll
                for (int e = 0; e < 16; ++e) { av[e] = dir ? ap_[-e * 33] : ap_[e * 33]; uv[e] = dir ? up_[-e * 33] : up_[e * 33]; H = av[e] * H + uv[e]; A *= av[e]; }
                segA[sg * 32 + sc] = A; segH[sg * 32 + sc] = H;
            }
            const int rbase = dir == 0 ? base + t0 + 32 * wave : base + t0 + LCH - 1 - 32 * wave - 16;
            float hfv[16]; unsigned grv[16];
            if (!isctx && dir == 1) {
                const float* hp_ = HF + (size_t)rbase * 1024; const bf16* gp_ = ZO + (size_t)rbase * ZO_LD;
#pragma unroll
                for (int e = 0; e < 16; ++e) { hfv[e] = (hp_ - (size_t)e * 1024)[hoff]; grv[e] = (unsigned)(gp_ - (size_t)e * ZO_LD)[goff]; }
            }
            __syncthreads();
            {
                float hin = carry, mine = 0.f;
#pragma unroll
                for (int s2 = 0; s2 < 16; ++s2) { if (s2 == sg) mine = hin; hin = segA[s2 * 32 + sc] * hin + segH[s2 * 32 + sc]; }
                carry = hin;
                if (!isctx) {
                    float hcur = mine;
                    if (dir == 0) {
                        float* hp_ = HF + (size_t)rbase * 1024;
#pragma unroll
                        for (int e = 0; e < 16; ++e) { hcur = av[e] * hcur + uv[e]; (hp_ + (size_t)e * 1024)[hoff] = hcur; }
                    } else {
                        bf16* mp_ = MIX + (size_t)rbase * D;
#pragma unroll
                        for (int e = 0; e < 16; ++e) { hcur = av[e] * hcur + uv[e];
                            (mp_ - (size_t)e * D)[moff] = (bf16)f2bf((hfv[e] + hcur) * gelu_tanh(__builtin_bit_cast(float, grv[e] << 16))); }
                    }
                }
            }
        }
#undef LRU_LOADX
        VM_WAIT(); __syncthreads();
    }
}


#if MK_SPLIT
#define GRID_BAR() do { } while (0)
#else
#define GRID_BAR() xcd_barrier(bar)
#endif
#ifndef PH_MASK
#define PH_MASK 0xffffffffu
#endif
#define IN(k) (lo <= (k) && (k) < hi && ((PH_MASK >> (k)) & 1u))
#ifndef PROBE_MASK
#define PROBE_MASK 0u
#endif
#ifndef PROBE_MULT
#define PROBE_MULT 4
#endif
#if PROBE_MASK
#define PROBE_STAMP(k) do { if (blockIdx.x == 0 && threadIdx.x == 0) { volatile LAS unsigned long long* pw = (volatile LAS unsigned long long*)(lds + MISC_OFF + 128); \
        const unsigned long long t_ = __builtin_amdgcn_s_memrealtime(); if ((PROBE_MASK >> (k)) & 1u) pw[1] += t_ - pw[0]; pw[0] = t_; } } while (0)
#else
#define PROBE_STAMP(k) do { } while (0)
#endif
#define SEAM(k) do { if (IN(k) && IN((k) + 1)) GRID_BAR(); PROBE_STAMP(k); } while (0)

template <int L>
__device__ __forceinline__ void layer_body(const Params& p, LAS unsigned char* lds, const XcdBarrier& bar, const int lo, const int hi) {
    constexpr int l = L;
    const int tid = threadIdx.x, lane = tid & 63, wave = __builtin_amdgcn_readfirstlane(tid >> 6);
    const int G = gridDim.x;
    float* MOD = (float*)(p.ws + WS_MOD);
    float* X = (float*)(p.ws + WS_X);
    bf16* HN = (bf16*)(p.ws + WS_HN);
    bf16* ACT = (bf16*)(p.ws + WS_ACT);
    bf16* Z = (bf16*)(p.ws + WS_Z);
    bf16* MIX = (bf16*)(p.ws + WS_MIX);
    float* PART = (float*)(p.ws + WS_PART);
        const int pb = 1 + 10 * l;
        const float* modl = MOD + (size_t)l * 9 * DMODW;
        const float* ng = p.in[IN_NORMG] + (size_t)l * 3 * D;
        constexpr bool first = (l == 0);
        const float* xs_lat = first ? p.in[IN_X] : X; const float* xs_ctx = first ? p.in[IN_CTX] : X + (size_t)M_LAT * D;

        if (IN(pb + 0)) norm_phase<!first>(xs_lat, xs_ctx, X + (size_t)M_LAT * D, PART, M_ALL, ng + 0 * D, modl, 0, 1, HN, lane, wave);
        SEAM(pb + 0);
        if (IN(pb + 1)) {
            SchedStd S{(const char*)HN, (const char*)(p.ws + WS_WFI + (size_t)(l * 2 + 0) * WFI_STRIDE), (size_t)256 * D * 2, M_ALL / 256, 2 * DFF / 256, G, (int)blockIdx.x, D / 64};
            EpiSwiGLU E{ACT};
            pg8::gemm_phase<EpiSwiGLU, SchedStd>(lds, D, S, E);
        }
        SEAM(pb + 1);
        if (IN(pb + 2)) {
            SchedDown S{(const char*)ACT, (const char*)(p.ws + WS_WFO + (size_t)(l * 2 + 0) * WFO_STRIDE), (size_t)256 * DFF * 2, G, (int)blockIdx.x, DFF / 64};
            EpiResid E{xs_lat, xs_ctx, X, modl + 2 * D, 0.5f, PART};
            pg8::gemm_phase<EpiResid, SchedDown>(lds, DFF, S, E);
        }
        SEAM(pb + 2);
        if (IN(pb + 3)) norm_phase<true>(X, X + (size_t)M_LAT * D, X + (size_t)M_LAT * D, PART, M_ALL, ng + 1 * D, modl, 3, 4, HN, lane, wave);
        SEAM(pb + 3);
        if constexpr (first) {
            if (IN(pb + 4)) {
                SchedStd S{(const char*)HN, (const char*)(p.ws + WS_WEI), (size_t)256 * D * 2, M_ALL / 256, D_EIN / 256, G, (int)blockIdx.x, D / 64};
                EpiEvIn E{Z};
                pg8::gemm_phase<EpiEvIn, SchedStd>(lds, D, S, E);
            }
            SEAM(pb + 4);
            if (IN(pb + 5)) even_conv_phase(p, lds, tid, lane, wave);
            SEAM(pb + 5);
            if (IN(pb + 6)) {
                SchedDown S{(const char*)MIX, (const char*)(p.ws + WS_WEO), (size_t)256 * D * 2, G, (int)blockIdx.x, D / 64};
                EpiResid E{X, X + (size_t)M_LAT * D, X, modl + 5 * D, 1.0f, PART};
                pg8::gemm_phase<EpiResid, SchedDown>(lds, D, S, E);
            }
            SEAM(pb + 6);
        } else {
            if (IN(pb + 4)) {
                SchedOdIn S{(const char*)HN, (const char*)(p.ws + WS_WOI), (size_t)256 * D * 2, G, (int)blockIdx.x};
                EpiOdIn E{Z, (u32x4*)(p.ws + WS_KF), (u32x2*)(p.ws + WS_VT), p.in[IN_QG], p.in[IN_KG]};
                pg8::gemm_phase<EpiOdIn, SchedOdIn>(lds, D, S, E);
            }
            SEAM(pb + 4);
            if (IN(pb + 5)) {
#ifndef NO_LRU
                for (int item = blockIdx.x; item < 256; item += G) lru_item(p, lds, item, tid, lane, wave);
#endif
#if PROBE_MASK
                __syncthreads();
                if (blockIdx.x == 0 && threadIdx.x == 0) { volatile LAS unsigned long long* pw = (volatile LAS unsigned long long*)(lds + MISC_OFF + 128);
                    const unsigned long long t_ = __builtin_amdgcn_s_memrealtime(); if ((PROBE_MASK >> 30) & 1u) pw[1] += t_ - pw[0]; }
#endif
#ifndef NO_ATTN
                attn_phase(p, lds, tid, lane, wave);
#endif
            }
            SEAM(pb + 5);
            if (IN(pb + 6)) {
                SchedStd S{(const char*)MIX, (const char*)(p.ws + WS_WOO), (size_t)256 * D * 2, M_LAT / 256, D / 256, G, (int)blockIdx.x, D / 64};
                EpiResid E{X, X + (size_t)M_LAT * D, X, modl + 5 * D, 1.0f, PART};
                pg8::gemm_phase<EpiResid, SchedStd>(lds, D, S, E);
            }
            SEAM(pb + 6);
        }
        const int nrows2 = first ? M_ALL : M_LAT;
        if (IN(pb + 7)) norm_phase<first>(X, X + (size_t)M_LAT * D, X + (size_t)M_LAT * D, PART, nrows2, ng + 2 * D, modl, 6, 7, HN, lane, wave);
        SEAM(pb + 7);
        if (IN(pb + 8)) {
            SchedStd S{(const char*)HN, (const char*)(p.ws + WS_WFI + (size_t)(l * 2 + 1) * WFI_STRIDE), (size_t)256 * D * 2, nrows2 / 256, 2 * DFF / 256, G, (int)blockIdx.x, D / 64};
            EpiSwiGLU E{ACT};
            pg8::gemm_phase<EpiSwiGLU, SchedStd>(lds, D, S, E);
        }
        SEAM(pb + 8);
        if (IN(pb + 9)) {
            if constexpr (first) {
                SchedDown S{(const char*)ACT, (const char*)(p.ws + WS_WFO + (size_t)(l * 2 + 1) * WFO_STRIDE), (size_t)256 * DFF * 2, G, (int)blockIdx.x, DFF / 64};
                EpiResid E{X, X + (size_t)M_LAT * D, X, modl + 8 * D, 0.5f, PART};
                pg8::gemm_phase<EpiResid, SchedDown>(lds, DFF, S, E);
            } else {
                SchedStd S{(const char*)ACT, (const char*)(p.ws + WS_WFO + (size_t)(l * 2 + 1) * WFO_STRIDE), (size_t)256 * DFF * 2, M_LAT / 256, D / 256, G, (int)blockIdx.x, DFF / 64};
                EpiResid E{X, X + (size_t)M_LAT * D, p.out, modl + 8 * D, 0.5f, PART};
                pg8::gemm_phase<EpiResid, SchedStd>(lds, DFF, S, E);
            }
        }
        SEAM(pb + 9);
}
__global__ void __launch_bounds__(512, 2) mega_fwd(Params p) {
    extern __shared__ __attribute__((aligned(16))) unsigned char lds_raw[];
    LAS unsigned char* lds = (LAS unsigned char*)lds_raw;
    volatile LAS unsigned* MISC = (volatile LAS unsigned*)(lds + MISC_OFF);
    const int tid = threadIdx.x, lane = tid & 63, wave = __builtin_amdgcn_readfirstlane(tid >> 6);
    const int G = gridDim.x;
    if (tid < 64) MISC[tid] = 0u;
    __syncthreads();
    unsigned* ctl = (unsigned*)(p.ws + WS_CTL);
#if MK_SPLIT
    XcdBarrier bar; bar.bar = ctl + CW_BAR; bar.x = 0; bar.st = MISC + 8;
#else
    XcdBarrier bar = xcd_barrier_post(ctl + CW_BAR, MISC + 8);
#endif
    const int lo = p.ph_lo, hi = p.ph_hi;
#if PROBE_MASK
    if (blockIdx.x == 0 && tid == 0) { volatile LAS unsigned long long* pw = (volatile LAS unsigned long long*)(lds + MISC_OFF + 128); pw[0] = __builtin_amdgcn_s_memrealtime(); pw[1] = 0ull; }
#endif

    float* MOD = (float*)(p.ws + WS_MOD);
    float* X = (float*)(p.ws + WS_X);
    bf16* HN = (bf16*)(p.ws + WS_HN);
    bf16* ACT = (bf16*)(p.ws + WS_ACT);
    bf16* Z = (bf16*)(p.ws + WS_Z);
    bf16* MIX = (bf16*)(p.ws + WS_MIX);

    if (IN(0)) {
#ifndef NO_WEIGHTS
        p0_weights(p, lds, lane, wave); __syncthreads();
#endif
#ifndef NO_MODVEC
        p0_modvec(p, lds, tid, lane, wave); __syncthreads();
#endif
    }
    SEAM(0);

    layer_body<0>(p, lds, bar, lo, hi);
    layer_body<1>(p, lds, bar, lo, hi);
#if PROBE_MASK
    if (blockIdx.x == 0 && tid == 0) { volatile LAS unsigned long long* pw = (volatile LAS unsigned long long*)(lds + MISC_OFF + 128); const unsigned long long t0 = __builtin_amdgcn_s_memrealtime(), dt = (unsigned long long)PROBE_MULT * pw[1];
        while (__builtin_amdgcn_s_memrealtime() - t0 < dt) __builtin_amdgcn_s_sleep(8); }
#endif
#undef IN
#undef SEAM
#undef GRID_BAR
}

extern "C" void kernel_launch(void* const* d_in, const int* in_sizes, int n_in, void* d_out, int out_size, void* d_ws, size_t ws_size, hipStream_t stream) {
    static int grid = 0;
    if (grid == 0) {
        if (n_in != 27 || in_sizes[0] != M_LAT * D || out_size != M_LAT * D || ws_size < WS_END) {
            fprintf(stderr, "kernel_launch: unexpected shapes (n_in %d, in0 %d, out %d, ws %zu; need ws >= %zu); nothing launched\n", n_in, n_in > 0 ? in_sizes[0] : -1, out_size, ws_size, (size_t)WS_END); grid = -1; return; }
        int dev = 0, cus = 0, per_cu = 0;
        if (hipGetDevice(&dev) != hipSuccess || hipDeviceGetAttribute(&cus, hipDeviceAttributeMultiprocessorCount, dev) != hipSuccess) { fprintf(stderr, "kernel_launch: device query failed\n"); grid = -1; return; }
        if (hipFuncSetAttribute((const void*)mega_fwd, hipFuncAttributeMaxDynamicSharedMemorySize, LDS_BYTES) != hipSuccess) { fprintf(stderr, "kernel_launch: hipFuncSetAttribute failed\n"); grid = -1; return; }
        if (hipOccupancyMaxActiveBlocksPerMultiprocessor(&per_cu, (const void*)mega_fwd, 512, LDS_BYTES) != hipSuccess || per_cu < 1) {
            fprintf(stderr, "kernel_launch: occupancy query reports %d workgroups per CU\n", per_cu); }
        (void)hipGetLastError();
        grid = cus;
    }
    if (grid < 0) return;
    if (hipMemsetAsync((char*)d_ws + WS_CTL, 0, CTL_ZERO_BYTES, stream) != hipSuccess) { fprintf(stderr, "kernel_launch: memset failed\n"); return; }
    Params a{};
    for (int i = 0; i < 27; ++i) a.in[i] = (const float*)d_in[i];
    a.out = (float*)d_out; a.ws = (unsigned char*)d_ws;
#if MK_SPLIT
    for (int ph = 0; ph < NPHASE; ++ph) { a.ph_lo = ph; a.ph_hi = ph + 1; hipLaunchKernelGGL(mega_fwd, dim3(grid), dim3(512), LDS_BYTES, stream, a); }
#else
    a.ph_lo = 0; a.ph_hi = NPHASE;
    hipLaunchKernelGGL(mega_fwd, dim3(grid), dim3(512), LDS_BYTES, stream, a);
#endif
    const hipError_t le = hipPeekAtLastError();
    if (le != hipSuccess) fprintf(stderr, "kernel_launch: launch failed: %s\n", hipGetErrorName(le));
}
```

```cpp
#include <hip/hip_runtime.h>
#include <cstdio>
#include <cstdint>

#ifndef MK_SPLIT
#define MK_SPLIT 0
#endif

namespace pg8 {
#define PG8_LAS __attribute__((address_space(3)))
typedef unsigned short bf16_t;
typedef short bf16x8 __attribute__((ext_vector_type(8)));
typedef float f32x4 __attribute__((ext_vector_type(4)));
typedef unsigned u32x4 __attribute__((ext_vector_type(4)));
typedef unsigned u32x2 __attribute__((ext_vector_type(2)));
constexpr int BM = 256, BK = 64, HALF = 128, HTB = HALF * BK * 2  , STAGE_BYTES = 8 * HTB, NXCD = 8, WGM = 8;

__host__ __device__ __forceinline__ int lds_byte(int r, int c) { const int st = (r >> 4) * 2 + (c >> 5), rr = r & 15, cc = c & 31, ob = rr * 64 + cc * 2; return st * 1024 + (ob ^ (((ob >> 9) & 1) << 5)); }
__host__ __device__ __forceinline__ void stage_rc(int b, int& R, int& C) { const int st = b / 1024, sb = b % 1024, swz = sb ^ (((sb >> 9) & 1) << 5); R = (st >> 1) * 16 + swz / 64; C = (st & 1) * 32 + (swz % 64) / 2; }
__host__ __device__ __forceinline__ int perm32(int rho) { const int n = rho >> 4, i = rho & 15; return 8 * (i >> 2) + 4 * n + (i & 3); }

struct Unit { int pm, pn, kind; };

__host__ __device__ __forceinline__ void tile_map(int wgid, int nM, int nN, int& pm, int& pn) {
    const int nwg = nM * nN;
    { const int q = nwg / NXCD, r = nwg % NXCD, xcd = wgid % NXCD, off = wgid / NXCD; wgid = (xcd < r ? xcd * (q + 1) : r * (q + 1) + (xcd - r) * q) + off; }
    const int nig = WGM * nN, gid = wgid / nig, fm = gid * WGM, gsz = (nM - fm) < WGM ? (nM - fm) : WGM;
    pm = fm + ((wgid % nig) % gsz); pn = (wgid % nig) / gsz;
}

__device__ __forceinline__ unsigned cvt_pk_bf16(float lo, float hi) { unsigned r; asm volatile("v_cvt_pk_bf16_f32 %0, %1, %2" : "=v"(r) : "v"(lo), "v"(hi)); return r; }

template <class Epi, class Sched, bool ALIGN_EPI = true, bool SP2 = true>
__device__ __forceinline__ void gemm_phase(PG8_LAS unsigned char* lds, const int K  , const Sched& S, const Epi& E) {
    const int tid = threadIdx.x, wid = __builtin_amdgcn_readfirstlane(tid >> 6), lane = tid & 63, wr = wid >> 2, wc = wid & 3, fr = lane & 15, fq = lane >> 4;
    unsigned voffA[2], voffB[2];
#pragma unroll
    for (int i = 0; i < 2; ++i) { int R, C; stage_rc(tid * 16 + i * 8192, R, C); const int Rb = Epi::PERM ? ((R & ~31) + perm32(R & 31)) : R;
        voffA[i] = (unsigned)(R * K + C) * 2u; voffB[i] = (unsigned)(Rb * K + C) * 2u; }
    const size_t kstep = (size_t)(BK * 2);
    const size_t hstep = (size_t)HALF * K * 2;
    const unsigned ldsw = (unsigned)wid * 1024u;
    const int aoff = lds_byte(wr * 64 + fr, fq * 8), boff = lds_byte(wc * 32 + fr, fq * 8);
#define PG8_SA(b, h) (((b) * 2 + (h)) * HTB)
#define PG8_SB(b, h) ((4 + (b) * 2 + (h)) * HTB)
#define PG8_STAGE(bufoff, gbase, voff) do { _Pragma("unroll") for (int _i = 0; _i < 2; ++_i) \
        __builtin_amdgcn_global_load_lds((const unsigned*)((const char*)(gbase) + (voff)[_i]), (PG8_LAS unsigned*)(lds + (bufoff) + ldsw + _i * 8192), 16, 0, 0); } while (0)
#define PG8_LDA(dst, b, h) do { _Pragma("unroll") for (int m = 0; m < 4; ++m) _Pragma("unroll") for (int k = 0; k < 2; ++k) dst[m][k] = *(const PG8_LAS bf16x8*)(lds + PG8_SA(b, h) + aoff + m * 2048 + k * 1024); } while (0)
#define PG8_LDB(dst, b, h) do { _Pragma("unroll") for (int n = 0; n < 2; ++n) _Pragma("unroll") for (int k = 0; k < 2; ++k) dst[n][k] = *(const PG8_LAS bf16x8*)(lds + PG8_SB(b, h) + boff + n * 2048 + k * 1024); } while (0)
#define PG8_MMA(ai, bj, At, Bt) do { __builtin_amdgcn_s_setprio(1); _Pragma("unroll") for (int m = 0; m < 4; ++m) _Pragma("unroll") for (int n = 0; n < 2; ++n) _Pragma("unroll") for (int k = 0; k < 2; ++k) \
        acc[ai][bj][m][n] = __builtin_amdgcn_mfma_f32_16x16x32_bf16(Bt[n][k], At[m][k], acc[ai][bj][m][n], 0, 0, 0); __builtin_amdgcn_s_setprio(0); } while (0)
#define PG8_WAIT_V(n) asm volatile("s_waitcnt vmcnt(" #n ")" ::: "memory")
#define PG8_WAIT_L(n) asm volatile("s_waitcnt lgkmcnt(" #n ")" ::: "memory")
#define PG8_BAR __builtin_amdgcn_s_barrier()
#define PG8_SCHED __builtin_amdgcn_sched_barrier(0)
    Unit cur, nxt; int ui = 0;
    if (!S.next(0, cur)) return;
    f32x4 acc[2][2][4][2];
#pragma unroll
    for (int a = 0; a < 2; ++a)
#pragma unroll
        for (int b = 0; b < 2; ++b)
#pragma unroll
            for (int m = 0; m < 4; ++m)
#pragma unroll
                for (int n = 0; n < 2; ++n) acc[a][b][m][n] = (f32x4){0.f, 0.f, 0.f, 0.f};
    bf16x8 At[4][2], B0[2][2], B1[2][2];
    const char* cA = S.a_base(cur); const char* cB = S.b_base(cur);
    if constexpr (SP2) {
        PG8_STAGE(PG8_SB(0, 0), cB, voffB); PG8_STAGE(PG8_SB(0, 1), cB + hstep, voffB); PG8_STAGE(PG8_SA(0, 0), cA, voffA); PG8_STAGE(PG8_SA(0, 1), cA + hstep, voffA);
        if (wr == 1) PG8_BAR;
        PG8_WAIT_V(2); PG8_BAR;
        PG8_STAGE(PG8_SB(1, 0), cB + kstep, voffB); PG8_STAGE(PG8_SA(1, 0), cA + kstep, voffA); PG8_STAGE(PG8_SB(1, 1), cB + hstep + kstep, voffB);
        PG8_WAIT_V(6); PG8_BAR;
    } else {
        PG8_STAGE(PG8_SB(0, 0), cB, voffB); PG8_STAGE(PG8_SA(0, 0), cA, voffA); PG8_STAGE(PG8_SB(0, 1), cB + hstep, voffB); PG8_STAGE(PG8_SA(0, 1), cA + hstep, voffA);
        if (wr == 1) PG8_BAR;
        PG8_WAIT_V(4); PG8_BAR;
        PG8_STAGE(PG8_SB(1, 0), cB + kstep, voffB); PG8_STAGE(PG8_SA(1, 0), cA + kstep, voffA); PG8_STAGE(PG8_SB(1, 1), cB + hstep + kstep, voffB);
        PG8_WAIT_V(6); PG8_BAR;
    }
    for (;;) {
        const bool has_next = S.next(ui + 1, nxt);
        const int nt = S.nt(cur);
        const char* nA = has_next ? S.a_base(nxt) : cA; const char* nB = has_next ? S.b_base(nxt) : cB;
        for (int t = 0; t < nt; t += 2) {
            const bool last = (t == nt - 2);
            const char* a1 = cA + (size_t)(t + 1) * kstep;
            const char* a2 = last ? nA : cA + (size_t)(t + 2) * kstep; const char* b2 = last ? nB : cB + (size_t)(t + 2) * kstep;
            const char* a3 = a2 + kstep; const char* b3 = b2 + kstep;
            if constexpr (SP2) {
            PG8_LDB(B0, 0, 0); PG8_LDB(B1, 0, 1); PG8_SCHED; PG8_LDA(At, 0, 0); PG8_STAGE(PG8_SA(1, 1), a1 + hstep, voffA);
            PG8_WAIT_V(8); PG8_WAIT_L(0); PG8_BAR; PG8_MMA(0, 0, At, B0); PG8_MMA(0, 1, At, B1); PG8_BAR; PG8_SCHED;
            PG8_LDA(At, 0, 1); PG8_STAGE(PG8_SB(0, 0), b2, voffB); PG8_STAGE(PG8_SB(0, 1), b2 + hstep, voffB); PG8_STAGE(PG8_SA(0, 0), a2, voffA);
            PG8_WAIT_V(8); PG8_WAIT_L(0); PG8_BAR; PG8_MMA(1, 0, At, B0); PG8_MMA(1, 1, At, B1); PG8_BAR; PG8_SCHED;
            PG8_LDB(B0, 1, 0); PG8_LDB(B1, 1, 1); PG8_SCHED; PG8_LDA(At, 1, 0); PG8_STAGE(PG8_SA(0, 1), a2 + hstep, voffA);
            PG8_WAIT_V(8); PG8_WAIT_L(0); PG8_BAR; PG8_MMA(0, 0, At, B0); PG8_MMA(0, 1, At, B1); PG8_BAR; PG8_SCHED;
            PG8_LDA(At, 1, 1); PG8_STAGE(PG8_SB(1, 0), b3, voffB); PG8_STAGE(PG8_SB(1, 1), b3 + hstep, voffB); PG8_STAGE(PG8_SA(1, 0), a3, voffA);
            PG8_WAIT_V(8); PG8_WAIT_L(0); PG8_BAR; PG8_MMA(1, 0, At, B0); PG8_MMA(1, 1, At, B1); PG8_BAR; PG8_SCHED;
            } else {
            PG8_LDB(B0, 0, 0); PG8_SCHED; PG8_LDA(At, 0, 0); PG8_STAGE(PG8_SA(1, 1), a1 + hstep, voffA);
            PG8_WAIT_L(8); PG8_BAR; PG8_WAIT_L(0); PG8_MMA(0, 0, At, B0); PG8_BAR; PG8_SCHED;
            PG8_LDB(B1, 0, 1); PG8_STAGE(PG8_SB(0, 0), b2, voffB);
            PG8_BAR; PG8_WAIT_L(0); PG8_MMA(0, 1, At, B1); PG8_BAR;
            PG8_LDA(At, 0, 1); PG8_STAGE(PG8_SA(0, 0), a2, voffA);
            PG8_BAR; PG8_WAIT_L(0); PG8_MMA(1, 0, At, B0); PG8_BAR; PG8_SCHED;
            PG8_STAGE(PG8_SB(0, 1), b2 + hstep, voffB);
            PG8_WAIT_V(6); PG8_BAR; PG8_MMA(1, 1, At, B1); PG8_BAR;
            PG8_LDB(B0, 1, 0); PG8_SCHED; PG8_LDA(At, 1, 0); PG8_STAGE(PG8_SA(0, 1), a2 + hstep, voffA);
            PG8_WAIT_L(8); PG8_BAR; PG8_WAIT_L(0); PG8_MMA(0, 0, At, B0); PG8_BAR; PG8_SCHED;
            PG8_LDB(B1, 1, 1); PG8_STAGE(PG8_SB(1, 0), b3, voffB);
            PG8_BAR; PG8_WAIT_L(0); PG8_MMA(0, 1, At, B1); PG8_BAR;
            PG8_LDA(At, 1, 1); PG8_STAGE(PG8_SA(1, 0), a3, voffA);
            PG8_BAR; PG8_WAIT_L(0); PG8_MMA(1, 0, At, B0); PG8_BAR; PG8_SCHED;
            PG8_STAGE(PG8_SB(1, 1), b3 + hstep, voffB);
            PG8_WAIT_V(6); PG8_BAR; PG8_MMA(1, 1, At, B1); PG8_BAR;
            }
        }
        if constexpr (ALIGN_EPI) { if (wr == 0) PG8_BAR; }
        E(acc, cur, wr, wc, fr, fq);
        if (!has_next) break;
#pragma unroll
        for (int a = 0; a < 2; ++a)
#pragma unroll
            for (int b = 0; b < 2; ++b)
#pragma unroll
                for (int m = 0; m < 4; ++m)
#pragma unroll
                    for (int n = 0; n < 2; ++n) acc[a][b][m][n] = (f32x4){0.f, 0.f, 0.f, 0.f};
        cur = nxt; cA = nA; cB = nB; ++ui;
        if constexpr (ALIGN_EPI) { if (wr == 1) PG8_BAR; }
    }
    PG8_WAIT_V(0);
    if constexpr (!ALIGN_EPI) { if (wr == 0) PG8_BAR; }
    PG8_BAR;
#undef PG8_SA
#undef PG8_SB
#undef PG8_STAGE
#undef PG8_LDA
#undef PG8_LDB
#undef PG8_MMA
#undef PG8_WAIT_V
#undef PG8_WAIT_L
#undef PG8_BAR
#undef PG8_SCHED
}
}

constexpr int D = 2048, NBATCH = 8, SEQ = 2048, CTXL = 256, DFF = 5632, NMODV = 9, DMODW = NMODV * D  ;
constexpr int M_LAT = NBATCH * SEQ  , M_CTX = NBATCH * CTXL  , M_ALL = M_LAT + M_CTX  ;
constexpr int NH = 16, HD = 64, GW = 64  , GROWS = SEQ / GW  , WIN_R = 8, WIN_C = 16;
constexpr int D_EIN = 5120, D_OIN = 5120, ZE_LD = 3072  , ZO_LD = 5120;
constexpr float EPS = 1e-6f;
constexpr int NPHASE = 21;

constexpr size_t MiB = 1u << 20;
constexpr size_t WS_CTL = 0, CTL_ZERO_BYTES = 1 * MiB;
constexpr size_t WS_MOD = 1 * MiB;
constexpr size_t WS_WFI = 4 * MiB, WFI_STRIDE = 44 * MiB;
constexpr size_t WS_WFO = 180 * MiB, WFO_STRIDE = 22 * MiB;
constexpr size_t WS_WEI = 268 * MiB, WS_WEO = 288 * MiB, WS_WOI = 296 * MiB, WS_WOO = 316 * MiB;
constexpr size_t WS_X = 324 * MiB;
constexpr size_t WS_HN = 468 * MiB;
constexpr size_t WS_ACT = 540 * MiB;
constexpr size_t WS_Z = 738 * MiB;
constexpr size_t WS_MIX = 918 * MiB;
constexpr size_t WS_VT = 990 * MiB;
constexpr size_t WS_HF = 1026 * MiB;
constexpr size_t WS_PART = 1090 * MiB, PART_STRIDE = 16 * MiB;
constexpr size_t WS_KF = 1138 * MiB;
constexpr size_t WS_END = 1174 * MiB;
constexpr int CW_BAR = 4096;
constexpr int CW_Q = 8192;

constexpr int RING_BYTES = 131072;
constexpr int LDS_BYTES = 147456;
constexpr int MISC_OFF = LDS_BYTES - 256;

#define GAS __attribute__((address_space(1)))
#define LAS __attribute__((address_space(3)))
typedef unsigned short bf16;
typedef float f32x4 __attribute__((ext_vector_type(4)));
typedef float f32x2 __attribute__((ext_vector_type(2)));
typedef unsigned u32x4 __attribute__((ext_vector_type(4)));
typedef unsigned u32x2 __attribute__((ext_vector_type(2)));
typedef short bf16x8 __attribute__((ext_vector_type(8)));
#define LDS_WAIT() asm volatile("s_waitcnt lgkmcnt(0)" ::: "memory")
#define VM_WAIT() asm volatile("s_waitcnt vmcnt(0)" ::: "memory")
__device__ __forceinline__ unsigned f2bf(float f) { unsigned u = __builtin_bit_cast(unsigned, f); return (u + 0x7fffu + ((u >> 16) & 1u)) >> 16; }
__device__ __forceinline__ unsigned pk2(float lo, float hi) { return f2bf(lo) | (f2bf(hi) << 16); }
__device__ __forceinline__ float bf_lo(unsigned v) { return __builtin_bit_cast(float, v << 16); }
__device__ __forceinline__ float bf_hi(unsigned v) { return __builtin_bit_cast(float, v & 0xffff0000u); }
__device__ __forceinline__ float bf2f(bf16 v) { return __builtin_bit_cast(float, (unsigned)v << 16); }
typedef _Float16 f16x4 __attribute__((ext_vector_type(4)));
typedef _Float16 f16x8 __attribute__((ext_vector_type(8)));
typedef float f32x8 __attribute__((ext_vector_type(8)));
__device__ __forceinline__ u32x2 f32x4_to_h4(f32x4 v) { return __builtin_bit_cast(u32x2, __builtin_convertvector(v, f16x4)); }
__device__ __forceinline__ f32x4 h4_to_f32x4(u32x2 v) { return __builtin_convertvector(__builtin_bit_cast(f16x4, v), f32x4); }
__device__ __forceinline__ float fast_sigmoid(float x) { return __builtin_amdgcn_rcpf(1.0f + __builtin_amdgcn_exp2f(-1.44269504089f * x)); }
__device__ __forceinline__ float wave_sum(float v) {
#pragma unroll
    for (int o = 1; o < 64; o <<= 1) v += __shfl_xor(v, o);
    return v;
}

#define XB_TMO      128
#define XB_XCNT(j)  (256  + 64 * (j))
#define XB_XSUB(j)  (1280 + 64 * (j))
#define XB_XGEN(j)  (2304 + 64 * (j))
#define XB_TOP      3328
#define XB_TOPGEN   3392
#define XCD_BAR_WORDS 3456
#define XB_SPIN_CAP (1u << 18)

__device__ __forceinline__ unsigned xb_ld(unsigned* p)              { return __hip_atomic_load(p, __ATOMIC_RELAXED, __HIP_MEMORY_SCOPE_AGENT); }
__device__ __forceinline__ unsigned xb_add(unsigned* p, unsigned v) { return __hip_atomic_fetch_add(p, v, __ATOMIC_RELAXED, __HIP_MEMORY_SCOPE_AGENT); }
__device__ __forceinline__ unsigned xb_xcc_id() { return (unsigned)__builtin_amdgcn_s_getreg((3 << 11) | 20) & 0xFu; }
#define XB_SPIN(cond, bar) do { unsigned _sp = 0; while (cond) { __builtin_amdgcn_s_sleep(1); \
    if ((++_sp & 255u) == 0u) { if (xb_ld(&(bar)[XB_TMO])) break; if (_sp > XB_SPIN_CAP) { atomicAdd(&(bar)[XB_TMO], 1u); break; } } } } while (0)

struct XcdBarrier {
    unsigned* bar; unsigned x;
    volatile LAS unsigned* st;
};

__device__ __forceinline__ XcdBarrier xcd_barrier_post(unsigned* bar, volatile LAS unsigned* st) {
    XcdBarrier b; b.bar = bar; b.x = xb_xcc_id(); b.st = st;
    if (threadIdx.x == 0) (void)xb_add(&bar[XB_XCNT(b.x)], 1u);
    return b;
}
__device__ __forceinline__ void xcd_barrier_complete(unsigned* bar, unsigned x, unsigned& nloc, unsigned& nx) {
    const unsigned G = gridDim.x * gridDim.y * gridDim.z;
    unsigned sum, cnt, mine, sp = 0u;
    for (;;) {
        sum = 0u; cnt = 0u; mine = 0u;
#pragma unroll
        for (unsigned j = 0; j < 16; ++j) { const unsigned c = xb_ld(&bar[XB_XCNT(j)]); sum += c; cnt += (c > 0u) ? 1u : 0u; mine = (j == x) ? c : mine; }
        if (sum == G) break;
        __builtin_amdgcn_s_sleep(1);
        if ((++sp & 255u) == 0u) { if (xb_ld(&bar[XB_TMO])) break; if (sp > XB_SPIN_CAP) { atomicAdd(&bar[XB_TMO], 1u); break; } }
    }
    nloc = mine > 0u ? mine : 1u; nx = cnt > 0u ? cnt : 1u;
}

__device__ __forceinline__ void xcd_barrier(const XcdBarrier& b) {
    asm volatile("s_waitcnt vmcnt(0)" ::: "memory");
    __syncthreads();
    if (threadIdx.x == 0) {
        unsigned* bar = b.bar;
        __builtin_amdgcn_s_waitcnt(0);
        unsigned nloc = b.st[0], nx = b.st[1];
        if (nloc == 0u) { xcd_barrier_complete(bar, b.x, nloc, nx); b.st[0] = nloc; b.st[1] = nx; }
        const unsigned old = xb_add(&bar[XB_XSUB(b.x)], 1u);
        const unsigned gen = old / nloc;
        if (old + 1u == (gen + 1u) * nloc) {
            __builtin_amdgcn_fence(__ATOMIC_RELEASE, "agent");
            asm volatile("s_waitcnt vmcnt(0)" ::: "memory");
            const unsigned og = xb_add(&bar[XB_TOP], 1u);
            const unsigned tg = og / nx;
            if (og + 1u == (tg + 1u) * nx) xb_add(&bar[XB_TOPGEN], 1u);
            else XB_SPIN(xb_ld(&bar[XB_TOPGEN]) == tg, bar);
            __builtin_amdgcn_fence(__ATOMIC_ACQUIRE, "agent");
            xb_add(&bar[XB_XGEN(b.x)], 1u);
            asm volatile("s_waitcnt vmcnt(0)" ::: "memory");
        } else {
            XB_SPIN(xb_ld(&bar[XB_XGEN(b.x)]) == gen, bar);
            __builtin_amdgcn_fence(__ATOMIC_ACQUIRE, "agent");
            asm volatile("s_waitcnt vmcnt(0)" ::: "memory");
        }
    }
    __syncthreads();
}

struct Params {
    const float* in[27];
    float* out;
    unsigned char* ws;
    int ph_lo, ph_hi;
};
enum { IN_X = 0, IN_C, IN_CTX, IN_CCTX, IN_WMOD, IN_BMOD, IN_NORMG, IN_FWI, IN_FWO, IN_EWI, IN_SCW, IN_SCB, IN_CCW, IN_CCB, IN_LNG, IN_LNB, IN_EWO,
       IN_OWI, IN_QG, IN_KG, IN_RPB, IN_LCW, IN_LCB, IN_LGW, IN_LGB, IN_LAM, IN_OWO };

struct SchedStd {
    const char* A; const char* Bt; size_t tstep; int nM, nN, G, c, ntiles;
    __device__ __forceinline__ int nt(const pg8::Unit&) const { return ntiles; }
    __device__ __forceinline__ bool next(int i, pg8::Unit& u) const {
        const long L = (long)i * G + c; if (L >= (long)nM * nN) return false;
        pg8::tile_map((int)L, nM, nN, u.pm, u.pn); u.kind = 0; return true;
    }
    __device__ __forceinline__ const char* a_base(const pg8::Unit& u) const { return A + (size_t)u.pm * tstep; }
    __device__ __forceinline__ const char* b_base(const pg8::Unit& u) const { return Bt + (size_t)u.pn * tstep; }
};

struct SchedDown {
    const char* A; const char* Bt; size_t tstep; int G, c, ntiles;
    __device__ __forceinline__ bool next(int i, pg8::Unit& u) const {
        const long L = (long)i * G + c;
        if (L < 512) { pg8::tile_map((int)L, 64, 8, u.pm, u.pn); u.kind = 0; return true; }
        if (L < 768) { const int q = (int)L - 512, t = q & 63; u.pm = 64 + (t >> 3); u.pn = t & 7; u.kind = 1 + (q >> 6); return true; }
        return false;
    }
    __device__ __forceinline__ int nt(const pg8::Unit& u) const { return u.kind == 0 ? ntiles : ntiles / 4; }
    __device__ __forceinline__ const char* a_base(const pg8::Unit& u) const { return A + (size_t)u.pm * tstep + (u.kind > 1 ? (size_t)(u.kind - 1) * (ntiles / 4) * 128 : 0); }
    __device__ __forceinline__ const char* b_base(const pg8::Unit& u) const { return Bt + (size_t)u.pn * tstep + (u.kind > 1 ? (size_t)(u.kind - 1) * (ntiles / 4) * 128 : 0); }
};
struct SchedOdIn {
    const char* HN; const char* W; size_t tstep; int G, c;
    __device__ __forceinline__ int nt(const pg8::Unit&) const { return D / 64; }
    __device__ __forceinline__ bool next(int i, pg8::Unit& u) const {
        const long L = (long)i * G + c;
        if (L < 72 * 16) { int pm, pnv; pg8::tile_map((int)L, 72, 16, pm, pnv); u.pm = pm; u.pn = pnv < 8 ? pnv : pnv + 4; u.kind = 0; return true; }
        if (L < 72 * 16 + 4 * 72) { int pm, pn; pg8::tile_map((int)L - 72 * 16, 4, 72, pm, pn); u.pm = pm; u.pn = pn; u.kind = 1; return true; }
        return false;
    }
    __device__ __forceinline__ const char* a_base(const pg8::Unit& u) const { return u.kind == 0 ? HN + (size_t)u.pm * tstep : W + (size_t)(8 + u.pm) * tstep; }
    __device__ __forceinline__ const char* b_base(const pg8::Unit& u) const { return u.kind == 0 ? W + (size_t)u.pn * tstep : HN + (size_t)u.pn * tstep; }
};

struct EpiSwiGLU {
    static constexpr bool PERM = true;
    bf16* O;
    __device__ __forceinline__ void operator()(const f32x4 (&acc)[2][2][4][2], const pg8::Unit& u, int wr, int wc, int fr, int fq) const {
        const int row0 = u.pm * 256 + wr * 64 + fr, col0 = u.pn * 128 + wc * 32 + 8 * fq;
#pragma unroll
        for (int ai = 0; ai < 2; ++ai)
#pragma unroll
            for (int m = 0; m < 4; ++m) {
                bf16* rowp = O + (size_t)(row0 + ai * 128 + m * 16) * DFF + col0;
                float v[8];
#pragma unroll
                for (int n = 0; n < 2; ++n)
#pragma unroll
                    for (int j = 0; j < 4; ++j) { const float g = acc[ai][0][m][n][j], up = acc[ai][1][m][n][j]; v[4 * n + j] = g * fast_sigmoid(g) * up; }
                u32x4 w; w.x = pg8::cvt_pk_bf16(v[0], v[1]); w.y = pg8::cvt_pk_bf16(v[2], v[3]); w.z = pg8::cvt_pk_bf16(v[4], v[5]); w.w = pg8::cvt_pk_bf16(v[6], v[7]);
                *(u32x4*)rowp = w;
            }
    }
};
template <bool BASE_F32, bool OUT_F32>
struct EpiResid {
    static constexpr bool PERM = true;
    const void* base_lat; const void* base_ctx; void* out; const float* gate; float coef; float* part;
    __device__ __forceinline__ void operator()(const f32x4 (&acc)[2][2][4][2], const pg8::Unit& u, int wr, int wc, int fr, int fq) const {
        const float coef = __builtin_bit_cast(float, __builtin_amdgcn_readfirstlane(__builtin_bit_cast(int, this->coef)));
        float* const part = (float*)(((unsigned long long)(unsigned)__builtin_amdgcn_readfirstlane((int)((unsigned long long)this->part >> 32)) << 32) | (unsigned)__builtin_amdgcn_readfirstlane((int)(unsigned long long)this->part));
        const int row0 = u.pm * 256 + wr * 64 + fr, col0 = u.pn * 256 + wc * 32 + 8 * fq;
        const int r = u.pm < 64 ? (u.pm >> 3) : 8;
        const float* gv = gate + (size_t)r * DMODW + col0;
        f32x4 gvv[2][2];
#pragma unroll
        for (int bj = 0; bj < 2; ++bj)
#pragma unroll
            for (int n = 0; n < 2; ++n) gvv[bj][n] = *(const f32x4*)(gv + bj * 128 + 4 * n) * coef;
        if (u.kind >= 2) {
            float* op = part + (size_t)(u.kind - 2) * (PART_STRIDE / 4) + (size_t)(row0 - M_LAT) * D + col0;
#pragma unroll
            for (int ai = 0; ai < 2; ++ai)
#pragma unroll
                for (int m = 0; m < 4; ++m) { const size_t ro = (size_t)(ai * 128 + m * 16) * D;
#pragma unroll
                    for (int bj = 0; bj < 2; ++bj)
#pragma unroll
                        for (int n = 0; n < 2; ++n) *(f32x4*)(op + ro + bj * 128 + 4 * n) = gvv[bj][n] * acc[ai][bj][m][n]; }
            return;
        }
        const size_t eo = (u.pm < 64 ? (size_t)row0 : (size_t)(row0 - M_LAT)) * D + col0;
        const void* bsel = u.pm < 64 ? base_lat : base_ctx;
        const size_t oo = (size_t)row0 * D + col0;
#pragma unroll
        for (int ai = 0; ai < 2; ++ai)
#pragma unroll
            for (int mh = 0; mh < 2; ++mh) {
                f32x4 b[2][2][2];
#pragma unroll
                for (int mm = 0; mm < 2; ++mm)
#pragma unroll
                    for (int bj = 0; bj < 2; ++bj) { const size_t ro = (size_t)(ai * 128 + (2 * mh + mm) * 16) * D + bj * 128;
                        if constexpr (BASE_F32) { b[mm][bj][0] = *(const f32x4*)((const float*)bsel + eo + ro); b[mm][bj][1] = *(const f32x4*)((const float*)bsel + eo + ro + 4); }
                        else { const u32x4 hv = *(const u32x4*)((const _Float16*)bsel + eo + ro); b[mm][bj][0] = h4_to_f32x4((u32x2){hv.x, hv.y}); b[mm][bj][1] = h4_to_f32x4((u32x2){hv.z, hv.w}); } }
#pragma unroll
                for (int mm = 0; mm < 2; ++mm)
#pragma unroll
                    for (int bj = 0; bj < 2; ++bj) { const size_t ro = (size_t)(ai * 128 + (2 * mh + mm) * 16) * D + bj * 128;
                        const f32x4 v0 = b[mm][bj][0] + gvv[bj][0] * acc[ai][bj][2 * mh + mm][0], v1 = b[mm][bj][1] + gvv[bj][1] * acc[ai][bj][2 * mh + mm][1];
                        if constexpr (OUT_F32) { *(f32x4*)((float*)out + oo + ro) = v0; *(f32x4*)((float*)out + oo + ro + 4) = v1; }
                        else { const u32x2 h0 = f32x4_to_h4(v0), h1 = f32x4_to_h4(v1); *(u32x4*)((_Float16*)out + oo + ro) = (u32x4){h0.x, h0.y, h1.x, h1.y}; } }
                asm volatile("" ::: "memory");
            }
    }
};
struct EpiEvIn {
    static constexpr bool PERM = true;
    bf16* O;
    __device__ __forceinline__ void operator()(const f32x4 (&acc)[2][2][4][2], const pg8::Unit& u, int wr, int wc, int fr, int fq) const {
        const int row0 = u.pm * 256 + wr * 64 + fr;
        if (u.pn < 4) {
            const int col0 = u.pn * 256 + wc * 32 + 8 * fq;
#pragma unroll
            for (int ai = 0; ai < 2; ++ai)
#pragma unroll
                for (int m = 0; m < 4; ++m) { bf16* rowp = O + (size_t)(row0 + ai * 128 + m * 16) * ZE_LD + col0;
#pragma unroll
                    for (int bj = 0; bj < 2; ++bj) { const f32x4 v0 = acc[ai][bj][m][0], v1 = acc[ai][bj][m][1];
                        u32x4 w; w.x = pg8::cvt_pk_bf16(v0[0], v0[1]); w.y = pg8::cvt_pk_bf16(v0[2], v0[3]); w.z = pg8::cvt_pk_bf16(v1[0], v1[1]); w.w = pg8::cvt_pk_bf16(v1[2], v1[3]);
                        *(u32x4*)(rowp + bj * 128) = w; } }
        } else {
            const bool glu = u.pn >= 12;
            const int col0 = (glu ? 2048 + (u.pn - 12) * 128 : 1024 + (u.pn - 4) * 128) + wc * 32 + 8 * fq;
#pragma unroll
            for (int ai = 0; ai < 2; ++ai)
#pragma unroll
                for (int m = 0; m < 4; ++m) { bf16* rowp = O + (size_t)(row0 + ai * 128 + m * 16) * ZE_LD + col0;
                    float v[8];
#pragma unroll
                    for (int n = 0; n < 2; ++n)
#pragma unroll
                        for (int j = 0; j < 4; ++j) { const float a = acc[ai][0][m][n][j], b = acc[ai][1][m][n][j]; v[4 * n + j] = glu ? a * fast_sigmoid(b) : a * b; }
                    u32x4 w; w.x = pg8::cvt_pk_bf16(v[0], v[1]); w.y = pg8::cvt_pk_bf16(v[2], v[3]); w.z = pg8::cvt_pk_bf16(v[4], v[5]); w.w = pg8::cvt_pk_bf16(v[6], v[7]);
                    *(u32x4*)rowp = w; }
        }
    }
};
struct EpiOdIn {
    static constexpr bool PERM = true;
    bf16* ZO; u32x4* KF; u32x2* VF; const float* qg; const float* kg;
    __device__ __forceinline__ void operator()(const f32x4 (&acc)[2][2][4][2], const pg8::Unit& u, int wr, int wc, int fr, int fq) const {
        const int row0 = u.pm * 256 + wr * 64 + fr;
        if (u.kind == 0 && u.pn < 8) {
            const bool isq = u.pn < 4;
            const float* gp = (isq ? qg : kg) + 8 * fq;
            f32x4 gn[2][2];
#pragma unroll
            for (int bj = 0; bj < 2; ++bj)
#pragma unroll
                for (int n = 0; n < 2; ++n) gn[bj][n] = *(const f32x4*)(gp + 32 * bj + 4 * n);
            const float sc = isq ? 0.125f : 1.0f;
            const int col0 = u.pn * 256 + wc * 64 + 8 * fq, hh = 4 * (u.pn & 3) + wc;
#pragma unroll
            for (int ai = 0; ai < 2; ++ai)
#pragma unroll
                for (int m = 0; m < 4; ++m) {
                    float ss = 0.f;
#pragma unroll
                    for (int bj = 0; bj < 2; ++bj)
#pragma unroll
                        for (int n = 0; n < 2; ++n) { const f32x4 v = acc[ai][bj][m][n]; ss += (v[0] * v[0] + v[1] * v[1]) + (v[2] * v[2] + v[3] * v[3]); }
                    ss += __shfl_xor(ss, 16); ss += __shfl_xor(ss, 32);
                    const float rs = sc / sqrtf(ss * (1.0f / HD) + EPS);
                    const int row = row0 + ai * 128 + m * 16;
                    bf16* rowp = ZO + (size_t)row * ZO_LD + col0;
                    u32x4* kfp = KF + ((size_t)((row >> 4) * 16 + hh) * 8 + fq) * 16 + (row & 15);
#pragma unroll
                    for (int bj = 0; bj < 2; ++bj) { const f32x4 v0 = acc[ai][bj][m][0] * rs * gn[bj][0], v1 = acc[ai][bj][m][1] * rs * gn[bj][1];
                        u32x4 w; w.x = pg8::cvt_pk_bf16(v0[0], v0[1]); w.y = pg8::cvt_pk_bf16(v0[2], v0[3]); w.z = pg8::cvt_pk_bf16(v1[0], v1[1]); w.w = pg8::cvt_pk_bf16(v1[2], v1[3]);
                        if (isq) *(u32x4*)(rowp + bj * 32) = w; else kfp[bj * 64] = w; }
                }
            return;
        }
        if (u.kind == 1) {
#pragma unroll
            for (int ai = 0; ai < 2; ++ai)
#pragma unroll
                for (int m = 0; m < 4; ++m) { const int ch = row0 + ai * 128 + m * 16;
#pragma unroll
                    for (int bj = 0; bj < 2; ++bj)
#pragma unroll
                        for (int n = 0; n < 2; ++n) { const int t = u.pn * 256 + bj * 128 + wc * 32 + 8 * fq + 4 * n; const f32x4 v = acc[ai][bj][m][n];
                            u32x2 w; w.x = pg8::cvt_pk_bf16(v[0], v[1]); w.y = pg8::cvt_pk_bf16(v[2], v[3]);
                            VF[((size_t)(((t >> 4) * 16 + (ch >> 6)) * 4 + ((ch >> 4) & 3)) * 4 + ((t >> 2) & 3)) * 16 + (ch & 15)] = w; } }
            return;
        }
        const int col0 = u.pn * 256 + wc * 32 + 8 * fq;
#pragma unroll
        for (int ai = 0; ai < 2; ++ai)
#pragma unroll
            for (int m = 0; m < 4; ++m) { bf16* rowp = ZO + (size_t)(row0 + ai * 128 + m * 16) * ZO_LD + col0;
#pragma unroll
                for (int bj = 0; bj < 2; ++bj) { const f32x4 v0 = acc[ai][bj][m][0], v1 = acc[ai][bj][m][1];
                    u32x4 w; w.x = pg8::cvt_pk_bf16(v0[0], v0[1]); w.y = pg8::cvt_pk_bf16(v0[2], v0[3]); w.z = pg8::cvt_pk_bf16(v1[0], v1[1]); w.w = pg8::cvt_pk_bf16(v1[2], v1[3]);
                    *(u32x4*)(rowp + bj * 128) = w; } }
    }
};

__device__ __forceinline__ int srccol(int map, int n) {
    if (map == 0) return n;
    const int pn = n >> 8, bj = (n >> 7) & 1, i = n & 127;
    if (map == 1) return bj * DFF + 128 * pn + i;
    if (map == 2) {
        if (pn < 4) return n;
        if (pn < 12) return 1024 + bj * 1024 + 128 * (pn - 4) + i;
        return 3072 + bj * 1024 + 128 * (pn - 12) + i;
    }
    if (pn < 8) return 256 * pn + 64 * ((n >> 5) & 3) + 32 * bj + (n & 31);
    return n;
}
__device__ __forceinline__ void p0_transpose_item(const float* W, int K, int N, bf16* WT, int map, LAS float* scr, int item, int lane) {
    const int nblk = N / 64, kb = item / nblk, nb = item % nblk, k0 = 64 * kb, n0 = 64 * nb;
    const float* src = W + (size_t)k0 * N + srccol(map, n0 + lane);
#pragma unroll 16
    for (int i = 0; i < 64; ++i) scr[i * 65 + lane] = src[(size_t)i * N];
    LDS_WAIT(); asm volatile("" ::: "memory");
    const int c = lane & 7;
#pragma unroll
    for (int j = 0; j < 8; ++j) { const int n = (lane >> 3) + 8 * j; const LAS float* s = scr + (8 * c) * 65 + n;
        u32x4 o; o.x = pk2(s[0 * 65], s[1 * 65]); o.y = pk2(s[2 * 65], s[3 * 65]); o.z = pk2(s[4 * 65], s[5 * 65]); o.w = pk2(s[6 * 65], s[7 * 65]);
        *(u32x4*)(WT + (size_t)(n0 + n) * K + k0 + 8 * c) = o; }
    LDS_WAIT(); asm volatile("" ::: "memory");
}
__device__ __forceinline__ void p0_weights(const Params& p, LAS unsigned char* lds, int lane, int wave) {
    LAS float* scr = (LAS float*)(lds + wave * (64 * 65 * 4));
    const int gw = blockIdx.x * 8 + wave, NGW = gridDim.x * 8;
    constexpr int I_FI = (D / 64) * (2 * DFF / 64), I_FO = (DFF / 64) * (D / 64), I_IN = (D / 64) * (D_EIN / 64), I_OUT = (D / 64) * (D / 64);
    constexpr int NITEMS = 4 * I_FI + 4 * I_FO + 2 * I_IN + 2 * I_OUT;
    for (int it = gw; it < NITEMS; it += NGW) {
        int r = it;
        if (r < 4 * I_FI) { const int q = r / I_FI; p0_transpose_item(p.in[IN_FWI] + (size_t)q * D * 2 * DFF, D, 2 * DFF, (bf16*)(p.ws + WS_WFI + q * WFI_STRIDE), 1, scr, r % I_FI, lane); continue; } r -= 4 * I_FI;
        if (r < 4 * I_FO) { const int q = r / I_FO; p0_transpose_item(p.in[IN_FWO] + (size_t)q * DFF * D, DFF, D, (bf16*)(p.ws + WS_WFO + q * WFO_STRIDE), 0, scr, r % I_FO, lane); continue; } r -= 4 * I_FO;
        if (r < I_IN) { p0_transpose_item(p.in[IN_EWI], D, D_EIN, (bf16*)(p.ws + WS_WEI), 2, scr, r, lane); continue; } r -= I_IN;
        if (r < I_IN) { p0_transpose_item(p.in[IN_OWI], D, D_OIN, (bf16*)(p.ws + WS_WOI), 3, scr, r, lane); continue; } r -= I_IN;
        if (r < I_OUT) { p0_transpose_item(p.in[IN_EWO], D, D, (bf16*)(p.ws + WS_WEO), 0, scr, r, lane); continue; } r -= I_OUT;
        p0_transpose_item(p.in[IN_OWO], D, D, (bf16*)(p.ws + WS_WOO), 0, scr, r, lane);
    }
}
__device__ __forceinline__ void p0_modvec(const Params& p, LAS unsigned char* lds, int tid, int lane, int wave) {
    LAS float* sv = (LAS float*)lds;
    LAS float* red = (LAS float*)(lds + 9 * 2048 * 4);
    volatile LAS int* qslot = (volatile LAS int*)(lds + 9 * 2048 * 4 + 8 * 9 * 64 * 4);
    const float* c = p.in[IN_C]; const float* cc = p.in[IN_CCTX];
    for (int i = tid; i < 9 * 2048; i += 512) { const float v = i < 8 * 2048 ? c[i] : cc[i - 8 * 2048]; sv[i] = v / (1.0f + __expf(-v)); }
    float* MOD = (float*)(p.ws + WS_MOD);
    unsigned* qhead = (unsigned*)(p.ws + WS_CTL) + CW_Q;
    for (;;) {
        __syncthreads();
        if (tid == 0) *qslot = (int)__hip_atomic_fetch_add(qhead, 1u, __ATOMIC_RELAXED, __HIP_MEMORY_SCOPE_AGENT);
        __syncthreads();
        const int item = *qslot;
        if (item >= 2 * 288) break;
        const int l = item / 288, col0 = (item % 288) * 64;
        const float* W = p.in[IN_WMOD] + (size_t)l * D * DMODW + col0 + lane + (size_t)(wave * 256) * DMODW;
        float acc[9];
#pragma unroll
        for (int r = 0; r < 9; ++r) acc[r] = 0.f;
#define MV_LOAD(w, k16) do { _Pragma("unroll") for (int e = 0; e < 16; ++e) w[e] = W[(size_t)(16 * (k16) + e) * DMODW]; } while (0)
#define MV_COMP(w, k16) do { _Pragma("unroll") for (int e4 = 0; e4 < 4; ++e4) { _Pragma("unroll") for (int r = 0; r < 9; ++r) { \
            const f32x4 s = *(const LAS f32x4*)(sv + r * 2048 + wave * 256 + 16 * (k16) + 4 * e4); \
            acc[r] += (s[0] * w[4 * e4] + s[1] * w[4 * e4 + 1]) + (s[2] * w[4 * e4 + 2] + s[3] * w[4 * e4 + 3]); } } } while (0)
        float wa[16], wb[16];
        MV_LOAD(wa, 0);
#pragma unroll 1
        for (int k16 = 0; k16 < 16; k16 += 2) {
            MV_LOAD(wb, k16 + 1);
            MV_COMP(wa, k16);
            if (k16 + 2 < 16) MV_LOAD(wa, k16 + 2);
            MV_COMP(wb, k16 + 1);
        }
#undef MV_LOAD
#undef MV_COMP
#pragma unroll
        for (int r = 0; r < 9; ++r) red[(wave * 9 + r) * 64 + lane] = acc[r];
        __syncthreads();
        for (int o = tid; o < 9 * 64; o += 512) {
            const int r = o >> 6, ln = o & 63; float s = 0.f;
#pragma unroll
            for (int w = 0; w < 8; ++w) s += red[(w * 9 + r) * 64 + ln];
            MOD[((size_t)l * 9 + r) * DMODW + col0 + ln] = s + p.in[IN_BMOD][(size_t)l * DMODW + col0 + ln];
        }
    }
}

template <bool COMBINE, bool SRC_F32>
__device__ __forceinline__ void norm_phase(const void* src_lat, const void* src_ctx, _Float16* xw_ctx, const float* part, int nrows, const float* g, const float* modl, int shift_idx, int scale_idx, bf16* HN, int lane, int wave) {
    const int gw = blockIdx.x * 8 + wave, NGW = gridDim.x * 8;
    if (gw >= nrows) return;
    f32x4 v[8], nv[8];
#define NORM_COL(jj) (SRC_F32 ? 4 * lane + 256 * (jj) : 8 * lane + 512 * ((jj) >> 1) + 4 * ((jj) & 1))
#define NORM_LOAD(dst, row) do { const int row_ = (row); const size_t ro_ = (row_ < M_LAT ? (size_t)row_ : (size_t)(row_ - M_LAT)) * D; const void* sp_ = row_ < M_LAT ? src_lat : src_ctx; \
        if constexpr (SRC_F32) { _Pragma("unroll") for (int j = 0; j < 8; ++j) dst[j] = *(const f32x4*)((const float*)sp_ + ro_ + NORM_COL(j)); } \
        else { _Pragma("unroll") for (int j = 0; j < 4; ++j) { const u32x4 hv_ = *(const u32x4*)((const _Float16*)sp_ + ro_ + NORM_COL(2 * j)); dst[2 * j] = h4_to_f32x4((u32x2){hv_.x, hv_.y}); dst[2 * j + 1] = h4_to_f32x4((u32x2){hv_.z, hv_.w}); } } \
        if (COMBINE && row_ >= M_LAT) { _Pragma("unroll") for (int q = 0; q < 3; ++q) { const float* pr_ = part + (size_t)q * (PART_STRIDE / 4) + ro_; \
            _Pragma("unroll") for (int j = 0; j < 8; ++j) dst[j] += *(const f32x4*)(pr_ + NORM_COL(j)); } } } while (0)
    NORM_LOAD(v, gw);
    for (int row = gw; row < nrows; row += NGW) {
        if (row + NGW < nrows) NORM_LOAD(nv, row + NGW);
        const int r = row < M_LAT ? (row >> 11) : 8;
        const float* sh = modl + (size_t)r * DMODW + shift_idx * D; const float* sc = modl + (size_t)r * DMODW + scale_idx * D;
        float ss = 0.f;
#pragma unroll
        for (int j = 0; j < 8; ++j) ss += (v[j][0] * v[j][0] + v[j][1] * v[j][1]) + (v[j][2] * v[j][2] + v[j][3] * v[j][3]);
        const float rstd = 1.0f / sqrtf(wave_sum(ss) * (1.0f / D) + EPS);
        bf16* o = HN + (size_t)row * D;
#pragma unroll
        for (int j = 0; j < 8; ++j) { const int c = NORM_COL(j); const f32x4 gg = *(const f32x4*)(g + c), s1 = *(const f32x4*)(sc + c), s0 = *(const f32x4*)(sh + c);
            const f32x4 y = (v[j] * rstd) * gg * (1.0f + s1) + s0;
            u32x2 w; w.x = pg8::cvt_pk_bf16(y[0], y[1]); w.y = pg8::cvt_pk_bf16(y[2], y[3]); *(u32x2*)(o + c) = w;
            if (COMBINE && row >= M_LAT) *(u32x2*)(xw_ctx + (size_t)(row - M_LAT) * D + c) = f32x4_to_h4(v[j]); }
#pragma unroll
        for (int j = 0; j < 8; ++j) v[j] = nv[j];
    }
#undef NORM_LOAD
#undef NORM_COL
}

__device__ __forceinline__ void even_conv_phase(const Params& p, LAS unsigned char* lds, int tid, int lane, int wave) {
    const bf16* Z3 = (const bf16*)(p.ws + WS_Z); bf16* MIX = (bf16*)(p.ws + WS_MIX);
    LAS unsigned* tile = (LAS unsigned*)lds;
    LAS float* red = (LAS float*)(lds + 62 * 2048);
    LAS float* stat = red + 256;
    const float* ccw = p.in[IN_CCW]; const float* ccb = p.in[IN_CCB]; const float* lng = p.in[IN_LNG]; const float* lnb = p.in[IN_LNB];
    const float* scw = p.in[IN_SCW]; const float* scb = p.in[IN_SCB];
    for (int u = blockIdx.x; u < 576; u += gridDim.x) {
        int base, T, t0;
        if (u < 512) { base = (u >> 6) * SEQ; T = SEQ; t0 = (u & 63) * 32; } else { const int v = u - 512; base = M_LAT + (v >> 3) * CTXL; T = CTXL; t0 = (v & 7) * 32; }
        {
            u32x4 sv[16];
#pragma unroll
            for (int q = 0; q < 16; ++q) { const int ch = tid + 512 * q, rr = min(ch >> 7, 61), cc = ch & 127, t = t0 - 15 + rr, tc = min(max(t, 0), T - 1);
                const unsigned msk = (t == tc) ? 0xffffffffu : 0u;
                sv[q] = *(const u32x4*)(Z3 + (size_t)(base + tc) * ZE_LD + 2048 + cc * 8) & msk; }
#pragma unroll
            for (int q = 0; q < 16; ++q) { const int ch = tid + 512 * q, rr = ch >> 7, cc = ch & 127; if (rr < 62) *(LAS u32x4*)(tile + rr * 512 + cc * 4) = sv[q]; }
        }
        unsigned pv[34], bgv[32];
#pragma unroll
        for (int i = 0; i < 34; ++i) { const int t = t0 - 1 + i, tc = min(max(t, 0), T - 1); const unsigned msk = (t == tc) ? 0xffffffffu : 0u; pv[i] = *(const unsigned*)(Z3 + (size_t)(base + tc) * ZE_LD + 1024 + 2 * tid) & msk; }
#pragma unroll
        for (int i = 0; i < 32; ++i) bgv[i] = *(const unsigned*)(Z3 + (size_t)(base + t0 + i) * ZE_LD + 2 * tid);
        __syncthreads();
        { const f32x2 w0 = *(const f32x2*)(scw + 2 * tid), w1 = *(const f32x2*)(scw + 1024 + 2 * tid), w2 = *(const f32x2*)(scw + 2048 + 2 * tid), b = *(const f32x2*)(scb + 2 * tid);
#pragma unroll
          for (int i = 0; i < 32; ++i) {
              const float c0 = w0[0] * bf_lo(pv[i]) + w1[0] * bf_lo(pv[i + 1]) + w2[0] * bf_lo(pv[i + 2]) + b[0];
              const float c1 = w0[1] * bf_hi(pv[i]) + w1[1] * bf_hi(pv[i + 1]) + w2[1] * bf_hi(pv[i + 2]) + b[1];
              *(unsigned*)(MIX + (size_t)(base + t0 + i) * D + 2 * tid) = pg8::cvt_pk_bf16(bf_lo(bgv[i]) * c0, bf_hi(bgv[i]) * c1); } }
        float acc[32][2];
#pragma unroll
        for (int i = 0; i < 32; ++i) { acc[i][0] = 0.f; acc[i][1] = 0.f; }
#pragma unroll 1
        for (int k = 0; k < 31; ++k) {
            const f32x2 w = *(const f32x2*)(ccw + (size_t)k * 1024 + 2 * tid);
            const LAS unsigned* tp = tile + k * 512 + tid;
#pragma unroll
            for (int i = 0; i < 32; ++i) { const unsigned v = tp[i * 512]; acc[i][0] += w[0] * bf_lo(v); acc[i][1] += w[1] * bf_hi(v); }
        }
        { const f32x2 b = *(const f32x2*)(ccb + 2 * tid);
#pragma unroll
          for (int i = 0; i < 32; ++i) { acc[i][0] += b[0]; acc[i][1] += b[1]; } }
#pragma unroll
        for (int i = 0; i < 32; ++i) { const float s = wave_sum(acc[i][0] + acc[i][1]); if (lane == 0) red[wave * 32 + i] = s; }
        __syncthreads();
        if (tid < 32) { float s = 0.f;
#pragma unroll
            for (int w = 0; w < 8; ++w) s += red[w * 32 + tid]; stat[tid] = s * (1.0f / 1024.0f); }
        __syncthreads();
#pragma unroll
        for (int i = 0; i < 32; ++i) { const float mu = stat[i]; acc[i][0] -= mu; acc[i][1] -= mu; }
        __syncthreads();
#pragma unroll
        for (int i = 0; i < 32; ++i) { const float s = wave_sum(acc[i][0] * acc[i][0] + acc[i][1] * acc[i][1]); if (lane == 0) red[wave * 32 + i] = s; }
        __syncthreads();
        if (tid < 32) { float s = 0.f;
#pragma unroll
            for (int w = 0; w < 8; ++w) s += red[w * 32 + tid]; stat[tid] = 1.0f / sqrtf(s * (1.0f / 1024.0f) + EPS); }
        __syncthreads();
        { const f32x2 g = *(const f32x2*)(lng + 2 * tid), b = *(const f32x2*)(lnb + 2 * tid);
#pragma unroll
          for (int i = 0; i < 32; ++i) { const float rs = stat[i]; const float y0 = acc[i][0] * rs * g[0] + b[0], y1 = acc[i][1] * rs * g[1] + b[1];
              *(unsigned*)(MIX + (size_t)(base + t0 + i) * D + 1024 + 2 * tid) = pg8::cvt_pk_bf16(y0 * fast_sigmoid(y0), y1 * fast_sigmoid(y1)); } }
        __syncthreads();
    }
}

__device__ __forceinline__ void attn_wave_unit(const Params& p, const LAS float* rpbL, int b, int h, int r, int qg, int lane) {
    const bf16* ZO = (const bf16*)(p.ws + WS_Z); const u32x4* KF = (const u32x4*)(p.ws + WS_KF); const u32x2* VF = (const u32x2*)(p.ws + WS_VT); bf16* MIX = (bf16*)(p.ws + WS_MIX);
    const int l15 = lane & 15, g = lane >> 4;
    const int c0 = 16 * qg, qc = c0 + l15, qrow = b * SEQ + r * GW + qc;
    const int r0 = min(max(r - WIN_R / 2, 0), GROWS - WIN_R);
    const int kb = qg == 0 ? 0 : (qg == 1 ? 8 : (qg == 2 ? 24 : 32));
    const int cs = min(max(qc - WIN_C / 2, 0), GW - WIN_C);
    bf16x8 qf[2];
#pragma unroll
    for (int kk = 0; kk < 2; ++kk) qf[kk] = __builtin_bit_cast(bf16x8, *(const u32x4*)(ZO + (size_t)qrow * ZO_LD + h * HD + 8 * g + 32 * kk));
    int dcol[8]; bool okk[8];
#pragma unroll
    for (int a = 0; a < 2; ++a)
#pragma unroll
        for (int e = 0; e < 4; ++e) { const int kc = kb + 16 * a + 4 * g + e; okk[4 * a + e] = (kc >= cs) && (kc < cs + WIN_C); dcol[4 * a + e] = min(max(kc - qc + WIN_C - 1, 0), 2 * WIN_C - 2); }
    const LAS float* rpbh = rpbL + h * 15 * 31;
    u32x4 kx[4][2][2]; u32x2 vx[4][4][2];
#define ATT_TOK0(ch) ((ch) < 8 ? M_LAT + b * CTXL + 32 * (ch) : b * SEQ + (r0 + ((ch) - 8)) * GW + kb)
#define ATT_LOADK(s) do { _Pragma("unroll") for (int c = 0; c < 4; ++c) { const int tok_ = ATT_TOK0(4 * (s) + c); \
        _Pragma("unroll") for (int a = 0; a < 2; ++a) { const int t_ = tok_ + 16 * a + l15; const u32x4* kp_ = KF + ((size_t)((t_ >> 4) * 16 + h) * 8 + g) * 16 + (t_ & 15); kx[c][a][0] = kp_[0]; kx[c][a][1] = kp_[64]; } } } while (0)
#define ATT_LOADV(s) do { _Pragma("unroll") for (int c = 0; c < 4; ++c) { const int tok_ = ATT_TOK0(4 * (s) + c); \
        _Pragma("unroll") for (int a = 0; a < 2; ++a) { const int t_ = tok_ + 16 * a + 4 * g; const u32x2* vp_ = VF + ((size_t)((t_ >> 4) * 16 + h) * 16 + ((t_ >> 2) & 3)) * 16 + l15; \
            _Pragma("unroll") for (int d = 0; d < 4; ++d) vx[c][d][a] = vp_[d * 64]; } } } while (0)
    f32x4 o[4];
#pragma unroll
    for (int d = 0; d < 4; ++d) o[d] = (f32x4){0.f, 0.f, 0.f, 0.f};
    float mrun = -1e30f, lsum = 0.f;
    ATT_LOADK(0); ATT_LOADV(0);
#pragma unroll 1
    for (int s = 0; s < 4; ++s) {
        f32x4 sc_[4][2];
#pragma unroll
        for (int c = 0; c < 4; ++c)
#pragma unroll
            for (int a = 0; a < 2; ++a) { f32x4 acc_ = (f32x4){0.f, 0.f, 0.f, 0.f};
                acc_ = __builtin_amdgcn_mfma_f32_16x16x32_bf16(__builtin_bit_cast(bf16x8, kx[c][a][0]), qf[0], acc_, 0, 0, 0);
                acc_ = __builtin_amdgcn_mfma_f32_16x16x32_bf16(__builtin_bit_cast(bf16x8, kx[c][a][1]), qf[1], acc_, 0, 0, 0); sc_[c][a] = acc_; }
        if (s < 3) ATT_LOADK(s + 1);
        if (s >= 2) {
#pragma unroll
            for (int c = 0; c < 4; ++c) { const LAS float* bp_ = rpbh + ((r0 + 4 * (s - 2) + c) - r + WIN_R - 1) * 31;
#pragma unroll
                for (int a = 0; a < 2; ++a)
#pragma unroll
                    for (int e = 0; e < 4; ++e) sc_[c][a][e] = okk[4 * a + e] ? sc_[c][a][e] + bp_[dcol[4 * a + e]] : -1e30f; }
        }
        float mx_ = -1e30f;
#pragma unroll
        for (int c = 0; c < 4; ++c)
#pragma unroll
            for (int a = 0; a < 2; ++a) mx_ = fmaxf(mx_, fmaxf(fmaxf(sc_[c][a][0], sc_[c][a][1]), fmaxf(sc_[c][a][2], sc_[c][a][3])));
        mx_ = fmaxf(mx_, __shfl_xor(mx_, 16)); mx_ = fmaxf(mx_, __shfl_xor(mx_, 32));
        const float mnew_ = fmaxf(mrun, mx_), alpha_ = __builtin_amdgcn_exp2f((mrun - mnew_) * 1.44269504089f); mrun = mnew_;
        const float mb_ = mnew_ * 1.44269504089f;
        float ps_ = 0.f; bf16x8 pf_[4];
#pragma unroll
        for (int c = 0; c < 4; ++c) { float pe_[8];
#pragma unroll
            for (int a = 0; a < 2; ++a)
#pragma unroll
                for (int e = 0; e < 4; ++e) { pe_[4 * a + e] = __builtin_amdgcn_exp2f(sc_[c][a][e] * 1.44269504089f - mb_); ps_ += pe_[4 * a + e]; }
            u32x4 pw_; pw_.x = pg8::cvt_pk_bf16(pe_[0], pe_[1]); pw_.y = pg8::cvt_pk_bf16(pe_[2], pe_[3]); pw_.z = pg8::cvt_pk_bf16(pe_[4], pe_[5]); pw_.w = pg8::cvt_pk_bf16(pe_[6], pe_[7]);
            pf_[c] = __builtin_bit_cast(bf16x8, pw_); }
        lsum = lsum * alpha_ + ps_;
#pragma unroll
        for (int d = 0; d < 4; ++d) { o[d] = o[d] * alpha_;
#pragma unroll
            for (int c = 0; c < 4; ++c) { u32x4 vw_; vw_.x = vx[c][d][0].x; vw_.y = vx[c][d][0].y; vw_.z = vx[c][d][1].x; vw_.w = vx[c][d][1].y;
                o[d] = __builtin_amdgcn_mfma_f32_16x16x32_bf16(__builtin_bit_cast(bf16x8, vw_), pf_[c], o[d], 0, 0, 0); } }
        if (s < 3) ATT_LOADV(s + 1);
    }
#undef ATT_TOK0
#undef ATT_LOADK
#undef ATT_LOADV
    lsum += __shfl_xor(lsum, 16); lsum += __shfl_xor(lsum, 32);
    const float inv = 1.0f / lsum;
#pragma unroll
    for (int d = 0; d < 4; ++d) { u32x2 w; w.x = pg8::cvt_pk_bf16(o[d][0] * inv, o[d][1] * inv); w.y = pg8::cvt_pk_bf16(o[d][2] * inv, o[d][3] * inv);
        *(u32x2*)(MIX + (size_t)qrow * D + h * HD + 16 * d + 4 * g) = w; }
}
__device__ __forceinline__ void attn_phase(const Params& p, LAS unsigned char* lds, int tid, int lane, int wave) {
    LAS float* rpbL = (LAS float*)lds;
    __syncthreads();
    for (int i = tid; i < NH * 15 * 31; i += 512) rpbL[i] = p.in[IN_RPB][i];
    __syncthreads();
    const int cls = blockIdx.x & 7, wgi = blockIdx.x >> 3, ncl = (gridDim.x - cls + 7) >> 3, nW = ncl * 8;
    if (gridDim.x >= 8) {
        for (int v = wgi * 8 + wave; v < NH * GROWS * 4; v += nW) { const int h = v >> 7, rem = v & 127; attn_wave_unit(p, rpbL, cls, h, rem >> 2, rem & 3, lane); }
    } else {
        for (int v = blockIdx.x * 8 + wave; v < NBATCH * NH * GROWS * 4; v += gridDim.x * 8) { const int b = v >> 11, w = v & 2047, h = w >> 7, rem = w & 127; attn_wave_unit(p, rpbL, b, h, rem >> 2, rem & 3, lane); }
    }
}

__device__ __forceinline__ float gelu_tanh(float x) { const float z = 0.7978845608028654f * (x + 0.044715f * x * x * x); return x * fast_sigmoid(2.0f * z); }
constexpr int LCH = 256;
__device__ __forceinline__ void lru_item(const Params& p, LAS unsigned char* lds, int item, int tid, int lane, int wave) {
    const bf16* ZO = (const bf16*)(p.ws + WS_Z); float* HF = (float*)(p.ws + WS_HF); bf16* MIX = (bf16*)(p.ws + WS_MIX);
    const int b = item >> 5, n = (item >> 1) & 15, half = item & 1, j0 = half * 32;
    LAS float* xcf = (LAS float*)lds;
    LAS bf16* xcb = (LAS bf16*)(lds + LCH * 33 * 4);
    LAS float* As = (LAS float*)(lds + LCH * 33 * 4 + LCH * 72 * 2);
    LAS float* Us = As + LCH * 33;
    LAS float* segA = Us + LCH * 33;
    LAS float* segH = segA + 16 * 32;
    const int ci = lane, cch = n * 64 + ci;
    const float* lcw = p.in[IN_LCW]; const float cw0 = lcw[cch], cw1 = lcw[1024 + cch], cw2 = lcw[2048 + cch], cw3 = lcw[3072 + cch], cb = p.in[IN_LCB][cch];
    const bool own = (ci >> 5) == half;
    const int jb = wave & 1, tb0 = (wave >> 1) * 4, l15 = lane & 15, g = lane >> 4, jl = 16 * jb + l15, gch = n * 64 + j0 + jl;
    const int sc = lane & 31, hi = lane >> 5, sg = 2 * wave + hi;
    const unsigned och = (unsigned)(n * 64 + j0 + sc);
    for (int dir = 0; dir < 2; ++dir) {
        bf16x8 Bg[2][2];
        {
            const float* gw = p.in[IN_LGW] + (size_t)((dir * 2) * 16 + n) * 4096;
#pragma unroll
            for (int gt = 0; gt < 2; ++gt)
#pragma unroll
                for (int kk = 0; kk < 2; ++kk) { const float* wp = gw + (size_t)gt * 16 * 4096 + (size_t)(8 * g + 32 * kk) * 64 + j0 + jl;
                    u32x4 w; w.x = pk2(wp[0], wp[64]); w.y = pk2(wp[128], wp[192]); w.z = pk2(wp[256], wp[320]); w.w = pk2(wp[384], wp[448]); Bg[gt][kk] = __builtin_bit_cast(bf16x8, w); }
        }
        const float br = p.in[IN_LGB][(dir * 2 + 0) * 1024 + gch], bi = p.in[IN_LGB][(dir * 2 + 1) * 1024 + gch];
        const float lam = p.in[IN_LAM][dir * 1024 + gch];
        const float sp8 = -8.0f * log1pf(expf(-lam)) * 1.44269504089f;
        float carry = 0.f;
        const unsigned hoff = (unsigned)((dir == 0 ? 16 * hi : 16 * (1 - hi)) * 1024) + och;
        const unsigned moff = (unsigned)((dir == 0 ? 16 * hi : 16 * (1 - hi)) * D) + 1024u + och;
        const unsigned goff = (unsigned)((dir == 0 ? 16 * hi : 16 * (1 - hi)) * ZO_LD) + 4096u + och;
        u32x4 xraw[5];
#define LRU_LOADX(cidx_) do { const int ci_ = (cidx_); const bool isctx_ = ci_ < 1; const int cc_ = isctx_ ? 0 : ci_ - 1, ncs_ = isctx_ ? 1 : 8, cpos_ = dir == 0 ? cc_ : ncs_ - 1 - cc_; \
        const int base_ = isctx_ ? M_LAT + b * CTXL : b * SEQ, T_ = isctx_ ? CTXL : SEQ, ts_ = cpos_ * LCH - 1; \
        _Pragma("unroll") for (int q = 0; q < 5; ++q) { const int pc = min(q * 512 + tid, 2071), t = ts_ + (pc >> 3), tc = min(max(t, 0), T_ - 1); const unsigned msk = (t == tc) ? 0xffffffffu : 0u; \
            xraw[q] = *(const u32x4*)(ZO + (size_t)(base_ + tc) * ZO_LD + 3072 + n * 64 + (pc & 7) * 8) & msk; } } while (0)
        LRU_LOADX(0);
        LAS unsigned char* rawt = (LAS unsigned char*)As;
#pragma unroll 1
        for (int cidx = 0; cidx < 9; ++cidx) {
            const bool isctx = cidx < 1;
            const int cc = isctx ? 0 : cidx - 1, ncs = isctx ? 1 : 8, cpos = dir == 0 ? cc : ncs - 1 - cc;
            const int base = isctx ? M_LAT + b * CTXL : b * SEQ, t0 = cpos * LCH;
#pragma unroll
            for (int q = 0; q < 5; ++q) { const int pc = q * 512 + tid; if (pc < 2072) *(LAS u32x4*)(rawt + pc * 16) = xraw[q]; }
            __syncthreads();
            {
                float xf[35];
                const LAS unsigned short* rp_ = (const LAS unsigned short*)(rawt + (32 * wave) * 128) + ci;
#pragma unroll
                for (int e = 0; e < 35; ++e) xf[e] = __builtin_bit_cast(float, (unsigned)rp_[e * 64] << 16);
                LAS bf16* xb_ = xcb + (32 * wave) * 72 + ci; LAS float* xf_ = xcf + (32 * wave) * 33 + (ci & 31);
#pragma unroll
                for (int e = 0; e < 32; ++e) { const float y = cw0 * xf[e] + cw1 * xf[e + 1] + cw2 * xf[e + 2] + cw3 * xf[e + 3] + cb;
                    xb_[e * 72] = (bf16)f2bf(y); if (own) xf_[e * 33] = y; }
            }
            if (cidx + 1 < 9) LRU_LOADX(cidx + 1);
            __syncthreads();
#pragma unroll 1
            for (int q = 0; q < 4; ++q) {
                const int tb = tb0 + q;
                const bf16x8 a0 = *(const LAS bf16x8*)(xcb + (16 * tb + l15) * 72 + 8 * g), a1 = *(const LAS bf16x8*)(xcb + (16 * tb + l15) * 72 + 8 * g + 32);
                f32x4 gr_ = (f32x4){0.f, 0.f, 0.f, 0.f}, gi_ = (f32x4){0.f, 0.f, 0.f, 0.f};
                gr_ = __builtin_amdgcn_mfma_f32_16x16x32_bf16(a0, Bg[0][0], gr_, 0, 0, 0); gr_ = __builtin_amdgcn_mfma_f32_16x16x32_bf16(a1, Bg[0][1], gr_, 0, 0, 0);
                gi_ = __builtin_amdgcn_mfma_f32_16x16x32_bf16(a0, Bg[1][0], gi_, 0, 0, 0); gi_ = __builtin_amdgcn_mfma_f32_16x16x32_bf16(a1, Bg[1][1], gi_, 0, 0, 0);
#pragma unroll
                for (int e = 0; e < 4; ++e) {
                    const int tl = 16 * tb + 4 * g + e;
                    const float rg = fast_sigmoid(gr_[e] + br), ig = fast_sigmoid(gi_[e] + bi);
                    const float la2 = sp8 * rg, a = __builtin_amdgcn_exp2f(la2);
                    const float x2 = la2 * 1.38629436112f;
                    const float em = x2 > -0.25f ? -x2 * (1.0f + x2 * (0.5f + x2 * (0.16666667f + x2 * (0.041666668f + x2 * 0.0083333338f)))) : 1.0f - a * a;
                    As[tl * 33 + jl] = a; Us[tl * 33 + jl] = sqrtf(em) * ig * xcf[tl * 33 + jl];
                }
            }
            __syncthreads();
            float av[16], uv[16];
            {
                float A = 1.f, H = 0.f;
                const LAS float* ap_ = As + (dir ? (LCH - 1 - 16 * sg) : 16 * sg) * 33 + sc; const LAS float* up_ = Us + (dir ? (LCH - 1 - 16 * sg) : 16 * sg) * 33 + sc;
#pragma unroll
                for (int e = 0; e < 16; ++e) { av[e] = dir ? ap_[-e * 33] : ap_[e * 33]; uv[e] = dir ? up_[-e * 33] : up_[e * 33]; H = av[e] * H + uv[e]; A *= av[e]; }
                segA[sg * 32 + sc] = A; segH[sg * 32 + sc] = H;
            }
            const int rbase = dir == 0 ? base + t0 + 32 * wave : base + t0 + LCH - 1 - 32 * wave - 16;
            float hfv[16]; unsigned grv[16];
            if (!isctx && dir == 1) {
                const float* hp_ = HF + (size_t)rbase * 1024; const bf16* gp_ = ZO + (size_t)rbase * ZO_LD;
#pragma unroll
                for (int e = 0; e < 16; ++e) { hfv[e] = (hp_ - (size_t)e * 1024)[hoff]; grv[e] = (unsigned)(gp_ - (size_t)e * ZO_LD)[goff]; }
            }
            __syncthreads();
            {
                float hin = carry, mine = 0.f;
#pragma unroll
                for (int s2 = 0; s2 < 16; ++s2) { if (s2 == sg) mine = hin; hin = segA[s2 * 32 + sc] * hin + segH[s2 * 32 + sc]; }
                carry = hin;
                if (!isctx) {
                    float hcur = mine;
                    if (dir == 0) {
                        float* hp_ = HF + (size_t)rbase * 1024;
#pragma unroll
                        for (int e = 0; e < 16; ++e) { hcur = av[e] * hcur + uv[e]; (hp_ + (size_t)e * 1024)[hoff] = hcur; }
                    } else {
                        bf16* mp_ = MIX + (size_t)rbase * D;
#pragma unroll
                        for (int e = 0; e < 16; ++e) { hcur = av[e] * hcur + uv[e];
                            (mp_ - (size_t)e * D)[moff] = (bf16)f2bf((hfv[e] + hcur) * gelu_tanh(__builtin_bit_cast(float, grv[e] << 16))); }
                    }
                }
            }
        }
#undef LRU_LOADX
        VM_WAIT(); __syncthreads();
    }
}


#if MK_SPLIT
#define GRID_BAR() do { } while (0)
#else
#define GRID_BAR() xcd_barrier(bar)
#endif
#ifndef PH_MASK
#define PH_MASK 0xffffffffu
#endif
#define IN(k) (lo <= (k) && (k) < hi && ((PH_MASK >> (k)) & 1u))
#ifndef PROBE_MASK
#define PROBE_MASK 0u
#endif
#ifndef PROBE_MULT
#define PROBE_MULT 4
#endif
#if PROBE_MASK
#define PROBE_STAMP(k) do { if (blockIdx.x == 0 && threadIdx.x == 0) { volatile LAS unsigned long long* pw = (volatile LAS unsigned long long*)(lds + MISC_OFF + 128); \
        const unsigned long long t_ = __builtin_amdgcn_s_memrealtime(); if ((PROBE_MASK >> (k)) & 1u) pw[1] += t_ - pw[0]; pw[0] = t_; } } while (0)
#else
#define PROBE_STAMP(k) do { } while (0)
#endif
#define SEAM(k) do { if (IN(k) && IN((k) + 1)) GRID_BAR(); PROBE_STAMP(k); } while (0)

template <int L>
__device__ __forceinline__ void layer_body(const Params& p, LAS unsigned char* lds, const XcdBarrier& bar, const int lo, const int hi) {
    constexpr int l = L;
    const int tid = threadIdx.x, lane = tid & 63, wave = __builtin_amdgcn_readfirstlane(tid >> 6);
    const int G = gridDim.x;
    float* MOD = (float*)(p.ws + WS_MOD);
    _Float16* X = (_Float16*)(p.ws + WS_X);
    bf16* HN = (bf16*)(p.ws + WS_HN);
    bf16* ACT = (bf16*)(p.ws + WS_ACT);
    bf16* Z = (bf16*)(p.ws + WS_Z);
    bf16* MIX = (bf16*)(p.ws + WS_MIX);
    float* PART = (float*)(p.ws + WS_PART);
        const int pb = 1 + 10 * l;
        const float* modl = MOD + (size_t)l * 9 * DMODW;
        const float* ng = p.in[IN_NORMG] + (size_t)l * 3 * D;
        constexpr bool first = (l == 0);
        const void* xs_lat = first ? (const void*)p.in[IN_X] : (const void*)X; const void* xs_ctx = first ? (const void*)p.in[IN_CTX] : (const void*)(X + (size_t)M_LAT * D);

        if (IN(pb + 0)) norm_phase<!first, first>(xs_lat, xs_ctx, X + (size_t)M_LAT * D, PART, M_ALL, ng + 0 * D, modl, 0, 1, HN, lane, wave);
        SEAM(pb + 0);
        if (IN(pb + 1)) {
            SchedStd S{(const char*)HN, (const char*)(p.ws + WS_WFI + (size_t)(l * 2 + 0) * WFI_STRIDE), (size_t)256 * D * 2, M_ALL / 256, 2 * DFF / 256, G, (int)blockIdx.x, D / 64};
            EpiSwiGLU E{ACT};
            pg8::gemm_phase<EpiSwiGLU, SchedStd>(lds, D, S, E);
        }
        SEAM(pb + 1);
        if (IN(pb + 2)) {
            SchedDown S{(const char*)ACT, (const char*)(p.ws + WS_WFO + (size_t)(l * 2 + 0) * WFO_STRIDE), (size_t)256 * DFF * 2, G, (int)blockIdx.x, DFF / 64};
            EpiResid<first, false> E{xs_lat, xs_ctx, X, modl + 2 * D, 0.5f, PART};
            pg8::gemm_phase<EpiResid<first, false>, SchedDown>(lds, DFF, S, E);
        }
        SEAM(pb + 2);
        if (IN(pb + 3)) norm_phase<true, false>(X, X + (size_t)M_LAT * D, X + (size_t)M_LAT * D, PART, M_ALL, ng + 1 * D, modl, 3, 4, HN, lane, wave);
        SEAM(pb + 3);
        if constexpr (first) {
            if (IN(pb + 4)) {
                SchedStd S{(const char*)HN, (const char*)(p.ws + WS_WEI), (size_t)256 * D * 2, M_ALL / 256, D_EIN / 256, G, (int)blockIdx.x, D / 64};
                EpiEvIn E{Z};
                pg8::gemm_phase<EpiEvIn, SchedStd>(lds, D, S, E);
            }
            SEAM(pb + 4);
            if (IN(pb + 5)) even_conv_phase(p, lds, tid, lane, wave);
            SEAM(pb + 5);
            if (IN(pb + 6)) {
                SchedDown S{(const char*)MIX, (const char*)(p.ws + WS_WEO), (size_t)256 * D * 2, G, (int)blockIdx.x, D / 64};
                EpiResid<false, false> E{X, X + (size_t)M_LAT * D, X, modl + 5 * D, 1.0f, PART};
                pg8::gemm_phase<EpiResid<false, false>, SchedDown>(lds, D, S, E);
            }
            SEAM(pb + 6);
        } else {
            if (IN(pb + 4)) {
                SchedOdIn S{(const char*)HN, (const char*)(p.ws + WS_WOI), (size_t)256 * D * 2, G, (int)blockIdx.x};
                EpiOdIn E{Z, (u32x4*)(p.ws + WS_KF), (u32x2*)(p.ws + WS_VT), p.in[IN_QG], p.in[IN_KG]};
                pg8::gemm_phase<EpiOdIn, SchedOdIn>(lds, D, S, E);
            }
            SEAM(pb + 4);
            if (IN(pb + 5)) {
#ifndef NO_LRU
                for (int item = blockIdx.x; item < 256; item += G) lru_item(p, lds, item, tid, lane, wave);
#endif
#if PROBE_MASK
                __syncthreads();
                if (blockIdx.x == 0 && threadIdx.x == 0) { volatile LAS unsigned long long* pw = (volatile LAS unsigned long long*)(lds + MISC_OFF + 128);
                    const unsigned long long t_ = __builtin_amdgcn_s_memrealtime(); if ((PROBE_MASK >> 30) & 1u) pw[1] += t_ - pw[0]; }
#endif
#ifndef NO_ATTN
                attn_phase(p, lds, tid, lane, wave);
#endif
            }
            SEAM(pb + 5);
            if (IN(pb + 6)) {
                SchedStd S{(const char*)MIX, (const char*)(p.ws + WS_WOO), (size_t)256 * D * 2, M_LAT / 256, D / 256, G, (int)blockIdx.x, D / 64};
                EpiResid<false, false> E{X, X + (size_t)M_LAT * D, X, modl + 5 * D, 1.0f, PART};
                pg8::gemm_phase<EpiResid<false, false>, SchedStd>(lds, D, S, E);
            }
            SEAM(pb + 6);
        }
        const int nrows2 = first ? M_ALL : M_LAT;
        if (IN(pb + 7)) norm_phase<first, false>(X, X + (size_t)M_LAT * D, X + (size_t)M_LAT * D, PART, nrows2, ng + 2 * D, modl, 6, 7, HN, lane, wave);
        SEAM(pb + 7);
        if (IN(pb + 8)) {
            SchedStd S{(const char*)HN, (const char*)(p.ws + WS_WFI + (size_t)(l * 2 + 1) * WFI_STRIDE), (size_t)256 * D * 2, nrows2 / 256, 2 * DFF / 256, G, (int)blockIdx.x, D / 64};
            EpiSwiGLU E{ACT};
            pg8::gemm_phase<EpiSwiGLU, SchedStd>(lds, D, S, E);
        }
        SEAM(pb + 8);
        if (IN(pb + 9)) {
            if constexpr (first) {
                SchedDown S{(const char*)ACT, (const char*)(p.ws + WS_WFO + (size_t)(l * 2 + 1) * WFO_STRIDE), (size_t)256 * DFF * 2, G, (int)blockIdx.x, DFF / 64};
                EpiResid<false, false> E{X, X + (size_t)M_LAT * D, X, modl + 8 * D, 0.5f, PART};
                pg8::gemm_phase<EpiResid<false, false>, SchedDown>(lds, DFF, S, E);
            } else {
                SchedStd S{(const char*)ACT, (const char*)(p.ws + WS_WFO + (size_t)(l * 2 + 1) * WFO_STRIDE), (size_t)256 * DFF * 2, M_LAT / 256, D / 256, G, (int)blockIdx.x, DFF / 64};
                EpiResid<false, true> E{X, X + (size_t)M_LAT * D, p.out, modl + 8 * D, 0.5f, PART};
                pg8::gemm_phase<EpiResid<false, true>, SchedStd>(lds, DFF, S, E);
            }
        }
        SEAM(pb + 9);
}
__global__ void __launch_bounds__(512, 2) mega_fwd(Params p) {
    extern __shared__ __attribute__((aligned(16))) unsigned char lds_raw[];
    LAS unsigned char* lds = (LAS unsigned char*)lds_raw;
    volatile LAS unsigned* MISC = (volatile LAS unsigned*)(lds + MISC_OFF);
    const int tid = threadIdx.x, lane = tid & 63, wave = __builtin_amdgcn_readfirstlane(tid >> 6);
    const int G = gridDim.x;
    if (tid < 64) MISC[tid] = 0u;
    __syncthreads();
    unsigned* ctl = (unsigned*)(p.ws + WS_CTL);
#if MK_SPLIT
    XcdBarrier bar; bar.bar = ctl + CW_BAR; bar.x = 0; bar.st = MISC + 8;
#else
    XcdBarrier bar = xcd_barrier_post(ctl + CW_BAR, MISC + 8);
#endif
    const int lo = p.ph_lo, hi = p.ph_hi;
#if PROBE_MASK
    if (blockIdx.x == 0 && tid == 0) { volatile LAS unsigned long long* pw = (volatile LAS unsigned long long*)(lds + MISC_OFF + 128); pw[0] = __builtin_amdgcn_s_memrealtime(); pw[1] = 0ull; }
#endif

    float* MOD = (float*)(p.ws + WS_MOD);
    float* X = (float*)(p.ws + WS_X);
    bf16* HN = (bf16*)(p.ws + WS_HN);
    bf16* ACT = (bf16*)(p.ws + WS_ACT);
    bf16* Z = (bf16*)(p.ws + WS_Z);
    bf16* MIX = (bf16*)(p.ws + WS_MIX);

    if (IN(0)) {
#ifndef NO_WEIGHTS
        p0_weights(p, lds, lane, wave); __syncthreads();
#endif
#ifndef NO_MODVEC
        p0_modvec(p, lds, tid, lane, wave); __syncthreads();
#endif
    }
    SEAM(0);

    layer_body<0>(p, lds, bar, lo, hi);
    layer_body<1>(p, lds, bar, lo, hi);
#if PROBE_MASK
    if (blockIdx.x == 0 && tid == 0) { volatile LAS unsigned long long* pw = (volatile LAS unsigned long long*)(lds + MISC_OFF + 128); const unsigned long long t0 = __builtin_amdgcn_s_memrealtime(), dt = (unsigned long long)PROBE_MULT * pw[1];
        while (__builtin_amdgcn_s_memrealtime() - t0 < dt) __builtin_amdgcn_s_sleep(8); }
#endif
#undef IN
#undef SEAM
#undef GRID_BAR
}

extern "C" void kernel_launch(void* const* d_in, const int* in_sizes, int n_in, void* d_out, int out_size, void* d_ws, size_t ws_size, hipStream_t stream) {
    static int grid = 0;
    if (grid == 0) {
        if (n_in != 27 || in_sizes[0] != M_LAT * D || out_size != M_LAT * D || ws_size < WS_END) {
            fprintf(stderr, "kernel_launch: unexpected shapes (n_in %d, in0 %d, out %d, ws %zu; need ws >= %zu); nothing launched\n", n_in, n_in > 0 ? in_sizes[0] : -1, out_size, ws_size, (size_t)WS_END); grid = -1; return; }
        int dev = 0, cus = 0, per_cu = 0;
        if (hipGetDevice(&dev) != hipSuccess || hipDeviceGetAttribute(&cus, hipDeviceAttributeMultiprocessorCount, dev) != hipSuccess) { fprintf(stderr, "kernel_launch: device query failed\n"); grid = -1; return; }
        if (hipFuncSetAttribute((const void*)mega_fwd, hipFuncAttributeMaxDynamicSharedMemorySize, LDS_BYTES) != hipSuccess) { fprintf(stderr, "kernel_launch: hipFuncSetAttribute failed\n"); grid = -1; return; }
        if (hipOccupancyMaxActiveBlocksPerMultiprocessor(&per_cu, (const void*)mega_fwd, 512, LDS_BYTES) != hipSuccess || per_cu < 1) {
            fprintf(stderr, "kernel_launch: occupancy query reports %d workgroups per CU\n", per_cu); }
        (void)hipGetLastError();
        grid = cus;
    }
    if (grid < 0) return;
    if (hipMemsetAsync((char*)d_ws + WS_CTL, 0, CTL_ZERO_BYTES, stream) != hipSuccess) { fprintf(stderr, "kernel_launch: memset failed\n"); return; }
    Params a{};
    for (int i = 0; i < 27; ++i) a.in[i] = (const float*)d_in[i];
    a.out = (float*)d_out; a.ws = (unsigned char*)d_ws;
#if MK_SPLIT
    for (int ph = 0; ph < NPHASE; ++ph) { a.ph_lo = ph; a.ph_hi = ph + 1; hipLaunchKernelGGL(mega_fwd, dim3(grid), dim3(512), LDS_BYTES, stream, a); }
#else
    a.ph_lo = 0; a.ph_hi = NPHASE;
    hipLaunchKernelGGL(mega_fwd, dim3(grid), dim3(512), LDS_BYTES, stream, a);
#endif
    const hipError_t le = hipPeekAtLastError();
    if (le != hipSuccess) fprintf(stderr, "kernel_launch: launch failed: %s\n", hipGetErrorName(le));
}
```

```cpp
#include <hip/hip_runtime.h>
#include <cstdio>
#include <cstdint>

#ifndef MK_SPLIT
#define MK_SPLIT 0
#endif

namespace pg8 {
#define PG8_LAS __attribute__((address_space(3)))
typedef unsigned short bf16_t;
typedef short bf16x8 __attribute__((ext_vector_type(8)));
typedef float f32x4 __attribute__((ext_vector_type(4)));
typedef unsigned u32x4 __attribute__((ext_vector_type(4)));
typedef unsigned u32x2 __attribute__((ext_vector_type(2)));
constexpr int BM = 256, BK = 64, HALF = 128, HTB = HALF * BK * 2  , STAGE_BYTES = 8 * HTB, NXCD = 8, WGM = 8;

__host__ __device__ __forceinline__ int lds_byte(int r, int c) { const int st = (r >> 4) * 2 + (c >> 5), rr = r & 15, cc = c & 31, ob = rr * 64 + cc * 2; return st * 1024 + (ob ^ (((ob >> 9) & 1) << 5)); }
__host__ __device__ __forceinline__ void stage_rc(int b, int& R, int& C) { const int st = b / 1024, sb = b % 1024, swz = sb ^ (((sb >> 9) & 1) << 5); R = (st >> 1) * 16 + swz / 64; C = (st & 1) * 32 + (swz % 64) / 2; }
__host__ __device__ __forceinline__ int perm32(int rho) { const int n = rho >> 4, i = rho & 15; return 8 * (i >> 2) + 4 * n + (i & 3); }

struct Unit { int pm, pn, kind; };

__host__ __device__ __forceinline__ void tile_map(int wgid, int nM, int nN, int& pm, int& pn) {
    const int nwg = nM * nN;
    { const int q = nwg / NXCD, r = nwg % NXCD, xcd = wgid % NXCD, off = wgid / NXCD; wgid = (xcd < r ? xcd * (q + 1) : r * (q + 1) + (xcd - r) * q) + off; }
    const int nig = WGM * nN, gid = wgid / nig, fm = gid * WGM, gsz = (nM - fm) < WGM ? (nM - fm) : WGM;
    pm = fm + ((wgid % nig) % gsz); pn = (wgid % nig) / gsz;
}

__device__ __forceinline__ unsigned cvt_pk_bf16(float lo, float hi) { unsigned r; asm volatile("v_cvt_pk_bf16_f32 %0, %1, %2" : "=v"(r) : "v"(lo), "v"(hi)); return r; }

template <class Epi, class Sched, bool ALIGN_EPI = true, bool SP2 = true>
__device__ __forceinline__ void gemm_phase(PG8_LAS unsigned char* lds, const int K  , const Sched& S, const Epi& E) {
    const int tid = threadIdx.x, wid = __builtin_amdgcn_readfirstlane(tid >> 6), lane = tid & 63, wr = wid >> 2, wc = wid & 3, fr = lane & 15, fq = lane >> 4;
    unsigned voffA[2], voffB[2];
#pragma unroll
    for (int i = 0; i < 2; ++i) { int R, C; stage_rc(tid * 16 + i * 8192, R, C); const int Rb = Epi::PERM ? ((R & ~31) + perm32(R & 31)) : R;
        voffA[i] = (unsigned)(R * K + C) * 2u; voffB[i] = (unsigned)(Rb * K + C) * 2u; }
    const size_t kstep = (size_t)(BK * 2);
    const size_t hstep = (size_t)HALF * K * 2;
    const unsigned ldsw = (unsigned)wid * 1024u;
    const int aoff = lds_byte(wr * 64 + fr, fq * 8), boff = lds_byte(wc * 32 + fr, fq * 8);
#define PG8_SA(b, h) (((b) * 2 + (h)) * HTB)
#define PG8_SB(b, h) ((4 + (b) * 2 + (h)) * HTB)
#define PG8_STAGE(bufoff, gbase, voff) do { _Pragma("unroll") for (int _i = 0; _i < 2; ++_i) \
        __builtin_amdgcn_global_load_lds((const unsigned*)((const char*)(gbase) + (voff)[_i]), (PG8_LAS unsigned*)(lds + (bufoff) + ldsw + _i * 8192), 16, 0, 0); } while (0)
#define PG8_LDA(dst, b, h) do { _Pragma("unroll") for (int m = 0; m < 4; ++m) _Pragma("unroll") for (int k = 0; k < 2; ++k) dst[m][k] = *(const PG8_LAS bf16x8*)(lds + PG8_SA(b, h) + aoff + m * 2048 + k * 1024); } while (0)
#define PG8_LDB(dst, b, h) do { _Pragma("unroll") for (int n = 0; n < 2; ++n) _Pragma("unroll") for (int k = 0; k < 2; ++k) dst[n][k] = *(const PG8_LAS bf16x8*)(lds + PG8_SB(b, h) + boff + n * 2048 + k * 1024); } while (0)
#define PG8_MMA(ai, bj, At, Bt) do { __builtin_amdgcn_s_setprio(1); _Pragma("unroll") for (int m = 0; m < 4; ++m) _Pragma("unroll") for (int n = 0; n < 2; ++n) _Pragma("unroll") for (int k = 0; k < 2; ++k) \
        acc[ai][bj][m][n] = __builtin_amdgcn_mfma_f32_16x16x32_bf16(Bt[n][k], At[m][k], acc[ai][bj][m][n], 0, 0, 0); __builtin_amdgcn_s_setprio(0); } while (0)
#define PG8_WAIT_V(n) asm volatile("s_waitcnt vmcnt(" #n ")" ::: "memory")
#define PG8_WAIT_L(n) asm volatile("s_waitcnt lgkmcnt(" #n ")" ::: "memory")
#define PG8_BAR __builtin_amdgcn_s_barrier()
#define PG8_SCHED __builtin_amdgcn_sched_barrier(0)
    Unit cur, nxt; int ui = 0;
    if (!S.next(0, cur)) return;
    f32x4 acc[2][2][4][2];
#pragma unroll
    for (int a = 0; a < 2; ++a)
#pragma unroll
        for (int b = 0; b < 2; ++b)
#pragma unroll
            for (int m = 0; m < 4; ++m)
#pragma unroll
                for (int n = 0; n < 2; ++n) acc[a][b][m][n] = (f32x4){0.f, 0.f, 0.f, 0.f};
    bf16x8 At[4][2], B0[2][2], B1[2][2];
    const char* cA = S.a_base(cur); const char* cB = S.b_base(cur);
    if constexpr (SP2) {
        PG8_STAGE(PG8_SB(0, 0), cB, voffB); PG8_STAGE(PG8_SB(0, 1), cB + hstep, voffB); PG8_STAGE(PG8_SA(0, 0), cA, voffA); PG8_STAGE(PG8_SA(0, 1), cA + hstep, voffA);
        if (wr == 1) PG8_BAR;
        PG8_WAIT_V(2); PG8_BAR;
        PG8_STAGE(PG8_SB(1, 0), cB + kstep, voffB); PG8_STAGE(PG8_SA(1, 0), cA + kstep, voffA); PG8_STAGE(PG8_SB(1, 1), cB + hstep + kstep, voffB);
        PG8_WAIT_V(6); PG8_BAR;
    } else {
        PG8_STAGE(PG8_SB(0, 0), cB, voffB); PG8_STAGE(PG8_SA(0, 0), cA, voffA); PG8_STAGE(PG8_SB(0, 1), cB + hstep, voffB); PG8_STAGE(PG8_SA(0, 1), cA + hstep, voffA);
        if (wr == 1) PG8_BAR;
        PG8_WAIT_V(4); PG8_BAR;
        PG8_STAGE(PG8_SB(1, 0), cB + kstep, voffB); PG8_STAGE(PG8_SA(1, 0), cA + kstep, voffA); PG8_STAGE(PG8_SB(1, 1), cB + hstep + kstep, voffB);
        PG8_WAIT_V(6); PG8_BAR;
    }
    for (;;) {
        const bool has_next = S.next(ui + 1, nxt);
        const int nt = S.nt(cur);
        const char* nA = has_next ? S.a_base(nxt) : cA; const char* nB = has_next ? S.b_base(nxt) : cB;
        for (int t = 0; t < nt; t += 2) {
            const bool last = (t == nt - 2);
            const char* a1 = cA + (size_t)(t + 1) * kstep;
            const char* a2 = last ? nA : cA + (size_t)(t + 2) * kstep; const char* b2 = last ? nB : cB + (size_t)(t + 2) * kstep;
            const char* a3 = a2 + kstep; const char* b3 = b2 + kstep;
            if constexpr (SP2) {
            PG8_LDB(B0, 0, 0); PG8_LDB(B1, 0, 1); PG8_SCHED; PG8_LDA(At, 0, 0); PG8_STAGE(PG8_SA(1, 1), a1 + hstep, voffA);
            PG8_WAIT_V(8); PG8_WAIT_L(0); PG8_BAR; PG8_MMA(0, 0, At, B0); PG8_MMA(0, 1, At, B1); PG8_BAR; PG8_SCHED;
            PG8_LDA(At, 0, 1); PG8_STAGE(PG8_SB(0, 0), b2, voffB); PG8_STAGE(PG8_SB(0, 1), b2 + hstep, voffB); PG8_STAGE(PG8_SA(0, 0), a2, voffA);
            PG8_WAIT_V(8); PG8_WAIT_L(0); PG8_BAR; PG8_MMA(1, 0, At, B0); PG8_MMA(1, 1, At, B1); PG8_BAR; PG8_SCHED;
            PG8_LDB(B0, 1, 0); PG8_LDB(B1, 1, 1); PG8_SCHED; PG8_LDA(At, 1, 0); PG8_STAGE(PG8_SA(0, 1), a2 + hstep, voffA);
            PG8_WAIT_V(8); PG8_WAIT_L(0); PG8_BAR; PG8_MMA(0, 0, At, B0); PG8_MMA(0, 1, At, B1); PG8_BAR; PG8_SCHED;
            PG8_LDA(At, 1, 1); PG8_STAGE(PG8_SB(1, 0), b3, voffB); PG8_STAGE(PG8_SB(1, 1), b3 + hstep, voffB); PG8_STAGE(PG8_SA(1, 0), a3, voffA);
            PG8_WAIT_V(8); PG8_WAIT_L(0); PG8_BAR; PG8_MMA(1, 0, At, B0); PG8_MMA(1, 1, At, B1); PG8_BAR; PG8_SCHED;
            } else {
            PG8_LDB(B0, 0, 0); PG8_SCHED; PG8_LDA(At, 0, 0); PG8_STAGE(PG8_SA(1, 1), a1 + hstep, voffA);
            PG8_WAIT_L(8); PG8_BAR; PG8_WAIT_L(0); PG8_MMA(0, 0, At, B0); PG8_BAR; PG8_SCHED;
            PG8_LDB(B1, 0, 1); PG8_STAGE(PG8_SB(0, 0), b2, voffB);
            PG8_BAR; PG8_WAIT_L(0); PG8_MMA(0, 1, At, B1); PG8_BAR;
            PG8_LDA(At, 0, 1); PG8_STAGE(PG8_SA(0, 0), a2, voffA);
            PG8_BAR; PG8_WAIT_L(0); PG8_MMA(1, 0, At, B0); PG8_BAR; PG8_SCHED;
            PG8_STAGE(PG8_SB(0, 1), b2 + hstep, voffB);
            PG8_WAIT_V(6); PG8_BAR; PG8_MMA(1, 1, At, B1); PG8_BAR;
            PG8_LDB(B0, 1, 0); PG8_SCHED; PG8_LDA(At, 1, 0); PG8_STAGE(PG8_SA(0, 1), a2 + hstep, voffA);
            PG8_WAIT_L(8); PG8_BAR; PG8_WAIT_L(0); PG8_MMA(0, 0, At, B0); PG8_BAR; PG8_SCHED;
            PG8_LDB(B1, 1, 1); PG8_STAGE(PG8_SB(1, 0), b3, voffB);
            PG8_BAR; PG8_WAIT_L(0); PG8_MMA(0, 1, At, B1); PG8_BAR;
            PG8_LDA(At, 1, 1); PG8_STAGE(PG8_SA(1, 0), a3, voffA);
            PG8_BAR; PG8_WAIT_L(0); PG8_MMA(1, 0, At, B0); PG8_BAR; PG8_SCHED;
            PG8_STAGE(PG8_SB(1, 1), b3 + hstep, voffB);
            PG8_WAIT_V(6); PG8_BAR; PG8_MMA(1, 1, At, B1); PG8_BAR;
            }
        }
        if constexpr (ALIGN_EPI) { if (wr == 0) PG8_BAR; }
        E(acc, cur, wr, wc, fr, fq);
        if (!has_next) break;
#pragma unroll
        for (int a = 0; a < 2; ++a)
#pragma unroll
            for (int b = 0; b < 2; ++b)
#pragma unroll
                for (int m = 0; m < 4; ++m)
#pragma unroll
                    for (int n = 0; n < 2; ++n) acc[a][b][m][n] = (f32x4){0.f, 0.f, 0.f, 0.f};
        cur = nxt; cA = nA; cB = nB; ++ui;
        if constexpr (ALIGN_EPI) { if (wr == 1) PG8_BAR; }
    }
    PG8_WAIT_V(0);
    if constexpr (!ALIGN_EPI) { if (wr == 0) PG8_BAR; }
    PG8_BAR;
#undef PG8_SA
#undef PG8_SB
#undef PG8_STAGE
#undef PG8_LDA
#undef PG8_LDB
#undef PG8_MMA
#undef PG8_WAIT_V
#undef PG8_WAIT_L
#undef PG8_BAR
#undef PG8_SCHED
}
}

constexpr int D = 2048, NBATCH = 8, SEQ = 2048, CTXL = 256, DFF = 5632, NMODV = 9, DMODW = NMODV * D  ;
constexpr int M_LAT = NBATCH * SEQ  , M_CTX = NBATCH * CTXL  , M_ALL = M_LAT + M_CTX  ;
constexpr int NH = 16, HD = 64, GW = 64  , GROWS = SEQ / GW  , WIN_R = 8, WIN_C = 16;
constexpr int D_EIN = 5120, D_OIN = 5120, ZE_LD = 3072  , ZO_LD = 5120;
constexpr float EPS = 1e-6f;
constexpr int NPHASE = 21;

constexpr size_t MiB = 1u << 20;
constexpr size_t WS_CTL = 0, CTL_ZERO_BYTES = 1 * MiB;
constexpr size_t WS_MOD = 1 * MiB;
constexpr size_t WS_WFI = 4 * MiB, WFI_STRIDE = 44 * MiB;
constexpr size_t WS_WFO = 180 * MiB, WFO_STRIDE = 22 * MiB;
constexpr size_t WS_WEI = 268 * MiB, WS_WEO = 288 * MiB, WS_WOI = 296 * MiB, WS_WOO = 316 * MiB;
constexpr size_t WS_X = 324 * MiB;
constexpr size_t WS_HN = 468 * MiB;
constexpr size_t WS_ACT = 540 * MiB;
constexpr size_t WS_Z = 738 * MiB;
constexpr size_t WS_MIX = 918 * MiB;
constexpr size_t WS_VT = 990 * MiB;
constexpr size_t WS_HF = 1026 * MiB;
constexpr size_t WS_PART = 1090 * MiB, PART_STRIDE = 16 * MiB;
constexpr size_t WS_KF = 1138 * MiB;
constexpr size_t WS_END = 1174 * MiB;
constexpr int CW_BAR = 4096;
constexpr int CW_Q = 8192;

constexpr int RING_BYTES = 131072;
constexpr int LDS_BYTES = 147456;
constexpr int MISC_OFF = LDS_BYTES - 256;

#define GAS __attribute__((address_space(1)))
#define LAS __attribute__((address_space(3)))
typedef unsigned short bf16;
typedef float f32x4 __attribute__((ext_vector_type(4)));
typedef float f32x2 __attribute__((ext_vector_type(2)));
typedef unsigned u32x4 __attribute__((ext_vector_type(4)));
typedef unsigned u32x2 __attribute__((ext_vector_type(2)));
typedef short bf16x8 __attribute__((ext_vector_type(8)));
#define LDS_WAIT() asm volatile("s_waitcnt lgkmcnt(0)" ::: "memory")
#define VM_WAIT() asm volatile("s_waitcnt vmcnt(0)" ::: "memory")
__device__ __forceinline__ unsigned f2bf(float f) { unsigned u = __builtin_bit_cast(unsigned, f); return (u + 0x7fffu + ((u >> 16) & 1u)) >> 16; }
__device__ __forceinline__ unsigned pk2(float lo, float hi) { return f2bf(lo) | (f2bf(hi) << 16); }
__device__ __forceinline__ float bf_lo(unsigned v) { return __builtin_bit_cast(float, v << 16); }
__device__ __forceinline__ float bf_hi(unsigned v) { return __builtin_bit_cast(float, v & 0xffff0000u); }
__device__ __forceinline__ float bf2f(bf16 v) { return __builtin_bit_cast(float, (unsigned)v << 16); }
typedef _Float16 f16x4 __attribute__((ext_vector_type(4)));
typedef _Float16 f16x8 __attribute__((ext_vector_type(8)));
typedef float f32x8 __attribute__((ext_vector_type(8)));
__device__ __forceinline__ u32x2 f32x4_to_h4(f32x4 v) { return __builtin_bit_cast(u32x2, __builtin_convertvector(v, f16x4)); }
__device__ __forceinline__ f32x4 h4_to_f32x4(u32x2 v) { return __builtin_convertvector(__builtin_bit_cast(f16x4, v), f32x4); }
__device__ __forceinline__ float fast_sigmoid(float x) { return __builtin_amdgcn_rcpf(1.0f + __builtin_amdgcn_exp2f(-1.44269504089f * x)); }
__device__ __forceinline__ float wave_sum(float v) {
#pragma unroll
    for (int o = 1; o < 64; o <<= 1) v += __shfl_xor(v, o);
    return v;
}

#define XB_TMO      128
#define XB_XCNT(j)  (256  + 64 * (j))
#define XB_XSUB(j)  (1280 + 64 * (j))
#define XB_XGEN(j)  (2304 + 64 * (j))
#define XB_TOP      3328
#define XB_TOPGEN   3392
#define XCD_BAR_WORDS 3456
#define XB_SPIN_CAP (1u << 18)

__device__ __forceinline__ unsigned xb_ld(unsigned* p)              { return __hip_atomic_load(p, __ATOMIC_RELAXED, __HIP_MEMORY_SCOPE_AGENT); }
__device__ __forceinline__ unsigned xb_add(unsigned* p, unsigned v) { return __hip_atomic_fetch_add(p, v, __ATOMIC_RELAXED, __HIP_MEMORY_SCOPE_AGENT); }
__device__ __forceinline__ unsigned xb_xcc_id() { return (unsigned)__builtin_amdgcn_s_getreg((3 << 11) | 20) & 0xFu; }
#define XB_SPIN(cond, bar) do { unsigned _sp = 0; while (cond) { __builtin_amdgcn_s_sleep(1); \
    if ((++_sp & 255u) == 0u) { if (xb_ld(&(bar)[XB_TMO])) break; if (_sp > XB_SPIN_CAP) { atomicAdd(&(bar)[XB_TMO], 1u); break; } } } } while (0)

struct XcdBarrier {
    unsigned* bar; unsigned x;
    volatile LAS unsigned* st;
};

__device__ __forceinline__ XcdBarrier xcd_barrier_post(unsigned* bar, volatile LAS unsigned* st) {
    XcdBarrier b; b.bar = bar; b.x = xb_xcc_id(); b.st = st;
    if (threadIdx.x == 0) (void)xb_add(&bar[XB_XCNT(b.x)], 1u);
    return b;
}
__device__ __forceinline__ void xcd_barrier_complete(unsigned* bar, unsigned x, unsigned& nloc, unsigned& nx) {
    const unsigned G = gridDim.x * gridDim.y * gridDim.z;
    unsigned sum, cnt, mine, sp = 0u;
    for (;;) {
        sum = 0u; cnt = 0u; mine = 0u;
#pragma unroll
        for (unsigned j = 0; j < 16; ++j) { const unsigned c = xb_ld(&bar[XB_XCNT(j)]); sum += c; cnt += (c > 0u) ? 1u : 0u; mine = (j == x) ? c : mine; }
        if (sum == G) break;
        __builtin_amdgcn_s_sleep(1);
        if ((++sp & 255u) == 0u) { if (xb_ld(&bar[XB_TMO])) break; if (sp > XB_SPIN_CAP) { atomicAdd(&bar[XB_TMO], 1u); break; } }
    }
    nloc = mine > 0u ? mine : 1u; nx = cnt > 0u ? cnt : 1u;
}

__device__ __forceinline__ void xcd_barrier(const XcdBarrier& b) {
    asm volatile("s_waitcnt vmcnt(0)" ::: "memory");
    __syncthreads();
    if (threadIdx.x == 0) {
        unsigned* bar = b.bar;
        __builtin_amdgcn_s_waitcnt(0);
        unsigned nloc = b.st[0], nx = b.st[1];
        if (nloc == 0u) { xcd_barrier_complete(bar, b.x, nloc, nx); b.st[0] = nloc; b.st[1] = nx; }
        const unsigned old = xb_add(&bar[XB_XSUB(b.x)], 1u);
        const unsigned gen = old / nloc;
        if (old + 1u == (gen + 1u) * nloc) {
            __builtin_amdgcn_fence(__ATOMIC_RELEASE, "agent");
            asm volatile("s_waitcnt vmcnt(0)" ::: "memory");
            const unsigned og = xb_add(&bar[XB_TOP], 1u);
            const unsigned tg = og / nx;
            if (og + 1u == (tg + 1u) * nx) xb_add(&bar[XB_TOPGEN], 1u);
            else XB_SPIN(xb_ld(&bar[XB_TOPGEN]) == tg, bar);
            __builtin_amdgcn_fence(__ATOMIC_ACQUIRE, "agent");
            xb_add(&bar[XB_XGEN(b.x)], 1u);
            asm volatile("s_waitcnt vmcnt(0)" ::: "memory");
        } else {
            XB_SPIN(xb_ld(&bar[XB_XGEN(b.x)]) == gen, bar);
            __builtin_amdgcn_fence(__ATOMIC_ACQUIRE, "agent");
            asm volatile("s_waitcnt vmcnt(0)" ::: "memory");
        }
    }
    __syncthreads();
}

struct Params {
    const float* in[27];
    float* out;
    unsigned char* ws;
    int ph_lo, ph_hi;
};
enum { IN_X = 0, IN_C, IN_CTX, IN_CCTX, IN_WMOD, IN_BMOD, IN_NORMG, IN_FWI, IN_FWO, IN_EWI, IN_SCW, IN_SCB, IN_CCW, IN_CCB, IN_LNG, IN_LNB, IN_EWO,
       IN_OWI, IN_QG, IN_KG, IN_RPB, IN_LCW, IN_LCB, IN_LGW, IN_LGB, IN_LAM, IN_OWO };

struct SchedStd {
    const char* A; const char* Bt; size_t tstep; int nM, nN, G, c, ntiles;
    __device__ __forceinline__ int nt(const pg8::Unit&) const { return ntiles; }
    __device__ __forceinline__ bool next(int i, pg8::Unit& u) const {
        const long L = (long)i * G + c; if (L >= (long)nM * nN) return false;
        pg8::tile_map((int)L, nM, nN, u.pm, u.pn); u.kind = 0; return true;
    }
    __device__ __forceinline__ const char* a_base(const pg8::Unit& u) const { return A + (size_t)u.pm * tstep; }
    __device__ __forceinline__ const char* b_base(const pg8::Unit& u) const { return Bt + (size_t)u.pn * tstep; }
};

struct SchedDown {
    const char* A; const char* Bt; size_t tstep; int G, c, ntiles;
    __device__ __forceinline__ bool next(int i, pg8::Unit& u) const {
        const long L = (long)i * G + c;
        if (L < 512) { pg8::tile_map((int)L, 64, 8, u.pm, u.pn); u.kind = 0; return true; }
        if (L < 768) { const int q = (int)L - 512, t = q & 63; u.pm = 64 + (t >> 3); u.pn = t & 7; u.kind = 1 + (q >> 6); return true; }
        return false;
    }
    __device__ __forceinline__ int nt(const pg8::Unit& u) const { return u.kind == 0 ? ntiles : ntiles / 4; }
    __device__ __forceinline__ const char* a_base(const pg8::Unit& u) const { return A + (size_t)u.pm * tstep + (u.kind > 1 ? (size_t)(u.kind - 1) * (ntiles / 4) * 128 : 0); }
    __device__ __forceinline__ const char* b_base(const pg8::Unit& u) const { return Bt + (size_t)u.pn * tstep + (u.kind > 1 ? (size_t)(u.kind - 1) * (ntiles / 4) * 128 : 0); }
};
struct SchedOdIn {
    const char* HN; const char* W; size_t tstep; int G, c;
    __device__ __forceinline__ int nt(const pg8::Unit&) const { return D / 64; }
    __device__ __forceinline__ bool next(int i, pg8::Unit& u) const {
        const long L = (long)i * G + c;
        if (L < 72 * 16) { int pm, pnv; pg8::tile_map((int)L, 72, 16, pm, pnv); u.pm = pm; u.pn = pnv < 8 ? pnv : pnv + 4; u.kind = 0; return true; }
        if (L < 72 * 16 + 4 * 72) { int pm, pn; pg8::tile_map((int)L - 72 * 16, 4, 72, pm, pn); u.pm = pm; u.pn = pn; u.kind = 1; return true; }
        return false;
    }
    __device__ __forceinline__ const char* a_base(const pg8::Unit& u) const { return u.kind == 0 ? HN + (size_t)u.pm * tstep : W + (size_t)(8 + u.pm) * tstep; }
    __device__ __forceinline__ const char* b_base(const pg8::Unit& u) const { return u.kind == 0 ? W + (size_t)u.pn * tstep : HN + (size_t)u.pn * tstep; }
};

struct EpiSwiGLU {
    static constexpr bool PERM = true;
    bf16* O;
    __device__ __forceinline__ void operator()(const f32x4 (&acc)[2][2][4][2], const pg8::Unit& u, int wr, int wc, int fr, int fq) const {
        const int row0 = u.pm * 256 + wr * 64 + fr, col0 = u.pn * 128 + wc * 32 + 8 * fq;
#pragma unroll
        for (int ai = 0; ai < 2; ++ai)
#pragma unroll
            for (int m = 0; m < 4; ++m) {
                bf16* rowp = O + (size_t)(row0 + ai * 128 + m * 16) * DFF + col0;
                float v[8];
#pragma unroll
                for (int n = 0; n < 2; ++n)
#pragma unroll
                    for (int j = 0; j < 4; ++j) { const float g = acc[ai][0][m][n][j], up = acc[ai][1][m][n][j]; v[4 * n + j] = g * fast_sigmoid(g) * up; }
                u32x4 w; w.x = pg8::cvt_pk_bf16(v[0], v[1]); w.y = pg8::cvt_pk_bf16(v[2], v[3]); w.z = pg8::cvt_pk_bf16(v[4], v[5]); w.w = pg8::cvt_pk_bf16(v[6], v[7]);
                *(u32x4*)rowp = w;
            }
    }
};
template <bool BASE_F32, bool OUT_F32>
struct EpiResid {
    static constexpr bool PERM = true;
    const void* base_lat; const void* base_ctx; void* out; const float* gate; float coef; float* part;
    __device__ __forceinline__ void operator()(const f32x4 (&acc)[2][2][4][2], const pg8::Unit& u, int wr, int wc, int fr, int fq) const {
        const float coef = __builtin_bit_cast(float, __builtin_amdgcn_readfirstlane(__builtin_bit_cast(int, this->coef)));
        float* const part = (float*)(((unsigned long long)(unsigned)__builtin_amdgcn_readfirstlane((int)((unsigned long long)this->part >> 32)) << 32) | (unsigned)__builtin_amdgcn_readfirstlane((int)(unsigned long long)this->part));
        const int row0 = u.pm * 256 + wr * 64 + fr, col0 = u.pn * 256 + wc * 32 + 8 * fq;
        const int r = u.pm < 64 ? (u.pm >> 3) : 8;
        const float* gv = gate + (size_t)r * DMODW + col0;
        f32x4 gvv[2][2];
#pragma unroll
        for (int bj = 0; bj < 2; ++bj)
#pragma unroll
            for (int n = 0; n < 2; ++n) gvv[bj][n] = *(const f32x4*)(gv + bj * 128 + 4 * n) * coef;
        if (u.kind >= 2) {
            float* op = part + (size_t)(u.kind - 2) * (PART_STRIDE / 4) + (size_t)(row0 - M_LAT) * D + col0;
#pragma unroll
            for (int ai = 0; ai < 2; ++ai)
#pragma unroll
                for (int m = 0; m < 4; ++m) { const size_t ro = (size_t)(ai * 128 + m * 16) * D;
#pragma unroll
                    for (int bj = 0; bj < 2; ++bj)
#pragma unroll
                        for (int n = 0; n < 2; ++n) *(f32x4*)(op + ro + bj * 128 + 4 * n) = gvv[bj][n] * acc[ai][bj][m][n]; }
            return;
        }
        const size_t eo = (u.pm < 64 ? (size_t)row0 : (size_t)(row0 - M_LAT)) * D + col0;
        const void* bsel = u.pm < 64 ? base_lat : base_ctx;
        const size_t oo = (size_t)row0 * D + col0;
#pragma unroll
        for (int ai = 0; ai < 2; ++ai)
#pragma unroll
            for (int mh = 0; mh < 2; ++mh) {
                f32x4 b[2][2][2];
#pragma unroll
                for (int mm = 0; mm < 2; ++mm)
#pragma unroll
                    for (int bj = 0; bj < 2; ++bj) { const size_t ro = (size_t)(ai * 128 + (2 * mh + mm) * 16) * D + bj * 128;
                        if constexpr (BASE_F32) { b[mm][bj][0] = *(const f32x4*)((const float*)bsel + eo + ro); b[mm][bj][1] = *(const f32x4*)((const float*)bsel + eo + ro + 4); }
                        else { const u32x4 hv = *(const u32x4*)((const _Float16*)bsel + eo + ro); b[mm][bj][0] = h4_to_f32x4((u32x2){hv.x, hv.y}); b[mm][bj][1] = h4_to_f32x4((u32x2){hv.z, hv.w}); } }
#pragma unroll
                for (int mm = 0; mm < 2; ++mm)
#pragma unroll
                    for (int bj = 0; bj < 2; ++bj) { const size_t ro = (size_t)(ai * 128 + (2 * mh + mm) * 16) * D + bj * 128;
                        const f32x4 v0 = b[mm][bj][0] + gvv[bj][0] * acc[ai][bj][2 * mh + mm][0], v1 = b[mm][bj][1] + gvv[bj][1] * acc[ai][bj][2 * mh + mm][1];
                        if constexpr (OUT_F32) { *(f32x4*)((float*)out + oo + ro) = v0; *(f32x4*)((float*)out + oo + ro + 4) = v1; }
                        else { const u32x2 h0 = f32x4_to_h4(v0), h1 = f32x4_to_h4(v1); *(u32x4*)((_Float16*)out + oo + ro) = (u32x4){h0.x, h0.y, h1.x, h1.y}; } }
                asm volatile("" ::: "memory");
            }
    }
};
struct EpiEvIn {
    static constexpr bool PERM = true;
    bf16* O;
    __device__ __forceinline__ void operator()(const f32x4 (&acc)[2][2][4][2], const pg8::Unit& u, int wr, int wc, int fr, int fq) const {
        const int row0 = u.pm * 256 + wr * 64 + fr;
        if (u.pn < 4) {
            const int col0 = u.pn * 256 + wc * 32 + 8 * fq;
#pragma unroll
            for (int ai = 0; ai < 2; ++ai)
#pragma unroll
                for (int m = 0; m < 4; ++m) { bf16* rowp = O + (size_t)(row0 + ai * 128 + m * 16) * ZE_LD + col0;
#pragma unroll
                    for (int bj = 0; bj < 2; ++bj) { const f32x4 v0 = acc[ai][bj][m][0], v1 = acc[ai][bj][m][1];
                        u32x4 w; w.x = pg8::cvt_pk_bf16(v0[0], v0[1]); w.y = pg8::cvt_pk_bf16(v0[2], v0[3]); w.z = pg8::cvt_pk_bf16(v1[0], v1[1]); w.w = pg8::cvt_pk_bf16(v1[2], v1[3]);
                        *(u32x4*)(rowp + bj * 128) = w; } }
        } else {
            const bool glu = u.pn >= 12;
            const int col0 = (glu ? 2048 + (u.pn - 12) * 128 : 1024 + (u.pn - 4) * 128) + wc * 32 + 8 * fq;
#pragma unroll
            for (int ai = 0; ai < 2; ++ai)
#pragma unroll
                for (int m = 0; m < 4; ++m) { bf16* rowp = O + (size_t)(row0 + ai * 128 + m * 16) * ZE_LD + col0;
                    float v[8];
#pragma unroll
                    for (int n = 0; n < 2; ++n)
#pragma unroll
                        for (int j = 0; j < 4; ++j) { const float a = acc[ai][0][m][n][j], b = acc[ai][1][m][n][j]; v[4 * n + j] = glu ? a * fast_sigmoid(b) : a * b; }
                    u32x4 w; w.x = pg8::cvt_pk_bf16(v[0], v[1]); w.y = pg8::cvt_pk_bf16(v[2], v[3]); w.z = pg8::cvt_pk_bf16(v[4], v[5]); w.w = pg8::cvt_pk_bf16(v[6], v[7]);
                    *(u32x4*)rowp = w; }
        }
    }
};
struct EpiOdIn {
    static constexpr bool PERM = true;
    bf16* ZO; u32x4* KF; u32x2* VF; const float* qg; const float* kg;
    __device__ __forceinline__ void operator()(const f32x4 (&acc)[2][2][4][2], const pg8::Unit& u, int wr, int wc, int fr, int fq) const {
        const int row0 = u.pm * 256 + wr * 64 + fr;
        if (u.kind == 0 && u.pn < 8) {
            const bool isq = u.pn < 4;
            const float* gp = (isq ? qg : kg) + 8 * fq;
            f32x4 gn[2][2];
#pragma unroll
            for (int bj = 0; bj < 2; ++bj)
#pragma unroll
                for (int n = 0; n < 2; ++n) gn[bj][n] = *(const f32x4*)(gp + 32 * bj + 4 * n);
            const float sc = isq ? 0.125f : 1.0f;
            const int col0 = u.pn * 256 + wc * 64 + 8 * fq, hh = 4 * (u.pn & 3) + wc;
#pragma unroll
            for (int ai = 0; ai < 2; ++ai)
#pragma unroll
                for (int m = 0; m < 4; ++m) {
                    float ss = 0.f;
#pragma unroll
                    for (int bj = 0; bj < 2; ++bj)
#pragma unroll
                        for (int n = 0; n < 2; ++n) { const f32x4 v = acc[ai][bj][m][n]; ss += (v[0] * v[0] + v[1] * v[1]) + (v[2] * v[2] + v[3] * v[3]); }
                    ss += __shfl_xor(ss, 16); ss += __shfl_xor(ss, 32);
                    const float rs = sc / sqrtf(ss * (1.0f / HD) + EPS);
                    const int row = row0 + ai * 128 + m * 16;
                    bf16* rowp = ZO + (size_t)row * ZO_LD + col0;
                    u32x4* kfp = KF + ((size_t)((row >> 4) * 16 + hh) * 8 + fq) * 16 + (row & 15);
#pragma unroll
                    for (int bj = 0; bj < 2; ++bj) { const f32x4 v0 = acc[ai][bj][m][0] * rs * gn[bj][0], v1 = acc[ai][bj][m][1] * rs * gn[bj][1];
                        u32x4 w; w.x = pg8::cvt_pk_bf16(v0[0], v0[1]); w.y = pg8::cvt_pk_bf16(v0[2], v0[3]); w.z = pg8::cvt_pk_bf16(v1[0], v1[1]); w.w = pg8::cvt_pk_bf16(v1[2], v1[3]);
                        if (isq) *(u32x4*)(rowp + bj * 32) = w; else kfp[bj * 64] = w; }
                }
            return;
        }
        if (u.kind == 1) {
#pragma unroll
            for (int ai = 0; ai < 2; ++ai)
#pragma unroll
                for (int m = 0; m < 4; ++m) { const int ch = row0 + ai * 128 + m * 16;
#pragma unroll
                    for (int bj = 0; bj < 2; ++bj)
#pragma unroll
                        for (int n = 0; n < 2; ++n) { const int t = u.pn * 256 + bj * 128 + wc * 32 + 8 * fq + 4 * n; const f32x4 v = acc[ai][bj][m][n];
                            u32x2 w; w.x = pg8::cvt_pk_bf16(v[0], v[1]); w.y = pg8::cvt_pk_bf16(v[2], v[3]);
                            VF[((size_t)(((t >> 4) * 16 + (ch >> 6)) * 4 + ((ch >> 4) & 3)) * 4 + ((t >> 2) & 3)) * 16 + (ch & 15)] = w; } }
            return;
        }
        const int col0 = u.pn * 256 + wc * 32 + 8 * fq;
#pragma unroll
        for (int ai = 0; ai < 2; ++ai)
#pragma unroll
            for (int m = 0; m < 4; ++m) { bf16* rowp = ZO + (size_t)(row0 + ai * 128 + m * 16) * ZO_LD + col0;
#pragma unroll
                for (int bj = 0; bj < 2; ++bj) { const f32x4 v0 = acc[ai][bj][m][0], v1 = acc[ai][bj][m][1];
                    u32x4 w; w.x = pg8::cvt_pk_bf16(v0[0], v0[1]); w.y = pg8::cvt_pk_bf16(v0[2], v0[3]); w.z = pg8::cvt_pk_bf16(v1[0], v1[1]); w.w = pg8::cvt_pk_bf16(v1[2], v1[3]);
                    *(u32x4*)(rowp + bj * 128) = w; } }
    }
};

__device__ __forceinline__ int srccol(int map, int n) {
    if (map == 0) return n;
    const int pn = n >> 8, bj = (n >> 7) & 1, i = n & 127;
    if (map == 1) return bj * DFF + 128 * pn + i;
    if (map == 2) {
        if (pn < 4) return n;
        if (pn < 12) return 1024 + bj * 1024 + 128 * (pn - 4) + i;
        return 3072 + bj * 1024 + 128 * (pn - 12) + i;
    }
    if (pn < 8) return 256 * pn + 64 * ((n >> 5) & 3) + 32 * bj + (n & 31);
    return n;
}
__device__ __forceinline__ void p0_transpose_item(const float* W, int K, int N, bf16* WT, int map, LAS float* scr, int item, int lane) {
    const int nblk = N / 64, kb = item / nblk, nb = item % nblk, k0 = 64 * kb, n0 = 64 * nb;
    const float* src = W + (size_t)k0 * N + srccol(map, n0 + lane);
#pragma unroll 32
    for (int i = 0; i < 64; ++i) scr[i * 65 + lane] = src[(size_t)i * N];
    LDS_WAIT(); asm volatile("" ::: "memory");
    const int c = lane & 7;
#pragma unroll
    for (int j = 0; j < 8; ++j) { const int n = (lane >> 3) + 8 * j; const LAS float* s = scr + (8 * c) * 65 + n;
        u32x4 o; o.x = pk2(s[0 * 65], s[1 * 65]); o.y = pk2(s[2 * 65], s[3 * 65]); o.z = pk2(s[4 * 65], s[5 * 65]); o.w = pk2(s[6 * 65], s[7 * 65]);
        *(u32x4*)(WT + (size_t)(n0 + n) * K + k0 + 8 * c) = o; }
    LDS_WAIT(); asm volatile("" ::: "memory");
}
__device__ __forceinline__ void p0_weights(const Params& p, LAS unsigned char* lds, int lane, int wave) {
    LAS float* scr = (LAS float*)(lds + wave * (64 * 65 * 4));
    const int gw = blockIdx.x * 8 + wave, NGW = gridDim.x * 8;
    constexpr int I_FI = (D / 64) * (2 * DFF / 64), I_FO = (DFF / 64) * (D / 64), I_IN = (D / 64) * (D_EIN / 64), I_OUT = (D / 64) * (D / 64);
    constexpr int NITEMS = 4 * I_FI + 4 * I_FO + 2 * I_IN + 2 * I_OUT;
    for (int it = gw; it < NITEMS; it += NGW) {
        int r = it;
        if (r < 4 * I_FI) { const int q = r / I_FI; p0_transpose_item(p.in[IN_FWI] + (size_t)q * D * 2 * DFF, D, 2 * DFF, (bf16*)(p.ws + WS_WFI + q * WFI_STRIDE), 1, scr, r % I_FI, lane); continue; } r -= 4 * I_FI;
        if (r < 4 * I_FO) { const int q = r / I_FO; p0_transpose_item(p.in[IN_FWO] + (size_t)q * DFF * D, DFF, D, (bf16*)(p.ws + WS_WFO + q * WFO_STRIDE), 0, scr, r % I_FO, lane); continue; } r -= 4 * I_FO;
        if (r < I_IN) { p0_transpose_item(p.in[IN_EWI], D, D_EIN, (bf16*)(p.ws + WS_WEI), 2, scr, r, lane); continue; } r -= I_IN;
        if (r < I_IN) { p0_transpose_item(p.in[IN_OWI], D, D_OIN, (bf16*)(p.ws + WS_WOI), 3, scr, r, lane); continue; } r -= I_IN;
        if (r < I_OUT) { p0_transpose_item(p.in[IN_EWO], D, D, (bf16*)(p.ws + WS_WEO), 0, scr, r, lane); continue; } r -= I_OUT;
        p0_transpose_item(p.in[IN_OWO], D, D, (bf16*)(p.ws + WS_WOO), 0, scr, r, lane);
    }
}
__device__ __forceinline__ void p0_modvec(const Params& p, LAS unsigned char* lds, int tid, int lane, int wave) {
    LAS float* sv = (LAS float*)lds;
    LAS float* red = (LAS float*)(lds + 9 * 2048 * 4);
    volatile LAS int* qslot = (volatile LAS int*)(lds + 9 * 2048 * 4 + 8 * 9 * 64 * 4);
    const float* c = p.in[IN_C]; const float* cc = p.in[IN_CCTX];
    for (int i = tid; i < 9 * 2048; i += 512) { const float v = i < 8 * 2048 ? c[i] : cc[i - 8 * 2048]; sv[i] = v / (1.0f + __expf(-v)); }
    float* MOD = (float*)(p.ws + WS_MOD);
    unsigned* qhead = (unsigned*)(p.ws + WS_CTL) + CW_Q;
    for (;;) {
        __syncthreads();
        if (tid == 0) *qslot = (int)__hip_atomic_fetch_add(qhead, 1u, __ATOMIC_RELAXED, __HIP_MEMORY_SCOPE_AGENT);
        __syncthreads();
        const int item = *qslot;
        if (item >= 2 * 288) break;
        const int l = item / 288, col0 = (item % 288) * 64;
        const float* W = p.in[IN_WMOD] + (size_t)l * D * DMODW + col0 + lane + (size_t)(wave * 256) * DMODW;
        float acc[9];
#pragma unroll
        for (int r = 0; r < 9; ++r) acc[r] = 0.f;
#define MV_LOAD(w, k16) do { _Pragma("unroll") for (int e = 0; e < 16; ++e) w[e] = W[(size_t)(16 * (k16) + e) * DMODW]; } while (0)
#define MV_COMP(w, k16) do { _Pragma("unroll") for (int e4 = 0; e4 < 4; ++e4) { _Pragma("unroll") for (int r = 0; r < 9; ++r) { \
            const f32x4 s = *(const LAS f32x4*)(sv + r * 2048 + wave * 256 + 16 * (k16) + 4 * e4); \
            acc[r] += (s[0] * w[4 * e4] + s[1] * w[4 * e4 + 1]) + (s[2] * w[4 * e4 + 2] + s[3] * w[4 * e4 + 3]); } } } while (0)
        float wa[16], wb[16];
        MV_LOAD(wa, 0);
#pragma unroll 1
        for (int k16 = 0; k16 < 16; k16 += 2) {
            MV_LOAD(wb, k16 + 1);
            MV_COMP(wa, k16);
            if (k16 + 2 < 16) MV_LOAD(wa, k16 + 2);
            MV_COMP(wb, k16 + 1);
        }
#undef MV_LOAD
#undef MV_COMP
#pragma unroll
        for (int r = 0; r < 9; ++r) red[(wave * 9 + r) * 64 + lane] = acc[r];
        __syncthreads();
        for (int o = tid; o < 9 * 64; o += 512) {
            const int r = o >> 6, ln = o & 63; float s = 0.f;
#pragma unroll
            for (int w = 0; w < 8; ++w) s += red[(w * 9 + r) * 64 + ln];
            MOD[((size_t)l * 9 + r) * DMODW + col0 + ln] = s + p.in[IN_BMOD][(size_t)l * DMODW + col0 + ln];
        }
    }
}

template <bool COMBINE, bool SRC_F32>
__device__ __forceinline__ void norm_phase(const void* src_lat, const void* src_ctx, _Float16* xw_ctx, const float* part, int nrows, const float* g, const float* modl, int shift_idx, int scale_idx, bf16* HN, int lane, int wave) {
    const int gw = blockIdx.x * 8 + wave, NGW = gridDim.x * 8;
    if (gw >= nrows) return;
    f32x4 v[8], nv[8];
#define NORM_COL(jj) (SRC_F32 ? 4 * lane + 256 * (jj) : 8 * lane + 512 * ((jj) >> 1) + 4 * ((jj) & 1))
#define NORM_LOAD(dst, row) do { const int row_ = (row); const size_t ro_ = (row_ < M_LAT ? (size_t)row_ : (size_t)(row_ - M_LAT)) * D; const void* sp_ = row_ < M_LAT ? src_lat : src_ctx; \
        if constexpr (SRC_F32) { _Pragma("unroll") for (int j = 0; j < 8; ++j) dst[j] = *(const f32x4*)((const float*)sp_ + ro_ + NORM_COL(j)); } \
        else { _Pragma("unroll") for (int j = 0; j < 4; ++j) { const u32x4 hv_ = *(const u32x4*)((const _Float16*)sp_ + ro_ + NORM_COL(2 * j)); dst[2 * j] = h4_to_f32x4((u32x2){hv_.x, hv_.y}); dst[2 * j + 1] = h4_to_f32x4((u32x2){hv_.z, hv_.w}); } } \
        if (COMBINE && row_ >= M_LAT) { _Pragma("unroll") for (int q = 0; q < 3; ++q) { const float* pr_ = part + (size_t)q * (PART_STRIDE / 4) + ro_; \
            _Pragma("unroll") for (int j = 0; j < 8; ++j) dst[j] += *(const f32x4*)(pr_ + NORM_COL(j)); } } } while (0)
    NORM_LOAD(v, gw);
    for (int row = gw; row < nrows; row += NGW) {
        if (row + NGW < nrows) NORM_LOAD(nv, row + NGW);
        const int r = row < M_LAT ? (row >> 11) : 8;
        const float* sh = modl + (size_t)r * DMODW + shift_idx * D; const float* sc = modl + (size_t)r * DMODW + scale_idx * D;
        float ss = 0.f;
#pragma unroll
        for (int j = 0; j < 8; ++j) ss += (v[j][0] * v[j][0] + v[j][1] * v[j][1]) + (v[j][2] * v[j][2] + v[j][3] * v[j][3]);
        const float rstd = 1.0f / sqrtf(wave_sum(ss) * (1.0f / D) + EPS);
        bf16* o = HN + (size_t)row * D;
#pragma unroll
        for (int j = 0; j < 8; ++j) { const int c = NORM_COL(j); const f32x4 gg = *(const f32x4*)(g + c), s1 = *(const f32x4*)(sc + c), s0 = *(const f32x4*)(sh + c);
            const f32x4 y = (v[j] * rstd) * gg * (1.0f + s1) + s0;
            u32x2 w; w.x = pg8::cvt_pk_bf16(y[0], y[1]); w.y = pg8::cvt_pk_bf16(y[2], y[3]); *(u32x2*)(o + c) = w;
            if (COMBINE && row >= M_LAT) *(u32x2*)(xw_ctx + (size_t)(row - M_LAT) * D + c) = f32x4_to_h4(v[j]); }
#pragma unroll
        for (int j = 0; j < 8; ++j) v[j] = nv[j];
    }
#undef NORM_LOAD
#undef NORM_COL
}

template <int NT>
__device__ __forceinline__ void even_conv_unit(const Params& p, LAS unsigned char* lds, int base, int T, int t0, int tid, int lane, int wave) {
    const bf16* Z3 = (const bf16*)(p.ws + WS_Z); bf16* MIX = (bf16*)(p.ws + WS_MIX);
    constexpr int NR = NT + 30;
    LAS unsigned* tile = (LAS unsigned*)lds;
    LAS float* red = (LAS float*)(lds + 62 * 2048);
    LAS float* stat = red + 256;
    const float* ccw = p.in[IN_CCW]; const float* ccb = p.in[IN_CCB]; const float* lng = p.in[IN_LNG]; const float* lnb = p.in[IN_LNB];
    const float* scw = p.in[IN_SCW]; const float* scb = p.in[IN_SCB];
    {
        constexpr int NQ = (NR * 128 + 511) / 512;
        u32x4 sv[NQ];
#pragma unroll
        for (int q = 0; q < NQ; ++q) { const int ch = tid + 512 * q, rr = min(ch >> 7, NR - 1), cc = ch & 127, t = t0 - 15 + rr, tc = min(max(t, 0), T - 1);
            const unsigned msk = (t == tc) ? 0xffffffffu : 0u;
            sv[q] = *(const u32x4*)(Z3 + (size_t)(base + tc) * ZE_LD + 2048 + cc * 8) & msk; }
#pragma unroll
        for (int q = 0; q < NQ; ++q) { const int ch = tid + 512 * q, rr = ch >> 7, cc = ch & 127; if (rr < NR) *(LAS u32x4*)(tile + rr * 512 + cc * 4) = sv[q]; }
    }
    unsigned pv[NT + 2], bgv[NT];
#pragma unroll
    for (int i = 0; i < NT + 2; ++i) { const int t = t0 - 1 + i, tc = min(max(t, 0), T - 1); const unsigned msk = (t == tc) ? 0xffffffffu : 0u; pv[i] = *(const unsigned*)(Z3 + (size_t)(base + tc) * ZE_LD + 1024 + 2 * tid) & msk; }
#pragma unroll
    for (int i = 0; i < NT; ++i) bgv[i] = *(const unsigned*)(Z3 + (size_t)(base + t0 + i) * ZE_LD + 2 * tid);
    const f32x2 lg = *(const f32x2*)(lng + 2 * tid), lb = *(const f32x2*)(lnb + 2 * tid), cbias = *(const f32x2*)(ccb + 2 * tid);
    __syncthreads();
    { const f32x2 w0 = *(const f32x2*)(scw + 2 * tid), w1 = *(const f32x2*)(scw + 1024 + 2 * tid), w2 = *(const f32x2*)(scw + 2048 + 2 * tid), b = *(const f32x2*)(scb + 2 * tid);
#pragma unroll
      for (int i = 0; i < NT; ++i) {
          const float c0 = w0[0] * bf_lo(pv[i]) + w1[0] * bf_lo(pv[i + 1]) + w2[0] * bf_lo(pv[i + 2]) + b[0];
          const float c1 = w0[1] * bf_hi(pv[i]) + w1[1] * bf_hi(pv[i + 1]) + w2[1] * bf_hi(pv[i + 2]) + b[1];
          *(unsigned*)(MIX + (size_t)(base + t0 + i) * D + 2 * tid) = pg8::cvt_pk_bf16(bf_lo(bgv[i]) * c0, bf_hi(bgv[i]) * c1); } }
    f32x2 acc[NT];
#pragma unroll
    for (int i = 0; i < NT; ++i) acc[i] = cbias;
    f32x2 w = *(const f32x2*)(ccw + 2 * tid);
#pragma unroll 1
    for (int k = 0; k < 31; ++k) {
        const f32x2 wn = *(const f32x2*)(ccw + (size_t)min(k + 1, 30) * 1024 + 2 * tid);
        const LAS unsigned* tp = tile + k * 512 + tid;
#pragma unroll
        for (int i = 0; i < NT; ++i) { const unsigned v = tp[i * 512]; acc[i] += w * (f32x2){bf_lo(v), bf_hi(v)}; }
        w = wn;
    }
#pragma unroll
    for (int i = 0; i < NT; ++i) { const float s = wave_sum(acc[i][0] + acc[i][1]); if (lane == 0) red[wave * 32 + i] = s; }
    __syncthreads();
    if (tid < NT) { float s = 0.f;
#pragma unroll
        for (int ww = 0; ww < 8; ++ww) s += red[ww * 32 + tid]; stat[tid] = s * (1.0f / 1024.0f); }
    __syncthreads();
#pragma unroll
    for (int i = 0; i < NT; ++i) { const float mu = stat[i]; acc[i] -= mu; }
    __syncthreads();
#pragma unroll
    for (int i = 0; i < NT; ++i) { const float s = wave_sum(acc[i][0] * acc[i][0] + acc[i][1] * acc[i][1]); if (lane == 0) red[wave * 32 + i] = s; }
    __syncthreads();
    if (tid < NT) { float s = 0.f;
#pragma unroll
        for (int ww = 0; ww < 8; ++ww) s += red[ww * 32 + tid]; stat[tid] = 1.0f / sqrtf(s * (1.0f / 1024.0f) + EPS); }
    __syncthreads();
#pragma unroll
    for (int i = 0; i < NT; ++i) { const float rs = stat[i]; const float y0 = acc[i][0] * rs * lg[0] + lb[0], y1 = acc[i][1] * rs * lg[1] + lb[1];
        *(unsigned*)(MIX + (size_t)(base + t0 + i) * D + 1024 + 2 * tid) = pg8::cvt_pk_bf16(y0 * fast_sigmoid(y0), y1 * fast_sigmoid(y1)); }
    __syncthreads();
}
__device__ __forceinline__ void even_conv_phase(const Params& p, LAS unsigned char* lds, int tid, int lane, int wave) {
    for (int u = blockIdx.x; u < 512 + 256; u += gridDim.x) {
        if (u < 512) even_conv_unit<32>(p, lds, (u >> 6) * SEQ, SEQ, (u & 63) * 32, tid, lane, wave);
        else { const int v = u - 512; even_conv_unit<8>(p, lds, M_LAT + (v >> 5) * CTXL, CTXL, (v & 31) * 8, tid, lane, wave); }
    }
}

__device__ __forceinline__ void attn_wave_unit(const Params& p, const LAS float* rpbL, int b, int h, int r, int qg, int lane) {
    const bf16* ZO = (const bf16*)(p.ws + WS_Z); const u32x4* KF = (const u32x4*)(p.ws + WS_KF); const u32x2* VF = (const u32x2*)(p.ws + WS_VT); bf16* MIX = (bf16*)(p.ws + WS_MIX);
    const int l15 = lane & 15, g = lane >> 4;
    const int c0 = 16 * qg, qc = c0 + l15, qrow = b * SEQ + r * GW + qc;
    const int r0 = min(max(r - WIN_R / 2, 0), GROWS - WIN_R);
    const int kb = qg == 0 ? 0 : (qg == 1 ? 8 : (qg == 2 ? 24 : 32));
    const int cs = min(max(qc - WIN_C / 2, 0), GW - WIN_C);
    bf16x8 qf[2];
#pragma unroll
    for (int kk = 0; kk < 2; ++kk) qf[kk] = __builtin_bit_cast(bf16x8, *(const u32x4*)(ZO + (size_t)qrow * ZO_LD + h * HD + 8 * g + 32 * kk));
    int dcol[8]; bool okk[8];
#pragma unroll
    for (int a = 0; a < 2; ++a)
#pragma unroll
        for (int e = 0; e < 4; ++e) { const int kc = kb + 16 * a + 4 * g + e; okk[4 * a + e] = (kc >= cs) && (kc < cs + WIN_C); dcol[4 * a + e] = min(max(kc - qc + WIN_C - 1, 0), 2 * WIN_C - 2); }
    const LAS float* rpbh = rpbL + h * 15 * 31;
    u32x4 kx[4][2][2]; u32x2 vx[4][4][2];
#define ATT_TOK0(ch) ((ch) < 8 ? M_LAT + b * CTXL + 32 * (ch) : b * SEQ + (r0 + ((ch) - 8)) * GW + kb)
#define ATT_LOADK(s) do { _Pragma("unroll") for (int c = 0; c < 4; ++c) { const int tok_ = ATT_TOK0(4 * (s) + c); \
        _Pragma("unroll") for (int a = 0; a < 2; ++a) { const int t_ = tok_ + 16 * a + l15; const u32x4* kp_ = KF + ((size_t)((t_ >> 4) * 16 + h) * 8 + g) * 16 + (t_ & 15); kx[c][a][0] = kp_[0]; kx[c][a][1] = kp_[64]; } } } while (0)
#define ATT_LOADV(s) do { _Pragma("unroll") for (int c = 0; c < 4; ++c) { const int tok_ = ATT_TOK0(4 * (s) + c); \
        _Pragma("unroll") for (int a = 0; a < 2; ++a) { const int t_ = tok_ + 16 * a + 4 * g; const u32x2* vp_ = VF + ((size_t)((t_ >> 4) * 16 + h) * 16 + ((t_ >> 2) & 3)) * 16 + l15; \
            _Pragma("unroll") for (int d = 0; d < 4; ++d) vx[c][d][a] = vp_[d * 64]; } } } while (0)
    f32x4 o[4];
#pragma unroll
    for (int d = 0; d < 4; ++d) o[d] = (f32x4){0.f, 0.f, 0.f, 0.f};
    float mrun = -1e30f, lsum = 0.f;
    ATT_LOADK(0); ATT_LOADV(0);
#pragma unroll 1
    for (int s = 0; s < 4; ++s) {
        f32x4 sc_[4][2];
#pragma unroll
        for (int c = 0; c < 4; ++c)
#pragma unroll
            for (int a = 0; a < 2; ++a) { f32x4 acc_ = (f32x4){0.f, 0.f, 0.f, 0.f};
                acc_ = __builtin_amdgcn_mfma_f32_16x16x32_bf16(__builtin_bit_cast(bf16x8, kx[c][a][0]), qf[0], acc_, 0, 0, 0);
                acc_ = __builtin_amdgcn_mfma_f32_16x16x32_bf16(__builtin_bit_cast(bf16x8, kx[c][a][1]), qf[1], acc_, 0, 0, 0); sc_[c][a] = acc_; }
        if (s < 3) ATT_LOADK(s + 1);
        if (s >= 2) {
#pragma unroll
            for (int c = 0; c < 4; ++c) { const LAS float* bp_ = rpbh + ((r0 + 4 * (s - 2) + c) - r + WIN_R - 1) * 31;
#pragma unroll
                for (int a = 0; a < 2; ++a)
#pragma unroll
                    for (int e = 0; e < 4; ++e) sc_[c][a][e] = okk[4 * a + e] ? sc_[c][a][e] + bp_[dcol[4 * a + e]] : -1e30f; }
        }
        float mx_ = -1e30f;
#pragma unroll
        for (int c = 0; c < 4; ++c)
#pragma unroll
            for (int a = 0; a < 2; ++a) mx_ = fmaxf(mx_, fmaxf(fmaxf(sc_[c][a][0], sc_[c][a][1]), fmaxf(sc_[c][a][2], sc_[c][a][3])));
        mx_ = fmaxf(mx_, __shfl_xor(mx_, 16)); mx_ = fmaxf(mx_, __shfl_xor(mx_, 32));
        const float mnew_ = fmaxf(mrun, mx_), alpha_ = __builtin_amdgcn_exp2f((mrun - mnew_) * 1.44269504089f); mrun = mnew_;
        const float mb_ = mnew_ * 1.44269504089f;
        float ps_ = 0.f; bf16x8 pf_[4];
#pragma unroll
        for (int c = 0; c < 4; ++c) { float pe_[8];
#pragma unroll
            for (int a = 0; a < 2; ++a)
#pragma unroll
                for (int e = 0; e < 4; ++e) { pe_[4 * a + e] = __builtin_amdgcn_exp2f(sc_[c][a][e] * 1.44269504089f - mb_); ps_ += pe_[4 * a + e]; }
            u32x4 pw_; pw_.x = pg8::cvt_pk_bf16(pe_[0], pe_[1]); pw_.y = pg8::cvt_pk_bf16(pe_[2], pe_[3]); pw_.z = pg8::cvt_pk_bf16(pe_[4], pe_[5]); pw_.w = pg8::cvt_pk_bf16(pe_[6], pe_[7]);
            pf_[c] = __builtin_bit_cast(bf16x8, pw_); }
        lsum = lsum * alpha_ + ps_;
#pragma unroll
        for (int d = 0; d < 4; ++d) { o[d] = o[d] * alpha_;
#pragma unroll
            for (int c = 0; c < 4; ++c) { u32x4 vw_; vw_.x = vx[c][d][0].x; vw_.y = vx[c][d][0].y; vw_.z = vx[c][d][1].x; vw_.w = vx[c][d][1].y;
                o[d] = __builtin_amdgcn_mfma_f32_16x16x32_bf16(__builtin_bit_cast(bf16x8, vw_), pf_[c], o[d], 0, 0, 0); } }
        if (s < 3) ATT_LOADV(s + 1);
    }
#undef ATT_TOK0
#undef ATT_LOADK
#undef ATT_LOADV
    lsum += __shfl_xor(lsum, 16); lsum += __shfl_xor(lsum, 32);
    const float inv = 1.0f / lsum;
#pragma unroll
    for (int d = 0; d < 4; ++d) { u32x2 w; w.x = pg8::cvt_pk_bf16(o[d][0] * inv, o[d][1] * inv); w.y = pg8::cvt_pk_bf16(o[d][2] * inv, o[d][3] * inv);
        *(u32x2*)(MIX + (size_t)qrow * D + h * HD + 16 * d + 4 * g) = w; }
}
__device__ __forceinline__ void attn_phase(const Params& p, LAS unsigned char* lds, int tid, int lane, int wave) {
    LAS float* rpbL = (LAS float*)lds;
    __syncthreads();
    for (int i = tid; i < NH * 15 * 31; i += 512) rpbL[i] = p.in[IN_RPB][i];
    __syncthreads();
    const int cls = blockIdx.x & 7, wgi = blockIdx.x >> 3, ncl = (gridDim.x - cls + 7) >> 3, nW = ncl * 8;
    if (gridDim.x >= 8) {
        for (int v = wgi * 8 + wave; v < NH * GROWS * 4; v += nW) { const int h = v >> 7, rem = v & 127; attn_wave_unit(p, rpbL, cls, h, rem >> 2, rem & 3, lane); }
    } else {
        for (int v = blockIdx.x * 8 + wave; v < NBATCH * NH * GROWS * 4; v += gridDim.x * 8) { const int b = v >> 11, w = v & 2047, h = w >> 7, rem = w & 127; attn_wave_unit(p, rpbL, b, h, rem >> 2, rem & 3, lane); }
    }
}

__device__ __forceinline__ float gelu_tanh(float x) { const float z = 0.7978845608028654f * (x + 0.044715f * x * x * x); return x * fast_sigmoid(2.0f * z); }
constexpr int LCH = 256;
__device__ __forceinline__ void lru_item(const Params& p, LAS unsigned char* lds, int item, int tid, int lane, int wave) {
    const bf16* ZO = (const bf16*)(p.ws + WS_Z); float* HF = (float*)(p.ws + WS_HF); bf16* MIX = (bf16*)(p.ws + WS_MIX);
    const int b = item >> 5, n = (item >> 1) & 15, half = item & 1, j0 = half * 32;
    LAS float* xcf = (LAS float*)lds;
    LAS bf16* xcb = (LAS bf16*)(lds + LCH * 33 * 4);
    LAS float* As = (LAS float*)(lds + LCH * 33 * 4 + LCH * 72 * 2);
    LAS float* Us = As + LCH * 33;
    LAS float* segA = Us + LCH * 33;
    LAS float* segH = segA + 16 * 32;
    const int ci = lane, cch = n * 64 + ci;
    const float* lcw = p.in[IN_LCW]; const float cw0 = lcw[cch], cw1 = lcw[1024 + cch], cw2 = lcw[2048 + cch], cw3 = lcw[3072 + cch], cb = p.in[IN_LCB][cch];
    const bool own = (ci >> 5) == half;
    const int jb = wave & 1, tb0 = (wave >> 1) * 4, l15 = lane & 15, g = lane >> 4, jl = 16 * jb + l15, gch = n * 64 + j0 + jl;
    const int sc = lane & 31, hi = lane >> 5, sg = 2 * wave + hi;
    const unsigned och = (unsigned)(n * 64 + j0 + sc);
    for (int dir = 0; dir < 2; ++dir) {
        bf16x8 Bg[2][2];
        {
            const float* gw = p.in[IN_LGW] + (size_t)((dir * 2) * 16 + n) * 4096;
#pragma unroll
            for (int gt = 0; gt < 2; ++gt)
#pragma unroll
                for (int kk = 0; kk < 2; ++kk) { const float* wp = gw + (size_t)gt * 16 * 4096 + (size_t)(8 * g + 32 * kk) * 64 + j0 + jl;
                    u32x4 w; w.x = pk2(wp[0], wp[64]); w.y = pk2(wp[128], wp[192]); w.z = pk2(wp[256], wp[320]); w.w = pk2(wp[384], wp[448]); Bg[gt][kk] = __builtin_bit_cast(bf16x8, w); }
        }
        const float br = p.in[IN_LGB][(dir * 2 + 0) * 1024 + gch], bi = p.in[IN_LGB][(dir * 2 + 1) * 1024 + gch];
        const float lam = p.in[IN_LAM][dir * 1024 + gch];
        const float sp8 = -8.0f * log1pf(expf(-lam)) * 1.44269504089f;
        float carry = 0.f;
        const unsigned hoff = (unsigned)((dir == 0 ? 16 * hi : 16 * (1 - hi)) * 1024) + och;
        const unsigned moff = (unsigned)((dir == 0 ? 16 * hi : 16 * (1 - hi)) * D) + 1024u + och;
        const unsigned goff = (unsigned)((dir == 0 ? 16 * hi : 16 * (1 - hi)) * ZO_LD) + 4096u + och;
        u32x4 xraw[5];
#define LRU_LOADX(cidx_) do { const int ci_ = (cidx_); const bool isctx_ = ci_ < 1; const int cc_ = isctx_ ? 0 : ci_ - 1, ncs_ = isctx_ ? 1 : 8, cpos_ = dir == 0 ? cc_ : ncs_ - 1 - cc_; \
        const int base_ = isctx_ ? M_LAT + b * CTXL : b * SEQ, T_ = isctx_ ? CTXL : SEQ, ts_ = cpos_ * LCH - 1; \
        _Pragma("unroll") for (int q = 0; q < 5; ++q) { const int pc = min(q * 512 + tid, 2071), t = ts_ + (pc >> 3), tc = min(max(t, 0), T_ - 1); const unsigned msk = (t == tc) ? 0xffffffffu : 0u; \
            xraw[q] = *(const u32x4*)(ZO + (size_t)(base_ + tc) * ZO_LD + 3072 + n * 64 + (pc & 7) * 8) & msk; } } while (0)
        LRU_LOADX(0);
        LAS unsigned char* rawt = (LAS unsigned char*)As;
#pragma unroll 1
        for (int cidx = 0; cidx < 9; ++cidx) {
            const bool isctx = cidx < 1;
            const int cc = isctx ? 0 : cidx - 1, ncs = isctx ? 1 : 8, cpos = dir == 0 ? cc : ncs - 1 - cc;
            const int base = isctx ? M_LAT + b * CTXL : b * SEQ, t0 = cpos * LCH;
            const int rbase = dir == 0 ? base + t0 + 32 * wave : base + t0 + LCH - 1 - 32 * wave - 16;
            float hfv[16]; unsigned grv[16];
            if (!isctx && dir == 1) {
                const float* hp_ = HF + (size_t)rbase * 1024; const bf16* gp_ = ZO + (size_t)rbase * ZO_LD;
#pragma unroll
                for (int e = 0; e < 16; ++e) { hfv[e] = (hp_ - (size_t)e * 1024)[hoff]; grv[e] = (unsigned)(gp_ - (size_t)e * ZO_LD)[goff]; }
            }
#pragma unroll
            for (int q = 0; q < 5; ++q) { const int pc = q * 512 + tid; if (pc < 2072) *(LAS u32x4*)(rawt + pc * 16) = xraw[q]; }
            __syncthreads();
            {
                float xf[35];
                const LAS unsigned short* rp_ = (const LAS unsigned short*)(rawt + (32 * wave) * 128) + ci;
#pragma unroll
                for (int e = 0; e < 35; ++e) xf[e] = __builtin_bit_cast(float, (unsigned)rp_[e * 64] << 16);
                LAS bf16* xb_ = xcb + (32 * wave) * 72 + ci; LAS float* xf_ = xcf + (32 * wave) * 33 + (ci & 31);
#pragma unroll
                for (int e = 0; e < 32; ++e) { const float y = cw0 * xf[e] + cw1 * xf[e + 1] + cw2 * xf[e + 2] + cw3 * xf[e + 3] + cb;
                    xb_[e * 72] = (bf16)f2bf(y); if (own) xf_[e * 33] = y; }
            }
            if (cidx + 1 < 9) LRU_LOADX(cidx + 1);
            __syncthreads();
#pragma unroll 1
            for (int q = 0; q < 4; ++q) {
                const int tb = tb0 + q;
                const bf16x8 a0 = *(const LAS bf16x8*)(xcb + (16 * tb + l15) * 72 + 8 * g), a1 = *(const LAS bf16x8*)(xcb + (16 * tb + l15) * 72 + 8 * g + 32);
                f32x4 gr_ = (f32x4){0.f, 0.f, 0.f, 0.f}, gi_ = (f32x4){0.f, 0.f, 0.f, 0.f};
                gr_ = __builtin_amdgcn_mfma_f32_16x16x32_bf16(a0, Bg[0][0], gr_, 0, 0, 0); gr_ = __builtin_amdgcn_mfma_f32_16x16x32_bf16(a1, Bg[0][1], gr_, 0, 0, 0);
                gi_ = __builtin_amdgcn_mfma_f32_16x16x32_bf16(a0, Bg[1][0], gi_, 0, 0, 0); gi_ = __builtin_amdgcn_mfma_f32_16x16x32_bf16(a1, Bg[1][1], gi_, 0, 0, 0);
#pragma unroll
                for (int e = 0; e < 4; ++e) {
                    const int tl = 16 * tb + 4 * g + e;
                    const float rg = fast_sigmoid(gr_[e] + br), ig = fast_sigmoid(gi_[e] + bi);
                    const float la2 = sp8 * rg, a = __builtin_amdgcn_exp2f(la2);
                    const float x2 = la2 * 1.38629436112f;
                    const float em = x2 > -0.25f ? -x2 * (1.0f + x2 * (0.5f + x2 * (0.16666667f + x2 * (0.041666668f + x2 * 0.0083333338f)))) : 1.0f - a * a;
                    As[tl * 33 + jl] = a; Us[tl * 33 + jl] = sqrtf(em) * ig * xcf[tl * 33 + jl];
                }
            }
            __syncthreads();
            float av[16], uv[16];
            {
                float A = 1.f, H = 0.f;
                const LAS float* ap_ = As + (dir ? (LCH - 1 - 16 * sg) : 16 * sg) * 33 + sc; const LAS float* up_ = Us + (dir ? (LCH - 1 - 16 * sg) : 16 * sg) * 33 + sc;
#pragma unroll
                for (int e = 0; e < 16; ++e) { av[e] = dir ? ap_[-e * 33] : ap_[e * 33]; uv[e] = dir ? up_[-e * 33] : up_[e * 33]; H = av[e] * H + uv[e]; A *= av[e]; }
                segA[sg * 32 + sc] = A; segH[sg * 32 + sc] = H;
            }
            __syncthreads();
            {
                float hin = carry, mine = 0.f;
#pragma unroll
                for (int s2 = 0; s2 < 16; ++s2) { if (s2 == sg) mine = hin; hin = segA[s2 * 32 + sc] * hin + segH[s2 * 32 + sc]; }
                carry = hin;
                if (!isctx) {
                    float hcur = mine;
                    if (dir == 0) {
                        float* hp_ = HF + (size_t)rbase * 1024;
#pragma unroll
                        for (int e = 0; e < 16; ++e) { hcur = av[e] * hcur + uv[e]; (hp_ + (size_t)e * 1024)[hoff] = hcur; }
                    } else {
                        bf16* mp_ = MIX + (size_t)rbase * D;
#pragma unroll
                        for (int e = 0; e < 16; ++e) { hcur = av[e] * hcur + uv[e];
                            (mp_ - (size_t)e * D)[moff] = (bf16)f2bf((hfv[e] + hcur) * gelu_tanh(__builtin_bit_cast(float, grv[e] << 16))); }
                    }
                }
            }
        }
#undef LRU_LOADX
        VM_WAIT(); __syncthreads();
    }
}


#if MK_SPLIT
#define GRID_BAR() do { } while (0)
#else
#define GRID_BAR() xcd_barrier(bar)
#endif
#ifndef PH_MASK
#define PH_MASK 0xffffffffu
#endif
#define IN(k) (lo <= (k) && (k) < hi && ((PH_MASK >> (k)) & 1u))
#ifndef PROBE_MASK
#define PROBE_MASK 0u
#endif
#ifndef PROBE_MULT
#define PROBE_MULT 4
#endif
#if PROBE_MASK
#define PROBE_STAMP(k) do { if (blockIdx.x == 0 && threadIdx.x == 0) { volatile LAS unsigned long long* pw = (volatile LAS unsigned long long*)(lds + MISC_OFF + 128); \
        const unsigned long long t_ = __builtin_amdgcn_s_memrealtime(); if ((PROBE_MASK >> (k)) & 1u) pw[1] += t_ - pw[0]; pw[0] = t_; } } while (0)
#else
#define PROBE_STAMP(k) do { } while (0)
#endif
#define SEAM(k) do { if (IN(k) && IN((k) + 1)) GRID_BAR(); PROBE_STAMP(k); } while (0)

template <int L>
__device__ __forceinline__ void layer_body(const Params& p, LAS unsigned char* lds, const XcdBarrier& bar, const int lo, const int hi) {
    constexpr int l = L;
    const int tid = threadIdx.x, lane = tid & 63, wave = __builtin_amdgcn_readfirstlane(tid >> 6);
    const int G = gridDim.x;
    float* MOD = (float*)(p.ws + WS_MOD);
    _Float16* X = (_Float16*)(p.ws + WS_X);
    bf16* HN = (bf16*)(p.ws + WS_HN);
    bf16* ACT = (bf16*)(p.ws + WS_ACT);
    bf16* Z = (bf16*)(p.ws + WS_Z);
    bf16* MIX = (bf16*)(p.ws + WS_MIX);
    float* PART = (float*)(p.ws + WS_PART);
        const int pb = 1 + 10 * l;
        const float* modl = MOD + (size_t)l * 9 * DMODW;
        const float* ng = p.in[IN_NORMG] + (size_t)l * 3 * D;
        constexpr bool first = (l == 0);
        const void* xs_lat = first ? (const void*)p.in[IN_X] : (const void*)X; const void* xs_ctx = first ? (const void*)p.in[IN_CTX] : (const void*)(X + (size_t)M_LAT * D);

        if (IN(pb + 0)) norm_phase<!first, first>(xs_lat, xs_ctx, X + (size_t)M_LAT * D, PART, M_ALL, ng + 0 * D, modl, 0, 1, HN, lane, wave);
        SEAM(pb + 0);
        if (IN(pb + 1)) {
            SchedStd S{(const char*)HN, (const char*)(p.ws + WS_WFI + (size_t)(l * 2 + 0) * WFI_STRIDE), (size_t)256 * D * 2, M_ALL / 256, 2 * DFF / 256, G, (int)blockIdx.x, D / 64};
            EpiSwiGLU E{ACT};
            pg8::gemm_phase<EpiSwiGLU, SchedStd>(lds, D, S, E);
        }
        SEAM(pb + 1);
        if (IN(pb + 2)) {
            SchedDown S{(const char*)ACT, (const char*)(p.ws + WS_WFO + (size_t)(l * 2 + 0) * WFO_STRIDE), (size_t)256 * DFF * 2, G, (int)blockIdx.x, DFF / 64};
            EpiResid<first, false> E{xs_lat, xs_ctx, X, modl + 2 * D, 0.5f, PART};
            pg8::gemm_phase<EpiResid<first, false>, SchedDown>(lds, DFF, S, E);
        }
        SEAM(pb + 2);
        if (IN(pb + 3)) norm_phase<true, false>(X, X + (size_t)M_LAT * D, X + (size_t)M_LAT * D, PART, M_ALL, ng + 1 * D, modl, 3, 4, HN, lane, wave);
        SEAM(pb + 3);
        if constexpr (first) {
            if (IN(pb + 4)) {
                SchedStd S{(const char*)HN, (const char*)(p.ws + WS_WEI), (size_t)256 * D * 2, M_ALL / 256, D_EIN / 256, G, (int)blockIdx.x, D / 64};
                EpiEvIn E{Z};
                pg8::gemm_phase<EpiEvIn, SchedStd>(lds, D, S, E);
            }
            SEAM(pb + 4);
            if (IN(pb + 5)) even_conv_phase(p, lds, tid, lane, wave);
            SEAM(pb + 5);
            if (IN(pb + 6)) {
                SchedDown S{(const char*)MIX, (const char*)(p.ws + WS_WEO), (size_t)256 * D * 2, G, (int)blockIdx.x, D / 64};
                EpiResid<false, false> E{X, X + (size_t)M_LAT * D, X, modl + 5 * D, 1.0f, PART};
                pg8::gemm_phase<EpiResid<false, false>, SchedDown>(lds, D, S, E);
            }
            SEAM(pb + 6);
        } else {
            if (IN(pb + 4)) {
                SchedOdIn S{(const char*)HN, (const char*)(p.ws + WS_WOI), (size_t)256 * D * 2, G, (int)blockIdx.x};
                EpiOdIn E{Z, (u32x4*)(p.ws + WS_KF), (u32x2*)(p.ws + WS_VT), p.in[IN_QG], p.in[IN_KG]};
                pg8::gemm_phase<EpiOdIn, SchedOdIn>(lds, D, S, E);
            }
            SEAM(pb + 4);
            if (IN(pb + 5)) {
#ifndef NO_LRU
                for (int item = blockIdx.x; item < 256; item += G) lru_item(p, lds, item, tid, lane, wave);
#endif
#if PROBE_MASK
                __syncthreads();
                if (blockIdx.x == 0 && threadIdx.x == 0) { volatile LAS unsigned long long* pw = (volatile LAS unsigned long long*)(lds + MISC_OFF + 128);
                    const unsigned long long t_ = __builtin_amdgcn_s_memrealtime(); if ((PROBE_MASK >> 30) & 1u) pw[1] += t_ - pw[0]; }
#endif
#ifndef NO_ATTN
                attn_phase(p, lds, tid, lane, wave);
#endif
            }
            SEAM(pb + 5);
            if (IN(pb + 6)) {
                SchedStd S{(const char*)MIX, (const char*)(p.ws + WS_WOO), (size_t)256 * D * 2, M_LAT / 256, D / 256, G, (int)blockIdx.x, D / 64};
                EpiResid<false, false> E{X, X + (size_t)M_LAT * D, X, modl + 5 * D, 1.0f, PART};
                pg8::gemm_phase<EpiResid<false, false>, SchedStd>(lds, D, S, E);
            }
            SEAM(pb + 6);
        }
        const int nrows2 = first ? M_ALL : M_LAT;
        if (IN(pb + 7)) norm_phase<first, false>(X, X + (size_t)M_LAT * D, X + (size_t)M_LAT * D, PART, nrows2, ng + 2 * D, modl, 6, 7, HN, lane, wave);
        SEAM(pb + 7);
        if (IN(pb + 8)) {
            SchedStd S{(const char*)HN, (const char*)(p.ws + WS_WFI + (size_t)(l * 2 + 1) * WFI_STRIDE), (size_t)256 * D * 2, nrows2 / 256, 2 * DFF / 256, G, (int)blockIdx.x, D / 64};
            EpiSwiGLU E{ACT};
            pg8::gemm_phase<EpiSwiGLU, SchedStd>(lds, D, S, E);
        }
        SEAM(pb + 8);
        if (IN(pb + 9)) {
            if constexpr (first) {
                SchedDown S{(const char*)ACT, (const char*)(p.ws + WS_WFO + (size_t)(l * 2 + 1) * WFO_STRIDE), (size_t)256 * DFF * 2, G, (int)blockIdx.x, DFF / 64};
                EpiResid<false, false> E{X, X + (size_t)M_LAT * D, X, modl + 8 * D, 0.5f, PART};
                pg8::gemm_phase<EpiResid<false, false>, SchedDown>(lds, DFF, S, E);
            } else {
                SchedStd S{(const char*)ACT, (const char*)(p.ws + WS_WFO + (size_t)(l * 2 + 1) * WFO_STRIDE), (size_t)256 * DFF * 2, M_LAT / 256, D / 256, G, (int)blockIdx.x, DFF / 64};
                EpiResid<false, true> E{X, X + (size_t)M_LAT * D, p.out, modl + 8 * D, 0.5f, PART};
                pg8::gemm_phase<EpiResid<false, true>, SchedStd>(lds, DFF, S, E);
            }
        }
        SEAM(pb + 9);
}
__global__ void __launch_bounds__(512, 2) mega_fwd(Params p) {
    extern __shared__ __attribute__((aligned(16))) unsigned char lds_raw[];
    LAS unsigned char* lds = (LAS unsigned char*)lds_raw;
    volatile LAS unsigned* MISC = (volatile LAS unsigned*)(lds + MISC_OFF);
    const int tid = threadIdx.x, lane = tid & 63, wave = __builtin_amdgcn_readfirstlane(tid >> 6);
    const int G = gridDim.x;
    if (tid < 64) MISC[tid] = 0u;
    __syncthreads();
    unsigned* ctl = (unsigned*)(p.ws + WS_CTL);
#if MK_SPLIT
    XcdBarrier bar; bar.bar = ctl + CW_BAR; bar.x = 0; bar.st = MISC + 8;
#else
    XcdBarrier bar = xcd_barrier_post(ctl + CW_BAR, MISC + 8);
#endif
    const int lo = p.ph_lo, hi = p.ph_hi;
#if PROBE_MASK
    if (blockIdx.x == 0 && tid == 0) { volatile LAS unsigned long long* pw = (volatile LAS unsigned long long*)(lds + MISC_OFF + 128); pw[0] = __builtin_amdgcn_s_memrealtime(); pw[1] = 0ull; }
#endif

    float* MOD = (float*)(p.ws + WS_MOD);
    float* X = (float*)(p.ws + WS_X);
    bf16* HN = (bf16*)(p.ws + WS_HN);
    bf16* ACT = (bf16*)(p.ws + WS_ACT);
    bf16* Z = (bf16*)(p.ws + WS_Z);
    bf16* MIX = (bf16*)(p.ws + WS_MIX);

    if (IN(0)) {
#ifndef NO_WEIGHTS
        p0_weights(p, lds, lane, wave); __syncthreads();
#endif
#ifndef NO_MODVEC
        p0_modvec(p, lds, tid, lane, wave); __syncthreads();
#endif
    }
    SEAM(0);

    layer_body<0>(p, lds, bar, lo, hi);
    layer_body<1>(p, lds, bar, lo, hi);
#if PROBE_MASK
    if (blockIdx.x == 0 && tid == 0) { volatile LAS unsigned long long* pw = (volatile LAS unsigned long long*)(lds + MISC_OFF + 128); const unsigned long long t0 = __builtin_amdgcn_s_memrealtime(), dt = (unsigned long long)PROBE_MULT * pw[1];
        while (__builtin_amdgcn_s_memrealtime() - t0 < dt) __builtin_amdgcn_s_sleep(8); }
#endif
#undef IN
#undef SEAM
#undef GRID_BAR
}

extern "C" void kernel_launch(void* const* d_in, const int* in_sizes, int n_in, void* d_out, int out_size, void* d_ws, size_t ws_size, hipStream_t stream) {
    static int grid = 0;
    if (grid == 0) {
        if (n_in != 27 || in_sizes[0] != M_LAT * D || out_size != M_LAT * D || ws_size < WS_END) {
            fprintf(stderr, "kernel_launch: unexpected shapes (n_in %d, in0 %d, out %d, ws %zu; need ws >= %zu); nothing launched\n", n_in, n_in > 0 ? in_sizes[0] : -1, out_size, ws_size, (size_t)WS_END); grid = -1; return; }
        int dev = 0, cus = 0, per_cu = 0;
        if (hipGetDevice(&dev) != hipSuccess || hipDeviceGetAttribute(&cus, hipDeviceAttributeMultiprocessorCount, dev) != hipSuccess) { fprintf(stderr, "kernel_launch: device query failed\n"); grid = -1; return; }
        if (hipFuncSetAttribute((const void*)mega_fwd, hipFuncAttributeMaxDynamicSharedMemorySize, LDS_BYTES) != hipSuccess) { fprintf(stderr, "kernel_launch: hipFuncSetAttribute failed\n"); grid = -1; return; }
        if (hipOccupancyMaxActiveBlocksPerMultiprocessor(&per_cu, (const void*)mega_fwd, 512, LDS_BYTES) != hipSuccess || per_cu < 1) {
            fprintf(stderr, "kernel_launch: occupancy query reports %d workgroups per CU\n", per_cu); }
        (void)hipGetLastError();
        grid = cus;
    }
    if (grid < 0) return;
    if (hipMemsetAsync((char*)d_ws + WS_CTL, 0, CTL_ZERO_BYTES, stream) != hipSuccess) { fprintf(stderr, "kernel_launch: memset failed\n"); return; }
    Params a{};
    for (int i = 0; i < 27; ++i) a.in[i] = (const float*)d_in[i];
    a.out = (float*)d_out; a.ws = (unsigned char*)d_ws;
#if MK_SPLIT
    for (int ph = 0; ph < NPHASE; ++ph) { a.ph_lo = ph; a.ph_hi = ph + 1; hipLaunchKernelGGL(mega_fwd, dim3(grid), dim3(512), LDS_BYTES, stream, a); }
#else
    a.ph_lo = 0; a.ph_hi = NPHASE;
    hipLaunchKernelGGL(mega_fwd, dim3(grid), dim3(512), LDS_BYTES, stream, a);
#endif
    const hipError_t le = hipPeekAtLastError();
    if (le != hipSuccess) fprintf(stderr, "kernel_launch: launch failed: %s\n", hipGetErrorName(le));
}
```

```cpp
#include <hip/hip_runtime.h>
#include <cstdio>
#include <cstdint>

#ifndef MK_SPLIT
#define MK_SPLIT 0
#endif

namespace pg8 {
#define PG8_LAS __attribute__((address_space(3)))
typedef unsigned short bf16_t;
typedef short bf16x8 __attribute__((ext_vector_type(8)));
typedef float f32x4 __attribute__((ext_vector_type(4)));
typedef unsigned u32x4 __attribute__((ext_vector_type(4)));
typedef unsigned u32x2 __attribute__((ext_vector_type(2)));
constexpr int BM = 256, BK = 64, HALF = 128, HTB = HALF * BK * 2  , STAGE_BYTES = 8 * HTB, NXCD = 8, WGM = 8;

__host__ __device__ __forceinline__ int lds_byte(int r, int c) { const int st = (r >> 4) * 2 + (c >> 5), rr = r & 15, cc = c & 31, ob = rr * 64 + cc * 2; return st * 1024 + (ob ^ (((ob >> 9) & 1) << 5)); }
__host__ __device__ __forceinline__ void stage_rc(int b, int& R, int& C) { const int st = b / 1024, sb = b % 1024, swz = sb ^ (((sb >> 9) & 1) << 5); R = (st >> 1) * 16 + swz / 64; C = (st & 1) * 32 + (swz % 64) / 2; }
__host__ __device__ __forceinline__ int perm32(int rho) { const int n = rho >> 4, i = rho & 15; return 8 * (i >> 2) + 4 * n + (i & 3); }

struct Unit { int pm, pn, kind; };

__host__ __device__ __forceinline__ void tile_map(int wgid, int nM, int nN, int& pm, int& pn) {
    const int nwg = nM * nN;
    { const int q = nwg / NXCD, r = nwg % NXCD, xcd = wgid % NXCD, off = wgid / NXCD; wgid = (xcd < r ? xcd * (q + 1) : r * (q + 1) + (xcd - r) * q) + off; }
    const int nig = WGM * nN, gid = wgid / nig, fm = gid * WGM, gsz = (nM - fm) < WGM ? (nM - fm) : WGM;
    pm = fm + ((wgid % nig) % gsz); pn = (wgid % nig) / gsz;
}

__device__ __forceinline__ unsigned cvt_pk_bf16(float lo, float hi) { unsigned r; asm volatile("v_cvt_pk_bf16_f32 %0, %1, %2" : "=v"(r) : "v"(lo), "v"(hi)); return r; }

template <class Epi, class Sched, bool ALIGN_EPI = true, bool SP2 = true>
__device__ __forceinline__ void gemm_phase(PG8_LAS unsigned char* lds, const int K  , const Sched& S, const Epi& E) {
    const int tid = threadIdx.x, wid = __builtin_amdgcn_readfirstlane(tid >> 6), lane = tid & 63, wr = wid >> 2, wc = wid & 3, fr = lane & 15, fq = lane >> 4;
    unsigned voffA[2], voffB[2];
#pragma unroll
    for (int i = 0; i < 2; ++i) { int R, C; stage_rc(tid * 16 + i * 8192, R, C); const int Rb = Epi::PERM ? ((R & ~31) + perm32(R & 31)) : R;
        voffA[i] = (unsigned)(R * K + C) * 2u; voffB[i] = (unsigned)(Rb * K + C) * 2u; }
    const size_t kstep = (size_t)(BK * 2);
    const size_t hstep = (size_t)HALF * K * 2;
    const unsigned ldsw = (unsigned)wid * 1024u;
    const int aoff = lds_byte(wr * 64 + fr, fq * 8), boff = lds_byte(wc * 32 + fr, fq * 8);
#define PG8_SA(b, h) (((b) * 2 + (h)) * HTB)
#define PG8_SB(b, h) ((4 + (b) * 2 + (h)) * HTB)
#define PG8_STAGE(bufoff, gbase, voff) do { _Pragma("unroll") for (int _i = 0; _i < 2; ++_i) \
        __builtin_amdgcn_global_load_lds((const unsigned*)((const char*)(gbase) + (voff)[_i]), (PG8_LAS unsigned*)(lds + (bufoff) + ldsw + _i * 8192), 16, 0, 0); } while (0)
#define PG8_LDA(dst, b, h) do { _Pragma("unroll") for (int m = 0; m < 4; ++m) _Pragma("unroll") for (int k = 0; k < 2; ++k) dst[m][k] = *(const PG8_LAS bf16x8*)(lds + PG8_SA(b, h) + aoff + m * 2048 + k * 1024); } while (0)
#define PG8_LDB(dst, b, h) do { _Pragma("unroll") for (int n = 0; n < 2; ++n) _Pragma("unroll") for (int k = 0; k < 2; ++k) dst[n][k] = *(const PG8_LAS bf16x8*)(lds + PG8_SB(b, h) + boff + n * 2048 + k * 1024); } while (0)
#define PG8_MMA(ai, bj, At, Bt) do { __builtin_amdgcn_s_setprio(1); _Pragma("unroll") for (int m = 0; m < 4; ++m) _Pragma("unroll") for (int n = 0; n < 2; ++n) _Pragma("unroll") for (int k = 0; k < 2; ++k) \
        acc[ai][bj][m][n] = __builtin_amdgcn_mfma_f32_16x16x32_bf16(Bt[n][k], At[m][k], acc[ai][bj][m][n], 0, 0, 0); __builtin_amdgcn_s_setprio(0); } while (0)
#define PG8_WAIT_V(n) asm volatile("s_waitcnt vmcnt(" #n ")" ::: "memory")
#define PG8_WAIT_L(n) asm volatile("s_waitcnt lgkmcnt(" #n ")" ::: "memory")
#define PG8_BAR __builtin_amdgcn_s_barrier()
#define PG8_SCHED __builtin_amdgcn_sched_barrier(0)
    Unit cur, nxt; int ui = 0;
    if (!S.next(0, cur)) return;
    f32x4 acc[2][2][4][2];
#pragma unroll
    for (int a = 0; a < 2; ++a)
#pragma unroll
        for (int b = 0; b < 2; ++b)
#pragma unroll
            for (int m = 0; m < 4; ++m)
#pragma unroll
                for (int n = 0; n < 2; ++n) acc[a][b][m][n] = (f32x4){0.f, 0.f, 0.f, 0.f};
    bf16x8 At[4][2], B0[2][2], B1[2][2];
    const char* cA = S.a_base(cur); const char* cB = S.b_base(cur);
    if constexpr (SP2) {
        PG8_STAGE(PG8_SB(0, 0), cB, voffB); PG8_STAGE(PG8_SB(0, 1), cB + hstep, voffB); PG8_STAGE(PG8_SA(0, 0), cA, voffA); PG8_STAGE(PG8_SA(0, 1), cA + hstep, voffA);
        if (wr == 1) PG8_BAR;
        PG8_WAIT_V(2); PG8_BAR;
        PG8_STAGE(PG8_SB(1, 0), cB + kstep, voffB); PG8_STAGE(PG8_SA(1, 0), cA + kstep, voffA); PG8_STAGE(PG8_SB(1, 1), cB + hstep + kstep, voffB);
        PG8_WAIT_V(6); PG8_BAR;
    } else {
        PG8_STAGE(PG8_SB(0, 0), cB, voffB); PG8_STAGE(PG8_SA(0, 0), cA, voffA); PG8_STAGE(PG8_SB(0, 1), cB + hstep, voffB); PG8_STAGE(PG8_SA(0, 1), cA + hstep, voffA);
        if (wr == 1) PG8_BAR;
        PG8_WAIT_V(4); PG8_BAR;
        PG8_STAGE(PG8_SB(1, 0), cB + kstep, voffB); PG8_STAGE(PG8_SA(1, 0), cA + kstep, voffA); PG8_STAGE(PG8_SB(1, 1), cB + hstep + kstep, voffB);
        PG8_WAIT_V(6); PG8_BAR;
    }
    for (;;) {
        const bool has_next = S.next(ui + 1, nxt);
        const int nt = S.nt(cur);
        const char* nA = has_next ? S.a_base(nxt) : cA; const char* nB = has_next ? S.b_base(nxt) : cB;
        for (int t = 0; t < nt; t += 2) {
            const bool last = (t == nt - 2);
            const char* a1 = cA + (size_t)(t + 1) * kstep;
            const char* a2 = last ? nA : cA + (size_t)(t + 2) * kstep; const char* b2 = last ? nB : cB + (size_t)(t + 2) * kstep;
            const char* a3 = a2 + kstep; const char* b3 = b2 + kstep;
            if constexpr (SP2) {
            PG8_LDB(B0, 0, 0); PG8_LDB(B1, 0, 1); PG8_SCHED; PG8_LDA(At, 0, 0); PG8_STAGE(PG8_SA(1, 1), a1 + hstep, voffA);
            PG8_WAIT_V(8); PG8_WAIT_L(0); PG8_BAR; PG8_MMA(0, 0, At, B0); PG8_MMA(0, 1, At, B1); PG8_BAR; PG8_SCHED;
            PG8_LDA(At, 0, 1); PG8_STAGE(PG8_SB(0, 0), b2, voffB); PG8_STAGE(PG8_SB(0, 1), b2 + hstep, voffB); PG8_STAGE(PG8_SA(0, 0), a2, voffA);
            PG8_WAIT_V(8); PG8_WAIT_L(0); PG8_BAR; PG8_MMA(1, 0, At, B0); PG8_MMA(1, 1, At, B1); PG8_BAR; PG8_SCHED;
            PG8_LDB(B0, 1, 0); PG8_LDB(B1, 1, 1); PG8_SCHED; PG8_LDA(At, 1, 0); PG8_STAGE(PG8_SA(0, 1), a2 + hstep, voffA);
            PG8_WAIT_V(8); PG8_WAIT_L(0); PG8_BAR; PG8_MMA(0, 0, At, B0); PG8_MMA(0, 1, At, B1); PG8_BAR; PG8_SCHED;
            PG8_LDA(At, 1, 1); PG8_STAGE(PG8_SB(1, 0), b3, voffB); PG8_STAGE(PG8_SB(1, 1), b3 + hstep, voffB); PG8_STAGE(PG8_SA(1, 0), a3, voffA);
            PG8_WAIT_V(8); PG8_WAIT_L(0); PG8_BAR; PG8_MMA(1, 0, At, B0); PG8_MMA(1, 1, At, B1); PG8_BAR; PG8_SCHED;
            } else {
            PG8_LDB(B0, 0, 0); PG8_SCHED; PG8_LDA(At, 0, 0); PG8_STAGE(PG8_SA(1, 1), a1 + hstep, voffA);
            PG8_WAIT_L(8); PG8_BAR; PG8_WAIT_L(0); PG8_MMA(0, 0, At, B0); PG8_BAR; PG8_SCHED;
            PG8_LDB(B1, 0, 1); PG8_STAGE(PG8_SB(0, 0), b2, voffB);
            PG8_BAR; PG8_WAIT_L(0); PG8_MMA(0, 1, At, B1); PG8_BAR;
            PG8_LDA(At, 0, 1); PG8_STAGE(PG8_SA(0, 0), a2, voffA);
            PG8_BAR; PG8_WAIT_L(0); PG8_MMA(1, 0, At, B0); PG8_BAR; PG8_SCHED;
            PG8_STAGE(PG8_SB(0, 1), b2 + hstep, voffB);
            PG8_WAIT_V(6); PG8_BAR; PG8_MMA(1, 1, At, B1); PG8_BAR;
            PG8_LDB(B0, 1, 0); PG8_SCHED; PG8_LDA(At, 1, 0); PG8_STAGE(PG8_SA(0, 1), a2 + hstep, voffA);
            PG8_WAIT_L(8); PG8_BAR; PG8_WAIT_L(0); PG8_MMA(0, 0, At, B0); PG8_BAR; PG8_SCHED;
            PG8_LDB(B1, 1, 1); PG8_STAGE(PG8_SB(1, 0), b3, voffB);
            PG8_BAR; PG8_WAIT_L(0); PG8_MMA(0, 1, At, B1); PG8_BAR;
            PG8_LDA(At, 1, 1); PG8_STAGE(PG8_SA(1, 0), a3, voffA);
            PG8_BAR; PG8_WAIT_L(0); PG8_MMA(1, 0, At, B0); PG8_BAR; PG8_SCHED;
            PG8_STAGE(PG8_SB(1, 1), b3 + hstep, voffB);
            PG8_WAIT_V(6); PG8_BAR; PG8_MMA(1, 1, At, B1); PG8_BAR;
            }
        }
        if constexpr (ALIGN_EPI) { if (wr == 0) PG8_BAR; }
        E(acc, cur, wr, wc, fr, fq);
        if (!has_next) break;
#pragma unroll
        for (int a = 0; a < 2; ++a)
#pragma unroll
            for (int b = 0; b < 2; ++b)
#pragma unroll
                for (int m = 0; m < 4; ++m)
#pragma unroll
                    for (int n = 0; n < 2; ++n) acc[a][b][m][n] = (f32x4){0.f, 0.f, 0.f, 0.f};
        cur = nxt; cA = nA; cB = nB; ++ui;
        if constexpr (ALIGN_EPI) { if (wr == 1) PG8_BAR; }
    }
    PG8_WAIT_V(0);
    if constexpr (!ALIGN_EPI) { if (wr == 0) PG8_BAR; }
    PG8_BAR;
#undef PG8_SA
#undef PG8_SB
#undef PG8_STAGE
#undef PG8_LDA
#undef PG8_LDB
#undef PG8_MMA
#undef PG8_WAIT_V
#undef PG8_WAIT_L
#undef PG8_BAR
#undef PG8_SCHED
}
}

constexpr int D = 2048, NBATCH = 8, SEQ = 2048, CTXL = 256, DFF = 5632, NMODV = 9, DMODW = NMODV * D  ;
constexpr int M_LAT = NBATCH * SEQ  , M_CTX = NBATCH * CTXL  , M_ALL = M_LAT + M_CTX  ;
constexpr int NH = 16, HD = 64, GW = 64  , GROWS = SEQ / GW  , WIN_R = 8, WIN_C = 16;
constexpr int D_EIN = 5120, D_OIN = 5120, ZE_LD = 3072  , ZO_LD = 5120;
constexpr float EPS = 1e-6f;
constexpr int NPHASE = 21;

constexpr size_t MiB = 1u << 20;
constexpr size_t WS_CTL = 0, CTL_ZERO_BYTES = 1 * MiB;
constexpr size_t WS_MOD = 1 * MiB;
constexpr size_t WS_WFI = 4 * MiB, WFI_STRIDE = 44 * MiB;
constexpr size_t WS_WFO = 180 * MiB, WFO_STRIDE = 22 * MiB;
constexpr size_t WS_WEI = 268 * MiB, WS_WEO = 288 * MiB, WS_WOI = 296 * MiB, WS_WOO = 316 * MiB;
constexpr size_t WS_X = 324 * MiB;
constexpr size_t WS_HN = 468 * MiB;
constexpr size_t WS_ACT = 540 * MiB;
constexpr size_t WS_Z = 738 * MiB;
constexpr size_t WS_MIX = 918 * MiB;
constexpr size_t WS_VT = 990 * MiB;
constexpr size_t WS_HF = 1026 * MiB;
constexpr size_t WS_PART = 1090 * MiB, PART_STRIDE = 16 * MiB;
constexpr size_t WS_KF = 1138 * MiB;
constexpr size_t WS_END = 1174 * MiB;
constexpr int CW_BAR = 4096;
constexpr int CW_Q = 8192;

constexpr int RING_BYTES = 131072;
constexpr int LDS_BYTES = 147456;
constexpr int MISC_OFF = LDS_BYTES - 256;

#define GAS __attribute__((address_space(1)))
#define LAS __attribute__((address_space(3)))
typedef unsigned short bf16;
typedef float f32x4 __attribute__((ext_vector_type(4)));
typedef float f32x2 __attribute__((ext_vector_type(2)));
typedef unsigned u32x4 __attribute__((ext_vector_type(4)));
typedef unsigned u32x2 __attribute__((ext_vector_type(2)));
typedef short bf16x8 __attribute__((ext_vector_type(8)));
#define LDS_WAIT() asm volatile("s_waitcnt lgkmcnt(0)" ::: "memory")
#define VM_WAIT() asm volatile("s_waitcnt vmcnt(0)" ::: "memory")
__device__ __forceinline__ unsigned f2bf(float f) { unsigned u = __builtin_bit_cast(unsigned, f); return (u + 0x7fffu + ((u >> 16) & 1u)) >> 16; }
__device__ __forceinline__ unsigned pk2(float lo, float hi) { return f2bf(lo) | (f2bf(hi) << 16); }
__device__ __forceinline__ float bf_lo(unsigned v) { return __builtin_bit_cast(float, v << 16); }
__device__ __forceinline__ float bf_hi(unsigned v) { return __builtin_bit_cast(float, v & 0xffff0000u); }
__device__ __forceinline__ float bf2f(bf16 v) { return __builtin_bit_cast(float, (unsigned)v << 16); }
typedef _Float16 f16x4 __attribute__((ext_vector_type(4)));
typedef _Float16 f16x8 __attribute__((ext_vector_type(8)));
typedef float f32x8 __attribute__((ext_vector_type(8)));
__device__ __forceinline__ u32x2 f32x4_to_h4(f32x4 v) { return __builtin_bit_cast(u32x2, __builtin_convertvector(v, f16x4)); }
__device__ __forceinline__ f32x4 h4_to_f32x4(u32x2 v) { return __builtin_convertvector(__builtin_bit_cast(f16x4, v), f32x4); }
__device__ __forceinline__ float fast_sigmoid(float x) { return __builtin_amdgcn_rcpf(1.0f + __builtin_amdgcn_exp2f(-1.44269504089f * x)); }
#define DPP_ADD_(v, ctrl, rmask) ((v) + __builtin_bit_cast(float, __builtin_amdgcn_update_dpp(0, __builtin_bit_cast(int, (v)), (ctrl), (rmask), 0xf, false)))
__device__ __forceinline__ float wave_sum_dpp(float v) {
    v = DPP_ADD_(v, 0xB1, 0xf);
    v = DPP_ADD_(v, 0x4E, 0xf);
    v = DPP_ADD_(v, 0x141, 0xf);
    v = DPP_ADD_(v, 0x140, 0xf);
    v = DPP_ADD_(v, 0x142, 0xa);
    v = DPP_ADD_(v, 0x143, 0xc);
    return __builtin_bit_cast(float, __builtin_amdgcn_readlane(__builtin_bit_cast(int, v), 63));
}
__device__ __forceinline__ float wave_sum(float v) {
#pragma unroll
    for (int o = 1; o < 64; o <<= 1) v += __shfl_xor(v, o);
    return v;
}

#define XB_TMO      128
#define XB_XCNT(j)  (256  + 64 * (j))
#define XB_XSUB(j)  (1280 + 64 * (j))
#define XB_XGEN(j)  (2304 + 64 * (j))
#define XB_TOP      3328
#define XB_TOPGEN   3392
#define XCD_BAR_WORDS 3456
#define XB_SPIN_CAP (1u << 18)

__device__ __forceinline__ unsigned xb_ld(unsigned* p)              { return __hip_atomic_load(p, __ATOMIC_RELAXED, __HIP_MEMORY_SCOPE_AGENT); }
__device__ __forceinline__ unsigned xb_add(unsigned* p, unsigned v) { return __hip_atomic_fetch_add(p, v, __ATOMIC_RELAXED, __HIP_MEMORY_SCOPE_AGENT); }
__device__ __forceinline__ unsigned xb_xcc_id() { return (unsigned)__builtin_amdgcn_s_getreg((3 << 11) | 20) & 0xFu; }
#define XB_SPIN(cond, bar) do { unsigned _sp = 0; while (cond) { __builtin_amdgcn_s_sleep(1); \
    if ((++_sp & 255u) == 0u) { if (xb_ld(&(bar)[XB_TMO])) break; if (_sp > XB_SPIN_CAP) { atomicAdd(&(bar)[XB_TMO], 1u); break; } } } } while (0)

struct XcdBarrier {
    unsigned* bar; unsigned x;
    volatile LAS unsigned* st;
};

__device__ __forceinline__ XcdBarrier xcd_barrier_post(unsigned* bar, volatile LAS unsigned* st) {
    XcdBarrier b; b.bar = bar; b.x = xb_xcc_id(); b.st = st;
    if (threadIdx.x == 0) (void)xb_add(&bar[XB_XCNT(b.x)], 1u);
    return b;
}
__device__ __forceinline__ void xcd_barrier_complete(unsigned* bar, unsigned x, unsigned& nloc, unsigned& nx) {
    const unsigned G = gridDim.x * gridDim.y * gridDim.z;
    unsigned sum, cnt, mine, sp = 0u;
    for (;;) {
        sum = 0u; cnt = 0u; mine = 0u;
#pragma unroll
        for (unsigned j = 0; j < 16; ++j) { const unsigned c = xb_ld(&bar[XB_XCNT(j)]); sum += c; cnt += (c > 0u) ? 1u : 0u; mine = (j == x) ? c : mine; }
        if (sum == G) break;
        __builtin_amdgcn_s_sleep(1);
        if ((++sp & 255u) == 0u) { if (xb_ld(&bar[XB_TMO])) break; if (sp > XB_SPIN_CAP) { atomicAdd(&bar[XB_TMO], 1u); break; } }
    }
    nloc = mine > 0u ? mine : 1u; nx = cnt > 0u ? cnt : 1u;
}

__device__ __forceinline__ void xcd_barrier(const XcdBarrier& b) {
    asm volatile("s_waitcnt vmcnt(0)" ::: "memory");
    __syncthreads();
    if (threadIdx.x == 0) {
        unsigned* bar = b.bar;
        __builtin_amdgcn_s_waitcnt(0);
        unsigned nloc = b.st[0], nx = b.st[1];
        if (nloc == 0u) { xcd_barrier_complete(bar, b.x, nloc, nx); b.st[0] = nloc; b.st[1] = nx; }
        const unsigned old = xb_add(&bar[XB_XSUB(b.x)], 1u);
        const unsigned gen = old / nloc;
        if (old + 1u == (gen + 1u) * nloc) {
            __builtin_amdgcn_fence(__ATOMIC_RELEASE, "agent");
            asm volatile("s_waitcnt vmcnt(0)" ::: "memory");
            const unsigned og = xb_add(&bar[XB_TOP], 1u);
            const unsigned tg = og / nx;
            if (og + 1u == (tg + 1u) * nx) xb_add(&bar[XB_TOPGEN], 1u);
            else XB_SPIN(xb_ld(&bar[XB_TOPGEN]) == tg, bar);
            __builtin_amdgcn_fence(__ATOMIC_ACQUIRE, "agent");
            xb_add(&bar[XB_XGEN(b.x)], 1u);
            asm volatile("s_waitcnt vmcnt(0)" ::: "memory");
        } else {
            XB_SPIN(xb_ld(&bar[XB_XGEN(b.x)]) == gen, bar);
            __builtin_amdgcn_fence(__ATOMIC_ACQUIRE, "agent");
            asm volatile("s_waitcnt vmcnt(0)" ::: "memory");
        }
    }
    __syncthreads();
}

struct Params {
    const float* in[27];
    float* out;
    unsigned char* ws;
    int ph_lo, ph_hi;
};
enum { IN_X = 0, IN_C, IN_CTX, IN_CCTX, IN_WMOD, IN_BMOD, IN_NORMG, IN_FWI, IN_FWO, IN_EWI, IN_SCW, IN_SCB, IN_CCW, IN_CCB, IN_LNG, IN_LNB, IN_EWO,
       IN_OWI, IN_QG, IN_KG, IN_RPB, IN_LCW, IN_LCB, IN_LGW, IN_LGB, IN_LAM, IN_OWO };

struct SchedStd {
    const char* A; const char* Bt; size_t tstep; int nM, nN, G, c, ntiles;
    __device__ __forceinline__ int nt(const pg8::Unit&) const { return ntiles; }
    __device__ __forceinline__ bool next(int i, pg8::Unit& u) const {
        const long L = (long)i * G + c; if (L >= (long)nM * nN) return false;
        pg8::tile_map((int)L, nM, nN, u.pm, u.pn); u.kind = 0; return true;
    }
    __device__ __forceinline__ const char* a_base(const pg8::Unit& u) const { return A + (size_t)u.pm * tstep; }
    __device__ __forceinline__ const char* b_base(const pg8::Unit& u) const { return Bt + (size_t)u.pn * tstep; }
};

struct SchedDown {
    const char* A; const char* Bt; size_t tstep; int G, c, ntiles;
    __device__ __forceinline__ bool next(int i, pg8::Unit& u) const {
        const long L = (long)i * G + c;
        if (L < 512) { pg8::tile_map((int)L, 64, 8, u.pm, u.pn); u.kind = 0; return true; }
        if (L < 768) { const int q = (int)L - 512, t = q & 63; u.pm = 64 + (t >> 3); u.pn = t & 7; u.kind = 1 + (q >> 6); return true; }
        return false;
    }
    __device__ __forceinline__ int nt(const pg8::Unit& u) const { return u.kind == 0 ? ntiles : ntiles / 4; }
    __device__ __forceinline__ const char* a_base(const pg8::Unit& u) const { return A + (size_t)u.pm * tstep + (u.kind > 1 ? (size_t)(u.kind - 1) * (ntiles / 4) * 128 : 0); }
    __device__ __forceinline__ const char* b_base(const pg8::Unit& u) const { return Bt + (size_t)u.pn * tstep + (u.kind > 1 ? (size_t)(u.kind - 1) * (ntiles / 4) * 128 : 0); }
};
struct SchedOdIn {
    const char* HN; const char* W; size_t tstep; int G, c;
    __device__ __forceinline__ int nt(const pg8::Unit&) const { return D / 64; }
    __device__ __forceinline__ bool next(int i, pg8::Unit& u) const {
        const long L = (long)i * G + c;
        if (L < 72 * 16) { int pm, pnv; pg8::tile_map((int)L, 72, 16, pm, pnv); u.pm = pm; u.pn = pnv < 8 ? pnv : pnv + 4; u.kind = 0; return true; }
        if (L < 72 * 16 + 4 * 72) { int pm, pn; pg8::tile_map((int)L - 72 * 16, 4, 72, pm, pn); u.pm = pm; u.pn = pn; u.kind = 1; return true; }
        return false;
    }
    __device__ __forceinline__ const char* a_base(const pg8::Unit& u) const { return u.kind == 0 ? HN + (size_t)u.pm * tstep : W + (size_t)(8 + u.pm) * tstep; }
    __device__ __forceinline__ const char* b_base(const pg8::Unit& u) const { return u.kind == 0 ? W + (size_t)u.pn * tstep : HN + (size_t)u.pn * tstep; }
};

struct EpiSwiGLU {
    static constexpr bool PERM = true;
    bf16* O;
    __device__ __forceinline__ void operator()(const f32x4 (&acc)[2][2][4][2], const pg8::Unit& u, int wr, int wc, int fr, int fq) const {
        const int row0 = u.pm * 256 + wr * 64 + fr, col0 = u.pn * 128 + wc * 32 + 8 * fq;
#pragma unroll
        for (int ai = 0; ai < 2; ++ai)
#pragma unroll
            for (int m = 0; m < 4; ++m) {
                bf16* rowp = O + (size_t)(row0 + ai * 128 + m * 16) * DFF + col0;
                float v[8];
#pragma unroll
                for (int n = 0; n < 2; ++n)
#pragma unroll
                    for (int j = 0; j < 4; ++j) { const float g = acc[ai][0][m][n][j], up = acc[ai][1][m][n][j]; v[4 * n + j] = g * fast_sigmoid(g) * up; }
                u32x4 w; w.x = pg8::cvt_pk_bf16(v[0], v[1]); w.y = pg8::cvt_pk_bf16(v[2], v[3]); w.z = pg8::cvt_pk_bf16(v[4], v[5]); w.w = pg8::cvt_pk_bf16(v[6], v[7]);
                *(u32x4*)rowp = w;
            }
    }
};
template <bool BASE_F32, bool OUT_F32>
struct EpiResid {
    static constexpr bool PERM = true;
    const void* base_lat; const void* base_ctx; void* out; const float* gate; float coef; float* part;
    __device__ __forceinline__ void operator()(const f32x4 (&acc)[2][2][4][2], const pg8::Unit& u, int wr, int wc, int fr, int fq) const {
        const float coef = __builtin_bit_cast(float, __builtin_amdgcn_readfirstlane(__builtin_bit_cast(int, this->coef)));
        float* const part = (float*)(((unsigned long long)(unsigned)__builtin_amdgcn_readfirstlane((int)((unsigned long long)this->part >> 32)) << 32) | (unsigned)__builtin_amdgcn_readfirstlane((int)(unsigned long long)this->part));
        const int row0 = u.pm * 256 + wr * 64 + fr, col0 = u.pn * 256 + wc * 32 + 8 * fq;
        const int r = u.pm < 64 ? (u.pm >> 3) : 8;
        const float* gv = gate + (size_t)r * DMODW + col0;
        f32x4 gvv[2][2];
#pragma unroll
        for (int bj = 0; bj < 2; ++bj)
#pragma unroll
            for (int n = 0; n < 2; ++n) gvv[bj][n] = *(const f32x4*)(gv + bj * 128 + 4 * n) * coef;
        if (u.kind >= 2) {
            float* op = part + (size_t)(u.kind - 2) * (PART_STRIDE / 4) + (size_t)(row0 - M_LAT) * D + col0;
#pragma unroll
            for (int ai = 0; ai < 2; ++ai)
#pragma unroll
                for (int m = 0; m < 4; ++m) { const size_t ro = (size_t)(ai * 128 + m * 16) * D;
#pragma unroll
                    for (int bj = 0; bj < 2; ++bj)
#pragma unroll
                        for (int n = 0; n < 2; ++n) *(f32x4*)(op + ro + bj * 128 + 4 * n) = gvv[bj][n] * acc[ai][bj][m][n]; }
            return;
        }
        const size_t eo = (u.pm < 64 ? (size_t)row0 : (size_t)(row0 - M_LAT)) * D + col0;
        const void* bsel = u.pm < 64 ? base_lat : base_ctx;
        const size_t oo = (size_t)row0 * D + col0;
#pragma unroll
        for (int ai = 0; ai < 2; ++ai)
#pragma unroll
            for (int mh = 0; mh < 2; ++mh) {
                f32x4 b[2][2][2];
#pragma unroll
                for (int mm = 0; mm < 2; ++mm)
#pragma unroll
                    for (int bj = 0; bj < 2; ++bj) { const size_t ro = (size_t)(ai * 128 + (2 * mh + mm) * 16) * D + bj * 128;
                        if constexpr (BASE_F32) { b[mm][bj][0] = *(const f32x4*)((const float*)bsel + eo + ro); b[mm][bj][1] = *(const f32x4*)((const float*)bsel + eo + ro + 4); }
                        else { const u32x4 hv = *(const u32x4*)((const _Float16*)bsel + eo + ro); b[mm][bj][0] = h4_to_f32x4((u32x2){hv.x, hv.y}); b[mm][bj][1] = h4_to_f32x4((u32x2){hv.z, hv.w}); } }
#pragma unroll
                for (int mm = 0; mm < 2; ++mm)
#pragma unroll
                    for (int bj = 0; bj < 2; ++bj) { const size_t ro = (size_t)(ai * 128 + (2 * mh + mm) * 16) * D + bj * 128;
                        const f32x4 v0 = b[mm][bj][0] + gvv[bj][0] * acc[ai][bj][2 * mh + mm][0], v1 = b[mm][bj][1] + gvv[bj][1] * acc[ai][bj][2 * mh + mm][1];
                        if constexpr (OUT_F32) { *(f32x4*)((float*)out + oo + ro) = v0; *(f32x4*)((float*)out + oo + ro + 4) = v1; }
                        else { const u32x2 h0 = f32x4_to_h4(v0), h1 = f32x4_to_h4(v1); *(u32x4*)((_Float16*)out + oo + ro) = (u32x4){h0.x, h0.y, h1.x, h1.y}; } }
                asm volatile("" ::: "memory");
            }
    }
};
struct EpiEvIn {
    static constexpr bool PERM = true;
    bf16* O;
    __device__ __forceinline__ void operator()(const f32x4 (&acc)[2][2][4][2], const pg8::Unit& u, int wr, int wc, int fr, int fq) const {
        const int row0 = u.pm * 256 + wr * 64 + fr;
        if (u.pn < 4) {
            const int col0 = u.pn * 256 + wc * 32 + 8 * fq;
#pragma unroll
            for (int ai = 0; ai < 2; ++ai)
#pragma unroll
                for (int m = 0; m < 4; ++m) { bf16* rowp = O + (size_t)(row0 + ai * 128 + m * 16) * ZE_LD + col0;
#pragma unroll
                    for (int bj = 0; bj < 2; ++bj) { const f32x4 v0 = acc[ai][bj][m][0], v1 = acc[ai][bj][m][1];
                        u32x4 w; w.x = pg8::cvt_pk_bf16(v0[0], v0[1]); w.y = pg8::cvt_pk_bf16(v0[2], v0[3]); w.z = pg8::cvt_pk_bf16(v1[0], v1[1]); w.w = pg8::cvt_pk_bf16(v1[2], v1[3]);
                        *(u32x4*)(rowp + bj * 128) = w; } }
        } else {
            const bool glu = u.pn >= 12;
            const int col0 = (glu ? 2048 + (u.pn - 12) * 128 : 1024 + (u.pn - 4) * 128) + wc * 32 + 8 * fq;
#pragma unroll
            for (int ai = 0; ai < 2; ++ai)
#pragma unroll
                for (int m = 0; m < 4; ++m) { bf16* rowp = O + (size_t)(row0 + ai * 128 + m * 16) * ZE_LD + col0;
                    float v[8];
#pragma unroll
                    for (int n = 0; n < 2; ++n)
#pragma unroll
                        for (int j = 0; j < 4; ++j) { const float a = acc[ai][0][m][n][j], b = acc[ai][1][m][n][j]; v[4 * n + j] = glu ? a * fast_sigmoid(b) : a * b; }
                    u32x4 w; w.x = pg8::cvt_pk_bf16(v[0], v[1]); w.y = pg8::cvt_pk_bf16(v[2], v[3]); w.z = pg8::cvt_pk_bf16(v[4], v[5]); w.w = pg8::cvt_pk_bf16(v[6], v[7]);
                    *(u32x4*)rowp = w; }
        }
    }
};
struct EpiOdIn {
    static constexpr bool PERM = true;
    bf16* ZO; u32x4* KF; u32x2* VF; const float* qg; const float* kg;
    __device__ __forceinline__ void operator()(const f32x4 (&acc)[2][2][4][2], const pg8::Unit& u, int wr, int wc, int fr, int fq) const {
        const int row0 = u.pm * 256 + wr * 64 + fr;
        if (u.kind == 0 && u.pn < 8) {
            const bool isq = u.pn < 4;
            const float* gp = (isq ? qg : kg) + 8 * fq;
            f32x4 gn[2][2];
#pragma unroll
            for (int bj = 0; bj < 2; ++bj)
#pragma unroll
                for (int n = 0; n < 2; ++n) gn[bj][n] = *(const f32x4*)(gp + 32 * bj + 4 * n);
            const float sc = isq ? 0.125f : 1.0f;
            const int col0 = u.pn * 256 + wc * 64 + 8 * fq, hh = 4 * (u.pn & 3) + wc;
#pragma unroll
            for (int ai = 0; ai < 2; ++ai)
#pragma unroll
                for (int m = 0; m < 4; ++m) {
                    float ss = 0.f;
#pragma unroll
                    for (int bj = 0; bj < 2; ++bj)
#pragma unroll
                        for (int n = 0; n < 2; ++n) { const f32x4 v = acc[ai][bj][m][n]; ss += (v[0] * v[0] + v[1] * v[1]) + (v[2] * v[2] + v[3] * v[3]); }
                    ss += __shfl_xor(ss, 16); ss += __shfl_xor(ss, 32);
                    const float rs = sc / sqrtf(ss * (1.0f / HD) + EPS);
                    const int row = row0 + ai * 128 + m * 16;
                    bf16* rowp = ZO + (size_t)row * ZO_LD + col0;
                    u32x4* kfp = KF + ((size_t)((row >> 4) * 16 + hh) * 8 + fq) * 16 + (row & 15);
#pragma unroll
                    for (int bj = 0; bj < 2; ++bj) { const f32x4 v0 = acc[ai][bj][m][0] * rs * gn[bj][0], v1 = acc[ai][bj][m][1] * rs * gn[bj][1];
                        u32x4 w; w.x = pg8::cvt_pk_bf16(v0[0], v0[1]); w.y = pg8::cvt_pk_bf16(v0[2], v0[3]); w.z = pg8::cvt_pk_bf16(v1[0], v1[1]); w.w = pg8::cvt_pk_bf16(v1[2], v1[3]);
                        if (isq) *(u32x4*)(rowp + bj * 32) = w; else kfp[bj * 64] = w; }
                }
            return;
        }
        if (u.kind == 1) {
#pragma unroll
            for (int ai = 0; ai < 2; ++ai)
#pragma unroll
                for (int m = 0; m < 4; ++m) { const int ch = row0 + ai * 128 + m * 16;
#pragma unroll
                    for (int bj = 0; bj < 2; ++bj)
#pragma unroll
                        for (int n = 0; n < 2; ++n) { const int t = u.pn * 256 + bj * 128 + wc * 32 + 8 * fq + 4 * n; const f32x4 v = acc[ai][bj][m][n];
                            u32x2 w; w.x = pg8::cvt_pk_bf16(v[0], v[1]); w.y = pg8::cvt_pk_bf16(v[2], v[3]);
                            VF[((size_t)(((t >> 4) * 16 + (ch >> 6)) * 4 + ((ch >> 4) & 3)) * 4 + ((t >> 2) & 3)) * 16 + (ch & 15)] = w; } }
            return;
        }
        const int col0 = u.pn * 256 + wc * 32 + 8 * fq;
#pragma unroll
        for (int ai = 0; ai < 2; ++ai)
#pragma unroll
            for (int m = 0; m < 4; ++m) { bf16* rowp = ZO + (size_t)(row0 + ai * 128 + m * 16) * ZO_LD + col0;
#pragma unroll
                for (int bj = 0; bj < 2; ++bj) { const f32x4 v0 = acc[ai][bj][m][0], v1 = acc[ai][bj][m][1];
                    u32x4 w; w.x = pg8::cvt_pk_bf16(v0[0], v0[1]); w.y = pg8::cvt_pk_bf16(v0[2], v0[3]); w.z = pg8::cvt_pk_bf16(v1[0], v1[1]); w.w = pg8::cvt_pk_bf16(v1[2], v1[3]);
                    *(u32x4*)(rowp + bj * 128) = w; } }
    }
};

__device__ __forceinline__ int srccol(int map, int n) {
    if (map == 0) return n;
    const int pn = n >> 8, bj = (n >> 7) & 1, i = n & 127;
    if (map == 1) return bj * DFF + 128 * pn + i;
    if (map == 2) {
        if (pn < 4) return n;
        if (pn < 12) return 1024 + bj * 1024 + 128 * (pn - 4) + i;
        return 3072 + bj * 1024 + 128 * (pn - 12) + i;
    }
    if (pn < 8) return 256 * pn + 64 * ((n >> 5) & 3) + 32 * bj + (n & 31);
    return n;
}
__device__ __forceinline__ void p0_transpose_item(const float* W, int K, int N, bf16* WT, int map, LAS float* scr, int item, int lane) {
    const int nblk = N / 64, kb = item / nblk, nb = item % nblk, k0 = 64 * kb, n0 = 64 * nb;
    const float* src = W + (size_t)k0 * N + srccol(map, n0 + lane);
#pragma unroll 32
    for (int i = 0; i < 64; ++i) scr[i * 65 + lane] = src[(size_t)i * N];
    LDS_WAIT(); asm volatile("" ::: "memory");
    const int c = lane & 7;
#pragma unroll
    for (int j = 0; j < 8; ++j) { const int n = (lane >> 3) + 8 * j; const LAS float* s = scr + (8 * c) * 65 + n;
        u32x4 o; o.x = pk2(s[0 * 65], s[1 * 65]); o.y = pk2(s[2 * 65], s[3 * 65]); o.z = pk2(s[4 * 65], s[5 * 65]); o.w = pk2(s[6 * 65], s[7 * 65]);
        *(u32x4*)(WT + (size_t)(n0 + n) * K + k0 + 8 * c) = o; }
    LDS_WAIT(); asm volatile("" ::: "memory");
}
__device__ __forceinline__ void p0_weights(const Params& p, LAS unsigned char* lds, int lane, int wave) {
    LAS float* scr = (LAS float*)(lds + wave * (64 * 65 * 4));
    const int gw = blockIdx.x * 8 + wave, NGW = gridDim.x * 8;
    constexpr int I_FI = (D / 64) * (2 * DFF / 64), I_FO = (DFF / 64) * (D / 64), I_IN = (D / 64) * (D_EIN / 64), I_OUT = (D / 64) * (D / 64);
    constexpr int NITEMS = 4 * I_FI + 4 * I_FO + 2 * I_IN + 2 * I_OUT;
    for (int it = gw; it < NITEMS; it += NGW) {
        int r = it;
        if (r < 4 * I_FI) { const int q = r / I_FI; p0_transpose_item(p.in[IN_FWI] + (size_t)q * D * 2 * DFF, D, 2 * DFF, (bf16*)(p.ws + WS_WFI + q * WFI_STRIDE), 1, scr, r % I_FI, lane); continue; } r -= 4 * I_FI;
        if (r < 4 * I_FO) { const int q = r / I_FO; p0_transpose_item(p.in[IN_FWO] + (size_t)q * DFF * D, DFF, D, (bf16*)(p.ws + WS_WFO + q * WFO_STRIDE), 0, scr, r % I_FO, lane); continue; } r -= 4 * I_FO;
        if (r < I_IN) { p0_transpose_item(p.in[IN_EWI], D, D_EIN, (bf16*)(p.ws + WS_WEI), 2, scr, r, lane); continue; } r -= I_IN;
        if (r < I_IN) { p0_transpose_item(p.in[IN_OWI], D, D_OIN, (bf16*)(p.ws + WS_WOI), 3, scr, r, lane); continue; } r -= I_IN;
        if (r < I_OUT) { p0_transpose_item(p.in[IN_EWO], D, D, (bf16*)(p.ws + WS_WEO), 0, scr, r, lane); continue; } r -= I_OUT;
        p0_transpose_item(p.in[IN_OWO], D, D, (bf16*)(p.ws + WS_WOO), 0, scr, r, lane);
    }
}
__device__ __forceinline__ void p0_modvec(const Params& p, LAS unsigned char* lds, int tid, int lane, int wave) {
    LAS float* sv = (LAS float*)lds;
    LAS float* red = (LAS float*)(lds + 9 * 2048 * 4);
    volatile LAS int* qslot = (volatile LAS int*)(lds + 9 * 2048 * 4 + 8 * 9 * 64 * 4);
    const float* c = p.in[IN_C]; const float* cc = p.in[IN_CCTX];
    for (int i = tid; i < 9 * 2048; i += 512) { const float v = i < 8 * 2048 ? c[i] : cc[i - 8 * 2048]; sv[i] = v / (1.0f + __expf(-v)); }
    float* MOD = (float*)(p.ws + WS_MOD);
    unsigned* qhead = (unsigned*)(p.ws + WS_CTL) + CW_Q;
    for (;;) {
        __syncthreads();
        if (tid == 0) *qslot = (int)__hip_atomic_fetch_add(qhead, 1u, __ATOMIC_RELAXED, __HIP_MEMORY_SCOPE_AGENT);
        __syncthreads();
        const int item = *qslot;
        if (item >= 2 * 288) break;
        const int l = item / 288, col0 = (item % 288) * 64;
        const float* W = p.in[IN_WMOD] + (size_t)l * D * DMODW + col0 + lane + (size_t)(wave * 256) * DMODW;
        float acc[9];
#pragma unroll
        for (int r = 0; r < 9; ++r) acc[r] = 0.f;
#define MV_LOAD(w, k16) do { _Pragma("unroll") for (int e = 0; e < 16; ++e) w[e] = W[(size_t)(16 * (k16) + e) * DMODW]; } while (0)
#define MV_COMP(w, k16) do { _Pragma("unroll") for (int e4 = 0; e4 < 4; ++e4) { _Pragma("unroll") for (int r = 0; r < 9; ++r) { \
            const f32x4 s = *(const LAS f32x4*)(sv + r * 2048 + wave * 256 + 16 * (k16) + 4 * e4); \
            acc[r] += (s[0] * w[4 * e4] + s[1] * w[4 * e4 + 1]) + (s[2] * w[4 * e4 + 2] + s[3] * w[4 * e4 + 3]); } } } while (0)
        float wa[16], wb[16];
        MV_LOAD(wa, 0);
#pragma unroll 1
        for (int k16 = 0; k16 < 16; k16 += 2) {
            MV_LOAD(wb, k16 + 1);
            MV_COMP(wa, k16);
            if (k16 + 2 < 16) MV_LOAD(wa, k16 + 2);
            MV_COMP(wb, k16 + 1);
        }
#undef MV_LOAD
#undef MV_COMP
#pragma unroll
        for (int r = 0; r < 9; ++r) red[(wave * 9 + r) * 64 + lane] = acc[r];
        __syncthreads();
        for (int o = tid; o < 9 * 64; o += 512) {
            const int r = o >> 6, ln = o & 63; float s = 0.f;
#pragma unroll
            for (int w = 0; w < 8; ++w) s += red[(w * 9 + r) * 64 + ln];
            MOD[((size_t)l * 9 + r) * DMODW + col0 + ln] = s + p.in[IN_BMOD][(size_t)l * DMODW + col0 + ln];
        }
    }
}

template <bool COMBINE, bool SRC_F32>
__device__ __forceinline__ void norm_phase(LAS unsigned char* lds, const void* src_lat, const void* src_ctx, _Float16* xw_ctx, const float* part, int nrows, const float* g, const float* modl, int shift_idx, int scale_idx, bf16* HN, int tid, int lane, int wave) {
    const int gw = blockIdx.x * 8 + wave, NGW = gridDim.x * 8, npass = (nrows + NGW - 1) / NGW;
    LAS float* Gs = (LAS float*)lds;
    LAS float* Ss = Gs + 2 * D;
    f32x4 v[8], nv[8];
#define NORM_COL(jj) (SRC_F32 ? 4 * lane + 256 * (jj) : 8 * lane + 512 * ((jj) >> 1) + 4 * ((jj) & 1))
#define NORM_LOAD(dst, row) do { const int row_ = (row); const size_t ro_ = (row_ < M_LAT ? (size_t)row_ : (size_t)(row_ - M_LAT)) * D; const void* sp_ = row_ < M_LAT ? src_lat : src_ctx; \
        if constexpr (SRC_F32) { _Pragma("unroll") for (int j = 0; j < 8; ++j) dst[j] = *(const f32x4*)((const float*)sp_ + ro_ + NORM_COL(j)); } \
        else { _Pragma("unroll") for (int j = 0; j < 4; ++j) { const u32x4 hv_ = *(const u32x4*)((const _Float16*)sp_ + ro_ + NORM_COL(2 * j)); dst[2 * j] = h4_to_f32x4((u32x2){hv_.x, hv_.y}); dst[2 * j + 1] = h4_to_f32x4((u32x2){hv_.z, hv_.w}); } } \
        if (COMBINE && row_ >= M_LAT) { _Pragma("unroll") for (int q = 0; q < 3; ++q) { const float* pr_ = part + (size_t)q * (PART_STRIDE / 4) + ro_; \
            _Pragma("unroll") for (int j = 0; j < 8; ++j) dst[j] += *(const f32x4*)(pr_ + NORM_COL(j)); } } } while (0)
    if (gw < nrows) NORM_LOAD(v, gw);
    for (int ps = 0; ps < npass; ++ps) {
        const int row = gw + ps * NGW, rowl = ps * NGW + blockIdx.x * 8;
        const int rl = rowl < M_LAT ? (rowl >> 11) : 8, buf = ps & 1;
        { const float* sh = modl + (size_t)rl * DMODW + shift_idx * D; const float* sc = modl + (size_t)rl * DMODW + scale_idx * D;
          const f32x4 gg = *(const f32x4*)(g + 4 * tid), s1 = *(const f32x4*)(sc + 4 * tid), s0 = *(const f32x4*)(sh + 4 * tid);
          *(LAS f32x4*)(Gs + buf * D + 4 * tid) = gg * (1.0f + s1); *(LAS f32x4*)(Ss + buf * D + 4 * tid) = s0; }
        __syncthreads();
        if (row < nrows) {
            if (row + NGW < nrows) NORM_LOAD(nv, row + NGW);
            const int r = row < M_LAT ? (row >> 11) : 8;
            float ss = 0.f;
#pragma unroll
            for (int j = 0; j < 8; ++j) ss += (v[j][0] * v[j][0] + v[j][1] * v[j][1]) + (v[j][2] * v[j][2] + v[j][3] * v[j][3]);
            const float rstd = 1.0f / sqrtf(wave_sum_dpp(ss) * (1.0f / D) + EPS);
            bf16* o = HN + (size_t)row * D;
            f32x4 y[8];
            if (r == rl) {
#pragma unroll
                for (int j = 0; j < 8; ++j) { const int c = NORM_COL(j); y[j] = (v[j] * rstd) * *(const LAS f32x4*)(Gs + buf * D + c) + *(const LAS f32x4*)(Ss + buf * D + c); }
            } else {
                const float* sh = modl + (size_t)r * DMODW + shift_idx * D; const float* sc = modl + (size_t)r * DMODW + scale_idx * D;
#pragma unroll
                for (int j = 0; j < 8; ++j) { const int c = NORM_COL(j); y[j] = (v[j] * rstd) * *(const f32x4*)(g + c) * (1.0f + *(const f32x4*)(sc + c)) + *(const f32x4*)(sh + c); }
            }
            if constexpr (SRC_F32) {
#pragma unroll
                for (int j = 0; j < 8; ++j) { u32x2 w; w.x = pg8::cvt_pk_bf16(y[j][0], y[j][1]); w.y = pg8::cvt_pk_bf16(y[j][2], y[j][3]); *(u32x2*)(o + NORM_COL(j)) = w; }
            } else {
#pragma unroll
                for (int j = 0; j < 4; ++j) { u32x4 w; w.x = pg8::cvt_pk_bf16(y[2 * j][0], y[2 * j][1]); w.y = pg8::cvt_pk_bf16(y[2 * j][2], y[2 * j][3]); w.z = pg8::cvt_pk_bf16(y[2 * j + 1][0], y[2 * j + 1][1]); w.w = pg8::cvt_pk_bf16(y[2 * j + 1][2], y[2 * j + 1][3]);
                    *(u32x4*)(o + NORM_COL(2 * j)) = w; }
            }
            if (COMBINE && row >= M_LAT) {
#pragma unroll
                for (int j = 0; j < 4; ++j) { const u32x2 h0 = f32x4_to_h4(v[2 * j]), h1 = f32x4_to_h4(v[2 * j + 1]); *(u32x4*)(xw_ctx + (size_t)(row - M_LAT) * D + NORM_COL(2 * j)) = (u32x4){h0.x, h0.y, h1.x, h1.y}; }
            }
#pragma unroll
            for (int j = 0; j < 8; ++j) v[j] = nv[j];
        }
    }
    __syncthreads();
#undef NORM_LOAD
#undef NORM_COL
}

template <int NT>
__device__ __forceinline__ void even_conv_unit(const Params& p, LAS unsigned char* lds, int base, int T, int t0, int tid, int lane, int wave) {
    const bf16* Z3 = (const bf16*)(p.ws + WS_Z); bf16* MIX = (bf16*)(p.ws + WS_MIX);
    constexpr int NR = NT + 30;
    LAS unsigned* tile = (LAS unsigned*)lds;
    LAS float* red = (LAS float*)(lds + 62 * 2048);
    LAS float* stat = red + 256;
    const float* ccw = p.in[IN_CCW]; const float* ccb = p.in[IN_CCB]; const float* lng = p.in[IN_LNG]; const float* lnb = p.in[IN_LNB];
    const float* scw = p.in[IN_SCW]; const float* scb = p.in[IN_SCB];
    {
        constexpr int NQ = (NR * 128 + 511) / 512;
        u32x4 sv[NQ];
#pragma unroll
        for (int q = 0; q < NQ; ++q) { const int ch = tid + 512 * q, rr = min(ch >> 7, NR - 1), cc = ch & 127, t = t0 - 15 + rr, tc = min(max(t, 0), T - 1);
            const unsigned msk = (t == tc) ? 0xffffffffu : 0u;
            sv[q] = *(const u32x4*)(Z3 + (size_t)(base + tc) * ZE_LD + 2048 + cc * 8) & msk; }
#pragma unroll
        for (int q = 0; q < NQ; ++q) { const int ch = tid + 512 * q, rr = ch >> 7, cc = ch & 127; if (rr < NR) *(LAS u32x4*)(tile + rr * 512 + cc * 4) = sv[q]; }
    }
    unsigned pv[NT + 2], bgv[NT];
#pragma unroll
    for (int i = 0; i < NT + 2; ++i) { const int t = t0 - 1 + i, tc = min(max(t, 0), T - 1); const unsigned msk = (t == tc) ? 0xffffffffu : 0u; pv[i] = *(const unsigned*)(Z3 + (size_t)(base + tc) * ZE_LD + 1024 + 2 * tid) & msk; }
#pragma unroll
    for (int i = 0; i < NT; ++i) bgv[i] = *(const unsigned*)(Z3 + (size_t)(base + t0 + i) * ZE_LD + 2 * tid);
    const f32x2 lg = *(const f32x2*)(lng + 2 * tid), lb = *(const f32x2*)(lnb + 2 * tid), cbias = *(const f32x2*)(ccb + 2 * tid);
    __syncthreads();
    { const f32x2 w0 = *(const f32x2*)(scw + 2 * tid), w1 = *(const f32x2*)(scw + 1024 + 2 * tid), w2 = *(const f32x2*)(scw + 2048 + 2 * tid), b = *(const f32x2*)(scb + 2 * tid);
#pragma unroll
      for (int i = 0; i < NT; ++i) {
          const float c0 = w0[0] * bf_lo(pv[i]) + w1[0] * bf_lo(pv[i + 1]) + w2[0] * bf_lo(pv[i + 2]) + b[0];
          const float c1 = w0[1] * bf_hi(pv[i]) + w1[1] * bf_hi(pv[i + 1]) + w2[1] * bf_hi(pv[i + 2]) + b[1];
          *(unsigned*)(MIX + (size_t)(base + t0 + i) * D + 2 * tid) = pg8::cvt_pk_bf16(bf_lo(bgv[i]) * c0, bf_hi(bgv[i]) * c1); } }
    f32x2 acc[NT];
#pragma unroll
    for (int i = 0; i < NT; ++i) acc[i] = cbias;
    f32x2 w = *(const f32x2*)(ccw + 2 * tid);
#pragma unroll 1
    for (int k = 0; k < 31; ++k) {
        const f32x2 wn = *(const f32x2*)(ccw + (size_t)min(k + 1, 30) * 1024 + 2 * tid);
        const LAS unsigned* tp = tile + k * 512 + tid;
#pragma unroll
        for (int i = 0; i < NT; ++i) { const unsigned v = tp[i * 512]; acc[i] += w * (f32x2){bf_lo(v), bf_hi(v)}; }
        w = wn;
    }
#pragma unroll
    for (int i = 0; i < NT; ++i) { const float s = wave_sum_dpp(acc[i][0] + acc[i][1]); if (lane == 0) red[wave * 32 + i] = s; }
    __syncthreads();
    if (tid < NT) { float s = 0.f;
#pragma unroll
        for (int ww = 0; ww < 8; ++ww) s += red[ww * 32 + tid]; stat[tid] = s * (1.0f / 1024.0f); }
    __syncthreads();
#pragma unroll
    for (int i = 0; i < NT; ++i) { const float mu = stat[i]; acc[i] -= mu; }
    __syncthreads();
#pragma unroll
    for (int i = 0; i < NT; ++i) { const float s = wave_sum_dpp(acc[i][0] * acc[i][0] + acc[i][1] * acc[i][1]); if (lane == 0) red[wave * 32 + i] = s; }
    __syncthreads();
    if (tid < NT) { float s = 0.f;
#pragma unroll
        for (int ww = 0; ww < 8; ++ww) s += red[ww * 32 + tid]; stat[tid] = 1.0f / sqrtf(s * (1.0f / 1024.0f) + EPS); }
    __syncthreads();
#pragma unroll
    for (int i = 0; i < NT; ++i) { const float rs = stat[i]; const float y0 = acc[i][0] * rs * lg[0] + lb[0], y1 = acc[i][1] * rs * lg[1] + lb[1];
        *(unsigned*)(MIX + (size_t)(base + t0 + i) * D + 1024 + 2 * tid) = pg8::cvt_pk_bf16(y0 * fast_sigmoid(y0), y1 * fast_sigmoid(y1)); }
    __syncthreads();
}
__device__ __forceinline__ void even_conv_phase(const Params& p, LAS unsigned char* lds, int tid, int lane, int wave) {
    for (int u = blockIdx.x; u < 512 + 256; u += gridDim.x) {
        if (u < 512) even_conv_unit<32>(p, lds, (u >> 6) * SEQ, SEQ, (u & 63) * 32, tid, lane, wave);
        else { const int v = u - 512; even_conv_unit<8>(p, lds, M_LAT + (v >> 5) * CTXL, CTXL, (v & 31) * 8, tid, lane, wave); }
    }
}

__device__ __forceinline__ void attn_wave_unit(const Params& p, const LAS float* rpbL, int b, int h, int r, int qg, int lane) {
    const bf16* ZO = (const bf16*)(p.ws + WS_Z); const u32x4* KF = (const u32x4*)(p.ws + WS_KF); const u32x2* VF = (const u32x2*)(p.ws + WS_VT); bf16* MIX = (bf16*)(p.ws + WS_MIX);
    const int l15 = lane & 15, g = lane >> 4;
    const int c0 = 16 * qg, qc = c0 + l15, qrow = b * SEQ + r * GW + qc;
    const int r0 = min(max(r - WIN_R / 2, 0), GROWS - WIN_R);
    const int kb = qg == 0 ? 0 : (qg == 1 ? 8 : (qg == 2 ? 24 : 32));
    const int cs = min(max(qc - WIN_C / 2, 0), GW - WIN_C);
    bf16x8 qf[2];
#pragma unroll
    for (int kk = 0; kk < 2; ++kk) qf[kk] = __builtin_bit_cast(bf16x8, *(const u32x4*)(ZO + (size_t)qrow * ZO_LD + h * HD + 8 * g + 32 * kk));
    int dcol[8]; bool okk[8];
#pragma unroll
    for (int a = 0; a < 2; ++a)
#pragma unroll
        for (int e = 0; e < 4; ++e) { const int kc = kb + 16 * a + 4 * g + e; okk[4 * a + e] = (kc >= cs) && (kc < cs + WIN_C); dcol[4 * a + e] = min(max(kc - qc + WIN_C - 1, 0), 2 * WIN_C - 2); }
    const LAS float* rpbh = rpbL + h * 15 * 31;
    u32x4 kx[4][2][2]; u32x2 vx[4][4][2];
#define ATT_TOK0(ch) ((ch) < 8 ? M_LAT + b * CTXL + 32 * (ch) : b * SEQ + (r0 + ((ch) - 8)) * GW + kb)
#define ATT_LOADK(s) do { _Pragma("unroll") for (int c = 0; c < 4; ++c) { const int tok_ = ATT_TOK0(4 * (s) + c); \
        _Pragma("unroll") for (int a = 0; a < 2; ++a) { const int t_ = tok_ + 16 * a + l15; const u32x4* kp_ = KF + ((size_t)((t_ >> 4) * 16 + h) * 8 + g) * 16 + (t_ & 15); kx[c][a][0] = kp_[0]; kx[c][a][1] = kp_[64]; } } } while (0)
#define ATT_LOADV(s) do { _Pragma("unroll") for (int c = 0; c < 4; ++c) { const int tok_ = ATT_TOK0(4 * (s) + c); \
        _Pragma("unroll") for (int a = 0; a < 2; ++a) { const int t_ = tok_ + 16 * a + 4 * g; const u32x2* vp_ = VF + ((size_t)((t_ >> 4) * 16 + h) * 16 + ((t_ >> 2) & 3)) * 16 + l15; \
            _Pragma("unroll") for (int d = 0; d < 4; ++d) vx[c][d][a] = vp_[d * 64]; } } } while (0)
    f32x4 o[4];
#pragma unroll
    for (int d = 0; d < 4; ++d) o[d] = (f32x4){0.f, 0.f, 0.f, 0.f};
    float mrun = -1e30f, lsum = 0.f;
    ATT_LOADK(0); ATT_LOADV(0);
#pragma unroll 1
    for (int s = 0; s < 4; ++s) {
        f32x4 sc_[4][2];
#pragma unroll
        for (int c = 0; c < 4; ++c)
#pragma unroll
            for (int a = 0; a < 2; ++a) { f32x4 acc_ = (f32x4){0.f, 0.f, 0.f, 0.f};
                acc_ = __builtin_amdgcn_mfma_f32_16x16x32_bf16(__builtin_bit_cast(bf16x8, kx[c][a][0]), qf[0], acc_, 0, 0, 0);
                acc_ = __builtin_amdgcn_mfma_f32_16x16x32_bf16(__builtin_bit_cast(bf16x8, kx[c][a][1]), qf[1], acc_, 0, 0, 0); sc_[c][a] = acc_; }
        if (s < 3) ATT_LOADK(s + 1);
        if (s >= 2) {
#pragma unroll
            for (int c = 0; c < 4; ++c) { const LAS float* bp_ = rpbh + ((r0 + 4 * (s - 2) + c) - r + WIN_R - 1) * 31;
#pragma unroll
                for (int a = 0; a < 2; ++a)
#pragma unroll
                    for (int e = 0; e < 4; ++e) sc_[c][a][e] = okk[4 * a + e] ? sc_[c][a][e] + bp_[dcol[4 * a + e]] : -1e30f; }
        }
        float mx_ = -1e30f;
#pragma unroll
        for (int c = 0; c < 4; ++c)
#pragma unroll
            for (int a = 0; a < 2; ++a) mx_ = fmaxf(mx_, fmaxf(fmaxf(sc_[c][a][0], sc_[c][a][1]), fmaxf(sc_[c][a][2], sc_[c][a][3])));
        mx_ = fmaxf(mx_, __shfl_xor(mx_, 16)); mx_ = fmaxf(mx_, __shfl_xor(mx_, 32));
        const float mnew_ = fmaxf(mrun, mx_), alpha_ = __builtin_amdgcn_exp2f((mrun - mnew_) * 1.44269504089f); mrun = mnew_;
        const float mb_ = mnew_ * 1.44269504089f;
        float ps_ = 0.f; bf16x8 pf_[4];
#pragma unroll
        for (int c = 0; c < 4; ++c) { float pe_[8];
#pragma unroll
            for (int a = 0; a < 2; ++a)
#pragma unroll
                for (int e = 0; e < 4; ++e) { pe_[4 * a + e] = __builtin_amdgcn_exp2f(sc_[c][a][e] * 1.44269504089f - mb_); ps_ += pe_[4 * a + e]; }
            u32x4 pw_; pw_.x = pg8::cvt_pk_bf16(pe_[0], pe_[1]); pw_.y = pg8::cvt_pk_bf16(pe_[2], pe_[3]); pw_.z = pg8::cvt_pk_bf16(pe_[4], pe_[5]); pw_.w = pg8::cvt_pk_bf16(pe_[6], pe_[7]);
            pf_[c] = __builtin_bit_cast(bf16x8, pw_); }
        lsum = lsum * alpha_ + ps_;
#pragma unroll
        for (int d = 0; d < 4; ++d) { o[d] = o[d] * alpha_;
#pragma unroll
            for (int c = 0; c < 4; ++c) { u32x4 vw_; vw_.x = vx[c][d][0].x; vw_.y = vx[c][d][0].y; vw_.z = vx[c][d][1].x; vw_.w = vx[c][d][1].y;
                o[d] = __builtin_amdgcn_mfma_f32_16x16x32_bf16(__builtin_bit_cast(bf16x8, vw_), pf_[c], o[d], 0, 0, 0); } }
        if (s < 3) ATT_LOADV(s + 1);
    }
#undef ATT_TOK0
#undef ATT_LOADK
#undef ATT_LOADV
    lsum += __shfl_xor(lsum, 16); lsum += __shfl_xor(lsum, 32);
    const float inv = 1.0f / lsum;
#pragma unroll
    for (int d = 0; d < 4; ++d) { u32x2 w; w.x = pg8::cvt_pk_bf16(o[d][0] * inv, o[d][1] * inv); w.y = pg8::cvt_pk_bf16(o[d][2] * inv, o[d][3] * inv);
        *(u32x2*)(MIX + (size_t)qrow * D + h * HD + 16 * d + 4 * g) = w; }
}
__device__ __forceinline__ void attn_phase(const Params& p, LAS unsigned char* lds, int tid, int lane, int wave) {
    LAS float* rpbL = (LAS float*)lds;
    __syncthreads();
    for (int i = tid; i < NH * 15 * 31; i += 512) rpbL[i] = p.in[IN_RPB][i];
    __syncthreads();
    const int cls = blockIdx.x & 7, wgi = blockIdx.x >> 3, ncl = (gridDim.x - cls + 7) >> 3, nW = ncl * 8;
    if (gridDim.x >= 8) {
        for (int v = wgi * 8 + wave; v < NH * GROWS * 4; v += nW) { const int h = v >> 7, rem = v & 127; attn_wave_unit(p, rpbL, cls, h, rem >> 2, rem & 3, lane); }
    } else {
        for (int v = blockIdx.x * 8 + wave; v < NBATCH * NH * GROWS * 4; v += gridDim.x * 8) { const int b = v >> 11, w = v & 2047, h = w >> 7, rem = w & 127; attn_wave_unit(p, rpbL, b, h, rem >> 2, rem & 3, lane); }
    }
}

__device__ __forceinline__ float gelu_tanh(float x) { const float z = 0.7978845608028654f * (x + 0.044715f * x * x * x); return x * fast_sigmoid(2.0f * z); }
constexpr int LCH = 256;
__device__ __forceinline__ void lru_item(const Params& p, LAS unsigned char* lds, int item, int tid, int lane, int wave) {
    const bf16* ZO = (const bf16*)(p.ws + WS_Z); float* HF = (float*)(p.ws + WS_HF); bf16* MIX = (bf16*)(p.ws + WS_MIX);
    const int b = item >> 5, n = (item >> 1) & 15, half = item & 1, j0 = half * 32;
    LAS float* xcf = (LAS float*)lds;
    LAS bf16* xcb = (LAS bf16*)(lds + LCH * 33 * 4);
    LAS float* As = (LAS float*)(lds + LCH * 33 * 4 + LCH * 72 * 2);
    LAS float* Us = As + LCH * 33;
    LAS float* segA = Us + LCH * 33;
    LAS float* segH = segA + 16 * 32;
    const int ci = lane, cch = n * 64 + ci;
    const float* lcw = p.in[IN_LCW]; const float cw0 = lcw[cch], cw1 = lcw[1024 + cch], cw2 = lcw[2048 + cch], cw3 = lcw[3072 + cch], cb = p.in[IN_LCB][cch];
    const bool own = (ci >> 5) == half;
    const int jb = wave & 1, tb0 = (wave >> 1) * 4, l15 = lane & 15, g = lane >> 4, jl = 16 * jb + l15, gch = n * 64 + j0 + jl;
    const int sc = lane & 31, hi = lane >> 5, sg = 2 * wave + hi;
    const unsigned och = (unsigned)(n * 64 + j0 + sc);
    for (int dir = 0; dir < 2; ++dir) {
        bf16x8 Bg[2][2];
        {
            const float* gw = p.in[IN_LGW] + (size_t)((dir * 2) * 16 + n) * 4096;
#pragma unroll
            for (int gt = 0; gt < 2; ++gt)
#pragma unroll
                for (int kk = 0; kk < 2; ++kk) { const float* wp = gw + (size_t)gt * 16 * 4096 + (size_t)(8 * g + 32 * kk) * 64 + j0 + jl;
                    u32x4 w; w.x = pk2(wp[0], wp[64]); w.y = pk2(wp[128], wp[192]); w.z = pk2(wp[256], wp[320]); w.w = pk2(wp[384], wp[448]); Bg[gt][kk] = __builtin_bit_cast(bf16x8, w); }
        }
        const float br = p.in[IN_LGB][(dir * 2 + 0) * 1024 + gch], bi = p.in[IN_LGB][(dir * 2 + 1) * 1024 + gch];
        const float lam = p.in[IN_LAM][dir * 1024 + gch];
        const float sp8 = -8.0f * log1pf(expf(-lam)) * 1.44269504089f;
        float carry = 0.f;
        const unsigned hoff = (unsigned)((dir == 0 ? 16 * hi : 16 * (1 - hi)) * 1024) + och;
        const unsigned moff = (unsigned)((dir == 0 ? 16 * hi : 16 * (1 - hi)) * D) + 1024u + och;
        const unsigned goff = (unsigned)((dir == 0 ? 16 * hi : 16 * (1 - hi)) * ZO_LD) + 4096u + och;
        u32x4 xraw[5];
#define LRU_LOADX(cidx_) do { const int ci_ = (cidx_); const bool isctx_ = ci_ < 1; const int cc_ = isctx_ ? 0 : ci_ - 1, ncs_ = isctx_ ? 1 : 8, cpos_ = dir == 0 ? cc_ : ncs_ - 1 - cc_; \
        const int base_ = isctx_ ? M_LAT + b * CTXL : b * SEQ, T_ = isctx_ ? CTXL : SEQ, ts_ = cpos_ * LCH - 1; \
        _Pragma("unroll") for (int q = 0; q < 5; ++q) { const int pc = min(q * 512 + tid, 2071), t = ts_ + (pc >> 3), tc = min(max(t, 0), T_ - 1); const unsigned msk = (t == tc) ? 0xffffffffu : 0u; \
            xraw[q] = *(const u32x4*)(ZO + (size_t)(base_ + tc) * ZO_LD + 3072 + n * 64 + (pc & 7) * 8) & msk; } } while (0)
        LRU_LOADX(0);
        LAS unsigned char* rawt = (LAS unsigned char*)As;
#pragma unroll 1
        for (int cidx = 0; cidx < 9; ++cidx) {
            const bool isctx = cidx < 1;
            const int cc = isctx ? 0 : cidx - 1, ncs = isctx ? 1 : 8, cpos = dir == 0 ? cc : ncs - 1 - cc;
            const int base = isctx ? M_LAT + b * CTXL : b * SEQ, t0 = cpos * LCH;
            const int rbase = dir == 0 ? base + t0 + 32 * wave : base + t0 + LCH - 1 - 32 * wave - 16;
            float hfv[16]; unsigned grv[16];
            if (!isctx && dir == 1) {
                const float* hp_ = HF + (size_t)rbase * 1024; const bf16* gp_ = ZO + (size_t)rbase * ZO_LD;
#pragma unroll
                for (int e = 0; e < 16; ++e) { hfv[e] = (hp_ - (size_t)e * 1024)[hoff]; grv[e] = (unsigned)(gp_ - (size_t)e * ZO_LD)[goff]; }
            }
#pragma unroll
            for (int q = 0; q < 5; ++q) { const int pc = q * 512 + tid; if (pc < 2072) *(LAS u32x4*)(rawt + pc * 16) = xraw[q]; }
            __syncthreads();
            {
                float xf[35];
                const LAS unsigned short* rp_ = (const LAS unsigned short*)(rawt + (32 * wave) * 128) + ci;
#pragma unroll
                for (int e = 0; e < 35; ++e) xf[e] = __builtin_bit_cast(float, (unsigned)rp_[e * 64] << 16);
                LAS bf16* xb_ = xcb + (32 * wave) * 72 + ci; LAS float* xf_ = xcf + (32 * wave) * 33 + (ci & 31);
#pragma unroll
                for (int e = 0; e < 32; ++e) { const float y = cw0 * xf[e] + cw1 * xf[e + 1] + cw2 * xf[e + 2] + cw3 * xf[e + 3] + cb;
                    xb_[e * 72] = (bf16)f2bf(y); if (own) xf_[e * 33] = y; }
            }
            if (cidx + 1 < 9) LRU_LOADX(cidx + 1);
            __syncthreads();
#pragma unroll 1
            for (int q = 0; q < 4; ++q) {
                const int tb = tb0 + q;
                const bf16x8 a0 = *(const LAS bf16x8*)(xcb + (16 * tb + l15) * 72 + 8 * g), a1 = *(const LAS bf16x8*)(xcb + (16 * tb + l15) * 72 + 8 * g + 32);
                f32x4 gr_ = (f32x4){0.f, 0.f, 0.f, 0.f}, gi_ = (f32x4){0.f, 0.f, 0.f, 0.f};
                gr_ = __builtin_amdgcn_mfma_f32_16x16x32_bf16(a0, Bg[0][0], gr_, 0, 0, 0); gr_ = __builtin_amdgcn_mfma_f32_16x16x32_bf16(a1, Bg[0][1], gr_, 0, 0, 0);
                gi_ = __builtin_amdgcn_mfma_f32_16x16x32_bf16(a0, Bg[1][0], gi_, 0, 0, 0); gi_ = __builtin_amdgcn_mfma_f32_16x16x32_bf16(a1, Bg[1][1], gi_, 0, 0, 0);
#pragma unroll
                for (int e = 0; e < 4; ++e) {
                    const int tl = 16 * tb + 4 * g + e;
                    const float rg = fast_sigmoid(gr_[e] + br), ig = fast_sigmoid(gi_[e] + bi);
                    const float la2 = sp8 * rg, a = __builtin_amdgcn_exp2f(la2);
                    const float x2 = la2 * 1.38629436112f;
                    const float em = x2 > -0.25f ? -x2 * (1.0f + x2 * (0.5f + x2 * (0.16666667f + x2 * (0.041666668f + x2 * 0.0083333338f)))) : 1.0f - a * a;
                    As[tl * 33 + jl] = a; Us[tl * 33 + jl] = sqrtf(em) * ig * xcf[tl * 33 + jl];
                }
            }
            __syncthreads();
            float av[16], uv[16];
            {
                float A = 1.f, H = 0.f;
                const LAS float* ap_ = As + (dir ? (LCH - 1 - 16 * sg) : 16 * sg) * 33 + sc; const LAS float* up_ = Us + (dir ? (LCH - 1 - 16 * sg) : 16 * sg) * 33 + sc;
#pragma unroll
                for (int e = 0; e < 16; ++e) { av[e] = dir ? ap_[-e * 33] : ap_[e * 33]; uv[e] = dir ? up_[-e * 33] : up_[e * 33]; H = av[e] * H + uv[e]; A *= av[e]; }
                segA[sg * 32 + sc] = A; segH[sg * 32 + sc] = H;
            }
            __syncthreads();
            {
                float hin = carry, mine = 0.f;
#pragma unroll
                for (int s2 = 0; s2 < 16; ++s2) { if (s2 == sg) mine = hin; hin = segA[s2 * 32 + sc] * hin + segH[s2 * 32 + sc]; }
                carry = hin;
                if (!isctx) {
                    float hcur = mine;
                    if (dir == 0) {
                        float* hp_ = HF + (size_t)rbase * 1024;
#pragma unroll
                        for (int e = 0; e < 16; ++e) { hcur = av[e] * hcur + uv[e]; (hp_ + (size_t)e * 1024)[hoff] = hcur; }
                    } else {
                        bf16* mp_ = MIX + (size_t)rbase * D;
#pragma unroll
                        for (int e = 0; e < 16; ++e) { hcur = av[e] * hcur + uv[e];
                            (mp_ - (size_t)e * D)[moff] = (bf16)f2bf((hfv[e] + hcur) * gelu_tanh(__builtin_bit_cast(float, grv[e] << 16))); }
                    }
                }
            }
        }
#undef LRU_LOADX
        VM_WAIT(); __syncthreads();
    }
}


#if MK_SPLIT
#define GRID_BAR() do { } while (0)
#else
#define GRID_BAR() xcd_barrier(bar)
#endif
#ifndef PH_MASK
#define PH_MASK 0xffffffffu
#endif
#define IN(k) (lo <= (k) && (k) < hi && ((PH_MASK >> (k)) & 1u))
#ifndef PROBE_MASK
#define PROBE_MASK 0u
#endif
#ifndef PROBE_MULT
#define PROBE_MULT 4
#endif
#if PROBE_MASK
#define PROBE_STAMP(k) do { if (blockIdx.x == 0 && threadIdx.x == 0) { volatile LAS unsigned long long* pw = (volatile LAS unsigned long long*)(lds + MISC_OFF + 128); \
        const unsigned long long t_ = __builtin_amdgcn_s_memrealtime(); if ((PROBE_MASK >> (k)) & 1u) pw[1] += t_ - pw[0]; pw[0] = t_; } } while (0)
#else
#define PROBE_STAMP(k) do { } while (0)
#endif
#define SEAM(k) do { if (IN(k) && IN((k) + 1)) GRID_BAR(); PROBE_STAMP(k); } while (0)

template <int L>
__device__ __forceinline__ void layer_body(const Params& p, LAS unsigned char* lds, const XcdBarrier& bar, const int lo, const int hi) {
    constexpr int l = L;
    const int tid = threadIdx.x, lane = tid & 63, wave = __builtin_amdgcn_readfirstlane(tid >> 6);
    const int G = gridDim.x;
    float* MOD = (float*)(p.ws + WS_MOD);
    _Float16* X = (_Float16*)(p.ws + WS_X);
    bf16* HN = (bf16*)(p.ws + WS_HN);
    bf16* ACT = (bf16*)(p.ws + WS_ACT);
    bf16* Z = (bf16*)(p.ws + WS_Z);
    bf16* MIX = (bf16*)(p.ws + WS_MIX);
    float* PART = (float*)(p.ws + WS_PART);
        const int pb = 1 + 10 * l;
        const float* modl = MOD + (size_t)l * 9 * DMODW;
        const float* ng = p.in[IN_NORMG] + (size_t)l * 3 * D;
        constexpr bool first = (l == 0);
        const void* xs_lat = first ? (const void*)p.in[IN_X] : (const void*)X; const void* xs_ctx = first ? (const void*)p.in[IN_CTX] : (const void*)(X + (size_t)M_LAT * D);

        if (IN(pb + 0)) norm_phase<!first, first>(lds, xs_lat, xs_ctx, X + (size_t)M_LAT * D, PART, M_ALL, ng + 0 * D, modl, 0, 1, HN, tid, lane, wave);
        SEAM(pb + 0);
        if (IN(pb + 1)) {
            SchedStd S{(const char*)HN, (const char*)(p.ws + WS_WFI + (size_t)(l * 2 + 0) * WFI_STRIDE), (size_t)256 * D * 2, M_ALL / 256, 2 * DFF / 256, G, (int)blockIdx.x, D / 64};
            EpiSwiGLU E{ACT};
            pg8::gemm_phase<EpiSwiGLU, SchedStd>(lds, D, S, E);
        }
        SEAM(pb + 1);
        if (IN(pb + 2)) {
            SchedDown S{(const char*)ACT, (const char*)(p.ws + WS_WFO + (size_t)(l * 2 + 0) * WFO_STRIDE), (size_t)256 * DFF * 2, G, (int)blockIdx.x, DFF / 64};
            EpiResid<first, false> E{xs_lat, xs_ctx, X, modl + 2 * D, 0.5f, PART};
            pg8::gemm_phase<EpiResid<first, false>, SchedDown>(lds, DFF, S, E);
        }
        SEAM(pb + 2);
        if (IN(pb + 3)) norm_phase<true, false>(lds, X, X + (size_t)M_LAT * D, X + (size_t)M_LAT * D, PART, M_ALL, ng + 1 * D, modl, 3, 4, HN, tid, lane, wave);
        SEAM(pb + 3);
        if constexpr (first) {
            if (IN(pb + 4)) {
                SchedStd S{(const char*)HN, (const char*)(p.ws + WS_WEI), (size_t)256 * D * 2, M_ALL / 256, D_EIN / 256, G, (int)blockIdx.x, D / 64};
                EpiEvIn E{Z};
                pg8::gemm_phase<EpiEvIn, SchedStd>(lds, D, S, E);
            }
            SEAM(pb + 4);
            if (IN(pb + 5)) even_conv_phase(p, lds, tid, lane, wave);
            SEAM(pb + 5);
            if (IN(pb + 6)) {
                SchedDown S{(const char*)MIX, (const char*)(p.ws + WS_WEO), (size_t)256 * D * 2, G, (int)blockIdx.x, D / 64};
                EpiResid<false, false> E{X, X + (size_t)M_LAT * D, X, modl + 5 * D, 1.0f, PART};
                pg8::gemm_phase<EpiResid<false, false>, SchedDown>(lds, D, S, E);
            }
            SEAM(pb + 6);
        } else {
            if (IN(pb + 4)) {
                SchedOdIn S{(const char*)HN, (const char*)(p.ws + WS_WOI), (size_t)256 * D * 2, G, (int)blockIdx.x};
                EpiOdIn E{Z, (u32x4*)(p.ws + WS_KF), (u32x2*)(p.ws + WS_VT), p.in[IN_QG], p.in[IN_KG]};
                pg8::gemm_phase<EpiOdIn, SchedOdIn>(lds, D, S, E);
            }
            SEAM(pb + 4);
            if (IN(pb + 5)) {
#ifndef NO_LRU
                for (int item = blockIdx.x; item < 256; item += G) lru_item(p, lds, item, tid, lane, wave);
#endif
#if PROBE_MASK
                __syncthreads();
                if (blockIdx.x == 0 && threadIdx.x == 0) { volatile LAS unsigned long long* pw = (volatile LAS unsigned long long*)(lds + MISC_OFF + 128);
                    const unsigned long long t_ = __builtin_amdgcn_s_memrealtime(); if ((PROBE_MASK >> 30) & 1u) pw[1] += t_ - pw[0]; }
#endif
#ifndef NO_ATTN
                attn_phase(p, lds, tid, lane, wave);
#endif
            }
            SEAM(pb + 5);
            if (IN(pb + 6)) {
                SchedStd S{(const char*)MIX, (const char*)(p.ws + WS_WOO), (size_t)256 * D * 2, M_LAT / 256, D / 256, G, (int)blockIdx.x, D / 64};
                EpiResid<false, false> E{X, X + (size_t)M_LAT * D, X, modl + 5 * D, 1.0f, PART};
                pg8::gemm_phase<EpiResid<false, false>, SchedStd>(lds, D, S, E);
            }
            SEAM(pb + 6);
        }
        const int nrows2 = first ? M_ALL : M_LAT;
        if (IN(pb + 7)) norm_phase<first, false>(lds, X, X + (size_t)M_LAT * D, X + (size_t)M_LAT * D, PART, nrows2, ng + 2 * D, modl, 6, 7, HN, tid, lane, wave);
        SEAM(pb + 7);
        if (IN(pb + 8)) {
            SchedStd S{(const char*)HN, (const char*)(p.ws + WS_WFI + (size_t)(l * 2 + 1) * WFI_STRIDE), (size_t)256 * D * 2, nrows2 / 256, 2 * DFF / 256, G, (int)blockIdx.x, D / 64};
            EpiSwiGLU E{ACT};
            pg8::gemm_phase<EpiSwiGLU, SchedStd>(lds, D, S, E);
        }
        SEAM(pb + 8);
        if (IN(pb + 9)) {
            if constexpr (first) {
                SchedDown S{(const char*)ACT, (const char*)(p.ws + WS_WFO + (size_t)(l * 2 + 1) * WFO_STRIDE), (size_t)256 * DFF * 2, G, (int)blockIdx.x, DFF / 64};
                EpiResid<false, false> E{X, X + (size_t)M_LAT * D, X, modl + 8 * D, 0.5f, PART};
                pg8::gemm_phase<EpiResid<false, false>, SchedDown>(lds, DFF, S, E);
            } else {
                SchedStd S{(const char*)ACT, (const char*)(p.ws + WS_WFO + (size_t)(l * 2 + 1) * WFO_STRIDE), (size_t)256 * DFF * 2, M_LAT / 256, D / 256, G, (int)blockIdx.x, DFF / 64};
                EpiResid<false, true> E{X, X + (size_t)M_LAT * D, p.out, modl + 8 * D, 0.5f, PART};
                pg8::gemm_phase<EpiResid<false, true>, SchedStd>(lds, DFF, S, E);
            }
        }
        SEAM(pb + 9);
}
__global__ void __launch_bounds__(512, 2) mega_fwd(Params p) {
    extern __shared__ __attribute__((aligned(16))) unsigned char lds_raw[];
    LAS unsigned char* lds = (LAS unsigned char*)lds_raw;
    volatile LAS unsigned* MISC = (volatile LAS unsigned*)(lds + MISC_OFF);
    const int tid = threadIdx.x, lane = tid & 63, wave = __builtin_amdgcn_readfirstlane(tid >> 6);
    const int G = gridDim.x;
    if (tid < 64) MISC[tid] = 0u;
    __syncthreads();
    unsigned* ctl = (unsigned*)(p.ws + WS_CTL);
#if MK_SPLIT
    XcdBarrier bar; bar.bar = ctl + CW_BAR; bar.x = 0; bar.st = MISC + 8;
#else
    XcdBarrier bar = xcd_barrier_post(ctl + CW_BAR, MISC + 8);
#endif
    const int lo = p.ph_lo, hi = p.ph_hi;
#if PROBE_MASK
    if (blockIdx.x == 0 && tid == 0) { volatile LAS unsigned long long* pw = (volatile LAS unsigned long long*)(lds + MISC_OFF + 128); pw[0] = __builtin_amdgcn_s_memrealtime(); pw[1] = 0ull; }
#endif

    float* MOD = (float*)(p.ws + WS_MOD);
    float* X = (float*)(p.ws + WS_X);
    bf16* HN = (bf16*)(p.ws + WS_HN);
    bf16* ACT = (bf16*)(p.ws + WS_ACT);
    bf16* Z = (bf16*)(p.ws + WS_Z);
    bf16* MIX = (bf16*)(p.ws + WS_MIX);

    if (IN(0)) {
#ifndef NO_WEIGHTS
        p0_weights(p, lds, lane, wave); __syncthreads();
#endif
#ifndef NO_MODVEC
        p0_modvec(p, lds, tid, lane, wave); __syncthreads();
#endif
    }
    SEAM(0);

    layer_body<0>(p, lds, bar, lo, hi);
    layer_body<1>(p, lds, bar, lo, hi);
#if PROBE_MASK
    if (blockIdx.x == 0 && tid == 0) { volatile LAS unsigned long long* pw = (volatile LAS unsigned long long*)(lds + MISC_OFF + 128); const unsigned long long t0 = __builtin_amdgcn_s_memrealtime(), dt = (unsigned long long)PROBE_MULT * pw[1];
        while (__builtin_amdgcn_s_memrealtime() - t0 < dt) __builtin_amdgcn_s_sleep(8); }
#endif
#undef IN
#undef SEAM
#undef GRID_BAR
}

extern "C" void kernel_launch(void* const* d_in, const int* in_sizes, int n_in, void* d_out, int out_size, void* d_ws, size_t ws_size, hipStream_t stream) {
    static int grid = 0;
    if (grid == 0) {
        if (n_in != 27 || in_sizes[0] != M_LAT * D || out_size != M_LAT * D || ws_size < WS_END) {
            fprintf(stderr, "kernel_launch: unexpected shapes (n_in %d, in0 %d, out %d, ws %zu; need ws >= %zu); nothing launched\n", n_in, n_in > 0 ? in_sizes[0] : -1, out_size, ws_size, (size_t)WS_END); grid = -1; return; }
        int dev = 0, cus = 0, per_cu = 0;
        if (hipGetDevice(&dev) != hipSuccess || hipDeviceGetAttribute(&cus, hipDeviceAttributeMultiprocessorCount, dev) != hipSuccess) { fprintf(stderr, "kernel_launch: device query failed\n"); grid = -1; return; }
        if (hipFuncSetAttribute((const void*)mega_fwd, hipFuncAttributeMaxDynamicSharedMemorySize, LDS_BYTES) != hipSuccess) { fprintf(stderr, "kernel_launch: hipFuncSetAttribute failed\n"); grid = -1; return; }
        if (hipOccupancyMaxActiveBlocksPerMultiprocessor(&per_cu, (const void*)mega_fwd, 512, LDS_BYTES) != hipSuccess || per_cu < 1) {
            fprintf(stderr, "kernel_launch: occupancy query reports %d workgroups per CU\n", per_cu); }
        (void)hipGetLastError();
        grid = cus;
    }
    if (grid < 0) return;
    if (hipMemsetAsync((char*)d_ws + WS_CTL, 0, CTL_ZERO_BYTES, stream) != hipSuccess) { fprintf(stderr, "kernel_launch: memset failed\n"); return; }
    Params a{};
    for (int i = 0; i < 27; ++i) a.in[i] = (const float*)d_in[i];
    a.out = (float*)d_out; a.ws = (unsigned char*)d_ws;
#if MK_SPLIT
    for (int ph = 0; ph < NPHASE; ++ph) { a.ph_lo = ph; a.ph_hi = ph + 1; hipLaunchKernelGGL(mega_fwd, dim3(grid), dim3(512), LDS_BYTES, stream, a); }
#else
    a.ph_lo = 0; a.ph_hi = NPHASE;
    hipLaunchKernelGGL(mega_fwd, dim3(grid), dim3(512), LDS_BYTES, stream, a);
#endif
    const hipError_t le = hipPeekAtLastError();
    if (le != hipSuccess) fprintf(stderr, "kernel_launch: launch failed: %s\n", hipGetErrorName(le));
}
```

```cpp
#include <hip/hip_runtime.h>
#include <cstdio>
#include <cstdint>

#ifndef MK_SPLIT
#define MK_SPLIT 0
#endif

namespace pg8 {
#define PG8_LAS __attribute__((address_space(3)))
typedef unsigned short bf16_t;
typedef short bf16x8 __attribute__((ext_vector_type(8)));
typedef float f32x4 __attribute__((ext_vector_type(4)));
typedef unsigned u32x4 __attribute__((ext_vector_type(4)));
typedef unsigned u32x2 __attribute__((ext_vector_type(2)));
constexpr int BM = 256, BK = 64, HALF = 128, HTB = HALF * BK * 2  , STAGE_BYTES = 8 * HTB, NXCD = 8, WGM = 8;

__host__ __device__ __forceinline__ int lds_byte(int r, int c) { const int st = (r >> 4) * 2 + (c >> 5), rr = r & 15, cc = c & 31, ob = rr * 64 + cc * 2; return st * 1024 + (ob ^ (((ob >> 9) & 1) << 5)); }
__host__ __device__ __forceinline__ void stage_rc(int b, int& R, int& C) { const int st = b / 1024, sb = b % 1024, swz = sb ^ (((sb >> 9) & 1) << 5); R = (st >> 1) * 16 + swz / 64; C = (st & 1) * 32 + (swz % 64) / 2; }
__host__ __device__ __forceinline__ int perm32(int rho) { const int n = rho >> 4, i = rho & 15; return 8 * (i >> 2) + 4 * n + (i & 3); }

struct Unit { int pm, pn, kind; };

__host__ __device__ __forceinline__ void tile_map(int wgid, int nM, int nN, int& pm, int& pn) {
    const int nwg = nM * nN;
    { const int q = nwg / NXCD, r = nwg % NXCD, xcd = wgid % NXCD, off = wgid / NXCD; wgid = (xcd < r ? xcd * (q + 1) : r * (q + 1) + (xcd - r) * q) + off; }
    const int nig = WGM * nN, gid = wgid / nig, fm = gid * WGM, gsz = (nM - fm) < WGM ? (nM - fm) : WGM;
    pm = fm + ((wgid % nig) % gsz); pn = (wgid % nig) / gsz;
}

__device__ __forceinline__ unsigned cvt_pk_bf16(float lo, float hi) { unsigned r; asm volatile("v_cvt_pk_bf16_f32 %0, %1, %2" : "=v"(r) : "v"(lo), "v"(hi)); return r; }

template <class Epi, class Sched, bool ALIGN_EPI = true, bool SP2 = true>
__device__ __forceinline__ void gemm_phase(PG8_LAS unsigned char* lds, const int K  , const Sched& S, const Epi& E) {
    const int tid = threadIdx.x, wid = __builtin_amdgcn_readfirstlane(tid >> 6), lane = tid & 63, wr = wid >> 2, wc = wid & 3, fr = lane & 15, fq = lane >> 4;
    unsigned voffA[2], voffB[2];
#pragma unroll
    for (int i = 0; i < 2; ++i) { int R, C; stage_rc(tid * 16 + i * 8192, R, C); const int Rb = Epi::PERM ? ((R & ~31) + perm32(R & 31)) : R;
        voffA[i] = (unsigned)(R * K + C) * 2u; voffB[i] = (unsigned)(Rb * K + C) * 2u; }
    const size_t kstep = (size_t)(BK * 2);
    const size_t hstep = (size_t)HALF * K * 2;
    const unsigned ldsw = (unsigned)wid * 1024u;
    const int aoff = lds_byte(wr * 64 + fr, fq * 8), boff = lds_byte(wc * 32 + fr, fq * 8);
#define PG8_SA(b, h) (((b) * 2 + (h)) * HTB)
#define PG8_SB(b, h) ((4 + (b) * 2 + (h)) * HTB)
#define PG8_STAGE(bufoff, gbase, voff) do { _Pragma("unroll") for (int _i = 0; _i < 2; ++_i) \
        __builtin_amdgcn_global_load_lds((const unsigned*)((const char*)(gbase) + (voff)[_i]), (PG8_LAS unsigned*)(lds + (bufoff) + ldsw + _i * 8192), 16, 0, 0); } while (0)
#define PG8_LDA(dst, b, h) do { _Pragma("unroll") for (int m = 0; m < 4; ++m) _Pragma("unroll") for (int k = 0; k < 2; ++k) dst[m][k] = *(const PG8_LAS bf16x8*)(lds + PG8_SA(b, h) + aoff + m * 2048 + k * 1024); } while (0)
#define PG8_LDB(dst, b, h) do { _Pragma("unroll") for (int n = 0; n < 2; ++n) _Pragma("unroll") for (int k = 0; k < 2; ++k) dst[n][k] = *(const PG8_LAS bf16x8*)(lds + PG8_SB(b, h) + boff + n * 2048 + k * 1024); } while (0)
#define PG8_MMA(ai, bj, At, Bt) do { __builtin_amdgcn_s_setprio(1); _Pragma("unroll") for (int m = 0; m < 4; ++m) _Pragma("unroll") for (int n = 0; n < 2; ++n) _Pragma("unroll") for (int k = 0; k < 2; ++k) \
        acc[ai][bj][m][n] = __builtin_amdgcn_mfma_f32_16x16x32_bf16(Bt[n][k], At[m][k], acc[ai][bj][m][n], 0, 0, 0); __builtin_amdgcn_s_setprio(0); } while (0)
#define PG8_WAIT_V(n) asm volatile("s_waitcnt vmcnt(" #n ")" ::: "memory")
#define PG8_WAIT_L(n) asm volatile("s_waitcnt lgkmcnt(" #n ")" ::: "memory")
#define PG8_BAR __builtin_amdgcn_s_barrier()
#define PG8_SCHED __builtin_amdgcn_sched_barrier(0)
    Unit cur, nxt; int ui = 0;
    if (!S.next(0, cur)) return;
    f32x4 acc[2][2][4][2];
#pragma unroll
    for (int a = 0; a < 2; ++a)
#pragma unroll
        for (int b = 0; b < 2; ++b)
#pragma unroll
            for (int m = 0; m < 4; ++m)
#pragma unroll
                for (int n = 0; n < 2; ++n) acc[a][b][m][n] = (f32x4){0.f, 0.f, 0.f, 0.f};
    bf16x8 At[4][2], B0[2][2], B1[2][2];
    const char* cA = S.a_base(cur); const char* cB = S.b_base(cur);
    if constexpr (SP2) {
        PG8_STAGE(PG8_SB(0, 0), cB, voffB); PG8_STAGE(PG8_SB(0, 1), cB + hstep, voffB); PG8_STAGE(PG8_SA(0, 0), cA, voffA); PG8_STAGE(PG8_SA(0, 1), cA + hstep, voffA);
        if (wr == 1) PG8_BAR;
        PG8_WAIT_V(2); PG8_BAR;
        PG8_STAGE(PG8_SB(1, 0), cB + kstep, voffB); PG8_STAGE(PG8_SA(1, 0), cA + kstep, voffA); PG8_STAGE(PG8_SB(1, 1), cB + hstep + kstep, voffB);
        PG8_WAIT_V(6); PG8_BAR;
    } else {
        PG8_STAGE(PG8_SB(0, 0), cB, voffB); PG8_STAGE(PG8_SA(0, 0), cA, voffA); PG8_STAGE(PG8_SB(0, 1), cB + hstep, voffB); PG8_STAGE(PG8_SA(0, 1), cA + hstep, voffA);
        if (wr == 1) PG8_BAR;
        PG8_WAIT_V(4); PG8_BAR;
        PG8_STAGE(PG8_SB(1, 0), cB + kstep, voffB); PG8_STAGE(PG8_SA(1, 0), cA + kstep, voffA); PG8_STAGE(PG8_SB(1, 1), cB + hstep + kstep, voffB);
        PG8_WAIT_V(6); PG8_BAR;
    }
    for (;;) {
        const bool has_next = S.next(ui + 1, nxt);
        const int nt = S.nt(cur);
        const char* nA = has_next ? S.a_base(nxt) : cA; const char* nB = has_next ? S.b_base(nxt) : cB;
        for (int t = 0; t < nt; t += 2) {
            const bool last = (t == nt - 2);
            const char* a1 = cA + (size_t)(t + 1) * kstep;
            const char* a2 = last ? nA : cA + (size_t)(t + 2) * kstep; const char* b2 = last ? nB : cB + (size_t)(t + 2) * kstep;
            const char* a3 = a2 + kstep; const char* b3 = b2 + kstep;
            if constexpr (SP2) {
            PG8_LDB(B0, 0, 0); PG8_LDB(B1, 0, 1); PG8_SCHED; PG8_LDA(At, 0, 0); PG8_STAGE(PG8_SA(1, 1), a1 + hstep, voffA);
            PG8_WAIT_V(8); PG8_WAIT_L(0); PG8_BAR; PG8_MMA(0, 0, At, B0); PG8_MMA(0, 1, At, B1); PG8_BAR; PG8_SCHED;
            PG8_LDA(At, 0, 1); PG8_STAGE(PG8_SB(0, 0), b2, voffB); PG8_STAGE(PG8_SB(0, 1), b2 + hstep, voffB); PG8_STAGE(PG8_SA(0, 0), a2, voffA);
            PG8_WAIT_V(8); PG8_WAIT_L(0); PG8_BAR; PG8_MMA(1, 0, At, B0); PG8_MMA(1, 1, At, B1); PG8_BAR; PG8_SCHED;
            PG8_LDB(B0, 1, 0); PG8_LDB(B1, 1, 1); PG8_SCHED; PG8_LDA(At, 1, 0); PG8_STAGE(PG8_SA(0, 1), a2 + hstep, voffA);
            PG8_WAIT_V(8); PG8_WAIT_L(0); PG8_BAR; PG8_MMA(0, 0, At, B0); PG8_MMA(0, 1, At, B1); PG8_BAR; PG8_SCHED;
            PG8_LDA(At, 1, 1); PG8_STAGE(PG8_SB(1, 0), b3, voffB); PG8_STAGE(PG8_SB(1, 1), b3 + hstep, voffB); PG8_STAGE(PG8_SA(1, 0), a3, voffA);
            PG8_WAIT_V(8); PG8_WAIT_L(0); PG8_BAR; PG8_MMA(1, 0, At, B0); PG8_MMA(1, 1, At, B1); PG8_BAR; PG8_SCHED;
            } else {
            PG8_LDB(B0, 0, 0); PG8_SCHED; PG8_LDA(At, 0, 0); PG8_STAGE(PG8_SA(1, 1), a1 + hstep, voffA);
            PG8_WAIT_L(8); PG8_BAR; PG8_WAIT_L(0); PG8_MMA(0, 0, At, B0); PG8_BAR; PG8_SCHED;
            PG8_LDB(B1, 0, 1); PG8_STAGE(PG8_SB(0, 0), b2, voffB);
            PG8_BAR; PG8_WAIT_L(0); PG8_MMA(0, 1, At, B1); PG8_BAR;
            PG8_LDA(At, 0, 1); PG8_STAGE(PG8_SA(0, 0), a2, voffA);
            PG8_BAR; PG8_WAIT_L(0); PG8_MMA(1, 0, At, B0); PG8_BAR; PG8_SCHED;
            PG8_STAGE(PG8_SB(0, 1), b2 + hstep, voffB);
            PG8_WAIT_V(6); PG8_BAR; PG8_MMA(1, 1, At, B1); PG8_BAR;
            PG8_LDB(B0, 1, 0); PG8_SCHED; PG8_LDA(At, 1, 0); PG8_STAGE(PG8_SA(0, 1), a2 + hstep, voffA);
            PG8_WAIT_L(8); PG8_BAR; PG8_WAIT_L(0); PG8_MMA(0, 0, At, B0); PG8_BAR; PG8_SCHED;
            PG8_LDB(B1, 1, 1); PG8_STAGE(PG8_SB(1, 0), b3, voffB);
            PG8_BAR; PG8_WAIT_L(0); PG8_MMA(0, 1, At, B1); PG8_BAR;
            PG8_LDA(At, 1, 1); PG8_STAGE(PG8_SA(1, 0), a3, voffA);
            PG8_BAR; PG8_WAIT_L(0); PG8_MMA(1, 0, At, B0); PG8_BAR; PG8_SCHED;
            PG8_STAGE(PG8_SB(1, 1), b3 + hstep, voffB);
            PG8_WAIT_V(6); PG8_BAR; PG8_MMA(1, 1, At, B1); PG8_BAR;
            }
        }
        if constexpr (ALIGN_EPI) { if (wr == 0) PG8_BAR; }
        E(acc, cur, wr, wc, fr, fq);
        if (!has_next) break;
#pragma unroll
        for (int a = 0; a < 2; ++a)
#pragma unroll
            for (int b = 0; b < 2; ++b)
#pragma unroll
                for (int m = 0; m < 4; ++m)
#pragma unroll
                    for (int n = 0; n < 2; ++n) acc[a][b][m][n] = (f32x4){0.f, 0.f, 0.f, 0.f};
        cur = nxt; cA = nA; cB = nB; ++ui;
        if constexpr (ALIGN_EPI) { if (wr == 1) PG8_BAR; }
    }
    PG8_WAIT_V(0);
    if constexpr (!ALIGN_EPI) { if (wr == 0) PG8_BAR; }
    PG8_BAR;
#undef PG8_SA
#undef PG8_SB
#undef PG8_STAGE
#undef PG8_LDA
#undef PG8_LDB
#undef PG8_MMA
#undef PG8_WAIT_V
#undef PG8_WAIT_L
#undef PG8_BAR
#undef PG8_SCHED
}
}

constexpr int D = 2048, NBATCH = 8, SEQ = 2048, CTXL = 256, DFF = 5632, NMODV = 9, DMODW = NMODV * D  ;
constexpr int M_LAT = NBATCH * SEQ  , M_CTX = NBATCH * CTXL  , M_ALL = M_LAT + M_CTX  ;
constexpr int NH = 16, HD = 64, GW = 64  , GROWS = SEQ / GW  , WIN_R = 8, WIN_C = 16;
constexpr int D_EIN = 5120, D_OIN = 5120, ZE_LD = 3072  , ZO_LD = 5120;
constexpr float EPS = 1e-6f;
constexpr int NPHASE = 21;

constexpr size_t MiB = 1u << 20;
constexpr size_t WS_CTL = 0, CTL_ZERO_BYTES = 1 * MiB;
constexpr size_t WS_MOD = 1 * MiB;
constexpr size_t WS_WFI = 4 * MiB, WFI_STRIDE = 44 * MiB;
constexpr size_t WS_WFO = 180 * MiB, WFO_STRIDE = 22 * MiB;
constexpr size_t WS_WEI = 268 * MiB, WS_WEO = 288 * MiB, WS_WOI = 296 * MiB, WS_WOO = 316 * MiB;
constexpr size_t WS_X = 324 * MiB;
constexpr size_t WS_HN = 468 * MiB;
constexpr size_t WS_ACT = 540 * MiB;
constexpr size_t WS_Z = 738 * MiB;
constexpr size_t WS_MIX = 918 * MiB;
constexpr size_t WS_VT = 990 * MiB;
constexpr size_t WS_HF = 1026 * MiB;
constexpr size_t WS_PART = 1090 * MiB, PART_STRIDE = 16 * MiB;
constexpr size_t WS_KF = 1138 * MiB;
constexpr size_t WS_END = 1174 * MiB;
constexpr int CW_BAR = 4096;
constexpr int CW_Q = 8192;

constexpr int RING_BYTES = 131072;
constexpr int LDS_BYTES = 147456;
constexpr int MISC_OFF = LDS_BYTES - 256;

#define GAS __attribute__((address_space(1)))
#define LAS __attribute__((address_space(3)))
typedef unsigned short bf16;
typedef float f32x4 __attribute__((ext_vector_type(4)));
typedef float f32x2 __attribute__((ext_vector_type(2)));
typedef unsigned u32x4 __attribute__((ext_vector_type(4)));
typedef unsigned u32x2 __attribute__((ext_vector_type(2)));
typedef short bf16x8 __attribute__((ext_vector_type(8)));
#define LDS_WAIT() asm volatile("s_waitcnt lgkmcnt(0)" ::: "memory")
#define VM_WAIT() asm volatile("s_waitcnt vmcnt(0)" ::: "memory")
__device__ __forceinline__ unsigned f2bf(float f) { unsigned u = __builtin_bit_cast(unsigned, f); return (u + 0x7fffu + ((u >> 16) & 1u)) >> 16; }
__device__ __forceinline__ unsigned pk2(float lo, float hi) { return f2bf(lo) | (f2bf(hi) << 16); }
__device__ __forceinline__ float bf_lo(unsigned v) { return __builtin_bit_cast(float, v << 16); }
__device__ __forceinline__ float bf_hi(unsigned v) { return __builtin_bit_cast(float, v & 0xffff0000u); }
__device__ __forceinline__ float bf2f(bf16 v) { return __builtin_bit_cast(float, (unsigned)v << 16); }
typedef _Float16 f16x4 __attribute__((ext_vector_type(4)));
typedef _Float16 f16x8 __attribute__((ext_vector_type(8)));
typedef float f32x8 __attribute__((ext_vector_type(8)));
__device__ __forceinline__ u32x2 f32x4_to_h4(f32x4 v) { return __builtin_bit_cast(u32x2, __builtin_convertvector(v, f16x4)); }
__device__ __forceinline__ f32x4 h4_to_f32x4(u32x2 v) { return __builtin_convertvector(__builtin_bit_cast(f16x4, v), f32x4); }
__device__ __forceinline__ float fast_sigmoid(float x) { return __builtin_amdgcn_rcpf(1.0f + __builtin_amdgcn_exp2f(-1.44269504089f * x)); }
#define DPP_ADD_(v, ctrl, rmask) ((v) + __builtin_bit_cast(float, __builtin_amdgcn_update_dpp(0, __builtin_bit_cast(int, (v)), (ctrl), (rmask), 0xf, false)))
__device__ __forceinline__ float wave_sum_dpp(float v) {
    v = DPP_ADD_(v, 0xB1, 0xf);
    v = DPP_ADD_(v, 0x4E, 0xf);
    v = DPP_ADD_(v, 0x141, 0xf);
    v = DPP_ADD_(v, 0x140, 0xf);
    v = DPP_ADD_(v, 0x142, 0xa);
    v = DPP_ADD_(v, 0x143, 0xc);
    return __builtin_bit_cast(float, __builtin_amdgcn_readlane(__builtin_bit_cast(int, v), 63));
}
__device__ __forceinline__ float wave_sum(float v) {
#pragma unroll
    for (int o = 1; o < 64; o <<= 1) v += __shfl_xor(v, o);
    return v;
}

#define XB_TMO      128
#define XB_XCNT(j)  (256  + 64 * (j))
#define XB_XSUB(j)  (1280 + 64 * (j))
#define XB_XGEN(j)  (2304 + 64 * (j))
#define XB_TOP      3328
#define XB_TOPGEN   3392
#define XCD_BAR_WORDS 3456
#define XB_SPIN_CAP (1u << 18)

__device__ __forceinline__ unsigned xb_ld(unsigned* p)              { return __hip_atomic_load(p, __ATOMIC_RELAXED, __HIP_MEMORY_SCOPE_AGENT); }
__device__ __forceinline__ unsigned xb_add(unsigned* p, unsigned v) { return __hip_atomic_fetch_add(p, v, __ATOMIC_RELAXED, __HIP_MEMORY_SCOPE_AGENT); }
__device__ __forceinline__ unsigned xb_xcc_id() { return (unsigned)__builtin_amdgcn_s_getreg((3 << 11) | 20) & 0xFu; }
#define XB_SPIN(cond, bar) do { unsigned _sp = 0; while (cond) { __builtin_amdgcn_s_sleep(1); \
    if ((++_sp & 255u) == 0u) { if (xb_ld(&(bar)[XB_TMO])) break; if (_sp > XB_SPIN_CAP) { atomicAdd(&(bar)[XB_TMO], 1u); break; } } } } while (0)

struct XcdBarrier {
    unsigned* bar; unsigned x;
    volatile LAS unsigned* st;
};

__device__ __forceinline__ XcdBarrier xcd_barrier_post(unsigned* bar, volatile LAS unsigned* st) {
    XcdBarrier b; b.bar = bar; b.x = xb_xcc_id(); b.st = st;
    if (threadIdx.x == 0) (void)xb_add(&bar[XB_XCNT(b.x)], 1u);
    return b;
}
__device__ __forceinline__ void xcd_barrier_complete(unsigned* bar, unsigned x, unsigned& nloc, unsigned& nx) {
    const unsigned G = gridDim.x * gridDim.y * gridDim.z;
    unsigned sum, cnt, mine, sp = 0u;
    for (;;) {
        sum = 0u; cnt = 0u; mine = 0u;
#pragma unroll
        for (unsigned j = 0; j < 16; ++j) { const unsigned c = xb_ld(&bar[XB_XCNT(j)]); sum += c; cnt += (c > 0u) ? 1u : 0u; mine = (j == x) ? c : mine; }
        if (sum == G) break;
        __builtin_amdgcn_s_sleep(1);
        if ((++sp & 255u) == 0u) { if (xb_ld(&bar[XB_TMO])) break; if (sp > XB_SPIN_CAP) { atomicAdd(&bar[XB_TMO], 1u); break; } }
    }
    nloc = mine > 0u ? mine : 1u; nx = cnt > 0u ? cnt : 1u;
}

__device__ __forceinline__ void xcd_barrier(const XcdBarrier& b) {
    asm volatile("s_waitcnt vmcnt(0)" ::: "memory");
    __syncthreads();
    if (threadIdx.x == 0) {
        unsigned* bar = b.bar;
        __builtin_amdgcn_s_waitcnt(0);
        unsigned nloc = b.st[0], nx = b.st[1];
        if (nloc == 0u) { xcd_barrier_complete(bar, b.x, nloc, nx); b.st[0] = nloc; b.st[1] = nx; }
        const unsigned old = xb_add(&bar[XB_XSUB(b.x)], 1u);
        const unsigned gen = old / nloc;
        if (old + 1u == (gen + 1u) * nloc) {
            __builtin_amdgcn_fence(__ATOMIC_RELEASE, "agent");
            asm volatile("s_waitcnt vmcnt(0)" ::: "memory");
            const unsigned og = xb_add(&bar[XB_TOP], 1u);
            const unsigned tg = og / nx;
            if (og + 1u == (tg + 1u) * nx) xb_add(&bar[XB_TOPGEN], 1u);
            else XB_SPIN(xb_ld(&bar[XB_TOPGEN]) == tg, bar);
            __builtin_amdgcn_fence(__ATOMIC_ACQUIRE, "agent");
            xb_add(&bar[XB_XGEN(b.x)], 1u);
            asm volatile("s_waitcnt vmcnt(0)" ::: "memory");
        } else {
            XB_SPIN(xb_ld(&bar[XB_XGEN(b.x)]) == gen, bar);
            __builtin_amdgcn_fence(__ATOMIC_ACQUIRE, "agent");
            asm volatile("s_waitcnt vmcnt(0)" ::: "memory");
        }
    }
    __syncthreads();
}

struct Params {
    const float* in[27];
    float* out;
    unsigned char* ws;
    int ph_lo, ph_hi;
};
enum { IN_X = 0, IN_C, IN_CTX, IN_CCTX, IN_WMOD, IN_BMOD, IN_NORMG, IN_FWI, IN_FWO, IN_EWI, IN_SCW, IN_SCB, IN_CCW, IN_CCB, IN_LNG, IN_LNB, IN_EWO,
       IN_OWI, IN_QG, IN_KG, IN_RPB, IN_LCW, IN_LCB, IN_LGW, IN_LGB, IN_LAM, IN_OWO };

struct SchedStd {
    const char* A; const char* Bt; size_t tstep; int nM, nN, G, c, ntiles;
    __device__ __forceinline__ int nt(const pg8::Unit&) const { return ntiles; }
    __device__ __forceinline__ bool next(int i, pg8::Unit& u) const {
        const long L = (long)i * G + c; if (L >= (long)nM * nN) return false;
        pg8::tile_map((int)L, nM, nN, u.pm, u.pn); u.kind = 0; return true;
    }
    __device__ __forceinline__ const char* a_base(const pg8::Unit& u) const { return A + (size_t)u.pm * tstep; }
    __device__ __forceinline__ const char* b_base(const pg8::Unit& u) const { return Bt + (size_t)u.pn * tstep; }
};

struct SchedDown {
    const char* A; const char* Bt; size_t tstep; int G, c, ntiles;
    __device__ __forceinline__ bool next(int i, pg8::Unit& u) const {
        const long L = (long)i * G + c;
        if (L < 512) { pg8::tile_map((int)L, 64, 8, u.pm, u.pn); u.kind = 0; return true; }
        if (L < 768) { const int q = (int)L - 512, t = q & 63; u.pm = 64 + (t >> 3); u.pn = t & 7; u.kind = 1 + (q >> 6); return true; }
        return false;
    }
    __device__ __forceinline__ int nt(const pg8::Unit& u) const { return u.kind == 0 ? ntiles : ntiles / 4; }
    __device__ __forceinline__ const char* a_base(const pg8::Unit& u) const { return A + (size_t)u.pm * tstep + (u.kind > 1 ? (size_t)(u.kind - 1) * (ntiles / 4) * 128 : 0); }
    __device__ __forceinline__ const char* b_base(const pg8::Unit& u) const { return Bt + (size_t)u.pn * tstep + (u.kind > 1 ? (size_t)(u.kind - 1) * (ntiles / 4) * 128 : 0); }
};
struct SchedOdIn {
    const char* HN; const char* W; size_t tstep; int G, c;
    __device__ __forceinline__ int nt(const pg8::Unit&) const { return D / 64; }
    __device__ __forceinline__ bool next(int i, pg8::Unit& u) const {
        const long L = (long)i * G + c;
        if (L < 72 * 16) { int pm, pnv; pg8::tile_map((int)L, 72, 16, pm, pnv); u.pm = pm; u.pn = pnv < 8 ? pnv : pnv + 4; u.kind = 0; return true; }
        if (L < 72 * 16 + 4 * 72) { int pm, pn; pg8::tile_map((int)L - 72 * 16, 4, 72, pm, pn); u.pm = pm; u.pn = pn; u.kind = 1; return true; }
        return false;
    }
    __device__ __forceinline__ const char* a_base(const pg8::Unit& u) const { return u.kind == 0 ? HN + (size_t)u.pm * tstep : W + (size_t)(8 + u.pm) * tstep; }
    __device__ __forceinline__ const char* b_base(const pg8::Unit& u) const { return u.kind == 0 ? W + (size_t)u.pn * tstep : HN + (size_t)u.pn * tstep; }
};

struct EpiSwiGLU {
    static constexpr bool PERM = true;
    bf16* O;
    __device__ __forceinline__ void operator()(const f32x4 (&acc)[2][2][4][2], const pg8::Unit& u, int wr, int wc, int fr, int fq) const {
        const int row0 = u.pm * 256 + wr * 64 + fr, col0 = u.pn * 128 + wc * 32 + 8 * fq;
#pragma unroll
        for (int ai = 0; ai < 2; ++ai)
#pragma unroll
            for (int m = 0; m < 4; ++m) {
                bf16* rowp = O + (size_t)(row0 + ai * 128 + m * 16) * DFF + col0;
                float v[8];
#pragma unroll
                for (int n = 0; n < 2; ++n)
#pragma unroll
                    for (int j = 0; j < 4; ++j) { const float g = acc[ai][0][m][n][j], up = acc[ai][1][m][n][j]; v[4 * n + j] = g * fast_sigmoid(g) * up; }
                u32x4 w; w.x = pg8::cvt_pk_bf16(v[0], v[1]); w.y = pg8::cvt_pk_bf16(v[2], v[3]); w.z = pg8::cvt_pk_bf16(v[4], v[5]); w.w = pg8::cvt_pk_bf16(v[6], v[7]);
                *(u32x4*)rowp = w;
            }
    }
};
template <bool BASE_F32, bool OUT_F32>
struct EpiResid {
    static constexpr bool PERM = true;
    const void* base_lat; const void* base_ctx; void* out; const float* gate; float coef; float* part;
    __device__ __forceinline__ void operator()(const f32x4 (&acc)[2][2][4][2], const pg8::Unit& u, int wr, int wc, int fr, int fq) const {
        const float coef = __builtin_bit_cast(float, __builtin_amdgcn_readfirstlane(__builtin_bit_cast(int, this->coef)));
        float* const part = (float*)(((unsigned long long)(unsigned)__builtin_amdgcn_readfirstlane((int)((unsigned long long)this->part >> 32)) << 32) | (unsigned)__builtin_amdgcn_readfirstlane((int)(unsigned long long)this->part));
        const int row0 = u.pm * 256 + wr * 64 + fr, col0 = u.pn * 256 + wc * 32 + 8 * fq;
        const int r = u.pm < 64 ? (u.pm >> 3) : 8;
        const float* gv = gate + (size_t)r * DMODW + col0;
        f32x4 gvv[2][2];
#pragma unroll
        for (int bj = 0; bj < 2; ++bj)
#pragma unroll
            for (int n = 0; n < 2; ++n) gvv[bj][n] = *(const f32x4*)(gv + bj * 128 + 4 * n) * coef;
        if (u.kind >= 2) {
            float* op = part + (size_t)(u.kind - 2) * (PART_STRIDE / 4) + (size_t)(row0 - M_LAT) * D + col0;
#pragma unroll
            for (int ai = 0; ai < 2; ++ai)
#pragma unroll
                for (int m = 0; m < 4; ++m) { const size_t ro = (size_t)(ai * 128 + m * 16) * D;
#pragma unroll
                    for (int bj = 0; bj < 2; ++bj)
#pragma unroll
                        for (int n = 0; n < 2; ++n) *(f32x4*)(op + ro + bj * 128 + 4 * n) = gvv[bj][n] * acc[ai][bj][m][n]; }
            return;
        }
        const size_t eo = (u.pm < 64 ? (size_t)row0 : (size_t)(row0 - M_LAT)) * D + col0;
        const void* bsel = u.pm < 64 ? base_lat : base_ctx;
        const size_t oo = (size_t)row0 * D + col0;
#pragma unroll
        for (int ai = 0; ai < 2; ++ai)
#pragma unroll
            for (int mh = 0; mh < 2; ++mh) {
                f32x4 b[2][2][2];
#pragma unroll
                for (int mm = 0; mm < 2; ++mm)
#pragma unroll
                    for (int bj = 0; bj < 2; ++bj) { const size_t ro = (size_t)(ai * 128 + (2 * mh + mm) * 16) * D + bj * 128;
                        if constexpr (BASE_F32) { b[mm][bj][0] = *(const f32x4*)((const float*)bsel + eo + ro); b[mm][bj][1] = *(const f32x4*)((const float*)bsel + eo + ro + 4); }
                        else { const u32x4 hv = *(const u32x4*)((const _Float16*)bsel + eo + ro); b[mm][bj][0] = h4_to_f32x4((u32x2){hv.x, hv.y}); b[mm][bj][1] = h4_to_f32x4((u32x2){hv.z, hv.w}); } }
#pragma unroll
                for (int mm = 0; mm < 2; ++mm)
#pragma unroll
                    for (int bj = 0; bj < 2; ++bj) { const size_t ro = (size_t)(ai * 128 + (2 * mh + mm) * 16) * D + bj * 128;
                        const f32x4 v0 = b[mm][bj][0] + gvv[bj][0] * acc[ai][bj][2 * mh + mm][0], v1 = b[mm][bj][1] + gvv[bj][1] * acc[ai][bj][2 * mh + mm][1];
                        if constexpr (OUT_F32) { *(f32x4*)((float*)out + oo + ro) = v0; *(f32x4*)((float*)out + oo + ro + 4) = v1; }
                        else { const u32x2 h0 = f32x4_to_h4(v0), h1 = f32x4_to_h4(v1); *(u32x4*)((_Float16*)out + oo + ro) = (u32x4){h0.x, h0.y, h1.x, h1.y}; } }
                asm volatile("" ::: "memory");
            }
    }
};
struct EpiEvIn {
    static constexpr bool PERM = true;
    bf16* O;
    __device__ __forceinline__ void operator()(const f32x4 (&acc)[2][2][4][2], const pg8::Unit& u, int wr, int wc, int fr, int fq) const {
        const int row0 = u.pm * 256 + wr * 64 + fr;
        if (u.pn < 4) {
            const int col0 = u.pn * 256 + wc * 32 + 8 * fq;
#pragma unroll
            for (int ai = 0; ai < 2; ++ai)
#pragma unroll
                for (int m = 0; m < 4; ++m) { bf16* rowp = O + (size_t)(row0 + ai * 128 + m * 16) * ZE_LD + col0;
#pragma unroll
                    for (int bj = 0; bj < 2; ++bj) { const f32x4 v0 = acc[ai][bj][m][0], v1 = acc[ai][bj][m][1];
                        u32x4 w; w.x = pg8::cvt_pk_bf16(v0[0], v0[1]); w.y = pg8::cvt_pk_bf16(v0[2], v0[3]); w.z = pg8::cvt_pk_bf16(v1[0], v1[1]); w.w = pg8::cvt_pk_bf16(v1[2], v1[3]);
                        *(u32x4*)(rowp + bj * 128) = w; } }
        } else {
            const bool glu = u.pn >= 12;
            const int col0 = (glu ? 2048 + (u.pn - 12) * 128 : 1024 + (u.pn - 4) * 128) + wc * 32 + 8 * fq;
#pragma unroll
            for (int ai = 0; ai < 2; ++ai)
#pragma unroll
                for (int m = 0; m < 4; ++m) { bf16* rowp = O + (size_t)(row0 + ai * 128 + m * 16) * ZE_LD + col0;
                    float v[8];
#pragma unroll
                    for (int n = 0; n < 2; ++n)
#pragma unroll
                        for (int j = 0; j < 4; ++j) { const float a = acc[ai][0][m][n][j], b = acc[ai][1][m][n][j]; v[4 * n + j] = glu ? a * fast_sigmoid(b) : a * b; }
                    u32x4 w; w.x = pg8::cvt_pk_bf16(v[0], v[1]); w.y = pg8::cvt_pk_bf16(v[2], v[3]); w.z = pg8::cvt_pk_bf16(v[4], v[5]); w.w = pg8::cvt_pk_bf16(v[6], v[7]);
                    *(u32x4*)rowp = w; }
        }
    }
};
struct EpiOdIn {
    static constexpr bool PERM = true;
    bf16* ZO; u32x4* KF; u32x2* VF; const float* qg; const float* kg;
    __device__ __forceinline__ void operator()(const f32x4 (&acc)[2][2][4][2], const pg8::Unit& u, int wr, int wc, int fr, int fq) const {
        const int row0 = u.pm * 256 + wr * 64 + fr;
        if (u.kind == 0 && u.pn < 8) {
            const bool isq = u.pn < 4;
            const float* gp = (isq ? qg : kg) + 8 * fq;
            f32x4 gn[2][2];
#pragma unroll
            for (int bj = 0; bj < 2; ++bj)
#pragma unroll
                for (int n = 0; n < 2; ++n) gn[bj][n] = *(const f32x4*)(gp + 32 * bj + 4 * n);
            const float sc = isq ? 0.125f * 1.44269504089f : 1.0f;
            const int col0 = u.pn * 256 + wc * 64 + 8 * fq, hh = 4 * (u.pn & 3) + wc;
#pragma unroll
            for (int ai = 0; ai < 2; ++ai)
#pragma unroll
                for (int m = 0; m < 4; ++m) {
                    float ss = 0.f;
#pragma unroll
                    for (int bj = 0; bj < 2; ++bj)
#pragma unroll
                        for (int n = 0; n < 2; ++n) { const f32x4 v = acc[ai][bj][m][n]; ss += (v[0] * v[0] + v[1] * v[1]) + (v[2] * v[2] + v[3] * v[3]); }
                    ss += __shfl_xor(ss, 16); ss += __shfl_xor(ss, 32);
                    const float rs = sc / sqrtf(ss * (1.0f / HD) + EPS);
                    const int row = row0 + ai * 128 + m * 16;
                    bf16* rowp = ZO + (size_t)row * ZO_LD + col0;
                    u32x4* kfp = KF + ((size_t)((row >> 4) * 16 + hh) * 8 + fq) * 16 + (row & 15);
#pragma unroll
                    for (int bj = 0; bj < 2; ++bj) { const f32x4 v0 = acc[ai][bj][m][0] * rs * gn[bj][0], v1 = acc[ai][bj][m][1] * rs * gn[bj][1];
                        u32x4 w; w.x = pg8::cvt_pk_bf16(v0[0], v0[1]); w.y = pg8::cvt_pk_bf16(v0[2], v0[3]); w.z = pg8::cvt_pk_bf16(v1[0], v1[1]); w.w = pg8::cvt_pk_bf16(v1[2], v1[3]);
                        if (isq) *(u32x4*)(rowp + bj * 32) = w; else kfp[bj * 64] = w; }
                }
            return;
        }
        if (u.kind == 1) {
#pragma unroll
            for (int ai = 0; ai < 2; ++ai)
#pragma unroll
                for (int m = 0; m < 4; ++m) { const int ch = row0 + ai * 128 + m * 16;
#pragma unroll
                    for (int bj = 0; bj < 2; ++bj)
#pragma unroll
                        for (int n = 0; n < 2; ++n) { const int t = u.pn * 256 + bj * 128 + wc * 32 + 8 * fq + 4 * n; const f32x4 v = acc[ai][bj][m][n];
                            u32x2 w; w.x = pg8::cvt_pk_bf16(v[0], v[1]); w.y = pg8::cvt_pk_bf16(v[2], v[3]);
                            VF[((size_t)(((t >> 4) * 16 + (ch >> 6)) * 4 + ((ch >> 4) & 3)) * 4 + ((t >> 2) & 3)) * 16 + (ch & 15)] = w; } }
            return;
        }
        const int col0 = u.pn * 256 + wc * 32 + 8 * fq;
#pragma unroll
        for (int ai = 0; ai < 2; ++ai)
#pragma unroll
            for (int m = 0; m < 4; ++m) { bf16* rowp = ZO + (size_t)(row0 + ai * 128 + m * 16) * ZO_LD + col0;
#pragma unroll
                for (int bj = 0; bj < 2; ++bj) { const f32x4 v0 = acc[ai][bj][m][0], v1 = acc[ai][bj][m][1];
                    u32x4 w; w.x = pg8::cvt_pk_bf16(v0[0], v0[1]); w.y = pg8::cvt_pk_bf16(v0[2], v0[3]); w.z = pg8::cvt_pk_bf16(v1[0], v1[1]); w.w = pg8::cvt_pk_bf16(v1[2], v1[3]);
                    *(u32x4*)(rowp + bj * 128) = w; } }
    }
};

__device__ __forceinline__ int srccol(int map, int n) {
    if (map == 0) return n;
    const int pn = n >> 8, bj = (n >> 7) & 1, i = n & 127;
    if (map == 1) return bj * DFF + 128 * pn + i;
    if (map == 2) {
        if (pn < 4) return n;
        if (pn < 12) return 1024 + bj * 1024 + 128 * (pn - 4) + i;
        return 3072 + bj * 1024 + 128 * (pn - 12) + i;
    }
    if (pn < 8) return 256 * pn + 64 * ((n >> 5) & 3) + 32 * bj + (n & 31);
    return n;
}
__device__ __forceinline__ void p0_transpose_item(const float* W, int K, int N, bf16* WT, int map, LAS float* scr, int item, int lane) {
    const int nblk = N / 64, kb = item / nblk, nb = item % nblk, k0 = 64 * kb, n0 = 64 * nb;
    const float* src = W + (size_t)k0 * N + srccol(map, n0 + lane);
#pragma unroll 32
    for (int i = 0; i < 64; ++i) scr[i * 65 + lane] = src[(size_t)i * N];
    LDS_WAIT(); asm volatile("" ::: "memory");
    const int c = lane & 7;
#pragma unroll
    for (int j = 0; j < 8; ++j) { const int n = (lane >> 3) + 8 * j; const LAS float* s = scr + (8 * c) * 65 + n;
        u32x4 o; o.x = pk2(s[0 * 65], s[1 * 65]); o.y = pk2(s[2 * 65], s[3 * 65]); o.z = pk2(s[4 * 65], s[5 * 65]); o.w = pk2(s[6 * 65], s[7 * 65]);
        *(u32x4*)(WT + (size_t)(n0 + n) * K + k0 + 8 * c) = o; }
    LDS_WAIT(); asm volatile("" ::: "memory");
}
__device__ __forceinline__ void p0_weights(const Params& p, LAS unsigned char* lds, int lane, int wave) {
    LAS float* scr = (LAS float*)(lds + wave * (64 * 65 * 4));
    const int gw = blockIdx.x * 8 + wave, NGW = gridDim.x * 8;
    constexpr int I_FI = (D / 64) * (2 * DFF / 64), I_FO = (DFF / 64) * (D / 64), I_IN = (D / 64) * (D_EIN / 64), I_OUT = (D / 64) * (D / 64);
    constexpr int NITEMS = 4 * I_FI + 4 * I_FO + 2 * I_IN + 2 * I_OUT;
    for (int it = gw; it < NITEMS; it += NGW) {
        int r = it;
        if (r < 4 * I_FI) { const int q = r / I_FI; p0_transpose_item(p.in[IN_FWI] + (size_t)q * D * 2 * DFF, D, 2 * DFF, (bf16*)(p.ws + WS_WFI + q * WFI_STRIDE), 1, scr, r % I_FI, lane); continue; } r -= 4 * I_FI;
        if (r < 4 * I_FO) { const int q = r / I_FO; p0_transpose_item(p.in[IN_FWO] + (size_t)q * DFF * D, DFF, D, (bf16*)(p.ws + WS_WFO + q * WFO_STRIDE), 0, scr, r % I_FO, lane); continue; } r -= 4 * I_FO;
        if (r < I_IN) { p0_transpose_item(p.in[IN_EWI], D, D_EIN, (bf16*)(p.ws + WS_WEI), 2, scr, r, lane); continue; } r -= I_IN;
        if (r < I_IN) { p0_transpose_item(p.in[IN_OWI], D, D_OIN, (bf16*)(p.ws + WS_WOI), 3, scr, r, lane); continue; } r -= I_IN;
        if (r < I_OUT) { p0_transpose_item(p.in[IN_EWO], D, D, (bf16*)(p.ws + WS_WEO), 0, scr, r, lane); continue; } r -= I_OUT;
        p0_transpose_item(p.in[IN_OWO], D, D, (bf16*)(p.ws + WS_WOO), 0, scr, r, lane);
    }
}
__device__ __forceinline__ void p0_modvec(const Params& p, LAS unsigned char* lds, int tid, int lane, int wave) {
    LAS float* sv = (LAS float*)lds;
    LAS float* red = (LAS float*)(lds + 9 * 2048 * 4);
    volatile LAS int* qslot = (volatile LAS int*)(lds + 9 * 2048 * 4 + 8 * 9 * 64 * 4);
    const float* c = p.in[IN_C]; const float* cc = p.in[IN_CCTX];
    for (int i = tid; i < 9 * 2048; i += 512) { const float v = i < 8 * 2048 ? c[i] : cc[i - 8 * 2048]; sv[i] = v / (1.0f + __expf(-v)); }
    float* MOD = (float*)(p.ws + WS_MOD);
    unsigned* qhead = (unsigned*)(p.ws + WS_CTL) + CW_Q;
    for (;;) {
        __syncthreads();
        if (tid == 0) *qslot = (int)__hip_atomic_fetch_add(qhead, 1u, __ATOMIC_RELAXED, __HIP_MEMORY_SCOPE_AGENT);
        __syncthreads();
        const int item = *qslot;
        if (item >= 2 * 288) break;
        const int l = item / 288, col0 = (item % 288) * 64;
        const float* W = p.in[IN_WMOD] + (size_t)l * D * DMODW + col0 + lane + (size_t)(wave * 256) * DMODW;
        float acc[9];
#pragma unroll
        for (int r = 0; r < 9; ++r) acc[r] = 0.f;
#define MV_LOAD(w, k16) do { _Pragma("unroll") for (int e = 0; e < 16; ++e) w[e] = W[(size_t)(16 * (k16) + e) * DMODW]; } while (0)
#define MV_COMP(w, k16) do { _Pragma("unroll") for (int e4 = 0; e4 < 4; ++e4) { _Pragma("unroll") for (int r = 0; r < 9; ++r) { \
            const f32x4 s = *(const LAS f32x4*)(sv + r * 2048 + wave * 256 + 16 * (k16) + 4 * e4); \
            acc[r] += (s[0] * w[4 * e4] + s[1] * w[4 * e4 + 1]) + (s[2] * w[4 * e4 + 2] + s[3] * w[4 * e4 + 3]); } } } while (0)
        float wa[16], wb[16];
        MV_LOAD(wa, 0);
#pragma unroll 1
        for (int k16 = 0; k16 < 16; k16 += 2) {
            MV_LOAD(wb, k16 + 1);
            MV_COMP(wa, k16);
            if (k16 + 2 < 16) MV_LOAD(wa, k16 + 2);
            MV_COMP(wb, k16 + 1);
        }
#undef MV_LOAD
#undef MV_COMP
#pragma unroll
        for (int r = 0; r < 9; ++r) red[(wave * 9 + r) * 64 + lane] = acc[r];
        __syncthreads();
        for (int o = tid; o < 9 * 64; o += 512) {
            const int r = o >> 6, ln = o & 63; float s = 0.f;
#pragma unroll
            for (int w = 0; w < 8; ++w) s += red[(w * 9 + r) * 64 + ln];
            MOD[((size_t)l * 9 + r) * DMODW + col0 + ln] = s + p.in[IN_BMOD][(size_t)l * DMODW + col0 + ln];
        }
    }
}

template <bool COMBINE, bool SRC_F32>
__device__ __forceinline__ void norm_phase(LAS unsigned char* lds, const void* src_lat, const void* src_ctx, _Float16* xw_ctx, const float* part, int nrows, const float* g, const float* modl, int shift_idx, int scale_idx, bf16* HN, int tid, int lane, int wave) {
    const int gw = blockIdx.x * 8 + wave, NGW = gridDim.x * 8, npass = (nrows + NGW - 1) / NGW;
    LAS float* Gs = (LAS float*)lds;
    LAS float* Ss = Gs + 2 * D;
    f32x4 v[8], nv[8];
#define NORM_COL(jj) (SRC_F32 ? 4 * lane + 256 * (jj) : 8 * lane + 512 * ((jj) >> 1) + 4 * ((jj) & 1))
#define NORM_LOAD(dst, row) do { const int row_ = (row); const size_t ro_ = (row_ < M_LAT ? (size_t)row_ : (size_t)(row_ - M_LAT)) * D; const void* sp_ = row_ < M_LAT ? src_lat : src_ctx; \
        if constexpr (SRC_F32) { _Pragma("unroll") for (int j = 0; j < 8; ++j) dst[j] = *(const f32x4*)((const float*)sp_ + ro_ + NORM_COL(j)); } \
        else { _Pragma("unroll") for (int j = 0; j < 4; ++j) { const u32x4 hv_ = *(const u32x4*)((const _Float16*)sp_ + ro_ + NORM_COL(2 * j)); dst[2 * j] = h4_to_f32x4((u32x2){hv_.x, hv_.y}); dst[2 * j + 1] = h4_to_f32x4((u32x2){hv_.z, hv_.w}); } } \
        if (COMBINE && row_ >= M_LAT) { _Pragma("unroll") for (int q = 0; q < 3; ++q) { const float* pr_ = part + (size_t)q * (PART_STRIDE / 4) + ro_; \
            _Pragma("unroll") for (int j = 0; j < 8; ++j) dst[j] += *(const f32x4*)(pr_ + NORM_COL(j)); } } } while (0)
    if (gw < nrows) NORM_LOAD(v, gw);
    for (int ps = 0; ps < npass; ++ps) {
        const int row = gw + ps * NGW, rowl = ps * NGW + blockIdx.x * 8;
        const int rl = rowl < M_LAT ? (rowl >> 11) : 8, buf = ps & 1;
        { const float* sh = modl + (size_t)rl * DMODW + shift_idx * D; const float* sc = modl + (size_t)rl * DMODW + scale_idx * D;
          const f32x4 gg = *(const f32x4*)(g + 4 * tid), s1 = *(const f32x4*)(sc + 4 * tid), s0 = *(const f32x4*)(sh + 4 * tid);
          *(LAS f32x4*)(Gs + buf * D + 4 * tid) = gg * (1.0f + s1); *(LAS f32x4*)(Ss + buf * D + 4 * tid) = s0; }
        __syncthreads();
        if (row < nrows) {
            if (row + NGW < nrows) NORM_LOAD(nv, row + NGW);
            const int r = row < M_LAT ? (row >> 11) : 8;
            float ss = 0.f;
#pragma unroll
            for (int j = 0; j < 8; ++j) ss += (v[j][0] * v[j][0] + v[j][1] * v[j][1]) + (v[j][2] * v[j][2] + v[j][3] * v[j][3]);
            const float rstd = 1.0f / sqrtf(wave_sum_dpp(ss) * (1.0f / D) + EPS);
            bf16* o = HN + (size_t)row * D;
            f32x4 y[8];
            if (r == rl) {
#pragma unroll
                for (int j = 0; j < 8; ++j) { const int c = NORM_COL(j); y[j] = (v[j] * rstd) * *(const LAS f32x4*)(Gs + buf * D + c) + *(const LAS f32x4*)(Ss + buf * D + c); }
            } else {
                const float* sh = modl + (size_t)r * DMODW + shift_idx * D; const float* sc = modl + (size_t)r * DMODW + scale_idx * D;
#pragma unroll
                for (int j = 0; j < 8; ++j) { const int c = NORM_COL(j); y[j] = (v[j] * rstd) * *(const f32x4*)(g + c) * (1.0f + *(const f32x4*)(sc + c)) + *(const f32x4*)(sh + c); }
            }
            if constexpr (SRC_F32) {
#pragma unroll
                for (int j = 0; j < 8; ++j) { u32x2 w; w.x = pg8::cvt_pk_bf16(y[j][0], y[j][1]); w.y = pg8::cvt_pk_bf16(y[j][2], y[j][3]); *(u32x2*)(o + NORM_COL(j)) = w; }
            } else {
#pragma unroll
                for (int j = 0; j < 4; ++j) { u32x4 w; w.x = pg8::cvt_pk_bf16(y[2 * j][0], y[2 * j][1]); w.y = pg8::cvt_pk_bf16(y[2 * j][2], y[2 * j][3]); w.z = pg8::cvt_pk_bf16(y[2 * j + 1][0], y[2 * j + 1][1]); w.w = pg8::cvt_pk_bf16(y[2 * j + 1][2], y[2 * j + 1][3]);
                    *(u32x4*)(o + NORM_COL(2 * j)) = w; }
            }
            if (COMBINE && row >= M_LAT) {
#pragma unroll
                for (int j = 0; j < 4; ++j) { const u32x2 h0 = f32x4_to_h4(v[2 * j]), h1 = f32x4_to_h4(v[2 * j + 1]); *(u32x4*)(xw_ctx + (size_t)(row - M_LAT) * D + NORM_COL(2 * j)) = (u32x4){h0.x, h0.y, h1.x, h1.y}; }
            }
#pragma unroll
            for (int j = 0; j < 8; ++j) v[j] = nv[j];
        }
    }
    __syncthreads();
#undef NORM_LOAD
#undef NORM_COL
}

template <int NT>
__device__ __forceinline__ void even_conv_unit(const Params& p, LAS unsigned char* lds, int base, int T, int t0, int tid, int lane, int wave) {
    const bf16* Z3 = (const bf16*)(p.ws + WS_Z); bf16* MIX = (bf16*)(p.ws + WS_MIX);
    constexpr int NR = NT + 30;
    LAS unsigned* tile = (LAS unsigned*)lds;
    LAS float* red = (LAS float*)(lds + 62 * 2048);
    LAS float* stat = red + 256;
    const float* ccw = p.in[IN_CCW]; const float* ccb = p.in[IN_CCB]; const float* lng = p.in[IN_LNG]; const float* lnb = p.in[IN_LNB];
    const float* scw = p.in[IN_SCW]; const float* scb = p.in[IN_SCB];
    {
        constexpr int NQ = (NR * 128 + 511) / 512;
        u32x4 sv[NQ];
#pragma unroll
        for (int q = 0; q < NQ; ++q) { const int ch = tid + 512 * q, rr = min(ch >> 7, NR - 1), cc = ch & 127, t = t0 - 15 + rr, tc = min(max(t, 0), T - 1);
            const unsigned msk = (t == tc) ? 0xffffffffu : 0u;
            sv[q] = *(const u32x4*)(Z3 + (size_t)(base + tc) * ZE_LD + 2048 + cc * 8) & msk; }
#pragma unroll
        for (int q = 0; q < NQ; ++q) { const int ch = tid + 512 * q, rr = ch >> 7, cc = ch & 127; if (rr < NR) *(LAS u32x4*)(tile + rr * 512 + cc * 4) = sv[q]; }
    }
    unsigned pv[NT + 2], bgv[NT];
#pragma unroll
    for (int i = 0; i < NT + 2; ++i) { const int t = t0 - 1 + i, tc = min(max(t, 0), T - 1); const unsigned msk = (t == tc) ? 0xffffffffu : 0u; pv[i] = *(const unsigned*)(Z3 + (size_t)(base + tc) * ZE_LD + 1024 + 2 * tid) & msk; }
#pragma unroll
    for (int i = 0; i < NT; ++i) bgv[i] = *(const unsigned*)(Z3 + (size_t)(base + t0 + i) * ZE_LD + 2 * tid);
    const f32x2 lg = *(const f32x2*)(lng + 2 * tid), lb = *(const f32x2*)(lnb + 2 * tid), cbias = *(const f32x2*)(ccb + 2 * tid);
    __syncthreads();
    { const f32x2 w0 = *(const f32x2*)(scw + 2 * tid), w1 = *(const f32x2*)(scw + 1024 + 2 * tid), w2 = *(const f32x2*)(scw + 2048 + 2 * tid), b = *(const f32x2*)(scb + 2 * tid);
#pragma unroll
      for (int i = 0; i < NT; ++i) {
          const float c0 = w0[0] * bf_lo(pv[i]) + w1[0] * bf_lo(pv[i + 1]) + w2[0] * bf_lo(pv[i + 2]) + b[0];
          const float c1 = w0[1] * bf_hi(pv[i]) + w1[1] * bf_hi(pv[i + 1]) + w2[1] * bf_hi(pv[i + 2]) + b[1];
          *(unsigned*)(MIX + (size_t)(base + t0 + i) * D + 2 * tid) = pg8::cvt_pk_bf16(bf_lo(bgv[i]) * c0, bf_hi(bgv[i]) * c1); } }
    f32x2 acc[NT];
#pragma unroll
    for (int i = 0; i < NT; ++i) acc[i] = cbias;
    f32x2 w = *(const f32x2*)(ccw + 2 * tid);
#pragma unroll 1
    for (int k = 0; k < 31; ++k) {
        const f32x2 wn = *(const f32x2*)(ccw + (size_t)min(k + 1, 30) * 1024 + 2 * tid);
        const LAS unsigned* tp = tile + k * 512 + tid;
#pragma unroll
        for (int i = 0; i < NT; ++i) { const unsigned v = tp[i * 512]; acc[i] += w * (f32x2){bf_lo(v), bf_hi(v)}; }
        w = wn;
    }
#pragma unroll
    for (int i = 0; i < NT; ++i) { const float s = wave_sum_dpp(acc[i][0] + acc[i][1]); if (lane == 0) red[wave * 32 + i] = s; }
    __syncthreads();
    if (tid < NT) { float s = 0.f;
#pragma unroll
        for (int ww = 0; ww < 8; ++ww) s += red[ww * 32 + tid]; stat[tid] = s * (1.0f / 1024.0f); }
    __syncthreads();
#pragma unroll
    for (int i = 0; i < NT; ++i) { const float mu = stat[i]; acc[i] -= mu; }
    __syncthreads();
#pragma unroll
    for (int i = 0; i < NT; ++i) { const float s = wave_sum_dpp(acc[i][0] * acc[i][0] + acc[i][1] * acc[i][1]); if (lane == 0) red[wave * 32 + i] = s; }
    __syncthreads();
    if (tid < NT) { float s = 0.f;
#pragma unroll
        for (int ww = 0; ww < 8; ++ww) s += red[ww * 32 + tid]; stat[tid] = 1.0f / sqrtf(s * (1.0f / 1024.0f) + EPS); }
    __syncthreads();
#pragma unroll
    for (int i = 0; i < NT; ++i) { const float rs = stat[i]; const float y0 = acc[i][0] * rs * lg[0] + lb[0], y1 = acc[i][1] * rs * lg[1] + lb[1];
        *(unsigned*)(MIX + (size_t)(base + t0 + i) * D + 1024 + 2 * tid) = pg8::cvt_pk_bf16(y0 * fast_sigmoid(y0), y1 * fast_sigmoid(y1)); }
    __syncthreads();
}
__device__ __forceinline__ void even_conv_phase(const Params& p, LAS unsigned char* lds, int tid, int lane, int wave) {
    for (int u = blockIdx.x; u < 512 + 256; u += gridDim.x) {
        if (u < 512) even_conv_unit<32>(p, lds, (u >> 6) * SEQ, SEQ, (u & 63) * 32, tid, lane, wave);
        else { const int v = u - 512; even_conv_unit<8>(p, lds, M_LAT + (v >> 5) * CTXL, CTXL, (v & 31) * 8, tid, lane, wave); }
    }
}

constexpr int ATT_PAD = 471, ATT_HT = 465 + ATT_PAD;
__device__ __forceinline__ void attn_wave_unit(const Params& p, const LAS float* rpbL, int b, int h, int r, int qg, int lane) {
    const bf16* ZO = (const bf16*)(p.ws + WS_Z); const u32x4* KF = (const u32x4*)(p.ws + WS_KF); const u32x2* VF = (const u32x2*)(p.ws + WS_VT); bf16* MIX = (bf16*)(p.ws + WS_MIX);
    const int l15 = lane & 15, g = lane >> 4;
    const int c0 = 16 * qg, qc = c0 + l15, qrow = b * SEQ + r * GW + qc;
    const int r0 = min(max(r - WIN_R / 2, 0), GROWS - WIN_R);
    const int kb = qg == 0 ? 0 : (qg == 1 ? 8 : (qg == 2 ? 24 : 32));
    const int cs = min(max(qc - WIN_C / 2, 0), GW - WIN_C);
    bf16x8 qf[2];
#pragma unroll
    for (int kk = 0; kk < 2; ++kk) qf[kk] = __builtin_bit_cast(bf16x8, *(const u32x4*)(ZO + (size_t)qrow * ZO_LD + h * HD + 8 * g + 32 * kk));
    int dcol[8];
#pragma unroll
    for (int a = 0; a < 2; ++a)
#pragma unroll
        for (int e = 0; e < 4; ++e) { const int kc = kb + 16 * a + 4 * g + e; dcol[4 * a + e] = ((kc >= cs) && (kc < cs + WIN_C)) ? kc - qc + WIN_C - 1 : 465; }
    const LAS float* rpbh = rpbL + h * ATT_HT;
    const bool mis = (kb & 8) != 0;
    const unsigned klo_ctx = (unsigned)(g * 16 + l15), klo_loc = mis ? (unsigned)(((l15 + 8) >> 4) * 2048 + g * 16 + ((l15 + 8) & 15)) : klo_ctx;
    const unsigned vlo_ctx = (unsigned)(g * 16 + l15), vlo_loc = mis ? (unsigned)(((4 * g + 8) >> 4) * 4096 + (((4 * g + 8) >> 2) & 3) * 16 + l15) : vlo_ctx;
    u32x4 kx[4][2][2]; u32x4 vx[4][4];
#define ATT_TOK0(ch) ((ch) < 8 ? M_LAT + b * CTXL + 32 * (ch) : b * SEQ + (r0 + ((ch) - 8)) * GW + kb)
#define ATT_LOADK(s) do { const unsigned klo_ = (s) < 2 ? klo_ctx : klo_loc; _Pragma("unroll") for (int c = 0; c < 4; ++c) { const int tb_ = ATT_TOK0(4 * (s) + c) >> 4; \
        _Pragma("unroll") for (int a = 0; a < 2; ++a) { const u32x4* kp_ = KF + ((size_t)(tb_ + a) * 2048 + h * 128); kx[c][a][0] = kp_[klo_]; kx[c][a][1] = (kp_ + 64)[klo_]; } } } while (0)
#define ATT_LOADV(s) do { const unsigned vlo_ = (s) < 2 ? vlo_ctx : vlo_loc; _Pragma("unroll") for (int c = 0; c < 4; ++c) { const int tb_ = ATT_TOK0(4 * (s) + c) >> 4; \
        _Pragma("unroll") for (int a = 0; a < 2; ++a) { const u32x2* vp_ = VF + ((size_t)(tb_ + a) * 4096 + h * 256); \
            _Pragma("unroll") for (int d = 0; d < 4; ++d) { const u32x2 t_ = (vp_ + d * 64)[vlo_]; if (a == 0) { vx[c][d].x = t_.x; vx[c][d].y = t_.y; } else { vx[c][d].z = t_.x; vx[c][d].w = t_.y; } } } } } while (0)
    f32x4 o[4];
#pragma unroll
    for (int d = 0; d < 4; ++d) o[d] = (f32x4){0.f, 0.f, 0.f, 0.f};
    float mrun = -1e30f, lsum = 0.f;
    ATT_LOADK(0); ATT_LOADV(0);
#pragma unroll 1
    for (int s = 0; s < 4; ++s) {
        f32x4 sc_[4][2];
#pragma unroll
        for (int c = 0; c < 4; ++c)
#pragma unroll
            for (int a = 0; a < 2; ++a) { f32x4 acc_ = (f32x4){0.f, 0.f, 0.f, 0.f};
                acc_ = __builtin_amdgcn_mfma_f32_16x16x32_bf16(__builtin_bit_cast(bf16x8, kx[c][a][0]), qf[0], acc_, 0, 0, 0);
                acc_ = __builtin_amdgcn_mfma_f32_16x16x32_bf16(__builtin_bit_cast(bf16x8, kx[c][a][1]), qf[1], acc_, 0, 0, 0); sc_[c][a] = acc_; }
        if (s < 3) ATT_LOADK(s + 1);
        if (s >= 2) {
#pragma unroll
            for (int c = 0; c < 4; ++c) { const LAS float* bp_ = rpbh + ((r0 + 4 * (s - 2) + c) - r + WIN_R - 1) * 31;
#pragma unroll
                for (int a = 0; a < 2; ++a)
#pragma unroll
                    for (int e = 0; e < 4; ++e) sc_[c][a][e] += bp_[dcol[4 * a + e]]; }
        }
        float mx_ = -1e30f;
#pragma unroll
        for (int c = 0; c < 4; ++c)
#pragma unroll
            for (int a = 0; a < 2; ++a) mx_ = fmaxf(mx_, fmaxf(fmaxf(sc_[c][a][0], sc_[c][a][1]), fmaxf(sc_[c][a][2], sc_[c][a][3])));
        mx_ = fmaxf(mx_, __shfl_xor(mx_, 16)); mx_ = fmaxf(mx_, __shfl_xor(mx_, 32));
        const float mnew_ = fmaxf(mrun, mx_), alpha_ = __builtin_amdgcn_exp2f(mrun - mnew_); mrun = mnew_;
        float ps_ = 0.f; bf16x8 pf_[4];
#pragma unroll
        for (int c = 0; c < 4; ++c) { float pe_[8];
#pragma unroll
            for (int a = 0; a < 2; ++a)
#pragma unroll
                for (int e = 0; e < 4; ++e) { pe_[4 * a + e] = __builtin_amdgcn_exp2f(sc_[c][a][e] - mnew_); ps_ += pe_[4 * a + e]; }
            u32x4 pw_; pw_.x = pg8::cvt_pk_bf16(pe_[0], pe_[1]); pw_.y = pg8::cvt_pk_bf16(pe_[2], pe_[3]); pw_.z = pg8::cvt_pk_bf16(pe_[4], pe_[5]); pw_.w = pg8::cvt_pk_bf16(pe_[6], pe_[7]);
            pf_[c] = __builtin_bit_cast(bf16x8, pw_); }
        lsum = lsum * alpha_ + ps_;
#pragma unroll
        for (int d = 0; d < 4; ++d) { o[d] = o[d] * alpha_;
#pragma unroll
            for (int c = 0; c < 4; ++c) o[d] = __builtin_amdgcn_mfma_f32_16x16x32_bf16(__builtin_bit_cast(bf16x8, vx[c][d]), pf_[c], o[d], 0, 0, 0); }
        if (s < 3) ATT_LOADV(s + 1);
    }
#undef ATT_TOK0
#undef ATT_LOADK
#undef ATT_LOADV
    lsum += __shfl_xor(lsum, 16); lsum += __shfl_xor(lsum, 32);
    const float inv = 1.0f / lsum;
#pragma unroll
    for (int d = 0; d < 4; ++d) { u32x2 w; w.x = pg8::cvt_pk_bf16(o[d][0] * inv, o[d][1] * inv); w.y = pg8::cvt_pk_bf16(o[d][2] * inv, o[d][3] * inv);
        *(u32x2*)(MIX + (size_t)qrow * D + h * HD + 16 * d + 4 * g) = w; }
}
__device__ __forceinline__ void attn_phase(const Params& p, LAS unsigned char* lds, int tid, int lane, int wave) {
    LAS float* rpbL = (LAS float*)lds;
    __syncthreads();
    for (int i = tid; i < NH * ATT_HT; i += 512) { const int hh = i / ATT_HT, j = i - hh * ATT_HT; rpbL[i] = j < 465 ? p.in[IN_RPB][hh * 465 + j] * 1.44269504089f : -1e30f; }
    __syncthreads();
    const int cls = blockIdx.x & 7, wgi = blockIdx.x >> 3, ncl = (gridDim.x - cls + 7) >> 3, nW = ncl * 8;
    if (gridDim.x >= 8) {
        for (int v = wgi * 8 + wave; v < NH * GROWS * 4; v += nW) { const int h = v >> 7, rem = v & 127; attn_wave_unit(p, rpbL, cls, h, rem >> 2, rem & 3, lane); }
    } else {
        for (int v = blockIdx.x * 8 + wave; v < NBATCH * NH * GROWS * 4; v += gridDim.x * 8) { const int b = v >> 11, w = v & 2047, h = w >> 7, rem = w & 127; attn_wave_unit(p, rpbL, b, h, rem >> 2, rem & 3, lane); }
    }
}

__device__ __forceinline__ float gelu_tanh(float x) { const float z = 0.7978845608028654f * (x + 0.044715f * x * x * x); return x * fast_sigmoid(2.0f * z); }
template <class T> __device__ __forceinline__ T* uniform_ptr(T* p) {
    const unsigned long long v = (unsigned long long)p;
    return (T*)(((unsigned long long)(unsigned)__builtin_amdgcn_readfirstlane((int)(v >> 32)) << 32) | (unsigned)__builtin_amdgcn_readfirstlane((int)v));
}
constexpr int LCH = 256;
__device__ __forceinline__ void lru_item(const Params& p, LAS unsigned char* lds, int item, int tid, int lane, int wave) {
    const bf16* ZO = (const bf16*)(p.ws + WS_Z); float* HF = (float*)(p.ws + WS_HF); bf16* MIX = (bf16*)(p.ws + WS_MIX);
    const int b = item >> 5, n = (item >> 1) & 15, half = item & 1, j0 = half * 32;
    LAS float* xcf = (LAS float*)lds;
    LAS bf16* xcb = (LAS bf16*)(lds + LCH * 33 * 4);
    LAS float* As = (LAS float*)(lds + LCH * 33 * 4 + LCH * 72 * 2);
    LAS float* Us = As + LCH * 33;
    LAS float* segA = Us + LCH * 33;
    LAS float* segH = segA + 16 * 32;
    const int ci = lane, cch = n * 64 + ci;
    const float* lcw = p.in[IN_LCW]; const float cw0 = lcw[cch], cw1 = lcw[1024 + cch], cw2 = lcw[2048 + cch], cw3 = lcw[3072 + cch], cb = p.in[IN_LCB][cch];
    const bool own = (ci >> 5) == half; (void)own; (void)cw0; (void)cw1; (void)cw2; (void)cw3; (void)cb;
    const int cpp = lane & 31;
    const f32x2 cwp0 = *(const f32x2*)(lcw + n * 64 + 2 * cpp), cwp1 = *(const f32x2*)(lcw + 1024 + n * 64 + 2 * cpp), cwp2 = *(const f32x2*)(lcw + 2048 + n * 64 + 2 * cpp), cwp3 = *(const f32x2*)(lcw + 3072 + n * 64 + 2 * cpp), cbp = *(const f32x2*)(p.in[IN_LCB] + n * 64 + 2 * cpp);
    const bool ownp = (cpp >> 4) == half;
    const int jb = wave & 1, tb0 = (wave >> 1) * 4, l15 = lane & 15, g = lane >> 4, jl = 16 * jb + l15, gch = n * 64 + j0 + jl;
    const int sc = lane & 31, hi = lane >> 5, sg = 2 * wave + hi;
    const unsigned och = (unsigned)(n * 64 + j0 + sc);
    for (int dir = 0; dir < 2; ++dir) {
        bf16x8 Bg[2][2];
        {
            const float* gw = p.in[IN_LGW] + (size_t)((dir * 2) * 16 + n) * 4096;
#pragma unroll
            for (int gt = 0; gt < 2; ++gt)
#pragma unroll
                for (int kk = 0; kk < 2; ++kk) { const float* wp = gw + (size_t)gt * 16 * 4096 + (size_t)(8 * g + 32 * kk) * 64 + j0 + jl;
                    u32x4 w; w.x = pk2(wp[0], wp[64]); w.y = pk2(wp[128], wp[192]); w.z = pk2(wp[256], wp[320]); w.w = pk2(wp[384], wp[448]); Bg[gt][kk] = __builtin_bit_cast(bf16x8, w); }
        }
        const float br = p.in[IN_LGB][(dir * 2 + 0) * 1024 + gch], bi = p.in[IN_LGB][(dir * 2 + 1) * 1024 + gch];
        const float lam = p.in[IN_LAM][dir * 1024 + gch];
        const float sp8 = -8.0f * log1pf(expf(-lam)) * 1.44269504089f;
        float carry = 0.f;
        const unsigned hoff = (unsigned)((dir == 0 ? 16 * hi : 16 * (1 - hi)) * 1024) + och;
        const unsigned moff = (unsigned)((dir == 0 ? 16 * hi : 16 * (1 - hi)) * D) + 1024u + och;
        const unsigned goff = (unsigned)((dir == 0 ? 16 * hi : 16 * (1 - hi)) * ZO_LD) + 4096u + och;
        u32x4 xraw[5];
#define LRU_LOADX(cidx_) do { const int ci_ = (cidx_); const bool isctx_ = ci_ < 1; const int cc_ = isctx_ ? 0 : ci_ - 1, ncs_ = isctx_ ? 1 : 8, cpos_ = dir == 0 ? cc_ : ncs_ - 1 - cc_; \
        const int base_ = isctx_ ? M_LAT + b * CTXL : b * SEQ, T_ = isctx_ ? CTXL : SEQ, ts_ = cpos_ * LCH - 1; \
        _Pragma("unroll") for (int q = 0; q < 5; ++q) { const int pc = min(q * 512 + tid, 2071), t = ts_ + (pc >> 3), tc = min(max(t, 0), T_ - 1); const unsigned msk = (t == tc) ? 0xffffffffu : 0u; \
            xraw[q] = *(const u32x4*)(ZO + (size_t)(base_ + tc) * ZO_LD + 3072 + n * 64 + (pc & 7) * 8) & msk; } } while (0)
        LRU_LOADX(0);
        LAS unsigned char* rawt = (LAS unsigned char*)As;
#pragma unroll 1
        for (int cidx = 0; cidx < 9; ++cidx) {
            const bool isctx = cidx < 1;
            const int cc = isctx ? 0 : cidx - 1, ncs = isctx ? 1 : 8, cpos = dir == 0 ? cc : ncs - 1 - cc;
            const int base = isctx ? M_LAT + b * CTXL : b * SEQ, t0 = cpos * LCH;
            const int rbase = dir == 0 ? base + t0 + 32 * wave : base + t0 + LCH - 1 - 32 * wave - 16;
            float hfv[16]; unsigned grv[16];
            if (!isctx && dir == 1) {
                const float* hp_ = uniform_ptr(HF + (size_t)rbase * 1024); const bf16* gp_ = uniform_ptr(ZO + (size_t)rbase * ZO_LD);
#pragma unroll
                for (int e = 0; e < 16; ++e) { hfv[e] = uniform_ptr(hp_ - (size_t)e * 1024)[hoff]; grv[e] = (unsigned)uniform_ptr(gp_ - (size_t)e * ZO_LD)[goff]; }
            }
#pragma unroll
            for (int q = 0; q < 5; ++q) { const int pc = q * 512 + tid; if (pc < 2072) *(LAS u32x4*)(rawt + pc * 16) = xraw[q]; }
            __syncthreads();
            {
                const int cp = lane & 31, tg = 2 * wave + (lane >> 5);
                const LAS unsigned* rp_ = (const LAS unsigned*)(rawt + (16 * tg) * 128) + cp;
                unsigned xr_[19];
#pragma unroll
                for (int e = 0; e < 19; ++e) xr_[e] = rp_[e * 32];
                LAS unsigned* xb_ = (LAS unsigned*)(xcb + (16 * tg) * 72) + cp; LAS f32x2* xf_ = (LAS f32x2*)(xcf + (16 * tg) * 33 + ((2 * cp) & 31));
#pragma unroll
                for (int e = 0; e < 16; ++e) {
                    const float y0 = cwp0[0] * bf_lo(xr_[e]) + cwp1[0] * bf_lo(xr_[e + 1]) + cwp2[0] * bf_lo(xr_[e + 2]) + cwp3[0] * bf_lo(xr_[e + 3]) + cbp[0];
                    const float y1 = cwp0[1] * bf_hi(xr_[e]) + cwp1[1] * bf_hi(xr_[e + 1]) + cwp2[1] * bf_hi(xr_[e + 2]) + cwp3[1] * bf_hi(xr_[e + 3]) + cbp[1];
                    xb_[e * 36] = pg8::cvt_pk_bf16(y0, y1);
                    if (ownp) { LAS float* q_ = (LAS float*)xf_ + e * 33; q_[0] = y0; q_[1] = y1; }
                }
            }
            if (cidx + 1 < 9) LRU_LOADX(cidx + 1);
            __syncthreads();
#pragma unroll 1
            for (int q = 0; q < 4; ++q) {
                const int tb = tb0 + q;
                const bf16x8 a0 = *(const LAS bf16x8*)(xcb + (16 * tb + l15) * 72 + 8 * g), a1 = *(const LAS bf16x8*)(xcb + (16 * tb + l15) * 72 + 8 * g + 32);
                f32x4 gr_ = (f32x4){0.f, 0.f, 0.f, 0.f}, gi_ = (f32x4){0.f, 0.f, 0.f, 0.f};
                gr_ = __builtin_amdgcn_mfma_f32_16x16x32_bf16(a0, Bg[0][0], gr_, 0, 0, 0); gr_ = __builtin_amdgcn_mfma_f32_16x16x32_bf16(a1, Bg[0][1], gr_, 0, 0, 0);
                gi_ = __builtin_amdgcn_mfma_f32_16x16x32_bf16(a0, Bg[1][0], gi_, 0, 0, 0); gi_ = __builtin_amdgcn_mfma_f32_16x16x32_bf16(a1, Bg[1][1], gi_, 0, 0, 0);
#pragma unroll
                for (int e = 0; e < 4; ++e) {
                    const int tl = 16 * tb + 4 * g + e;
                    const float rg = fast_sigmoid(gr_[e] + br), ig = fast_sigmoid(gi_[e] + bi);
                    const float la2 = sp8 * rg, a = __builtin_amdgcn_exp2f(la2);
                    const float em = __builtin_fmaf(-a, a, 1.0f);
                    As[tl * 33 + jl] = a; Us[tl * 33 + jl] = sqrtf(em) * ig * xcf[tl * 33 + jl];
                }
            }
            __syncthreads();
            float av[16], uv[16];
            {
                float A = 1.f, H = 0.f;
                const LAS float* ap_ = As + (dir ? (LCH - 1 - 16 * sg) : 16 * sg) * 33 + sc; const LAS float* up_ = Us + (dir ? (LCH - 1 - 16 * sg) : 16 * sg) * 33 + sc;
#pragma unroll
                for (int e = 0; e < 16; ++e) { av[e] = dir ? ap_[-e * 33] : ap_[e * 33]; uv[e] = dir ? up_[-e * 33] : up_[e * 33]; H = av[e] * H + uv[e]; A *= av[e]; }
                segA[sg * 32 + sc] = A; segH[sg * 32 + sc] = H;
            }
            __syncthreads();
            {
                float hin = carry, mine = 0.f;
#pragma unroll
                for (int s2 = 0; s2 < 16; ++s2) { if (s2 == sg) mine = hin; hin = segA[s2 * 32 + sc] * hin + segH[s2 * 32 + sc]; }
                carry = hin;
                if (!isctx) {
                    float hcur = mine;
                    if (dir == 0) {
                        float* hp_ = uniform_ptr(HF + (size_t)rbase * 1024);
#pragma unroll
                        for (int e = 0; e < 16; ++e) { hcur = av[e] * hcur + uv[e]; uniform_ptr(hp_ + (size_t)e * 1024)[hoff] = hcur; }
                    } else {
                        bf16* mp_ = uniform_ptr(MIX + (size_t)rbase * D);
#pragma unroll
                        for (int e = 0; e < 16; ++e) { hcur = av[e] * hcur + uv[e];
                            uniform_ptr(mp_ - (size_t)e * D)[moff] = (bf16)f2bf((hfv[e] + hcur) * gelu_tanh(__builtin_bit_cast(float, grv[e] << 16))); }
                    }
                }
            }
        }
#undef LRU_LOADX
        VM_WAIT(); __syncthreads();
    }
}


#if MK_SPLIT
#define GRID_BAR() do { } while (0)
#else
#define GRID_BAR() xcd_barrier(bar)
#endif
#ifndef PH_MASK
#define PH_MASK 0xffffffffu
#endif
#define IN(k) (lo <= (k) && (k) < hi && ((PH_MASK >> (k)) & 1u))
#ifndef PROBE_MASK
#define PROBE_MASK 0u
#endif
#ifndef PROBE_MULT
#define PROBE_MULT 4
#endif
#if PROBE_MASK
#define PROBE_STAMP(k) do { if (blockIdx.x == 0 && threadIdx.x == 0) { volatile LAS unsigned long long* pw = (volatile LAS unsigned long long*)(lds + MISC_OFF + 128); \
        const unsigned long long t_ = __builtin_amdgcn_s_memrealtime(); if ((PROBE_MASK >> (k)) & 1u) pw[1] += t_ - pw[0]; pw[0] = t_; } } while (0)
#else
#define PROBE_STAMP(k) do { } while (0)
#endif
#define SEAM(k) do { if (IN(k) && IN((k) + 1)) GRID_BAR(); PROBE_STAMP(k); } while (0)

template <int L>
__device__ __forceinline__ void layer_body(const Params& p, LAS unsigned char* lds, const XcdBarrier& bar, const int lo, const int hi) {
    constexpr int l = L;
    const int tid = threadIdx.x, lane = tid & 63, wave = __builtin_amdgcn_readfirstlane(tid >> 6);
    const int G = gridDim.x;
    float* MOD = (float*)(p.ws + WS_MOD);
    _Float16* X = (_Float16*)(p.ws + WS_X);
    bf16* HN = (bf16*)(p.ws + WS_HN);
    bf16* ACT = (bf16*)(p.ws + WS_ACT);
    bf16* Z = (bf16*)(p.ws + WS_Z);
    bf16* MIX = (bf16*)(p.ws + WS_MIX);
    float* PART = (float*)(p.ws + WS_PART);
        const int pb = 1 + 10 * l;
        const float* modl = MOD + (size_t)l * 9 * DMODW;
        const float* ng = p.in[IN_NORMG] + (size_t)l * 3 * D;
        constexpr bool first = (l == 0);
        const void* xs_lat = first ? (const void*)p.in[IN_X] : (const void*)X; const void* xs_ctx = first ? (const void*)p.in[IN_CTX] : (const void*)(X + (size_t)M_LAT * D);

        if (IN(pb + 0)) norm_phase<!first, first>(lds, xs_lat, xs_ctx, X + (size_t)M_LAT * D, PART, M_ALL, ng + 0 * D, modl, 0, 1, HN, tid, lane, wave);
        SEAM(pb + 0);
        if (IN(pb + 1)) {
            SchedStd S{(const char*)HN, (const char*)(p.ws + WS_WFI + (size_t)(l * 2 + 0) * WFI_STRIDE), (size_t)256 * D * 2, M_ALL / 256, 2 * DFF / 256, G, (int)blockIdx.x, D / 64};
            EpiSwiGLU E{ACT};
            pg8::gemm_phase<EpiSwiGLU, SchedStd>(lds, D, S, E);
        }
        SEAM(pb + 1);
        if (IN(pb + 2)) {
            SchedDown S{(const char*)ACT, (const char*)(p.ws + WS_WFO + (size_t)(l * 2 + 0) * WFO_STRIDE), (size_t)256 * DFF * 2, G, (int)blockIdx.x, DFF / 64};
            EpiResid<first, false> E{xs_lat, xs_ctx, X, modl + 2 * D, 0.5f, PART};
            pg8::gemm_phase<EpiResid<first, false>, SchedDown>(lds, DFF, S, E);
        }
        SEAM(pb + 2);
        if (IN(pb + 3)) norm_phase<true, false>(lds, X, X + (size_t)M_LAT * D, X + (size_t)M_LAT * D, PART, M_ALL, ng + 1 * D, modl, 3, 4, HN, tid, lane, wave);
        SEAM(pb + 3);
        if constexpr (first) {
            if (IN(pb + 4)) {
                SchedStd S{(const char*)HN, (const char*)(p.ws + WS_WEI), (size_t)256 * D * 2, M_ALL / 256, D_EIN / 256, G, (int)blockIdx.x, D / 64};
                EpiEvIn E{Z};
                pg8::gemm_phase<EpiEvIn, SchedStd>(lds, D, S, E);
            }
            SEAM(pb + 4);
            if (IN(pb + 5)) even_conv_phase(p, lds, tid, lane, wave);
            SEAM(pb + 5);
            if (IN(pb + 6)) {
                SchedDown S{(const char*)MIX, (const char*)(p.ws + WS_WEO), (size_t)256 * D * 2, G, (int)blockIdx.x, D / 64};
                EpiResid<false, false> E{X, X + (size_t)M_LAT * D, X, modl + 5 * D, 1.0f, PART};
                pg8::gemm_phase<EpiResid<false, false>, SchedDown>(lds, D, S, E);
            }
            SEAM(pb + 6);
        } else {
            if (IN(pb + 4)) {
                SchedOdIn S{(const char*)HN, (const char*)(p.ws + WS_WOI), (size_t)256 * D * 2, G, (int)blockIdx.x};
                EpiOdIn E{Z, (u32x4*)(p.ws + WS_KF), (u32x2*)(p.ws + WS_VT), p.in[IN_QG], p.in[IN_KG]};
                pg8::gemm_phase<EpiOdIn, SchedOdIn>(lds, D, S, E);
            }
            SEAM(pb + 4);
            if (IN(pb + 5)) {
#ifndef NO_LRU
                for (int item = blockIdx.x; item < 256; item += G) lru_item(p, lds, item, tid, lane, wave);
#endif
#if PROBE_MASK
                __syncthreads();
                if (blockIdx.x == 0 && threadIdx.x == 0) { volatile LAS unsigned long long* pw = (volatile LAS unsigned long long*)(lds + MISC_OFF + 128);
                    const unsigned long long t_ = __builtin_amdgcn_s_memrealtime(); if ((PROBE_MASK >> 30) & 1u) pw[1] += t_ - pw[0]; }
#endif
#ifndef NO_ATTN
                attn_phase(p, lds, tid, lane, wave);
#endif
            }
            SEAM(pb + 5);
            if (IN(pb + 6)) {
                SchedStd S{(const char*)MIX, (const char*)(p.ws + WS_WOO), (size_t)256 * D * 2, M_LAT / 256, D / 256, G, (int)blockIdx.x, D / 64};
                EpiResid<false, false> E{X, X + (size_t)M_LAT * D, X, modl + 5 * D, 1.0f, PART};
                pg8::gemm_phase<EpiResid<false, false>, SchedStd>(lds, D, S, E);
            }
            SEAM(pb + 6);
        }
        const int nrows2 = first ? M_ALL : M_LAT;
        if (IN(pb + 7)) norm_phase<first, false>(lds, X, X + (size_t)M_LAT * D, X + (size_t)M_LAT * D, PART, nrows2, ng + 2 * D, modl, 6, 7, HN, tid, lane, wave);
        SEAM(pb + 7);
        if (IN(pb + 8)) {
            SchedStd S{(const char*)HN, (const char*)(p.ws + WS_WFI + (size_t)(l * 2 + 1) * WFI_STRIDE), (size_t)256 * D * 2, nrows2 / 256, 2 * DFF / 256, G, (int)blockIdx.x, D / 64};
            EpiSwiGLU E{ACT};
            pg8::gemm_phase<EpiSwiGLU, SchedStd>(lds, D, S, E);
        }
        SEAM(pb + 8);
        if (IN(pb + 9)) {
            if constexpr (first) {
                SchedDown S{(const char*)ACT, (const char*)(p.ws + WS_WFO + (size_t)(l * 2 + 1) * WFO_STRIDE), (size_t)256 * DFF * 2, G, (int)blockIdx.x, DFF / 64};
                EpiResid<false, false> E{X, X + (size_t)M_LAT * D, X, modl + 8 * D, 0.5f, PART};
                pg8::gemm_phase<EpiResid<false, false>, SchedDown>(lds, DFF, S, E);
            } else {
                SchedStd S{(const char*)ACT, (const char*)(p.ws + WS_WFO + (size_t)(l * 2 + 1) * WFO_STRIDE), (size_t)256 * DFF * 2, M_LAT / 256, D / 256, G, (int)blockIdx.x, DFF / 64};
                EpiResid<false, true> E{X, X + (size_t)M_LAT * D, p.out, modl + 8 * D, 0.5f, PART};
                pg8::gemm_phase<EpiResid<false, true>, SchedStd>(lds, DFF, S, E);
            }
        }
        SEAM(pb + 9);
}
__global__ void __launch_bounds__(512, 2) mega_fwd(Params p) {
    extern __shared__ __attribute__((aligned(16))) unsigned char lds_raw[];
    LAS unsigned char* lds = (LAS unsigned char*)lds_raw;
    volatile LAS unsigned* MISC = (volatile LAS unsigned*)(lds + MISC_OFF);
    const int tid = threadIdx.x, lane = tid & 63, wave = __builtin_amdgcn_readfirstlane(tid >> 6);
    const int G = gridDim.x;
    if (tid < 64) MISC[tid] = 0u;
    __syncthreads();
    unsigned* ctl = (unsigned*)(p.ws + WS_CTL);
#if MK_SPLIT
    XcdBarrier bar; bar.bar = ctl + CW_BAR; bar.x = 0; bar.st = MISC + 8;
#else
    XcdBarrier bar = xcd_barrier_post(ctl + CW_BAR, MISC + 8);
#endif
    const int lo = p.ph_lo, hi = p.ph_hi;
#if PROBE_MASK
    if (blockIdx.x == 0 && tid == 0) { volatile LAS unsigned long long* pw = (volatile LAS unsigned long long*)(lds + MISC_OFF + 128); pw[0] = __builtin_amdgcn_s_memrealtime(); pw[1] = 0ull; }
#endif

    float* MOD = (float*)(p.ws + WS_MOD);
    float* X = (float*)(p.ws + WS_X);
    bf16* HN = (bf16*)(p.ws + WS_HN);
    bf16* ACT = (bf16*)(p.ws + WS_ACT);
    bf16* Z = (bf16*)(p.ws + WS_Z);
    bf16* MIX = (bf16*)(p.ws + WS_MIX);

    if (IN(0)) {
#ifndef NO_WEIGHTS
        p0_weights(p, lds, lane, wave); __syncthreads();
#endif
#ifndef NO_MODVEC
        p0_modvec(p, lds, tid, lane, wave); __syncthreads();
#endif
    }
    SEAM(0);

    layer_body<0>(p, lds, bar, lo, hi);
    layer_body<1>(p, lds, bar, lo, hi);
#if PROBE_MASK
    if (blockIdx.x == 0 && tid == 0) { volatile LAS unsigned long long* pw = (volatile LAS unsigned long long*)(lds + MISC_OFF + 128); const unsigned long long t0 = __builtin_amdgcn_s_memrealtime(), dt = (unsigned long long)PROBE_MULT * pw[1];
        while (__builtin_amdgcn_s_memrealtime() - t0 < dt) __builtin_amdgcn_s_sleep(8); }
#endif
#undef IN
#undef SEAM
#undef GRID_BAR
}

extern "C" void kernel_launch(void* const* d_in, const int* in_sizes, int n_in, void* d_out, int out_size, void* d_ws, size_t ws_size, hipStream_t stream) {
    static int grid = 0;
    if (grid == 0) {
        if (n_in != 27 || in_sizes[0] != M_LAT * D || out_size != M_LAT * D || ws_size < WS_END) {
            fprintf(stderr, "kernel_launch: unexpected shapes (n_in %d, in0 %d, out %d, ws %zu; need ws >= %zu); nothing launched\n", n_in, n_in > 0 ? in_sizes[0] : -1, out_size, ws_size, (size_t)WS_END); grid = -1; return; }
        int dev = 0, cus = 0, per_cu = 0;
        if (hipGetDevice(&dev) != hipSuccess || hipDeviceGetAttribute(&cus, hipDeviceAttributeMultiprocessorCount, dev) != hipSuccess) { fprintf(stderr, "kernel_launch: device query failed\n"); grid = -1; return; }
        if (hipFuncSetAttribute((const void*)mega_fwd, hipFuncAttributeMaxDynamicSharedMemorySize, LDS_BYTES) != hipSuccess) { fprintf(stderr, "kernel_launch: hipFuncSetAttribute failed\n"); grid = -1; return; }
        if (hipOccupancyMaxActiveBlocksPerMultiprocessor(&per_cu, (const void*)mega_fwd, 512, LDS_BYTES) != hipSuccess || per_cu < 1) {
            fprintf(stderr, "kernel_launch: occupancy query reports %d workgroups per CU\n", per_cu); }
        (void)hipGetLastError();
        grid = cus;
    }
    if (grid < 0) return;
    if (hipMemsetAsync((char*)d_ws + WS_CTL, 0, CTL_ZERO_BYTES, stream) != hipSuccess) { fprintf(stderr, "kernel_launch: memset failed\n"); return; }
    Params a{};
    for (int i = 0; i < 27; ++i) a.in[i] = (const float*)d_in[i];
    a.out = (float*)d_out; a.ws = (unsigned char*)d_ws;
#if MK_SPLIT
    for (int ph = 0; ph < NPHASE; ++ph) { a.ph_lo = ph; a.ph_hi = ph + 1; hipLaunchKernelGGL(mega_fwd, dim3(grid), dim3(512), LDS_BYTES, stream, a); }
#else
    a.ph_lo = 0; a.ph_hi = NPHASE;
    hipLaunchKernelGGL(mega_fwd, dim3(grid), dim3(512), LDS_BYTES, stream, a);
#endif
    const hipError_t le = hipPeekAtLastError();
    if (le != hipSuccess) fprintf(stderr, "kernel_launch: launch failed: %s\n", hipGetErrorName(le));
}
```

```cpp
#include <hip/hip_runtime.h>
#include <cstdio>
#include <cstdint>

#ifndef MK_SPLIT
#define MK_SPLIT 0
#endif

namespace pg8 {
#define PG8_LAS __attribute__((address_space(3)))
typedef unsigned short bf16_t;
typedef short bf16x8 __attribute__((ext_vector_type(8)));
typedef float f32x4 __attribute__((ext_vector_type(4)));
typedef unsigned u32x4 __attribute__((ext_vector_type(4)));
typedef unsigned u32x2 __attribute__((ext_vector_type(2)));
typedef int v4i_t __attribute__((ext_vector_type(4)));
typedef int v8i_t __attribute__((ext_vector_type(8)));
constexpr int BM = 256, BK = 64, HALF = 128, HTB = HALF * BK * 2  , STAGE_BYTES = 8 * HTB, NXCD = 8, WGM = 8;

__host__ __device__ __forceinline__ int lds_byte(int r, int c) { const int st = (r >> 4) * 2 + (c >> 5), rr = r & 15, cc = c & 31, ob = rr * 64 + cc * 2; return st * 1024 + (ob ^ (((ob >> 9) & 1) << 5)); }
__host__ __device__ __forceinline__ void stage_rc(int b, int& R, int& C) { const int st = b / 1024, sb = b % 1024, swz = sb ^ (((sb >> 9) & 1) << 5); R = (st >> 1) * 16 + swz / 64; C = (st & 1) * 32 + (swz % 64) / 2; }
__host__ __device__ __forceinline__ int perm32(int rho) { const int n = rho >> 4, i = rho & 15; return 8 * (i >> 2) + 4 * n + (i & 3); }

struct Unit { int pm, pn, kind; };

__host__ __device__ __forceinline__ void tile_map(int wgid, int nM, int nN, int& pm, int& pn) {
    const int nwg = nM * nN;
    { const int q = nwg / NXCD, r = nwg % NXCD, xcd = wgid % NXCD, off = wgid / NXCD; wgid = (xcd < r ? xcd * (q + 1) : r * (q + 1) + (xcd - r) * q) + off; }
    const int nig = WGM * nN, gid = wgid / nig, fm = gid * WGM, gsz = (nM - fm) < WGM ? (nM - fm) : WGM;
    pm = fm + ((wgid % nig) % gsz); pn = (wgid % nig) / gsz;
}

__device__ __forceinline__ unsigned cvt_pk_bf16(float lo, float hi) { unsigned r; asm volatile("v_cvt_pk_bf16_f32 %0, %1, %2" : "=v"(r) : "v"(lo), "v"(hi)); return r; }

template <class Epi, class Sched, bool ALIGN_EPI = true, bool SP2 = true>
__device__ __forceinline__ void gemm_phase(PG8_LAS unsigned char* lds, const int K  , const Sched& S, const Epi& E) {
    const int tid = threadIdx.x, wid = __builtin_amdgcn_readfirstlane(tid >> 6), lane = tid & 63, wr = wid >> 2, wc = wid & 3, fr = lane & 15, fq = lane >> 4;
    unsigned voffA[2], voffB[2];
#pragma unroll
    for (int i = 0; i < 2; ++i) { int R, C; stage_rc(tid * 16 + i * 8192, R, C); const int Rb = Epi::PERM ? ((R & ~31) + perm32(R & 31)) : R;
        voffA[i] = (unsigned)(R * K + C) * 2u; voffB[i] = (unsigned)(Rb * K + C) * 2u; }
    const size_t kstep = (size_t)(BK * 2);
    const size_t hstep = (size_t)HALF * K * 2;
    const unsigned ldsw = (unsigned)wid * 1024u;
    const int aoff = lds_byte(wr * 64 + fr, fq * 8), boff = lds_byte(wc * 32 + fr, fq * 8);
#define PG8_SA(b, h) (((b) * 2 + (h)) * HTB)
#define PG8_SB(b, h) ((4 + (b) * 2 + (h)) * HTB)
#define PG8_STAGE(bufoff, gbase, voff) do { _Pragma("unroll") for (int _i = 0; _i < 2; ++_i) \
        __builtin_amdgcn_global_load_lds((const unsigned*)((const char*)(gbase) + (voff)[_i]), (PG8_LAS unsigned*)(lds + (bufoff) + ldsw + _i * 8192), 16, 0, 0); } while (0)
#define PG8_LDA(dst, b, h) do { _Pragma("unroll") for (int m = 0; m < 4; ++m) { if constexpr (Epi::FP8) { \
            dst##8[m] = __builtin_shufflevector(*(const PG8_LAS v4i_t*)(lds + PG8_SA(b, h) + aoff + m * 2048), *(const PG8_LAS v4i_t*)(lds + PG8_SA(b, h) + aoff + m * 2048 + 1024), 0, 1, 2, 3, 4, 5, 6, 7); } \
        else { _Pragma("unroll") for (int k = 0; k < 2; ++k) dst[m][k] = *(const PG8_LAS bf16x8*)(lds + PG8_SA(b, h) + aoff + m * 2048 + k * 1024); } } } while (0)
#define PG8_LDB(dst, b, h) do { _Pragma("unroll") for (int n = 0; n < 2; ++n) { if constexpr (Epi::FP8) { \
            dst##8[n] = __builtin_shufflevector(*(const PG8_LAS v4i_t*)(lds + PG8_SB(b, h) + boff + n * 2048), *(const PG8_LAS v4i_t*)(lds + PG8_SB(b, h) + boff + n * 2048 + 1024), 0, 1, 2, 3, 4, 5, 6, 7); } \
        else { _Pragma("unroll") for (int k = 0; k < 2; ++k) dst[n][k] = *(const PG8_LAS bf16x8*)(lds + PG8_SB(b, h) + boff + n * 2048 + k * 1024); } } } while (0)
#define PG8_MMA(ai, bj, At, Bt) do { __builtin_amdgcn_s_setprio(1); \
        if constexpr (Epi::FP8) { _Pragma("unroll") for (int m = 0; m < 4; ++m) _Pragma("unroll") for (int n = 0; n < 2; ++n) \
            asm volatile("v_mfma_scale_f32_16x16x128_f8f6f4 %0, %1, %2, %0, %3, %3 op_sel_hi:[0,0,0]" : "+v"(acc[ai][bj][m][n]) : "v"(Bt##8[n]), "v"(At##8[m]), "v"(one_scale)); } \
        else { _Pragma("unroll") for (int m = 0; m < 4; ++m) _Pragma("unroll") for (int n = 0; n < 2; ++n) _Pragma("unroll") for (int k = 0; k < 2; ++k) \
            acc[ai][bj][m][n] = __builtin_amdgcn_mfma_f32_16x16x32_bf16(Bt[n][k], At[m][k], acc[ai][bj][m][n], 0, 0, 0); } \
        __builtin_amdgcn_s_setprio(0); } while (0)
#define PG8_WAIT_V(n) asm volatile("s_waitcnt vmcnt(" #n ")" ::: "memory")
#define PG8_WAIT_L(n) asm volatile("s_waitcnt lgkmcnt(" #n ")" ::: "memory")
#define PG8_BAR __builtin_amdgcn_s_barrier()
#define PG8_SCHED __builtin_amdgcn_sched_barrier(0)
    Unit cur, nxt; int ui = 0;
    if (!S.next(0, cur)) return;
    f32x4 acc[2][2][4][2];
#pragma unroll
    for (int a = 0; a < 2; ++a)
#pragma unroll
        for (int b = 0; b < 2; ++b)
#pragma unroll
            for (int m = 0; m < 4; ++m)
#pragma unroll
                for (int n = 0; n < 2; ++n) acc[a][b][m][n] = (f32x4){0.f, 0.f, 0.f, 0.f};
    bf16x8 At[4][2], B0[2][2], B1[2][2];
    v8i_t At8[4], B08[2], B18[2];
    int one_scale = 0x7f7f7f7f; asm volatile("" : "+v"(one_scale));
    const char* cA = S.a_base(cur); const char* cB = S.b_base(cur);
    if constexpr (SP2) {
        PG8_STAGE(PG8_SB(0, 0), cB, voffB); PG8_STAGE(PG8_SB(0, 1), cB + hstep, voffB); PG8_STAGE(PG8_SA(0, 0), cA, voffA); PG8_STAGE(PG8_SA(0, 1), cA + hstep, voffA);
        if (wr == 1) PG8_BAR;
        PG8_WAIT_V(2); PG8_BAR;
        PG8_STAGE(PG8_SB(1, 0), cB + kstep, voffB); PG8_STAGE(PG8_SA(1, 0), cA + kstep, voffA); PG8_STAGE(PG8_SB(1, 1), cB + hstep + kstep, voffB);
        PG8_WAIT_V(6); PG8_BAR;
    } else {
        PG8_STAGE(PG8_SB(0, 0), cB, voffB); PG8_STAGE(PG8_SA(0, 0), cA, voffA); PG8_STAGE(PG8_SB(0, 1), cB + hstep, voffB); PG8_STAGE(PG8_SA(0, 1), cA + hstep, voffA);
        if (wr == 1) PG8_BAR;
        PG8_WAIT_V(4); PG8_BAR;
        PG8_STAGE(PG8_SB(1, 0), cB + kstep, voffB); PG8_STAGE(PG8_SA(1, 0), cA + kstep, voffA); PG8_STAGE(PG8_SB(1, 1), cB + hstep + kstep, voffB);
        PG8_WAIT_V(6); PG8_BAR;
    }
    for (;;) {
        const bool has_next = S.next(ui + 1, nxt);
        const int nt = S.nt(cur);
        const char* nA = has_next ? S.a_base(nxt) : cA; const char* nB = has_next ? S.b_base(nxt) : cB;
        for (int t = 0; t < nt; t += 2) {
            const bool last = (t == nt - 2);
            const char* a1 = cA + (size_t)(t + 1) * kstep;
            const char* a2 = last ? nA : cA + (size_t)(t + 2) * kstep; const char* b2 = last ? nB : cB + (size_t)(t + 2) * kstep;
            const char* a3 = a2 + kstep; const char* b3 = b2 + kstep;
            if constexpr (SP2) {
            PG8_LDB(B0, 0, 0); PG8_LDB(B1, 0, 1); PG8_SCHED; PG8_LDA(At, 0, 0); PG8_STAGE(PG8_SA(1, 1), a1 + hstep, voffA);
            PG8_WAIT_V(8); PG8_WAIT_L(0); PG8_BAR; PG8_MMA(0, 0, At, B0); PG8_MMA(0, 1, At, B1); PG8_BAR; PG8_SCHED;
            PG8_LDA(At, 0, 1); PG8_STAGE(PG8_SB(0, 0), b2, voffB); PG8_STAGE(PG8_SB(0, 1), b2 + hstep, voffB); PG8_STAGE(PG8_SA(0, 0), a2, voffA);
            PG8_WAIT_V(8); PG8_WAIT_L(0); PG8_BAR; PG8_MMA(1, 0, At, B0); PG8_MMA(1, 1, At, B1); PG8_BAR; PG8_SCHED;
            PG8_LDB(B0, 1, 0); PG8_LDB(B1, 1, 1); PG8_SCHED; PG8_LDA(At, 1, 0); PG8_STAGE(PG8_SA(0, 1), a2 + hstep, voffA);
            PG8_WAIT_V(8); PG8_WAIT_L(0); PG8_BAR; PG8_MMA(0, 0, At, B0); PG8_MMA(0, 1, At, B1); PG8_BAR; PG8_SCHED;
            PG8_LDA(At, 1, 1); PG8_STAGE(PG8_SB(1, 0), b3, voffB); PG8_STAGE(PG8_SB(1, 1), b3 + hstep, voffB); PG8_STAGE(PG8_SA(1, 0), a3, voffA);
            PG8_WAIT_V(8); PG8_WAIT_L(0); PG8_BAR; PG8_MMA(1, 0, At, B0); PG8_MMA(1, 1, At, B1); PG8_BAR; PG8_SCHED;
            } else {
            PG8_LDB(B0, 0, 0); PG8_SCHED; PG8_LDA(At, 0, 0); PG8_STAGE(PG8_SA(1, 1), a1 + hstep, voffA);
            PG8_WAIT_L(8); PG8_BAR; PG8_WAIT_L(0); PG8_MMA(0, 0, At, B0); PG8_BAR; PG8_SCHED;
            PG8_LDB(B1, 0, 1); PG8_STAGE(PG8_SB(0, 0), b2, voffB);
            PG8_BAR; PG8_WAIT_L(0); PG8_MMA(0, 1, At, B1); PG8_BAR;
            PG8_LDA(At, 0, 1); PG8_STAGE(PG8_SA(0, 0), a2, voffA);
            PG8_BAR; PG8_WAIT_L(0); PG8_MMA(1, 0, At, B0); PG8_BAR; PG8_SCHED;
            PG8_STAGE(PG8_SB(0, 1), b2 + hstep, voffB);
            PG8_WAIT_V(6); PG8_BAR; PG8_MMA(1, 1, At, B1); PG8_BAR;
            PG8_LDB(B0, 1, 0); PG8_SCHED; PG8_LDA(At, 1, 0); PG8_STAGE(PG8_SA(0, 1), a2 + hstep, voffA);
            PG8_WAIT_L(8); PG8_BAR; PG8_WAIT_L(0); PG8_MMA(0, 0, At, B0); PG8_BAR; PG8_SCHED;
            PG8_LDB(B1, 1, 1); PG8_STAGE(PG8_SB(1, 0), b3, voffB);
            PG8_BAR; PG8_WAIT_L(0); PG8_MMA(0, 1, At, B1); PG8_BAR;
            PG8_LDA(At, 1, 1); PG8_STAGE(PG8_SA(1, 0), a3, voffA);
            PG8_BAR; PG8_WAIT_L(0); PG8_MMA(1, 0, At, B0); PG8_BAR; PG8_SCHED;
            PG8_STAGE(PG8_SB(1, 1), b3 + hstep, voffB);
            PG8_WAIT_V(6); PG8_BAR; PG8_MMA(1, 1, At, B1); PG8_BAR;
            }
        }
        if constexpr (Epi::FP8) asm volatile("s_nop 15\n\ts_nop 15\n\ts_nop 15\n\ts_nop 15\n\ts_nop 15" ::: "memory");
        if constexpr (ALIGN_EPI) { if (wr == 0) PG8_BAR; }
        E(acc, cur, wr, wc, fr, fq);
        if (!has_next) break;
#pragma unroll
        for (int a = 0; a < 2; ++a)
#pragma unroll
            for (int b = 0; b < 2; ++b)
#pragma unroll
                for (int m = 0; m < 4; ++m)
#pragma unroll
                    for (int n = 0; n < 2; ++n) acc[a][b][m][n] = (f32x4){0.f, 0.f, 0.f, 0.f};
        cur = nxt; cA = nA; cB = nB; ++ui;
        if constexpr (ALIGN_EPI) { if (wr == 1) PG8_BAR; }
    }
    PG8_WAIT_V(0);
    if constexpr (!ALIGN_EPI) { if (wr == 0) PG8_BAR; }
    PG8_BAR;
#undef PG8_SA
#undef PG8_SB
#undef PG8_STAGE
#undef PG8_LDA
#undef PG8_LDB
#undef PG8_MMA
#undef PG8_WAIT_V
#undef PG8_WAIT_L
#undef PG8_BAR
#undef PG8_SCHED
}
}

constexpr int D = 2048, NBATCH = 8, SEQ = 2048, CTXL = 256, DFF = 5632, NMODV = 9, DMODW = NMODV * D  ;
constexpr int M_LAT = NBATCH * SEQ  , M_CTX = NBATCH * CTXL  , M_ALL = M_LAT + M_CTX  ;
constexpr int NH = 16, HD = 64, GW = 64  , GROWS = SEQ / GW  , WIN_R = 8, WIN_C = 16;
constexpr int D_EIN = 5120, D_OIN = 5120, ZE_LD = 3072  , ZO_LD = 5120;
constexpr float EPS = 1e-6f;
constexpr float ACT8_SCALE = 8.0f, W8_SCALE = 1024.0f;
constexpr int NPHASE = 21;

constexpr size_t MiB = 1u << 20;
constexpr size_t WS_CTL = 0, CTL_ZERO_BYTES = 1 * MiB;
constexpr size_t WS_MOD = 1 * MiB;
constexpr size_t WS_WFI = 4 * MiB, WFI_STRIDE = 44 * MiB;
constexpr size_t WS_WFO = 180 * MiB, WFO_STRIDE = 22 * MiB;
constexpr size_t WS_WEI = 268 * MiB, WS_WEO = 288 * MiB, WS_WOI = 296 * MiB, WS_WOO = 316 * MiB;
constexpr size_t WS_X = 324 * MiB;
constexpr size_t WS_HN = 468 * MiB;
constexpr size_t WS_ACT = 540 * MiB;
constexpr size_t WS_Z = 738 * MiB;
constexpr size_t WS_MIX = 918 * MiB;
constexpr size_t WS_VT = 990 * MiB;
constexpr size_t WS_HF = 1026 * MiB;
constexpr size_t WS_PART = 1090 * MiB, PART_STRIDE = 16 * MiB;
constexpr size_t WS_KF = 1138 * MiB;
constexpr size_t WS_END = 1174 * MiB;
constexpr int CW_BAR = 4096;
constexpr int CW_Q = 8192;

constexpr int RING_BYTES = 131072;
constexpr int LDS_BYTES = 163840;
constexpr int MISC_OFF = LDS_BYTES - 256;

#define GAS __attribute__((address_space(1)))
#define LAS __attribute__((address_space(3)))
typedef unsigned short bf16;
typedef float f32x4 __attribute__((ext_vector_type(4)));
typedef float f32x2 __attribute__((ext_vector_type(2)));
typedef unsigned u32x4 __attribute__((ext_vector_type(4)));
typedef unsigned u32x2 __attribute__((ext_vector_type(2)));
typedef short bf16x8 __attribute__((ext_vector_type(8)));
#define LDS_WAIT() asm volatile("s_waitcnt lgkmcnt(0)" ::: "memory")
#define VM_WAIT() asm volatile("s_waitcnt vmcnt(0)" ::: "memory")
__device__ __forceinline__ unsigned f2bf(float f) { unsigned u = __builtin_bit_cast(unsigned, f); return (u + 0x7fffu + ((u >> 16) & 1u)) >> 16; }
__device__ __forceinline__ unsigned pk2(float lo, float hi) { return f2bf(lo) | (f2bf(hi) << 16); }
__device__ __forceinline__ float bf_lo(unsigned v) { return __builtin_bit_cast(float, v << 16); }
__device__ __forceinline__ float bf_hi(unsigned v) { return __builtin_bit_cast(float, v & 0xffff0000u); }
__device__ __forceinline__ float bf2f(bf16 v) { return __builtin_bit_cast(float, (unsigned)v << 16); }
typedef _Float16 f16x4 __attribute__((ext_vector_type(4)));
typedef _Float16 f16x8 __attribute__((ext_vector_type(8)));
typedef float f32x8 __attribute__((ext_vector_type(8)));
__device__ __forceinline__ u32x2 f32x4_to_h4(f32x4 v) { return __builtin_bit_cast(u32x2, __builtin_convertvector(v, f16x4)); }
__device__ __forceinline__ f32x4 h4_to_f32x4(u32x2 v) { return __builtin_convertvector(__builtin_bit_cast(f16x4, v), f32x4); }
__device__ __forceinline__ float clamp448(float x) { return __builtin_fminf(__builtin_fmaxf(x, -448.0f), 448.0f); }
__device__ __forceinline__ unsigned pk4_fp8(float a, float b, float c, float d) {
    unsigned w = 0u; w = __builtin_amdgcn_cvt_pk_fp8_f32(clamp448(a), clamp448(b), w, false); w = __builtin_amdgcn_cvt_pk_fp8_f32(clamp448(c), clamp448(d), w, true); return w; }
__device__ __forceinline__ float fast_sigmoid(float x) { return __builtin_amdgcn_rcpf(1.0f + __builtin_amdgcn_exp2f(-1.44269504089f * x)); }
__device__ __forceinline__ void lds_barrier() { asm volatile("s_waitcnt lgkmcnt(0)" ::: "memory"); __builtin_amdgcn_s_barrier(); asm volatile("" ::: "memory"); }
#define DPP_ADD_(v, ctrl, rmask) ((v) + __builtin_bit_cast(float, __builtin_amdgcn_update_dpp(0, __builtin_bit_cast(int, (v)), (ctrl), (rmask), 0xf, false)))
__device__ __forceinline__ float wave_sum_dpp(float v) {
    v = DPP_ADD_(v, 0xB1, 0xf);
    v = DPP_ADD_(v, 0x4E, 0xf);
    v = DPP_ADD_(v, 0x141, 0xf);
    v = DPP_ADD_(v, 0x140, 0xf);
    v = DPP_ADD_(v, 0x142, 0xa);
    v = DPP_ADD_(v, 0x143, 0xc);
    return __builtin_bit_cast(float, __builtin_amdgcn_readlane(__builtin_bit_cast(int, v), 63));
}
__device__ __forceinline__ float wave_sum(float v) {
#pragma unroll
    for (int o = 1; o < 64; o <<= 1) v += __shfl_xor(v, o);
    return v;
}

#define XB_TMO      128
#define XB_XCNT(j)  (256  + 64 * (j))
#define XB_XSUB(j)  (1280 + 64 * (j))
#define XB_XGEN(j)  (2304 + 64 * (j))
#define XB_TOP      3328
#define XB_TOPGEN   3392
#define XCD_BAR_WORDS 3456
#define XB_SPIN_CAP (1u << 18)

__device__ __forceinline__ unsigned xb_ld(unsigned* p)              { return __hip_atomic_load(p, __ATOMIC_RELAXED, __HIP_MEMORY_SCOPE_AGENT); }
__device__ __forceinline__ unsigned xb_add(unsigned* p, unsigned v) { return __hip_atomic_fetch_add(p, v, __ATOMIC_RELAXED, __HIP_MEMORY_SCOPE_AGENT); }
__device__ __forceinline__ unsigned xb_xcc_id() { return (unsigned)__builtin_amdgcn_s_getreg((3 << 11) | 20) & 0xFu; }
#define XB_SPIN(cond, bar) do { unsigned _sp = 0; while (cond) { __builtin_amdgcn_s_sleep(1); \
    if ((++_sp & 255u) == 0u) { if (xb_ld(&(bar)[XB_TMO])) break; if (_sp > XB_SPIN_CAP) { atomicAdd(&(bar)[XB_TMO], 1u); break; } } } } while (0)

struct XcdBarrier {
    unsigned* bar; unsigned x;
    volatile LAS unsigned* st;
};

__device__ __forceinline__ XcdBarrier xcd_barrier_post(unsigned* bar, volatile LAS unsigned* st) {
    XcdBarrier b; b.bar = bar; b.x = xb_xcc_id(); b.st = st;
    if (threadIdx.x == 0) (void)xb_add(&bar[XB_XCNT(b.x)], 1u);
    return b;
}
__device__ __forceinline__ void xcd_barrier_complete(unsigned* bar, unsigned x, unsigned& nloc, unsigned& nx) {
    const unsigned G = gridDim.x * gridDim.y * gridDim.z;
    unsigned sum, cnt, mine, sp = 0u;
    for (;;) {
        sum = 0u; cnt = 0u; mine = 0u;
#pragma unroll
        for (unsigned j = 0; j < 16; ++j) { const unsigned c = xb_ld(&bar[XB_XCNT(j)]); sum += c; cnt += (c > 0u) ? 1u : 0u; mine = (j == x) ? c : mine; }
        if (sum == G) break;
        __builtin_amdgcn_s_sleep(1);
        if ((++sp & 255u) == 0u) { if (xb_ld(&bar[XB_TMO])) break; if (sp > XB_SPIN_CAP) { atomicAdd(&bar[XB_TMO], 1u); break; } }
    }
    nloc = mine > 0u ? mine : 1u; nx = cnt > 0u ? cnt : 1u;
}

__device__ __forceinline__ void xcd_barrier(const XcdBarrier& b) {
    asm volatile("s_waitcnt vmcnt(0)" ::: "memory");
    __syncthreads();
    if (threadIdx.x == 0) {
        unsigned* bar = b.bar;
        __builtin_amdgcn_s_waitcnt(0);
        unsigned nloc = b.st[0], nx = b.st[1];
        if (nloc == 0u) { xcd_barrier_complete(bar, b.x, nloc, nx); b.st[0] = nloc; b.st[1] = nx; }
        const unsigned old = xb_add(&bar[XB_XSUB(b.x)], 1u);
        const unsigned gen = old / nloc;
        if (old + 1u == (gen + 1u) * nloc) {
            __builtin_amdgcn_fence(__ATOMIC_RELEASE, "agent");
            asm volatile("s_waitcnt vmcnt(0)" ::: "memory");
            const unsigned og = xb_add(&bar[XB_TOP], 1u);
            const unsigned tg = og / nx;
            if (og + 1u == (tg + 1u) * nx) xb_add(&bar[XB_TOPGEN], 1u);
            else XB_SPIN(xb_ld(&bar[XB_TOPGEN]) == tg, bar);
            __builtin_amdgcn_fence(__ATOMIC_ACQUIRE, "agent");
            xb_add(&bar[XB_XGEN(b.x)], 1u);
            asm volatile("s_waitcnt vmcnt(0)" ::: "memory");
        } else {
            XB_SPIN(xb_ld(&bar[XB_XGEN(b.x)]) == gen, bar);
            __builtin_amdgcn_fence(__ATOMIC_ACQUIRE, "agent");
            asm volatile("s_waitcnt vmcnt(0)" ::: "memory");
        }
    }
    __syncthreads();
}

struct Params {
    const float* in[27];
    float* out;
    unsigned char* ws;
    int ph_lo, ph_hi;
};
enum { IN_X = 0, IN_C, IN_CTX, IN_CCTX, IN_WMOD, IN_BMOD, IN_NORMG, IN_FWI, IN_FWO, IN_EWI, IN_SCW, IN_SCB, IN_CCW, IN_CCB, IN_LNG, IN_LNB, IN_EWO,
       IN_OWI, IN_QG, IN_KG, IN_RPB, IN_LCW, IN_LCB, IN_LGW, IN_LGB, IN_LAM, IN_OWO };

struct SchedStd {
    const char* A; const char* Bt; size_t tstep; int nM, nN, G, c, ntiles;
    __device__ __forceinline__ int nt(const pg8::Unit&) const { return ntiles; }
    __device__ __forceinline__ bool next(int i, pg8::Unit& u) const {
        const long L = (long)i * G + c; if (L >= (long)nM * nN) return false;
        pg8::tile_map((int)L, nM, nN, u.pm, u.pn); u.kind = 0; return true;
    }
    __device__ __forceinline__ const char* a_base(const pg8::Unit& u) const { return A + (size_t)u.pm * tstep; }
    __device__ __forceinline__ const char* b_base(const pg8::Unit& u) const { return Bt + (size_t)u.pn * tstep; }
};

struct SchedDown {
    const char* A; const char* Bt; size_t tstep; int G, c, ntiles;
    __device__ __forceinline__ bool next(int i, pg8::Unit& u) const {
        const long L = (long)i * G + c;
        if (L < 512) { pg8::tile_map((int)L, 64, 8, u.pm, u.pn); u.kind = 0; return true; }
        if (L < 768) { const int q = (int)L - 512, t = q & 63; u.pm = 64 + (t >> 3); u.pn = t & 7; u.kind = 1 + (q >> 6); return true; }
        return false;
    }
    __device__ __forceinline__ int q_nt(int kp) const { const int h = ntiles / 4; return (h & 1) ? ((kp & 1) ? h - 1 : h + 1) : h; }
    __device__ __forceinline__ int q_off(int kp) const { const int h = ntiles / 4; return kp * h + (((h & 1) && (kp & 1)) ? 1 : 0); }
    __device__ __forceinline__ int nt(const pg8::Unit& u) const { return u.kind == 0 ? ntiles : q_nt(u.kind - 1); }
    __device__ __forceinline__ const char* a_base(const pg8::Unit& u) const { return A + (size_t)u.pm * tstep + (u.kind > 1 ? (size_t)q_off(u.kind - 1) * 128 : 0); }
    __device__ __forceinline__ const char* b_base(const pg8::Unit& u) const { return Bt + (size_t)u.pn * tstep + (u.kind > 1 ? (size_t)q_off(u.kind - 1) * 128 : 0); }
};
struct SchedOdIn {
    const char* HN; const char* W; size_t tstep; int G, c;
    __device__ __forceinline__ int nt(const pg8::Unit&) const { return D / 64; }
    __device__ __forceinline__ bool next(int i, pg8::Unit& u) const {
        const long L = (long)i * G + c;
        if (L < 72 * 16) { int pm, pnv; pg8::tile_map((int)L, 72, 16, pm, pnv); u.pm = pm; u.pn = pnv < 8 ? pnv : pnv + 4; u.kind = 0; return true; }
        if (L < 72 * 16 + 4 * 72) { int pm, pn; pg8::tile_map((int)L - 72 * 16, 4, 72, pm, pn); u.pm = pm; u.pn = pn; u.kind = 1; return true; }
        return false;
    }
    __device__ __forceinline__ const char* a_base(const pg8::Unit& u) const { return u.kind == 0 ? HN + (size_t)u.pm * tstep : W + (size_t)(8 + u.pm) * tstep; }
    __device__ __forceinline__ const char* b_base(const pg8::Unit& u) const { return u.kind == 0 ? W + (size_t)u.pn * tstep : HN + (size_t)u.pn * tstep; }
};

struct EpiSwiGLU {
    static constexpr bool PERM = true; static constexpr bool FP8 = false;
    unsigned char* O;
    __device__ __forceinline__ void operator()(const f32x4 (&acc)[2][2][4][2], const pg8::Unit& u, int wr, int wc, int fr, int fq) const {
        const int row0 = u.pm * 256 + wr * 64 + fr, col0 = u.pn * 128 + wc * 32 + 8 * fq;
#pragma unroll
        for (int ai = 0; ai < 2; ++ai)
#pragma unroll
            for (int m = 0; m < 4; ++m) {
                unsigned char* rowp = O + (size_t)(row0 + ai * 128 + m * 16) * DFF + col0;
                float v[8];
#pragma unroll
                for (int n = 0; n < 2; ++n)
#pragma unroll
                    for (int j = 0; j < 4; ++j) { const float g = acc[ai][0][m][n][j], up = acc[ai][1][m][n][j]; v[4 * n + j] = g * fast_sigmoid(g) * up * ACT8_SCALE; }
                u32x2 w; w.x = pk4_fp8(v[0], v[1], v[2], v[3]); w.y = pk4_fp8(v[4], v[5], v[6], v[7]);
                *(u32x2*)rowp = w;
            }
    }
};
template <bool BASE_F32, bool OUT_F32, bool FP8_ = false>
struct EpiResid {
    static constexpr bool PERM = true; static constexpr bool FP8 = FP8_;
    const void* base_lat; const void* base_ctx; void* out; const float* gate; float coef; float* part;
    __device__ __forceinline__ void operator()(const f32x4 (&acc)[2][2][4][2], const pg8::Unit& u, int wr, int wc, int fr, int fq) const {
        const float coef = __builtin_bit_cast(float, __builtin_amdgcn_readfirstlane(__builtin_bit_cast(int, this->coef)));
        GAS float* const part = (GAS float*)(((unsigned long long)(unsigned)__builtin_amdgcn_readfirstlane((int)((unsigned long long)this->part >> 32)) << 32) | (unsigned)__builtin_amdgcn_readfirstlane((int)(unsigned long long)this->part));
        const int row0 = u.pm * 256 + wr * 64 + fr, col0 = u.pn * 256 + wc * 32 + 8 * fq;
        const int r = u.pm < 64 ? (u.pm >> 3) : 8;
        const float* gv = gate + (size_t)r * DMODW + col0;
        f32x4 gvv[2][2];
#pragma unroll
        for (int bj = 0; bj < 2; ++bj)
#pragma unroll
            for (int n = 0; n < 2; ++n) gvv[bj][n] = *(const f32x4*)(gv + bj * 128 + 4 * n) * coef;
        if (u.kind >= 2) {
            GAS float* op = part + (size_t)(u.kind - 2) * (PART_STRIDE / 4) + (size_t)(row0 - M_LAT) * D + col0;
#pragma unroll
            for (int ai = 0; ai < 2; ++ai)
#pragma unroll
                for (int m = 0; m < 4; ++m) { const size_t ro = (size_t)(ai * 128 + m * 16) * D;
#pragma unroll
                    for (int bj = 0; bj < 2; ++bj)
#pragma unroll
                        for (int n = 0; n < 2; ++n) *(GAS f32x4*)(op + ro + bj * 128 + 4 * n) = gvv[bj][n] * acc[ai][bj][m][n]; }
            return;
        }
        const size_t eo = (u.pm < 64 ? (size_t)row0 : (size_t)(row0 - M_LAT)) * D + col0;
        const void* bsel = u.pm < 64 ? base_lat : base_ctx;
        const size_t oo = (size_t)row0 * D + col0;
        if constexpr (!BASE_F32) {
            u32x4 hb[2][4][2];
#pragma unroll
            for (int ai = 0; ai < 2; ++ai)
#pragma unroll
                for (int m = 0; m < 4; ++m)
#pragma unroll
                    for (int bj = 0; bj < 2; ++bj) hb[ai][m][bj] = *(const u32x4*)((const _Float16*)bsel + eo + (size_t)(ai * 128 + m * 16) * D + bj * 128);
#pragma unroll
            for (int ai = 0; ai < 2; ++ai)
#pragma unroll
                for (int m = 0; m < 4; ++m)
#pragma unroll
                    for (int bj = 0; bj < 2; ++bj) { const size_t ro = (size_t)(ai * 128 + m * 16) * D + bj * 128; const u32x4 hv = hb[ai][m][bj];
                        const f32x4 v0 = h4_to_f32x4((u32x2){hv.x, hv.y}) + gvv[bj][0] * acc[ai][bj][m][0], v1 = h4_to_f32x4((u32x2){hv.z, hv.w}) + gvv[bj][1] * acc[ai][bj][m][1];
                        if constexpr (OUT_F32) { *(f32x4*)((float*)out + oo + ro) = v0; *(f32x4*)((float*)out + oo + ro + 4) = v1; }
                        else { const u32x2 h0 = f32x4_to_h4(v0), h1 = f32x4_to_h4(v1); *(u32x4*)((_Float16*)out + oo + ro) = (u32x4){h0.x, h0.y, h1.x, h1.y}; } }
        } else {
#pragma unroll
            for (int ai = 0; ai < 2; ++ai)
#pragma unroll
                for (int mh = 0; mh < 2; ++mh) {
                    f32x4 b[2][2][2];
#pragma unroll
                    for (int mm = 0; mm < 2; ++mm)
#pragma unroll
                        for (int bj = 0; bj < 2; ++bj) { const size_t ro = (size_t)(ai * 128 + (2 * mh + mm) * 16) * D + bj * 128;
                            b[mm][bj][0] = *(const f32x4*)((const float*)bsel + eo + ro); b[mm][bj][1] = *(const f32x4*)((const float*)bsel + eo + ro + 4); }
#pragma unroll
                    for (int mm = 0; mm < 2; ++mm)
#pragma unroll
                        for (int bj = 0; bj < 2; ++bj) { const size_t ro = (size_t)(ai * 128 + (2 * mh + mm) * 16) * D + bj * 128;
                            const f32x4 v0 = b[mm][bj][0] + gvv[bj][0] * acc[ai][bj][2 * mh + mm][0], v1 = b[mm][bj][1] + gvv[bj][1] * acc[ai][bj][2 * mh + mm][1];
                            if constexpr (OUT_F32) { *(f32x4*)((float*)out + oo + ro) = v0; *(f32x4*)((float*)out + oo + ro + 4) = v1; }
                            else { const u32x2 h0 = f32x4_to_h4(v0), h1 = f32x4_to_h4(v1); *(u32x4*)((_Float16*)out + oo + ro) = (u32x4){h0.x, h0.y, h1.x, h1.y}; } }
                    asm volatile("" ::: "memory");
                }
        }
    }
};
struct EpiEvIn {
    static constexpr bool PERM = true; static constexpr bool FP8 = false;
    bf16* O;
    __device__ __forceinline__ void operator()(const f32x4 (&acc)[2][2][4][2], const pg8::Unit& u, int wr, int wc, int fr, int fq) const {
        const int row0 = u.pm * 256 + wr * 64 + fr;
        if (u.pn < 4) {
            const int col0 = u.pn * 256 + wc * 32 + 8 * fq;
#pragma unroll
            for (int ai = 0; ai < 2; ++ai)
#pragma unroll
                for (int m = 0; m < 4; ++m) { bf16* rowp = O + (size_t)(row0 + ai * 128 + m * 16) * ZE_LD + col0;
#pragma unroll
                    for (int bj = 0; bj < 2; ++bj) { const f32x4 v0 = acc[ai][bj][m][0], v1 = acc[ai][bj][m][1];
                        u32x4 w; w.x = pg8::cvt_pk_bf16(v0[0], v0[1]); w.y = pg8::cvt_pk_bf16(v0[2], v0[3]); w.z = pg8::cvt_pk_bf16(v1[0], v1[1]); w.w = pg8::cvt_pk_bf16(v1[2], v1[3]);
                        *(u32x4*)(rowp + bj * 128) = w; } }
        } else {
            const bool glu = u.pn >= 12;
            const int col0 = (glu ? 2048 + (u.pn - 12) * 128 : 1024 + (u.pn - 4) * 128) + wc * 32 + 8 * fq;
#pragma unroll
            for (int ai = 0; ai < 2; ++ai)
#pragma unroll
                for (int m = 0; m < 4; ++m) { bf16* rowp = O + (size_t)(row0 + ai * 128 + m * 16) * ZE_LD + col0;
                    float v[8];
#pragma unroll
                    for (int n = 0; n < 2; ++n)
#pragma unroll
                        for (int j = 0; j < 4; ++j) { const float a = acc[ai][0][m][n][j], b = acc[ai][1][m][n][j]; v[4 * n + j] = glu ? a * fast_sigmoid(b) : a * b; }
                    u32x4 w; w.x = pg8::cvt_pk_bf16(v[0], v[1]); w.y = pg8::cvt_pk_bf16(v[2], v[3]); w.z = pg8::cvt_pk_bf16(v[4], v[5]); w.w = pg8::cvt_pk_bf16(v[6], v[7]);
                    *(u32x4*)rowp = w; }
        }
    }
};
struct EpiOdIn {
    static constexpr bool PERM = true; static constexpr bool FP8 = false;
    bf16* ZO; u32x4* KF; u32x2* VF; const float* qg; const float* kg;
    __device__ __forceinline__ void operator()(const f32x4 (&acc)[2][2][4][2], const pg8::Unit& u, int wr, int wc, int fr, int fq) const {
        const int row0 = u.pm * 256 + wr * 64 + fr;
        if (u.kind == 0 && u.pn < 8) {
            const bool isq = u.pn < 4;
            const float* gp = (isq ? qg : kg) + 8 * fq;
            f32x4 gn[2][2];
#pragma unroll
            for (int bj = 0; bj < 2; ++bj)
#pragma unroll
                for (int n = 0; n < 2; ++n) gn[bj][n] = *(const f32x4*)(gp + 32 * bj + 4 * n);
            const float sc = isq ? 0.125f * 1.44269504089f : 1.0f;
            const int col0 = u.pn * 256 + wc * 64 + 8 * fq, hh = 4 * (u.pn & 3) + wc;
#pragma unroll
            for (int ai = 0; ai < 2; ++ai)
#pragma unroll
                for (int m = 0; m < 4; ++m) {
                    float ss = 0.f;
#pragma unroll
                    for (int bj = 0; bj < 2; ++bj)
#pragma unroll
                        for (int n = 0; n < 2; ++n) { const f32x4 v = acc[ai][bj][m][n]; ss += (v[0] * v[0] + v[1] * v[1]) + (v[2] * v[2] + v[3] * v[3]); }
                    ss += __shfl_xor(ss, 16); ss += __shfl_xor(ss, 32);
                    const float rs = sc / sqrtf(ss * (1.0f / HD) + EPS);
                    const int row = row0 + ai * 128 + m * 16;
                    bf16* rowp = ZO + (size_t)row * ZO_LD + col0;
                    u32x4* kfp = KF + ((size_t)((row >> 4) * 16 + hh) * 8 + fq) * 16 + (row & 15);
#pragma unroll
                    for (int bj = 0; bj < 2; ++bj) { const f32x4 v0 = acc[ai][bj][m][0] * rs * gn[bj][0], v1 = acc[ai][bj][m][1] * rs * gn[bj][1];
                        u32x4 w; w.x = pg8::cvt_pk_bf16(v0[0], v0[1]); w.y = pg8::cvt_pk_bf16(v0[2], v0[3]); w.z = pg8::cvt_pk_bf16(v1[0], v1[1]); w.w = pg8::cvt_pk_bf16(v1[2], v1[3]);
                        if (isq) *(u32x4*)(rowp + bj * 32) = w; else kfp[bj * 64] = w; }
                }
            return;
        }
        if (u.kind == 1) {
#pragma unroll
            for (int ai = 0; ai < 2; ++ai)
#pragma unroll
                for (int m = 0; m < 4; ++m) { const int ch = row0 + ai * 128 + m * 16;
#pragma unroll
                    for (int bj = 0; bj < 2; ++bj)
#pragma unroll
                        for (int n = 0; n < 2; ++n) { const int t = u.pn * 256 + bj * 128 + wc * 32 + 8 * fq + 4 * n; const f32x4 v = acc[ai][bj][m][n];
                            u32x2 w; w.x = pg8::cvt_pk_bf16(v[0], v[1]); w.y = pg8::cvt_pk_bf16(v[2], v[3]);
                            VF[((size_t)(((t >> 4) * 16 + (ch >> 6)) * 4 + ((ch >> 4) & 3)) * 4 + ((t >> 2) & 3)) * 16 + (ch & 15)] = w; } }
            return;
        }
        const int col0 = u.pn * 256 + wc * 32 + 8 * fq;
#pragma unroll
        for (int ai = 0; ai < 2; ++ai)
#pragma unroll
            for (int m = 0; m < 4; ++m) { bf16* rowp = ZO + (size_t)(row0 + ai * 128 + m * 16) * ZO_LD + col0;
#pragma unroll
                for (int bj = 0; bj < 2; ++bj) { const f32x4 v0 = acc[ai][bj][m][0], v1 = acc[ai][bj][m][1];
                    u32x4 w; w.x = pg8::cvt_pk_bf16(v0[0], v0[1]); w.y = pg8::cvt_pk_bf16(v0[2], v0[3]); w.z = pg8::cvt_pk_bf16(v1[0], v1[1]); w.w = pg8::cvt_pk_bf16(v1[2], v1[3]);
                    *(u32x4*)(rowp + bj * 128) = w; } }
    }
};

__device__ __forceinline__ int srccol(int map, int n) {
    if (map == 0) return n;
    const int pn = n >> 8, bj = (n >> 7) & 1, i = n & 127;
    if (map == 1) return bj * DFF + 128 * pn + i;
    if (map == 2) {
        if (pn < 4) return n;
        if (pn < 12) return 1024 + bj * 1024 + 128 * (pn - 4) + i;
        return 3072 + bj * 1024 + 128 * (pn - 12) + i;
    }
    if (pn < 8) return 256 * pn + 64 * ((n >> 5) & 3) + 32 * bj + (n & 31);
    return n;
}
constexpr int TR_FI = (D / 64) * (2 * DFF / 64), TR_FO = (DFF / 64) * (D / 64), TR_IN = (D / 64) * (D_EIN / 64), TR_OUT = (D / 64) * (D / 64);
constexpr int TR_NITEMS = 4 * TR_FI + 4 * TR_FO + 2 * TR_IN + 2 * TR_OUT;
#ifndef TR_SA
#define TR_SA 11264
#endif
#ifndef TR_SB
#define TR_SB 768
#endif
constexpr int TR_PRO = TR_NITEMS - 3 * TR_SA - 2 * TR_SB;
constexpr int TR_SLOT[6] = {TR_PRO, TR_PRO + TR_SA, TR_PRO + TR_SA + TR_SB, TR_PRO + 2 * TR_SA + TR_SB, TR_PRO + 3 * TR_SA + TR_SB, TR_NITEMS};
static_assert(TR_SLOT[0] >= TR_FI, "FFN-in q0 is needed by phase 2: prologue");
static_assert(TR_SLOT[1] >= TR_FI + TR_FO + TR_IN, "FFN-out q0 (phase 3) and even-in (phase 5) must be done by the end of slot 0 (phase 2)");
static_assert(TR_SLOT[2] >= TR_FI + TR_FO + TR_IN + TR_OUT + TR_FI, "even-out (phase 7), FFN-in q1 (phase 9) by the end of slot 1 (phase 5)");
static_assert(TR_SLOT[3] >= 3 * TR_FI + 3 * TR_FO + TR_IN + TR_OUT, "FFN-out q1 (10), FFN-in q2 (12), FFN-out q2 (13) by the end of slot 2 (phase 9)");
static_assert(TR_SLOT[4] >= 3 * TR_FI + 3 * TR_FO + 2 * TR_IN + 2 * TR_OUT, "odd-in (15), odd-out (17) by the end of slot 3 (phase 12)");
struct TrItem { const float* src; bf16* dst; int N, K, fp8; };
__device__ __forceinline__ TrItem p0_item_of(const Params& p, int it, int lane) {
    const float* W; bf16* WT; int K, N, map, r = it, f8 = 0;
#define TR_FFN_IN(q)  { W = p.in[IN_FWI] + (size_t)(q) * D * 2 * DFF; WT = (bf16*)(p.ws + WS_WFI + (q) * WFI_STRIDE); K = D; N = 2 * DFF; map = 1; }
#define TR_FFN_OUT(q) { W = p.in[IN_FWO] + (size_t)(q) * DFF * D; WT = (bf16*)(p.ws + WS_WFO + (q) * WFO_STRIDE); K = DFF; N = D; map = 0; f8 = 1; }
    if (r < TR_FI) TR_FFN_IN(0)
    else if ((r -= TR_FI) < TR_FO) TR_FFN_OUT(0)
    else if ((r -= TR_FO) < TR_IN) { W = p.in[IN_EWI]; WT = (bf16*)(p.ws + WS_WEI); K = D; N = D_EIN; map = 2; }
    else if ((r -= TR_IN) < TR_OUT) { W = p.in[IN_EWO]; WT = (bf16*)(p.ws + WS_WEO); K = D; N = D; map = 0; }
    else if ((r -= TR_OUT) < TR_FI) TR_FFN_IN(1)
    else if ((r -= TR_FI) < TR_FO) TR_FFN_OUT(1)
    else if ((r -= TR_FO) < TR_FI) TR_FFN_IN(2)
    else if ((r -= TR_FI) < TR_FO) TR_FFN_OUT(2)
    else if ((r -= TR_FO) < TR_IN) { W = p.in[IN_OWI]; WT = (bf16*)(p.ws + WS_WOI); K = D; N = D_OIN; map = 3; }
    else if ((r -= TR_IN) < TR_OUT) { W = p.in[IN_OWO]; WT = (bf16*)(p.ws + WS_WOO); K = D; N = D; map = 0; }
    else if ((r -= TR_OUT) < TR_FI) TR_FFN_IN(3)
    else { r -= TR_FI; TR_FFN_OUT(3) }
#undef TR_FFN_IN
#undef TR_FFN_OUT
    const int nblk = N / 64, kb = r / nblk, nb = r % nblk, k0 = 64 * kb, n0 = 64 * nb;
    TrItem t; t.src = W + (size_t)k0 * N + srccol(map, n0 + lane); t.N = N; t.K = K; t.fp8 = f8;
    t.dst = f8 ? (bf16*)((unsigned char*)WT + (size_t)n0 * K + k0) : WT + (size_t)n0 * K + k0; return t;
}
__device__ __forceinline__ void tr_range(const Params& p, LAS unsigned char* lds, int first, int stride, int end, int lane, int wave) {
    LAS float* scr = (LAS float*)(lds + wave * (64 * 65 * 4));
    if (first >= end) return;
    float ra[64];
    TrItem cur = p0_item_of(p, first, lane);
#pragma unroll
    for (int i = 0; i < 64; ++i) ra[i] = cur.src[(size_t)i * cur.N];
#pragma unroll 1
    for (int it = first; it < end; it += stride) {
#pragma unroll
        for (int i = 0; i < 64; ++i) scr[i * 65 + lane] = ra[i];
        const bool more = it + stride < end;
        TrItem nxt = cur;
        if (more) { nxt = p0_item_of(p, it + stride, lane);
#pragma unroll
            for (int i = 0; i < 64; ++i) ra[i] = nxt.src[(size_t)i * nxt.N]; }
        LDS_WAIT(); asm volatile("" ::: "memory");
        if (cur.fp8) {
            const int c = lane & 3;
#pragma unroll
            for (int j = 0; j < 4; ++j) { const int n = (lane >> 2) + 16 * j; const LAS float* s = scr + (16 * c) * 65 + n;
                u32x4 o;
                o.x = pk4_fp8(s[0 * 65] * W8_SCALE, s[1 * 65] * W8_SCALE, s[2 * 65] * W8_SCALE, s[3 * 65] * W8_SCALE);
                o.y = pk4_fp8(s[4 * 65] * W8_SCALE, s[5 * 65] * W8_SCALE, s[6 * 65] * W8_SCALE, s[7 * 65] * W8_SCALE);
                o.z = pk4_fp8(s[8 * 65] * W8_SCALE, s[9 * 65] * W8_SCALE, s[10 * 65] * W8_SCALE, s[11 * 65] * W8_SCALE);
                o.w = pk4_fp8(s[12 * 65] * W8_SCALE, s[13 * 65] * W8_SCALE, s[14 * 65] * W8_SCALE, s[15 * 65] * W8_SCALE);
                *(u32x4*)((unsigned char*)cur.dst + (size_t)n * cur.K + 16 * c) = o; }
        } else {
        const int c = lane & 7;
#pragma unroll
        for (int j = 0; j < 8; ++j) { const int n = (lane >> 3) + 8 * j; const LAS float* s = scr + (8 * c) * 65 + n;
            u32x4 o; o.x = pg8::cvt_pk_bf16(s[0 * 65], s[1 * 65]); o.y = pg8::cvt_pk_bf16(s[2 * 65], s[3 * 65]); o.z = pg8::cvt_pk_bf16(s[4 * 65], s[5 * 65]); o.w = pg8::cvt_pk_bf16(s[6 * 65], s[7 * 65]);
            *(u32x4*)(cur.dst + (size_t)n * cur.K + 8 * c) = o; }
        }
        LDS_WAIT(); asm volatile("" ::: "memory");
        cur = nxt;
    }
}
__device__ __forceinline__ void p0_weights(const Params& p, LAS unsigned char* lds, int lane, int wave) {
    tr_range(p, lds, blockIdx.x * 8 + wave, gridDim.x * 8, TR_SLOT[0], lane, wave);
}
__device__ __forceinline__ void tail_convert(const Params& p, LAS unsigned char* lds, int slot, int units, int lane, int wave) {
    const int G = gridDim.x, c = blockIdx.x, rem = units % G;
    if (rem != 0 && c < rem) return;
    const int nw = rem ? G - rem : G, j = rem ? c - rem : c;
    tr_range(p, lds, TR_SLOT[slot] + j * 8 + wave, nw * 8, TR_SLOT[slot + 1], lane, wave);
}
template <class T> __device__ __forceinline__ T* uniform_ptr(T* p) {
    const unsigned long long v = (unsigned long long)p;
    return (T*)(((unsigned long long)(unsigned)__builtin_amdgcn_readfirstlane((int)(v >> 32)) << 32) | (unsigned)__builtin_amdgcn_readfirstlane((int)v));
}
#define CAS __attribute__((address_space(4)))
__device__ __forceinline__ void p0_modvec(const Params& p, LAS unsigned char* lds, int tid, int lane, int wave) {
    LAS float* red = (LAS float*)lds;
    volatile LAS int* qslot = (volatile LAS int*)(lds + 8 * 9 * 64 * 4);
    const float* c = p.in[IN_C]; const float* cc = p.in[IN_CCTX];
    float* svg = (float*)(p.ws + WS_PART) + (size_t)blockIdx.x * (9 * 2048);
    for (int i = tid; i < 9 * 2048; i += 512) { const float v = i < 8 * 2048 ? c[i] : cc[i - 8 * 2048]; svg[i] = v / (1.0f + __expf(-v)); }
    float* MOD = (float*)(p.ws + WS_MOD);
    unsigned* qhead = (unsigned*)(p.ws + WS_CTL) + CW_Q;
    if (tid == 0) qslot[0] = (int)__hip_atomic_fetch_add(qhead, 1u, __ATOMIC_RELAXED, __HIP_MEMORY_SCOPE_AGENT);
    VM_WAIT();
    __syncthreads();
    const CAS float* svw = (const CAS float*)uniform_ptr(svg + wave * 256);
    int par = 0;
    for (;;) {
        __syncthreads();
        const int item = __builtin_amdgcn_readfirstlane(qslot[par]);
        if (item >= 2 * 288) break;
        const int l = item / 288, col0 = (item % 288) * 64;
        const GAS float* Wu = (const GAS float*)uniform_ptr(p.in[IN_WMOD] + (size_t)l * D * DMODW + col0 + (size_t)(wave * 256) * DMODW);
        float acc[9];
#pragma unroll
        for (int r = 0; r < 9; ++r) acc[r] = 0.f;
#define MV_LOAD(w, g16) do { const GAS float* rp_ = Wu + (size_t)(16 * (g16)) * DMODW; _Pragma("unroll") for (int e = 0; e < 16; ++e) w[e] = (rp_ + (size_t)e * DMODW)[lane]; asm volatile("" ::: "memory"); } while (0)
#define MV_COMP(w, g16) do { _Pragma("unroll") for (int r = 0; r < 9; ++r) { const CAS float* sp_ = svw + r * 2048 + 16 * (g16); \
            _Pragma("unroll") for (int e = 0; e < 16; ++e) acc[r] = __builtin_fmaf(sp_[e], w[e], acc[r]); } } while (0)
        float wa[16], wb[16], wc[16];
        MV_LOAD(wa, 0); MV_LOAD(wb, 1); MV_LOAD(wc, 2);
        unsigned nxt = 0u;
        if (tid == 0) nxt = __hip_atomic_fetch_add(qhead, 1u, __ATOMIC_RELAXED, __HIP_MEMORY_SCOPE_AGENT);
        MV_COMP(wa, 0); MV_LOAD(wa, 3);
        MV_COMP(wb, 1); MV_LOAD(wb, 4);
        MV_COMP(wc, 2); MV_LOAD(wc, 5);
        MV_COMP(wa, 3); MV_LOAD(wa, 6);
        MV_COMP(wb, 4); MV_LOAD(wb, 7);
        MV_COMP(wc, 5); MV_LOAD(wc, 8);
        MV_COMP(wa, 6); MV_LOAD(wa, 9);
        MV_COMP(wb, 7); MV_LOAD(wb, 10);
        MV_COMP(wc, 8); MV_LOAD(wc, 11);
        MV_COMP(wa, 9); MV_LOAD(wa, 12);
        MV_COMP(wb, 10); MV_LOAD(wb, 13);
        MV_COMP(wc, 11); MV_LOAD(wc, 14);
        MV_COMP(wa, 12); MV_LOAD(wa, 15);
        MV_COMP(wb, 13);
        MV_COMP(wc, 14);
        MV_COMP(wa, 15);
#undef MV_LOAD
#undef MV_COMP
        { int l2 = lane; asm volatile("" : "+v"(l2));
#pragma unroll
          for (int r = 0; r < 9; ++r) red[(wave * 9 + r) * 64 + l2] = acc[r]; }
        if (tid == 0) qslot[par ^ 1] = (int)nxt;
        __syncthreads();
        int t2 = tid; asm volatile("" : "+v"(t2));
        for (int o = t2; o < 9 * 64; o += 512) {
            const int r = o >> 6, ln = o & 63; float s = 0.f;
#pragma unroll
            for (int w = 0; w < 8; ++w) s += red[(w * 9 + r) * 64 + ln];
            MOD[((size_t)l * 9 + r) * DMODW + col0 + ln] = s + p.in[IN_BMOD][(size_t)l * DMODW + col0 + ln];
        }
        par ^= 1;
    }
}
#undef CAS

template <bool COMBINE, bool SRC_F32>
__device__ __forceinline__ void norm_phase(LAS unsigned char* lds, const void* src_lat, const void* src_ctx, _Float16* xw_ctx, const float* part, int nrows, const float* g, const float* modl, int shift_idx, int scale_idx, bf16* HN, int tid, int lane, int wave) {
    const int gw = blockIdx.x * 8 + wave, NGW = gridDim.x * 8;
    LAS _Float16* Gs = (LAS _Float16*)lds;
    LAS _Float16* Ss = Gs + 9 * D;
    {
        const f32x4 gg = *(const f32x4*)(g + 4 * tid);
        f32x4 s1[9], s0[9];
#pragma unroll
        for (int r = 0; r < 9; ++r) { s1[r] = *(const f32x4*)(modl + (size_t)r * DMODW + scale_idx * D + 4 * tid); s0[r] = *(const f32x4*)(modl + (size_t)r * DMODW + shift_idx * D + 4 * tid); }
#pragma unroll
        for (int r = 0; r < 9; ++r) { *(LAS u32x2*)(Gs + r * D + 4 * tid) = f32x4_to_h4(gg * (1.0f + s1[r])); *(LAS u32x2*)(Ss + r * D + 4 * tid) = f32x4_to_h4(s0[r]); }
    }
    f32x4 v[8], nv[8];
#define NORM_COL(jj) (SRC_F32 ? 4 * lane + 256 * (jj) : 8 * lane + 512 * ((jj) >> 1) + 4 * ((jj) & 1))
#define NORM_LOAD(dst, row) do { const int row_ = (row); const size_t ro_ = (row_ < M_LAT ? (size_t)row_ : (size_t)(row_ - M_LAT)) * D; const void* sp_ = row_ < M_LAT ? src_lat : src_ctx; \
        if constexpr (SRC_F32) { _Pragma("unroll") for (int j = 0; j < 8; ++j) dst[j] = *(const f32x4*)((const float*)sp_ + ro_ + NORM_COL(j)); } \
        else { _Pragma("unroll") for (int j = 0; j < 4; ++j) { const u32x4 hv_ = *(const u32x4*)((const _Float16*)sp_ + ro_ + NORM_COL(2 * j)); dst[2 * j] = h4_to_f32x4((u32x2){hv_.x, hv_.y}); dst[2 * j + 1] = h4_to_f32x4((u32x2){hv_.z, hv_.w}); } } \
        if (COMBINE && row_ >= M_LAT) { f32x4 tp_[3][8]; _Pragma("unroll") for (int q = 0; q < 3; ++q) { const float* pr_ = part + (size_t)q * (PART_STRIDE / 4) + ro_; \
            _Pragma("unroll") for (int j = 0; j < 8; ++j) tp_[q][j] = *(const f32x4*)(pr_ + NORM_COL(j)); } \
            _Pragma("unroll") for (int j = 0; j < 8; ++j) dst[j] += (tp_[0][j] + tp_[1][j]) + tp_[2][j]; } } while (0)
    if (gw < nrows) NORM_LOAD(v, gw);
    lds_barrier();
    for (int row = gw; row < nrows; row += NGW) {
        if (row + NGW < nrows) NORM_LOAD(nv, row + NGW);
        const int r = row < M_LAT ? (row >> 11) : 8;
        float ss = 0.f;
#pragma unroll
        for (int j = 0; j < 8; ++j) ss += (v[j][0] * v[j][0] + v[j][1] * v[j][1]) + (v[j][2] * v[j][2] + v[j][3] * v[j][3]);
        const float rstd = 1.0f / sqrtf(wave_sum_dpp(ss) * (1.0f / D) + EPS);
        bf16* o = HN + (size_t)row * D;
        f32x4 y[8];
#pragma unroll
        for (int j = 0; j < 8; ++j) { const int c = NORM_COL(j); y[j] = (v[j] * rstd) * h4_to_f32x4(*(const LAS u32x2*)(Gs + r * D + c)) + h4_to_f32x4(*(const LAS u32x2*)(Ss + r * D + c)); }
        if constexpr (SRC_F32) {
#pragma unroll
            for (int j = 0; j < 8; ++j) { u32x2 w; w.x = pg8::cvt_pk_bf16(y[j][0], y[j][1]); w.y = pg8::cvt_pk_bf16(y[j][2], y[j][3]); *(u32x2*)(o + NORM_COL(j)) = w; }
        } else {
#pragma unroll
            for (int j = 0; j < 4; ++j) { u32x4 w; w.x = pg8::cvt_pk_bf16(y[2 * j][0], y[2 * j][1]); w.y = pg8::cvt_pk_bf16(y[2 * j][2], y[2 * j][3]); w.z = pg8::cvt_pk_bf16(y[2 * j + 1][0], y[2 * j + 1][1]); w.w = pg8::cvt_pk_bf16(y[2 * j + 1][2], y[2 * j + 1][3]);
                *(u32x4*)(o + NORM_COL(2 * j)) = w; }
        }
        if (COMBINE && row >= M_LAT) {
#pragma unroll
            for (int j = 0; j < 4; ++j) { const u32x2 h0 = f32x4_to_h4(v[2 * j]), h1 = f32x4_to_h4(v[2 * j + 1]); *(u32x4*)(xw_ctx + (size_t)(row - M_LAT) * D + NORM_COL(2 * j)) = (u32x4){h0.x, h0.y, h1.x, h1.y}; }
        }
#pragma unroll
        for (int j = 0; j < 8; ++j) v[j] = nv[j];
    }
    __syncthreads();
#undef NORM_LOAD
#undef NORM_COL
}

template <int NT>
__device__ __forceinline__ void even_conv_unit(const Params& p, LAS unsigned char* lds, int base, int T, int t0, int tid_in, int lane, int wave) {
    int tid = tid_in; asm volatile("" : "+v"(tid));
    const bf16* Z3 = (const bf16*)(p.ws + WS_Z); bf16* MIX = (bf16*)(p.ws + WS_MIX);
    constexpr int NR = NT + 30;
    LAS float* red = (LAS float*)lds;
    LAS float* stat = red + 256;
    const float* ccw = p.in[IN_CCW]; const float* ccb = p.in[IN_CCB]; const float* lng = p.in[IN_LNG]; const float* lnb = p.in[IN_LNB];
    const float* scw = p.in[IN_SCW]; const float* scb = p.in[IN_SCB];
    unsigned pv[NT + 2], bgv[NT], xr[NR];
#pragma unroll
    for (int i = 0; i < NT + 2; ++i) { const int tc = min(max(t0 - 1 + i, 0), T - 1); pv[i] = *(const unsigned*)(Z3 + (size_t)(base + tc) * ZE_LD + 1024 + 2 * tid); }
#pragma unroll
    for (int i = 0; i < NT; ++i) bgv[i] = *(const unsigned*)(Z3 + (size_t)(base + t0 + i) * ZE_LD + 2 * tid);
#pragma unroll
    for (int j = 0; j < NR; ++j) { const int tc = min(max(t0 - 15 + j, 0), T - 1); xr[j] = *(const unsigned*)(Z3 + (size_t)(base + tc) * ZE_LD + 2048 + 2 * tid); }
    const f32x2 cbias = *(const f32x2*)(ccb + 2 * tid);
    if (t0 == 0) pv[0] = 0u;
    if (t0 + NT == T) pv[NT + 1] = 0u;
    { const f32x2 w0 = *(const f32x2*)(scw + 2 * tid), w1 = *(const f32x2*)(scw + 1024 + 2 * tid), w2 = *(const f32x2*)(scw + 2048 + 2 * tid), b = *(const f32x2*)(scb + 2 * tid);
#pragma unroll
      for (int i = 0; i < NT; ++i) {
          const float c0 = w0[0] * bf_lo(pv[i]) + w1[0] * bf_lo(pv[i + 1]) + w2[0] * bf_lo(pv[i + 2]) + b[0];
          const float c1 = w0[1] * bf_hi(pv[i]) + w1[1] * bf_hi(pv[i + 1]) + w2[1] * bf_hi(pv[i + 2]) + b[1];
          *(unsigned*)(MIX + (size_t)(base + t0 + i) * D + 2 * tid) = pg8::cvt_pk_bf16(bf_lo(bgv[i]) * c0, bf_hi(bgv[i]) * c1); } }
    if (t0 < 15 || t0 + NT + 15 > T) {
#pragma unroll
        for (int j = 0; j < NR; ++j) { const int t = t0 - 15 + j; if (t < 0 || t >= T) xr[j] = 0u; }
    }
    f32x2 xf[NR];
#pragma unroll
    for (int j = 0; j < NR; ++j) xf[j] = (f32x2){bf_lo(xr[j]), bf_hi(xr[j])};
    f32x2 acc[NT];
#pragma unroll
    for (int i = 0; i < NT; ++i) acc[i] = cbias;
    {
        const float* wp_ = ccw + 2 * tid;
#pragma unroll
        for (int k = 0; k < 31; ++k) { const f32x2 w = *(const f32x2*)(wp_ + (size_t)k * 1024);
#pragma unroll
            for (int i = 0; i < NT; ++i) acc[i] += w * xf[i + k]; }
    }
#pragma unroll
    for (int i = 0; i < NT; ++i) { const float s = wave_sum_dpp(acc[i][0] + acc[i][1]); if (lane == 0) red[wave * 32 + i] = s; }
    lds_barrier();
    if (tid < NT) { float s = 0.f;
#pragma unroll
        for (int ww = 0; ww < 8; ++ww) s += red[ww * 32 + tid]; stat[tid] = s * (1.0f / 1024.0f); }
    lds_barrier();
#pragma unroll
    for (int i = 0; i < NT; ++i) { const float mu = stat[i]; acc[i] -= mu; }
    lds_barrier();
#pragma unroll
    for (int i = 0; i < NT; ++i) { const float s = wave_sum_dpp(acc[i][0] * acc[i][0] + acc[i][1] * acc[i][1]); if (lane == 0) red[wave * 32 + i] = s; }
    lds_barrier();
    const f32x2 lg = *(const f32x2*)(lng + 2 * tid), lb = *(const f32x2*)(lnb + 2 * tid);
    if (tid < NT) { float s = 0.f;
#pragma unroll
        for (int ww = 0; ww < 8; ++ww) s += red[ww * 32 + tid]; stat[tid] = 1.0f / sqrtf(s * (1.0f / 1024.0f) + EPS); }
    lds_barrier();
#pragma unroll
    for (int i = 0; i < NT; ++i) { const float rs = stat[i]; const float y0 = acc[i][0] * rs * lg[0] + lb[0], y1 = acc[i][1] * rs * lg[1] + lb[1];
        *(unsigned*)(MIX + (size_t)(base + t0 + i) * D + 1024 + 2 * tid) = pg8::cvt_pk_bf16(y0 * fast_sigmoid(y0), y1 * fast_sigmoid(y1)); }
    lds_barrier();
}
__device__ __forceinline__ void even_conv_phase(const Params& p, LAS unsigned char* lds, int tid, int lane, int wave) {
    for (int k = blockIdx.x; k < 512 + 256; k += gridDim.x) {
        if (k < 512) { const int u = (k & 7) * 64 + (k >> 3); even_conv_unit<32>(p, lds, (u >> 6) * SEQ, SEQ, (u & 63) * 32, tid, lane, wave); }
        else { const int v0 = k - 512, v = (v0 & 7) * 32 + (v0 >> 3); even_conv_unit<8>(p, lds, M_LAT + (v >> 5) * CTXL, CTXL, (v & 31) * 8, tid, lane, wave); }
    }
}

__device__ __forceinline__ float rows_max(float v) { float a = v, c = v; asm volatile("s_nop 1\n\tv_permlane16_swap_b32 %0, %1" : "+v"(a), "+v"(c)); v = __builtin_fmaxf(a, c);
    a = v; c = v; asm volatile("s_nop 1\n\tv_permlane32_swap_b32 %0, %1" : "+v"(a), "+v"(c)); return __builtin_fmaxf(a, c); }
__device__ __forceinline__ float rows_sum(float v) { float a = v, c = v; asm volatile("s_nop 1\n\tv_permlane16_swap_b32 %0, %1" : "+v"(a), "+v"(c)); v = a + c;
    a = v; c = v; asm volatile("s_nop 1\n\tv_permlane32_swap_b32 %0, %1" : "+v"(a), "+v"(c)); return a + c; }
__device__ __forceinline__ float max3f(float a, float b, float c) { float r; asm("v_max3_f32 %0, %1, %2, %3" : "=v"(r) : "v"(a), "v"(b), "v"(c)); return r; }
constexpr int ATT_PAD = 471, ATT_HT = 465 + ATT_PAD;
constexpr int ATT_CK_OFF = 4096, ATT_CV_OFF = ATT_CK_OFF + 32768, ATT_Q_OFF = ATT_CV_OFF + 32768, ATT_RING_OFF = ATT_Q_OFF + 8 * 2048, ATT_NSLOT = 9;
static_assert(ATT_HT * 4 <= ATT_CK_OFF && ATT_RING_OFF + ATT_NSLOT * 8192 <= MISC_OFF, "attention LDS map");
__device__ __forceinline__ void attn_wave_unit(const Params& p, const LAS float* rpbh, const LAS u32x4* ckL, const LAS u32x4* cvL, const LAS u32x4* ringL, LAS u32x4* qL, int b, int h, int r, int qg, int lane) {
    const bf16* ZO = (const bf16*)(p.ws + WS_Z); const u32x2* VF = (const u32x2*)(p.ws + WS_VT); bf16* MIX = (bf16*)(p.ws + WS_MIX);
    const int l15 = lane & 15, g = lane >> 4;
    const int c0 = 16 * qg, qc = c0 + l15, qrow = b * SEQ + r * GW + qc;
    const int r0 = min(max(r - WIN_R / 2, 0), GROWS - WIN_R);
    const int kb = qg == 0 ? 0 : (qg == 1 ? 8 : (qg == 2 ? 24 : 32));
    const int cs = min(max(qc - WIN_C / 2, 0), GW - WIN_C);
#pragma unroll
    for (int kk = 0; kk < 2; ++kk) qL[kk * 64 + lane] = *(const u32x4*)(ZO + (size_t)qrow * ZO_LD + h * HD + 8 * g + 32 * kk);
#define ATT_QF() bf16x8 qf[2]; asm volatile("" ::: "memory"); qf[0] = __builtin_bit_cast(bf16x8, qL[lane]); qf[1] = __builtin_bit_cast(bf16x8, qL[64 + lane]);
    unsigned dcol[4];
#pragma unroll
    for (int j = 0; j < 8; ++j) { const int a = j >> 2, e = j & 3, kc = kb + 16 * a + 4 * g + e; const unsigned dc = ((kc >= cs) && (kc < cs + WIN_C)) ? (unsigned)(kc - qc + WIN_C - 1) : 465u;
        if (j & 1) dcol[j >> 1] |= dc << 16; else dcol[j >> 1] = dc; }
    const bool mis = (kb & 8) != 0;
    const unsigned klo_ctx = (unsigned)(g * 16 + l15), klo_ring = (unsigned)((kb >> 4) * 128) + (mis ? (unsigned)(((l15 + 8) >> 4) * 128 + g * 16 + ((l15 + 8) & 15)) : klo_ctx);
    const unsigned vlo_ctx = (unsigned)(g * 16 + l15), vlo_loc = mis ? (unsigned)(((4 * g + 8) >> 4) * 4096 + (((4 * g + 8) >> 2) & 3) * 16 + l15) : vlo_ctx;
    u32x4 vx[4][4];
#define ATT_TOK0(ch) (b * SEQ + (r0 + ((ch) - 8)) * GW + kb)
#define ATT_LOADV(s) do { _Pragma("unroll") for (int c = 0; c < 4; ++c) { const int tb_ = ATT_TOK0(4 * (s) + c) >> 4; \
        _Pragma("unroll") for (int a = 0; a < 2; ++a) { const u32x2* vp_ = VF + ((size_t)(tb_ + a) * 4096 + h * 256); \
            _Pragma("unroll") for (int d = 0; d < 4; ++d) { const u32x2 t_ = (vp_ + d * 64)[vlo_loc]; if (a == 0) { vx[c][d].x = t_.x; vx[c][d].y = t_.y; } else { vx[c][d].z = t_.x; vx[c][d].w = t_.y; } } } } } while (0)
#define ATT_SOFTMAX() \
        float mx_ = -1e30f, my_ = -1e30f; \
        _Pragma("unroll") for (int c = 0; c < 4; ++c) _Pragma("unroll") for (int a = 0; a < 2; ++a) { mx_ = max3f(mx_, sc_[c][a][0], sc_[c][a][1]); my_ = max3f(my_, sc_[c][a][2], sc_[c][a][3]); } \
        mx_ = rows_max(max3f(mx_, my_, my_)); \
        const float mnew_ = fmaxf(mrun, mx_), alpha_ = __builtin_amdgcn_exp2f(mrun - mnew_); mrun = mnew_; \
        float ps_ = 0.f; bf16x8 pf_[4]; \
        _Pragma("unroll") for (int c = 0; c < 4; ++c) { float pe_[8]; \
            _Pragma("unroll") for (int a = 0; a < 2; ++a) _Pragma("unroll") for (int e = 0; e < 4; ++e) { pe_[4 * a + e] = __builtin_amdgcn_exp2f(sc_[c][a][e] - mnew_); ps_ += pe_[4 * a + e]; } \
            u32x4 pw_; pw_.x = pg8::cvt_pk_bf16(pe_[0], pe_[1]); pw_.y = pg8::cvt_pk_bf16(pe_[2], pe_[3]); pw_.z = pg8::cvt_pk_bf16(pe_[4], pe_[5]); pw_.w = pg8::cvt_pk_bf16(pe_[6], pe_[7]); \
            pf_[c] = __builtin_bit_cast(bf16x8, pw_); } \
        lsum = lsum * alpha_ + ps_;
    f32x4 o[4];
#pragma unroll
    for (int d = 0; d < 4; ++d) o[d] = (f32x4){0.f, 0.f, 0.f, 0.f};
    float mrun = -1e30f, lsum = 0.f;
    ATT_LOADV(2);
#pragma unroll 1
    for (int s = 0; s < 2; ++s) {
        f32x4 sc_[4][2]; ATT_QF()
        const LAS u32x4* kb_ = ckL + s * 1024 + klo_ctx;
#pragma unroll
        for (int c = 0; c < 4; ++c)
#pragma unroll
            for (int a = 0; a < 2; ++a) { f32x4 acc_ = (f32x4){0.f, 0.f, 0.f, 0.f};
                acc_ = __builtin_amdgcn_mfma_f32_16x16x32_bf16(__builtin_bit_cast(bf16x8, kb_[c * 256 + a * 128]), qf[0], acc_, 0, 0, 0);
                acc_ = __builtin_amdgcn_mfma_f32_16x16x32_bf16(__builtin_bit_cast(bf16x8, kb_[c * 256 + a * 128 + 64]), qf[1], acc_, 0, 0, 0); sc_[c][a] = acc_; }
        ATT_SOFTMAX()
        const LAS u32x4* vb_ = cvL + s * 1024 + vlo_ctx;
#pragma unroll
        for (int d = 0; d < 4; ++d) { o[d] = o[d] * alpha_;
#pragma unroll
            for (int c = 0; c < 4; ++c) o[d] = __builtin_amdgcn_mfma_f32_16x16x32_bf16(__builtin_bit_cast(bf16x8, vb_[c * 256 + d * 64]), pf_[c], o[d], 0, 0, 0); }
    }
    asm volatile("s_waitcnt vmcnt(0)" ::: "memory"); __builtin_amdgcn_s_barrier(); asm volatile("" ::: "memory");
#pragma unroll 1
    for (int s = 2; s < 4; ++s) {
        f32x4 sc_[4][2]; ATT_QF()
#pragma unroll
        for (int c = 0; c < 4; ++c) { const int rr_ = r0 + 4 * (s - 2) + c; const LAS u32x4* kr_ = ringL + (rr_ % ATT_NSLOT) * 512 + klo_ring;
#pragma unroll
            for (int a = 0; a < 2; ++a) { f32x4 acc_ = (f32x4){0.f, 0.f, 0.f, 0.f};
                acc_ = __builtin_amdgcn_mfma_f32_16x16x32_bf16(__builtin_bit_cast(bf16x8, kr_[a * 128]), qf[0], acc_, 0, 0, 0);
                acc_ = __builtin_amdgcn_mfma_f32_16x16x32_bf16(__builtin_bit_cast(bf16x8, kr_[a * 128 + 64]), qf[1], acc_, 0, 0, 0); sc_[c][a] = acc_; } }
#pragma unroll
        for (int c = 0; c < 4; ++c) { const LAS float* bp_ = rpbh + ((r0 + 4 * (s - 2) + c) - r + WIN_R - 1) * 31;
#pragma unroll
            for (int a = 0; a < 2; ++a)
#pragma unroll
                for (int e = 0; e < 4; ++e) { const int j = 4 * a + e; sc_[c][a][e] += bp_[(j & 1) ? (dcol[j >> 1] >> 16) : (dcol[j >> 1] & 0xffffu)]; } }
        ATT_SOFTMAX()
#pragma unroll
        for (int d = 0; d < 4; ++d) { o[d] = o[d] * alpha_;
#pragma unroll
            for (int c = 0; c < 4; ++c) o[d] = __builtin_amdgcn_mfma_f32_16x16x32_bf16(__builtin_bit_cast(bf16x8, vx[c][d]), pf_[c], o[d], 0, 0, 0); }
        if (s < 3) ATT_LOADV(s + 1);
    }
#undef ATT_TOK0
#undef ATT_LOADV
#undef ATT_SOFTMAX
#undef ATT_QF
    lsum = rows_sum(lsum);
    const float inv = __builtin_amdgcn_rcpf(lsum);
    int le; asm volatile("v_mbcnt_lo_u32_b32 %0, -1, 0\n\tv_mbcnt_hi_u32_b32 %0, -1, %0" : "=v"(le));
    bf16* op = MIX + (size_t)(b * SEQ + r * GW + c0 + (le & 15)) * D + h * HD + 4 * (le >> 4);
#pragma unroll
    for (int d = 0; d < 4; ++d) { u32x2 w; w.x = pg8::cvt_pk_bf16(o[d][0] * inv, o[d][1] * inv); w.y = pg8::cvt_pk_bf16(o[d][2] * inv, o[d][3] * inv);
        *(u32x2*)(op + 16 * d) = w; }
}
__device__ __forceinline__ void attn_phase(const Params& p, LAS unsigned char* lds, int tid, int lane, int wave) {
    LAS float* rpbh = (LAS float*)lds;
    LAS u32x4* ckL = (LAS u32x4*)(lds + ATT_CK_OFF); LAS u32x4* cvL = (LAS u32x4*)(lds + ATT_CV_OFF);
    const u32x4* KF = (const u32x4*)(p.ws + WS_KF); const u32x2* VF8 = (const u32x2*)(p.ws + WS_VT);
    constexpr int NR = NH * GROWS * 4 / 8;
    const bool cl = gridDim.x >= 8;
    const int cls = blockIdx.x & 7, idx = cl ? (int)(blockIdx.x >> 3) : (int)blockIdx.x, cnt = cl ? (int)((gridDim.x - cls + 7) >> 3) : (int)gridDim.x;
    const int Rlo = idx * NR / cnt, Rhi = (idx + 1) * NR / cnt;
    for (int bi = 0; bi < (cl ? 1 : NBATCH); ++bi) {
        const int b = cl ? cls : bi; int hcur = -1, have_hi = -1;
        for (int R = Rlo; R < Rhi; ++R) {
            const int h = R >> 4, j = R & 15;
            int ln; asm volatile("v_mbcnt_lo_u32_b32 %0, -1, 0\n\tv_mbcnt_hi_u32_b32 %0, -1, %0" : "=v"(ln));
            if (h != hcur) {
                __syncthreads();
                const size_t tb0 = (size_t)((M_LAT + b * CTXL) >> 4);
                const int td = wave * 64 + ln;
                for (int i = td; i < ATT_HT; i += 512) rpbh[i] = i < 465 ? p.in[IN_RPB][h * 465 + i] * 1.44269504089f : -1e30f;
                for (int i = td; i < 2048; i += 512) ckL[i] = KF[(tb0 + (i >> 7)) * 2048 + h * 128 + (i & 127)];
                for (int i = td; i < 4096; i += 512) { const int tb = i >> 8, d = (i >> 6) & 3, l_ = i & 63;
                    ((LAS u32x2*)cvL)[((((tb >> 1) * 4 + d) * 64 + l_) << 1) + (tb & 1)] = VF8[(tb0 + tb) * 4096 + h * 256 + d * 64 + l_]; }
                hcur = h; have_hi = -1;
            }
            __syncthreads();
            {
                const int need_lo = min(max(2 * j - WIN_R / 2, 0), GROWS - WIN_R), need_hi = min(max(2 * j + 1 - WIN_R / 2, 0), GROWS - WIN_R) + WIN_R - 1;
                for (int rr = max(need_lo, have_hi + 1); rr <= need_hi; ++rr) {
                    const u32x4* src = KF + ((size_t)(b * (SEQ / 16) + rr * (GW / 16) + (wave >> 1)) * 2048 + h * 128 + (wave & 1) * 64 + ln);
                    const unsigned dst = (unsigned)(unsigned long long)(lds + ATT_RING_OFF + (rr % ATT_NSLOT) * 8192 + wave * 1024);
                    asm volatile("s_mov_b32 m0, %1\n\ts_nop 0\n\tglobal_load_lds_dwordx4 %0, off" :: "v"(src), "s"(dst) : "memory", "m0");
                }
                have_hi = need_hi;
            }
            const int rem = j * 8 + wave;
            attn_wave_unit(p, rpbh, ckL, cvL, (const LAS u32x4*)(lds + ATT_RING_OFF), (LAS u32x4*)(lds + ATT_Q_OFF + wave * 2048), b, h, rem >> 2, rem & 3, ln);
        }
    }
}

__device__ __forceinline__ float gelu_tanh(float x) { const float z = 0.7978845608028654f * (x + 0.044715f * x * x * x); return x * fast_sigmoid(2.0f * z); }
constexpr int LCH = 256;
__device__ __forceinline__ void lru_item(const Params& p, LAS unsigned char* lds, int item, int tid, int lane, int wave) {
    const bf16* ZO = (const bf16*)(p.ws + WS_Z); float* HF = (float*)(p.ws + WS_HF); bf16* MIX = (bf16*)(p.ws + WS_MIX);
    const int b = item >> 5, n = (item >> 1) & 15, half = item & 1, j0 = half * 32;
    LAS float* xcf = (LAS float*)lds;
    LAS bf16* xcb = (LAS bf16*)(lds + LCH * 33 * 4);
    LAS float* As = (LAS float*)(lds + LCH * 33 * 4 + LCH * 72 * 2);
    LAS float* Us = As + LCH * 33;
    LAS float* segA = Us + LCH * 33;
    LAS float* segH = segA + 16 * 32;
    const int ci = lane, cch = n * 64 + ci;
    const float* lcw = p.in[IN_LCW]; const float cw0 = lcw[cch], cw1 = lcw[1024 + cch], cw2 = lcw[2048 + cch], cw3 = lcw[3072 + cch], cb = p.in[IN_LCB][cch];
    const bool own = (ci >> 5) == half; (void)own; (void)cw0; (void)cw1; (void)cw2; (void)cw3; (void)cb;
    const int cpp = lane & 31;
    const f32x2 cwp0 = *(const f32x2*)(lcw + n * 64 + 2 * cpp), cwp1 = *(const f32x2*)(lcw + 1024 + n * 64 + 2 * cpp), cwp2 = *(const f32x2*)(lcw + 2048 + n * 64 + 2 * cpp), cwp3 = *(const f32x2*)(lcw + 3072 + n * 64 + 2 * cpp), cbp = *(const f32x2*)(p.in[IN_LCB] + n * 64 + 2 * cpp);
    const bool ownp = (cpp >> 4) == half;
    const int jb = wave & 1, tb0 = (wave >> 1) * 4, l15 = lane & 15, g = lane >> 4, jl = 16 * jb + l15, gch = n * 64 + j0 + jl;
    const int sc = lane & 31, hi = lane >> 5, sg = 2 * wave + hi;
    const unsigned och = (unsigned)(n * 64 + j0 + sc);
    for (int dir = 0; dir < 2; ++dir) {
        bf16x8 Bg[2][2];
        {
            const float* gw = p.in[IN_LGW] + (size_t)((dir * 2) * 16 + n) * 4096;
#pragma unroll
            for (int gt = 0; gt < 2; ++gt)
#pragma unroll
                for (int kk = 0; kk < 2; ++kk) { const float* wp = gw + (size_t)gt * 16 * 4096 + (size_t)(8 * g + 32 * kk) * 64 + j0 + jl;
                    u32x4 w; w.x = pk2(wp[0], wp[64]); w.y = pk2(wp[128], wp[192]); w.z = pk2(wp[256], wp[320]); w.w = pk2(wp[384], wp[448]); Bg[gt][kk] = __builtin_bit_cast(bf16x8, w); }
        }
        const float br = p.in[IN_LGB][(dir * 2 + 0) * 1024 + gch], bi = p.in[IN_LGB][(dir * 2 + 1) * 1024 + gch];
        const float lam = p.in[IN_LAM][dir * 1024 + gch];
        const float sp8 = -8.0f * log1pf(expf(-lam)) * 1.44269504089f;
        float carry = 0.f;
        const unsigned hoff = (unsigned)((dir == 0 ? 16 * hi : 16 * (1 - hi)) * 1024) + och;
        const unsigned moff = (unsigned)((dir == 0 ? 16 * hi : 16 * (1 - hi)) * D) + 1024u + och;
        const unsigned goff = (unsigned)((dir == 0 ? 16 * hi : 16 * (1 - hi)) * ZO_LD) + 4096u + och;
        u32x4 xraw[5]; unsigned xmsk[5];
#define LRU_LOADX(cidx_) do { const int ci_ = (cidx_); const bool isctx_ = ci_ < 1; const int cc_ = isctx_ ? 0 : ci_ - 1, ncs_ = isctx_ ? 1 : 8, cpos_ = dir == 0 ? cc_ : ncs_ - 1 - cc_; \
        const int base_ = isctx_ ? M_LAT + b * CTXL : b * SEQ, T_ = isctx_ ? CTXL : SEQ, ts_ = cpos_ * LCH - 1; \
        _Pragma("unroll") for (int q = 0; q < 5; ++q) { const int pc = min(q * 512 + tid, 2071), t = ts_ + (pc >> 3), tc = min(max(t, 0), T_ - 1); const unsigned msk = (t == tc) ? 0xffffffffu : 0u; \
            xraw[q] = *(const u32x4*)(ZO + (size_t)(base_ + tc) * ZO_LD + 3072 + n * 64 + (pc & 7) * 8); xmsk[q] = msk; } } while (0)
        LRU_LOADX(0);
        LAS unsigned char* rawt = (LAS unsigned char*)As;
#pragma unroll 1
        for (int cidx = 0; cidx < 9; ++cidx) {
            const bool isctx = cidx < 1;
            const int cc = isctx ? 0 : cidx - 1, ncs = isctx ? 1 : 8, cpos = dir == 0 ? cc : ncs - 1 - cc;
            const int base = isctx ? M_LAT + b * CTXL : b * SEQ, t0 = cpos * LCH;
#pragma unroll
            for (int q = 0; q < 5; ++q) { const int pc = q * 512 + tid; if (pc < 2072) *(LAS u32x4*)(rawt + pc * 16) = xraw[q] & xmsk[q]; }
            lds_barrier();
            {
                const int cp = lane & 31, tg = 2 * wave + (lane >> 5);
                const LAS unsigned* rp_ = (const LAS unsigned*)(rawt + (16 * tg) * 128) + cp;
                unsigned xr_[19];
#pragma unroll
                for (int e = 0; e < 19; ++e) xr_[e] = rp_[e * 32];
                LAS unsigned* xb_ = (LAS unsigned*)(xcb + (16 * tg) * 72) + cp; LAS f32x2* xf_ = (LAS f32x2*)(xcf + (16 * tg) * 33 + ((2 * cp) & 31));
#pragma unroll
                for (int e = 0; e < 16; ++e) {
                    const float y0 = cwp0[0] * bf_lo(xr_[e]) + cwp1[0] * bf_lo(xr_[e + 1]) + cwp2[0] * bf_lo(xr_[e + 2]) + cwp3[0] * bf_lo(xr_[e + 3]) + cbp[0];
                    const float y1 = cwp0[1] * bf_hi(xr_[e]) + cwp1[1] * bf_hi(xr_[e + 1]) + cwp2[1] * bf_hi(xr_[e + 2]) + cwp3[1] * bf_hi(xr_[e + 3]) + cbp[1];
                    xb_[e * 36] = pg8::cvt_pk_bf16(y0, y1);
                    if (ownp) { LAS float* q_ = (LAS float*)xf_ + e * 33; q_[0] = y0; q_[1] = y1; }
                }
            }
            if (cidx + 1 < 9) LRU_LOADX(cidx + 1);
            lds_barrier();
#pragma unroll 1
            for (int q = 0; q < 4; ++q) {
                const int tb = tb0 + q;
                const bf16x8 a0 = *(const LAS bf16x8*)(xcb + (16 * tb + l15) * 72 + 8 * g), a1 = *(const LAS bf16x8*)(xcb + (16 * tb + l15) * 72 + 8 * g + 32);
                f32x4 gr_ = (f32x4){0.f, 0.f, 0.f, 0.f}, gi_ = (f32x4){0.f, 0.f, 0.f, 0.f};
                gr_ = __builtin_amdgcn_mfma_f32_16x16x32_bf16(a0, Bg[0][0], gr_, 0, 0, 0); gr_ = __builtin_amdgcn_mfma_f32_16x16x32_bf16(a1, Bg[0][1], gr_, 0, 0, 0);
                gi_ = __builtin_amdgcn_mfma_f32_16x16x32_bf16(a0, Bg[1][0], gi_, 0, 0, 0); gi_ = __builtin_amdgcn_mfma_f32_16x16x32_bf16(a1, Bg[1][1], gi_, 0, 0, 0);
#pragma unroll
                for (int e = 0; e < 4; ++e) {
                    const int tl = 16 * tb + 4 * g + e;
                    const float rg = fast_sigmoid(gr_[e] + br), ig = fast_sigmoid(gi_[e] + bi);
                    const float la2 = sp8 * rg, a = __builtin_amdgcn_exp2f(la2);
                    const float em = __builtin_fmaf(-a, a, 1.0f);
                    As[tl * 33 + jl] = a; Us[tl * 33 + jl] = __builtin_amdgcn_sqrtf(em) * ig * xcf[tl * 33 + jl];
                }
            }
            lds_barrier();
            float av[16], uv[16];
            {
                float A = 1.f, H = 0.f;
                const LAS float* ap_ = As + (dir ? (LCH - 1 - 16 * sg) : 16 * sg) * 33 + sc; const LAS float* up_ = Us + (dir ? (LCH - 1 - 16 * sg) : 16 * sg) * 33 + sc;
#pragma unroll
                for (int e = 0; e < 16; ++e) { av[e] = dir ? ap_[-e * 33] : ap_[e * 33]; uv[e] = dir ? up_[-e * 33] : up_[e * 33]; H = av[e] * H + uv[e]; A *= av[e]; }
                segA[sg * 32 + sc] = A; segH[sg * 32 + sc] = H;
            }
            const int rbase = dir == 0 ? base + t0 + 32 * wave : base + t0 + LCH - 1 - 32 * wave - 16;
            float hfv[16]; unsigned grv[16];
            if (!isctx && dir == 1) {
                const float* hp_ = HF + (size_t)rbase * 1024; const bf16* gp_ = ZO + (size_t)rbase * ZO_LD;
#pragma unroll
                for (int e = 0; e < 16; ++e) { hfv[e] = (hp_ - (size_t)e * 1024)[hoff]; grv[e] = (unsigned)(gp_ - (size_t)e * ZO_LD)[goff]; }
            }
            lds_barrier();
            {
                float hin = carry, mine = 0.f;
#pragma unroll
                for (int s2 = 0; s2 < 16; ++s2) { if (s2 == sg) mine = hin; hin = segA[s2 * 32 + sc] * hin + segH[s2 * 32 + sc]; }
                carry = hin;
                if (!isctx) {
                    float hcur = mine;
                    if (dir == 0) {
                        float* hp_ = HF + (size_t)rbase * 1024;
#pragma unroll
                        for (int e = 0; e < 16; ++e) { hcur = av[e] * hcur + uv[e]; (hp_ + (size_t)e * 1024)[hoff] = hcur; }
                    } else {
                        bf16* mp_ = MIX + (size_t)rbase * D;
#pragma unroll
                        for (int e = 0; e < 16; ++e) { hcur = av[e] * hcur + uv[e];
                            { const float o_ = (hfv[e] + hcur) * gelu_tanh(__builtin_bit_cast(float, grv[e] << 16)); (mp_ - (size_t)e * D)[moff] = (bf16)pg8::cvt_pk_bf16(o_, o_); } }
                    }
                }
            }
        }
#undef LRU_LOADX
        VM_WAIT(); __syncthreads();
    }
}


#if MK_SPLIT
#define GRID_BAR() do { } while (0)
#else
#define GRID_BAR() xcd_barrier(bar)
#endif
#ifndef PH_MASK
#define PH_MASK 0xffffffffu
#endif
#define IN(k) (lo <= (k) && (k) < hi && ((PH_MASK >> (k)) & 1u))
#ifndef PROBE_MASK
#define PROBE_MASK 0u
#endif
#ifndef PROBE_MULT
#define PROBE_MULT 4
#endif
#if PROBE_MASK
#define PROBE_STAMP(k) do { if (blockIdx.x == 0 && threadIdx.x == 0) { volatile LAS unsigned long long* pw = (volatile LAS unsigned long long*)(lds + MISC_OFF + 128); \
        const unsigned long long t_ = __builtin_amdgcn_s_memrealtime(); if ((PROBE_MASK >> (k)) & 1u) pw[1] += t_ - pw[0]; pw[0] = t_; } } while (0)
#else
#define PROBE_STAMP(k) do { } while (0)
#endif
#define SEAM(k) do { if (IN(k) && IN((k) + 1)) GRID_BAR(); PROBE_STAMP(k); } while (0)

template <int L>
__device__ __forceinline__ void layer_body(const Params& p, LAS unsigned char* lds, const XcdBarrier& bar, const int lo, const int hi) {
    constexpr int l = L;
    const int tid = threadIdx.x, lane = tid & 63, wave = __builtin_amdgcn_readfirstlane(tid >> 6);
    const int G = gridDim.x;
    float* MOD = (float*)(p.ws + WS_MOD);
    _Float16* X = (_Float16*)(p.ws + WS_X);
    bf16* HN = (bf16*)(p.ws + WS_HN);
    unsigned char* ACT = p.ws + WS_ACT;
    bf16* Z = (bf16*)(p.ws + WS_Z);
    bf16* MIX = (bf16*)(p.ws + WS_MIX);
    float* PART = (float*)(p.ws + WS_PART);
        const int pb = 1 + 10 * l;
        const float* modl = MOD + (size_t)l * 9 * DMODW;
        const float* ng = p.in[IN_NORMG] + (size_t)l * 3 * D;
        constexpr bool first = (l == 0);
        const void* xs_lat = first ? (const void*)p.in[IN_X] : (const void*)X; const void* xs_ctx = first ? (const void*)p.in[IN_CTX] : (const void*)(X + (size_t)M_LAT * D);

        if (IN(pb + 0)) norm_phase<!first, first>(lds, xs_lat, xs_ctx, X + (size_t)M_LAT * D, PART, M_ALL, ng + 0 * D, modl, 0, 1, HN, tid, lane, wave);
        SEAM(pb + 0);
        if (IN(pb + 1)) {
            SchedStd S{(const char*)HN, (const char*)(p.ws + WS_WFI + (size_t)(l * 2 + 0) * WFI_STRIDE), (size_t)256 * D * 2, M_ALL / 256, 2 * DFF / 256, G, (int)blockIdx.x, D / 64};
            EpiSwiGLU E{ACT};
            pg8::gemm_phase<EpiSwiGLU, SchedStd>(lds, D, S, E);
            tail_convert(p, lds, first ? 0 : 3, (M_ALL / 256) * (2 * DFF / 256), lane, wave);
        }
        SEAM(pb + 1);
        if (IN(pb + 2)) {
            SchedDown S{(const char*)ACT, (const char*)(p.ws + WS_WFO + (size_t)(l * 2 + 0) * WFO_STRIDE), (size_t)256 * DFF, G, (int)blockIdx.x, DFF / 128};
            EpiResid<first, false, true> E{xs_lat, xs_ctx, X, modl + 2 * D, 0.5f / (ACT8_SCALE * W8_SCALE), PART};
            pg8::gemm_phase<EpiResid<first, false, true>, SchedDown>(lds, DFF / 2, S, E);
        }
        SEAM(pb + 2);
        if (IN(pb + 3)) norm_phase<true, false>(lds, X, X + (size_t)M_LAT * D, X + (size_t)M_LAT * D, PART, M_ALL, ng + 1 * D, modl, 3, 4, HN, tid, lane, wave);
        SEAM(pb + 3);
        if constexpr (first) {
            if (IN(pb + 4)) {
                SchedStd S{(const char*)HN, (const char*)(p.ws + WS_WEI), (size_t)256 * D * 2, M_ALL / 256, D_EIN / 256, G, (int)blockIdx.x, D / 64};
                EpiEvIn E{Z};
                pg8::gemm_phase<EpiEvIn, SchedStd>(lds, D, S, E);
                tail_convert(p, lds, 1, (M_ALL / 256) * (D_EIN / 256), lane, wave);
            }
            SEAM(pb + 4);
            if (IN(pb + 5)) even_conv_phase(p, lds, tid, lane, wave);
            SEAM(pb + 5);
            if (IN(pb + 6)) {
                SchedDown S{(const char*)MIX, (const char*)(p.ws + WS_WEO), (size_t)256 * D * 2, G, (int)blockIdx.x, D / 64};
                EpiResid<false, false> E{X, X + (size_t)M_LAT * D, X, modl + 5 * D, 1.0f, PART};
                pg8::gemm_phase<EpiResid<false, false>, SchedDown>(lds, D, S, E);
            }
            SEAM(pb + 6);
        } else {
            if (IN(pb + 4)) {
                SchedOdIn S{(const char*)HN, (const char*)(p.ws + WS_WOI), (size_t)256 * D * 2, G, (int)blockIdx.x};
                EpiOdIn E{Z, (u32x4*)(p.ws + WS_KF), (u32x2*)(p.ws + WS_VT), p.in[IN_QG], p.in[IN_KG]};
                pg8::gemm_phase<EpiOdIn, SchedOdIn>(lds, D, S, E);
                tail_convert(p, lds, 4, 72 * 16 + 4 * 72, lane, wave);
            }
            SEAM(pb + 4);
            if (IN(pb + 5)) {
#ifndef NO_LRU
                for (int k = blockIdx.x; k < 256; k += G) lru_item(p, lds, (k & 7) * 32 + (k >> 3), tid, lane, wave);
#endif
#if PROBE_MASK
                __syncthreads();
                if (blockIdx.x == 0 && threadIdx.x == 0) { volatile LAS unsigned long long* pw = (volatile LAS unsigned long long*)(lds + MISC_OFF + 128);
                    const unsigned long long t_ = __builtin_amdgcn_s_memrealtime(); if ((PROBE_MASK >> 30) & 1u) pw[1] += t_ - pw[0]; }
#endif
#ifndef NO_ATTN
                attn_phase(p, lds, tid, lane, wave);
#endif
            }
            SEAM(pb + 5);
            if (IN(pb + 6)) {
                SchedStd S{(const char*)MIX, (const char*)(p.ws + WS_WOO), (size_t)256 * D * 2, M_LAT / 256, D / 256, G, (int)blockIdx.x, D / 64};
                EpiResid<false, false> E{X, X + (size_t)M_LAT * D, X, modl + 5 * D, 1.0f, PART};
                pg8::gemm_phase<EpiResid<false, false>, SchedStd>(lds, D, S, E);
            }
            SEAM(pb + 6);
        }
        const int nrows2 = first ? M_ALL : M_LAT;
        if (IN(pb + 7)) norm_phase<first, false>(lds, X, X + (size_t)M_LAT * D, X + (size_t)M_LAT * D, PART, nrows2, ng + 2 * D, modl, 6, 7, HN, tid, lane, wave);
        SEAM(pb + 7);
        if (IN(pb + 8)) {
            SchedStd S{(const char*)HN, (const char*)(p.ws + WS_WFI + (size_t)(l * 2 + 1) * WFI_STRIDE), (size_t)256 * D * 2, nrows2 / 256, 2 * DFF / 256, G, (int)blockIdx.x, D / 64};
            EpiSwiGLU E{ACT};
            pg8::gemm_phase<EpiSwiGLU, SchedStd>(lds, D, S, E);
            if constexpr (first) tail_convert(p, lds, 2, (M_ALL / 256) * (2 * DFF / 256), lane, wave);
        }
        SEAM(pb + 8);
        if (IN(pb + 9)) {
            if constexpr (first) {
                SchedDown S{(const char*)ACT, (const char*)(p.ws + WS_WFO + (size_t)(l * 2 + 1) * WFO_STRIDE), (size_t)256 * DFF, G, (int)blockIdx.x, DFF / 128};
                EpiResid<false, false, true> E{X, X + (size_t)M_LAT * D, X, modl + 8 * D, 0.5f / (ACT8_SCALE * W8_SCALE), PART};
                pg8::gemm_phase<EpiResid<false, false, true>, SchedDown>(lds, DFF / 2, S, E);
            } else {
                SchedStd S{(const char*)ACT, (const char*)(p.ws + WS_WFO + (size_t)(l * 2 + 1) * WFO_STRIDE), (size_t)256 * DFF, M_LAT / 256, D / 256, G, (int)blockIdx.x, DFF / 128};
                EpiResid<false, true, true> E{X, X + (size_t)M_LAT * D, p.out, modl + 8 * D, 0.5f / (ACT8_SCALE * W8_SCALE), PART};
                pg8::gemm_phase<EpiResid<false, true, true>, SchedStd>(lds, DFF / 2, S, E);
            }
        }
        SEAM(pb + 9);
}
__global__ void __launch_bounds__(512, 2) mega_fwd(Params p) {
    extern __shared__ __attribute__((aligned(16))) unsigned char lds_raw[];
    LAS unsigned char* lds = (LAS unsigned char*)lds_raw;
    volatile LAS unsigned* MISC = (volatile LAS unsigned*)(lds + MISC_OFF);
    const int tid = threadIdx.x, lane = tid & 63, wave = __builtin_amdgcn_readfirstlane(tid >> 6);
    const int G = gridDim.x;
    if (tid < 64) MISC[tid] = 0u;
    __syncthreads();
    unsigned* ctl = (unsigned*)(p.ws + WS_CTL);
#if MK_SPLIT
    XcdBarrier bar; bar.bar = ctl + CW_BAR; bar.x = 0; bar.st = MISC + 8;
#else
    XcdBarrier bar = xcd_barrier_post(ctl + CW_BAR, MISC + 8);
#endif
    const int lo = p.ph_lo, hi = p.ph_hi;
#if PROBE_MASK
    if (blockIdx.x == 0 && tid == 0) { volatile LAS unsigned long long* pw = (volatile LAS unsigned long long*)(lds + MISC_OFF + 128); pw[0] = __builtin_amdgcn_s_memrealtime(); pw[1] = 0ull; }
#endif

    float* MOD = (float*)(p.ws + WS_MOD);
    float* X = (float*)(p.ws + WS_X);
    bf16* HN = (bf16*)(p.ws + WS_HN);
    bf16* ACT = (bf16*)(p.ws + WS_ACT);
    bf16* Z = (bf16*)(p.ws + WS_Z);
    bf16* MIX = (bf16*)(p.ws + WS_MIX);

    if (IN(0)) {
#ifndef NO_WEIGHTS
        p0_weights(p, lds, lane, wave); __syncthreads();
#endif
#if PROBE_MASK
        if (blockIdx.x == 0 && threadIdx.x == 0) { volatile LAS unsigned long long* pw = (volatile LAS unsigned long long*)(lds + MISC_OFF + 128);
            const unsigned long long t_ = __builtin_amdgcn_s_memrealtime(); if ((PROBE_MASK >> 29) & 1u) pw[1] += t_ - pw[0]; }
#endif
#ifndef NO_MODVEC
        p0_modvec(p, lds, tid, lane, wave); __syncthreads();
#endif
    }
    SEAM(0);

    layer_body<0>(p, lds, bar, lo, hi);
    layer_body<1>(p, lds, bar, lo, hi);
#if PROBE_MASK
    if (blockIdx.x == 0 && tid == 0) { volatile LAS unsigned long long* pw = (volatile LAS unsigned long long*)(lds + MISC_OFF + 128); const unsigned long long t0 = __builtin_amdgcn_s_memrealtime(), dt = (unsigned long long)PROBE_MULT * pw[1];
        while (__builtin_amdgcn_s_memrealtime() - t0 < dt) __builtin_amdgcn_s_sleep(8); }
#endif
#undef IN
#undef SEAM
#undef GRID_BAR
}

extern "C" void kernel_launch(void* const* d_in, const int* in_sizes, int n_in, void* d_out, int out_size, void* d_ws, size_t ws_size, hipStream_t stream) {
    static int grid = 0;
    if (grid == 0) {
        if (n_in != 27 || in_sizes[0] != M_LAT * D || out_size != M_LAT * D || ws_size < WS_END) {
            fprintf(stderr, "kernel_launch: unexpected shapes (n_in %d, in0 %d, out %d, ws %zu; need ws >= %zu); nothing launched\n", n_in, n_in > 0 ? in_sizes[0] : -1, out_size, ws_size, (size_t)WS_END); grid = -1; return; }
        int dev = 0, cus = 0, per_cu = 0;
        if (hipGetDevice(&dev) != hipSuccess || hipDeviceGetAttribute(&cus, hipDeviceAttributeMultiprocessorCount, dev) != hipSuccess) { fprintf(stderr, "kernel_launch: device query failed\n"); grid = -1; return; }
        if (hipFuncSetAttribute((const void*)mega_fwd, hipFuncAttributeMaxDynamicSharedMemorySize, LDS_BYTES) != hipSuccess) { fprintf(stderr, "kernel_launch: hipFuncSetAttribute failed\n"); grid = -1; return; }
        if (hipOccupancyMaxActiveBlocksPerMultiprocessor(&per_cu, (const void*)mega_fwd, 512, LDS_BYTES) != hipSuccess || per_cu < 1) {
            fprintf(stderr, "kernel_launch: occupancy query reports %d workgroups per CU\n", per_cu); }
        (void)hipGetLastError();
        grid = cus;
    }
    if (grid < 0) return;
    if (hipMemsetAsync((char*)d_ws + WS_CTL, 0, CTL_ZERO_BYTES, stream) != hipSuccess) { fprintf(stderr, "kernel_launch: memset failed\n"); return; }
    Params a{};
    for (int i = 0; i < 27; ++i) a.in[i] = (const float*)d_in[i];
    a.out = (float*)d_out; a.ws = (unsigned char*)d_ws;
#if MK_SPLIT
    for (int ph = 0; ph < NPHASE; ++ph) { a.ph_lo = ph; a.ph_hi = ph + 1; hipLaunchKernelGGL(mega_fwd, dim3(grid), dim3(512), LDS_BYTES, stream, a); }
#else
    a.ph_lo = 0; a.ph_hi = NPHASE;
    hipLaunchKernelGGL(mega_fwd, dim3(grid), dim3(512), LDS_BYTES, stream, a);
#endif
    const hipError_t le = hipPeekAtLastError();
    if (le != hipSuccess) fprintf(stderr, "kernel_launch: launch failed: %s\n", hipGetErrorName(le));
}
```

```cpp
#include <hip/hip_runtime.h>
#include <cstdio>
#include <cstdint>

#ifndef MK_SPLIT
#define MK_SPLIT 0
#endif

namespace pg8 {
#define PG8_LAS __attribute__((address_space(3)))
typedef unsigned short bf16_t;
typedef short bf16x8 __attribute__((ext_vector_type(8)));
typedef float f32x4 __attribute__((ext_vector_type(4)));
typedef unsigned u32x4 __attribute__((ext_vector_type(4)));
typedef unsigned u32x2 __attribute__((ext_vector_type(2)));
typedef int v4i_t __attribute__((ext_vector_type(4)));
typedef int v8i_t __attribute__((ext_vector_type(8)));
constexpr int BM = 256, BK = 64, HALF = 128, HTB = HALF * BK * 2  , STAGE_BYTES = 8 * HTB, NXCD = 8, WGM = 8;

__host__ __device__ __forceinline__ int lds_byte(int r, int c) { const int st = (r >> 4) * 2 + (c >> 5), rr = r & 15, cc = c & 31, ob = rr * 64 + cc * 2; return st * 1024 + (ob ^ (((ob >> 9) & 1) << 5)); }
__host__ __device__ __forceinline__ void stage_rc(int b, int& R, int& C) { const int st = b / 1024, sb = b % 1024, swz = sb ^ (((sb >> 9) & 1) << 5); R = (st >> 1) * 16 + swz / 64; C = (st & 1) * 32 + (swz % 64) / 2; }
__host__ __device__ __forceinline__ int perm32(int rho) { const int n = rho >> 4, i = rho & 15; return 8 * (i >> 2) + 4 * n + (i & 3); }

struct Unit { int pm, pn, kind; };

__host__ __device__ __forceinline__ void tile_map(int wgid, int nM, int nN, int& pm, int& pn) {
    const int nwg = nM * nN;
    { const int q = nwg / NXCD, r = nwg % NXCD, xcd = wgid % NXCD, off = wgid / NXCD; wgid = (xcd < r ? xcd * (q + 1) : r * (q + 1) + (xcd - r) * q) + off; }
    const int nig = WGM * nN, gid = wgid / nig, fm = gid * WGM, gsz = (nM - fm) < WGM ? (nM - fm) : WGM;
    pm = fm + ((wgid % nig) % gsz); pn = (wgid % nig) / gsz;
}

__device__ __forceinline__ unsigned cvt_pk_bf16(float lo, float hi) { unsigned r; asm volatile("v_cvt_pk_bf16_f32 %0, %1, %2" : "=v"(r) : "v"(lo), "v"(hi)); return r; }

template <class Epi, class Sched, bool ALIGN_EPI = true, bool SP2 = true>
__device__ __forceinline__ void gemm_phase(PG8_LAS unsigned char* lds, const int K  , const Sched& S, const Epi& E) {
    const int tid = threadIdx.x, wid = __builtin_amdgcn_readfirstlane(tid >> 6), lane = tid & 63, wr = wid >> 2, wc = wid & 3, fr = lane & 15, fq = lane >> 4;
    unsigned voffA[2], voffB[2];
#pragma unroll
    for (int i = 0; i < 2; ++i) { int R, C; stage_rc(tid * 16 + i * 8192, R, C); const int Rb = Epi::PERM ? ((R & ~31) + perm32(R & 31)) : R;
        voffA[i] = (unsigned)(R * K + C) * 2u; voffB[i] = (unsigned)(Rb * K + C) * 2u; }
    const size_t kstep = (size_t)(BK * 2);
    const size_t hstep = (size_t)HALF * K * 2;
    const unsigned ldsw = (unsigned)wid * 1024u;
    const int aoff = lds_byte(wr * 64 + fr, fq * 8), boff = lds_byte(wc * 32 + fr, fq * 8);
#define PG8_SA(b, h) (((b) * 2 + (h)) * HTB)
#define PG8_SB(b, h) ((4 + (b) * 2 + (h)) * HTB)
#define PG8_STAGE(bufoff, gbase, voff) do { _Pragma("unroll") for (int _i = 0; _i < 2; ++_i) \
        __builtin_amdgcn_global_load_lds((const unsigned*)((const char*)(gbase) + (voff)[_i]), (PG8_LAS unsigned*)(lds + (bufoff) + ldsw + _i * 8192), 16, 0, 0); } while (0)
#define PG8_LDA(dst, b, h) do { _Pragma("unroll") for (int m = 0; m < 4; ++m) { if constexpr (Epi::FP8) { \
            dst##8[m] = __builtin_shufflevector(*(const PG8_LAS v4i_t*)(lds + PG8_SA(b, h) + aoff + m * 2048), *(const PG8_LAS v4i_t*)(lds + PG8_SA(b, h) + aoff + m * 2048 + 1024), 0, 1, 2, 3, 4, 5, 6, 7); } \
        else { _Pragma("unroll") for (int k = 0; k < 2; ++k) dst[m][k] = *(const PG8_LAS bf16x8*)(lds + PG8_SA(b, h) + aoff + m * 2048 + k * 1024); } } } while (0)
#define PG8_LDB(dst, b, h) do { _Pragma("unroll") for (int n = 0; n < 2; ++n) { if constexpr (Epi::FP8) { \
            dst##8[n] = __builtin_shufflevector(*(const PG8_LAS v4i_t*)(lds + PG8_SB(b, h) + boff + n * 2048), *(const PG8_LAS v4i_t*)(lds + PG8_SB(b, h) + boff + n * 2048 + 1024), 0, 1, 2, 3, 4, 5, 6, 7); } \
        else { _Pragma("unroll") for (int k = 0; k < 2; ++k) dst[n][k] = *(const PG8_LAS bf16x8*)(lds + PG8_SB(b, h) + boff + n * 2048 + k * 1024); } } } while (0)
#define PG8_MMA(ai, bj, At, Bt) do { __builtin_amdgcn_s_setprio(1); \
        if constexpr (Epi::FP8) { _Pragma("unroll") for (int m = 0; m < 4; ++m) _Pragma("unroll") for (int n = 0; n < 2; ++n) \
            asm volatile("v_mfma_scale_f32_16x16x128_f8f6f4 %0, %1, %2, %0, %3, %3 op_sel_hi:[0,0,0]" : "+v"(acc[ai][bj][m][n]) : "v"(Bt##8[n]), "v"(At##8[m]), "v"(one_scale)); } \
        else { _Pragma("unroll") for (int m = 0; m < 4; ++m) _Pragma("unroll") for (int n = 0; n < 2; ++n) _Pragma("unroll") for (int k = 0; k < 2; ++k) \
            acc[ai][bj][m][n] = __builtin_amdgcn_mfma_f32_16x16x32_bf16(Bt[n][k], At[m][k], acc[ai][bj][m][n], 0, 0, 0); } \
        __builtin_amdgcn_s_setprio(0); } while (0)
#define PG8_WAIT_V(n) asm volatile("s_waitcnt vmcnt(" #n ")" ::: "memory")
#define PG8_WAIT_L(n) asm volatile("s_waitcnt lgkmcnt(" #n ")" ::: "memory")
#define PG8_BAR __builtin_amdgcn_s_barrier()
#define PG8_SCHED __builtin_amdgcn_sched_barrier(0)
    Unit cur, nxt; int ui = 0;
    if (!S.next(0, cur)) return;
    f32x4 acc[2][2][4][2];
#pragma unroll
    for (int a = 0; a < 2; ++a)
#pragma unroll
        for (int b = 0; b < 2; ++b)
#pragma unroll
            for (int m = 0; m < 4; ++m)
#pragma unroll
                for (int n = 0; n < 2; ++n) acc[a][b][m][n] = (f32x4){0.f, 0.f, 0.f, 0.f};
    bf16x8 At[4][2], B0[2][2], B1[2][2];
    v8i_t At8[4], B08[2], B18[2];
    int one_scale = 0x7f7f7f7f; asm volatile("" : "+v"(one_scale));
    const char* cA = S.a_base(cur); const char* cB = S.b_base(cur);
    if constexpr (SP2) {
        PG8_STAGE(PG8_SB(0, 0), cB, voffB); PG8_STAGE(PG8_SB(0, 1), cB + hstep, voffB); PG8_STAGE(PG8_SA(0, 0), cA, voffA); PG8_STAGE(PG8_SA(0, 1), cA + hstep, voffA);
        if (wr == 1) PG8_BAR;
        PG8_WAIT_V(2); PG8_BAR;
        PG8_STAGE(PG8_SB(1, 0), cB + kstep, voffB); PG8_STAGE(PG8_SA(1, 0), cA + kstep, voffA); PG8_STAGE(PG8_SB(1, 1), cB + hstep + kstep, voffB);
        PG8_WAIT_V(6); PG8_BAR;
    } else {
        PG8_STAGE(PG8_SB(0, 0), cB, voffB); PG8_STAGE(PG8_SA(0, 0), cA, voffA); PG8_STAGE(PG8_SB(0, 1), cB + hstep, voffB); PG8_STAGE(PG8_SA(0, 1), cA + hstep, voffA);
        if (wr == 1) PG8_BAR;
        PG8_WAIT_V(4); PG8_BAR;
        PG8_STAGE(PG8_SB(1, 0), cB + kstep, voffB); PG8_STAGE(PG8_SA(1, 0), cA + kstep, voffA); PG8_STAGE(PG8_SB(1, 1), cB + hstep + kstep, voffB);
        PG8_WAIT_V(6); PG8_BAR;
    }
    for (;;) {
        const bool has_next = S.next(ui + 1, nxt);
        const int nt = S.nt(cur);
        const char* nA = has_next ? S.a_base(nxt) : cA; const char* nB = has_next ? S.b_base(nxt) : cB;
        for (int t = 0; t < nt; t += 2) {
            const bool last = (t == nt - 2);
            const char* a1 = cA + (size_t)(t + 1) * kstep;
            const char* a2 = last ? nA : cA + (size_t)(t + 2) * kstep; const char* b2 = last ? nB : cB + (size_t)(t + 2) * kstep;
            const char* a3 = a2 + kstep; const char* b3 = b2 + kstep;
            if constexpr (SP2) {
            PG8_LDB(B0, 0, 0); PG8_LDB(B1, 0, 1); PG8_SCHED; PG8_LDA(At, 0, 0); PG8_STAGE(PG8_SA(1, 1), a1 + hstep, voffA);
            PG8_WAIT_V(8); PG8_WAIT_L(0); PG8_BAR; PG8_MMA(0, 0, At, B0); PG8_MMA(0, 1, At, B1); PG8_BAR; PG8_SCHED;
            PG8_LDA(At, 0, 1); PG8_STAGE(PG8_SB(0, 0), b2, voffB); PG8_STAGE(PG8_SB(0, 1), b2 + hstep, voffB); PG8_STAGE(PG8_SA(0, 0), a2, voffA);
            PG8_WAIT_V(8); PG8_WAIT_L(0); PG8_BAR; PG8_MMA(1, 0, At, B0); PG8_MMA(1, 1, At, B1); PG8_BAR; PG8_SCHED;
            PG8_LDB(B0, 1, 0); PG8_LDB(B1, 1, 1); PG8_SCHED; PG8_LDA(At, 1, 0); PG8_STAGE(PG8_SA(0, 1), a2 + hstep, voffA);
            PG8_WAIT_V(8); PG8_WAIT_L(0); PG8_BAR; PG8_MMA(0, 0, At, B0); PG8_MMA(0, 1, At, B1); PG8_BAR; PG8_SCHED;
            PG8_LDA(At, 1, 1); PG8_STAGE(PG8_SB(1, 0), b3, voffB); PG8_STAGE(PG8_SB(1, 1), b3 + hstep, voffB); PG8_STAGE(PG8_SA(1, 0), a3, voffA);
            PG8_WAIT_V(8); PG8_WAIT_L(0); PG8_BAR; PG8_MMA(1, 0, At, B0); PG8_MMA(1, 1, At, B1); PG8_BAR; PG8_SCHED;
            } else {
            PG8_LDB(B0, 0, 0); PG8_SCHED; PG8_LDA(At, 0, 0); PG8_STAGE(PG8_SA(1, 1), a1 + hstep, voffA);
            PG8_WAIT_L(8); PG8_BAR; PG8_WAIT_L(0); PG8_MMA(0, 0, At, B0); PG8_BAR; PG8_SCHED;
            PG8_LDB(B1, 0, 1); PG8_STAGE(PG8_SB(0, 0), b2, voffB);
            PG8_BAR; PG8_WAIT_L(0); PG8_MMA(0, 1, At, B1); PG8_BAR;
            PG8_LDA(At, 0, 1); PG8_STAGE(PG8_SA(0, 0), a2, voffA);
            PG8_BAR; PG8_WAIT_L(0); PG8_MMA(1, 0, At, B0); PG8_BAR; PG8_SCHED;
            PG8_STAGE(PG8_SB(0, 1), b2 + hstep, voffB);
            PG8_WAIT_V(6); PG8_BAR; PG8_MMA(1, 1, At, B1); PG8_BAR;
            PG8_LDB(B0, 1, 0); PG8_SCHED; PG8_LDA(At, 1, 0); PG8_STAGE(PG8_SA(0, 1), a2 + hstep, voffA);
            PG8_WAIT_L(8); PG8_BAR; PG8_WAIT_L(0); PG8_MMA(0, 0, At, B0); PG8_BAR; PG8_SCHED;
            PG8_LDB(B1, 1, 1); PG8_STAGE(PG8_SB(1, 0), b3, voffB);
            PG8_BAR; PG8_WAIT_L(0); PG8_MMA(0, 1, At, B1); PG8_BAR;
            PG8_LDA(At, 1, 1); PG8_STAGE(PG8_SA(1, 0), a3, voffA);
            PG8_BAR; PG8_WAIT_L(0); PG8_MMA(1, 0, At, B0); PG8_BAR; PG8_SCHED;
            PG8_STAGE(PG8_SB(1, 1), b3 + hstep, voffB);
            PG8_WAIT_V(6); PG8_BAR; PG8_MMA(1, 1, At, B1); PG8_BAR;
            }
        }
        if constexpr (Epi::FP8) asm volatile("s_nop 15\n\ts_nop 15\n\ts_nop 15\n\ts_nop 15\n\ts_nop 15" ::: "memory");
        if constexpr (ALIGN_EPI) { if (wr == 0) PG8_BAR; }
        E(acc, cur, wr, wc, fr, fq);
        if (!has_next) break;
#pragma unroll
        for (int a = 0; a < 2; ++a)
#pragma unroll
            for (int b = 0; b < 2; ++b)
#pragma unroll
                for (int m = 0; m < 4; ++m)
#pragma unroll
                    for (int n = 0; n < 2; ++n) acc[a][b][m][n] = (f32x4){0.f, 0.f, 0.f, 0.f};
        cur = nxt; cA = nA; cB = nB; ++ui;
        if constexpr (ALIGN_EPI) { if (wr == 1) PG8_BAR; }
    }
    PG8_WAIT_V(0);
    if constexpr (!ALIGN_EPI) { if (wr == 0) PG8_BAR; }
    PG8_BAR;
#undef PG8_SA
#undef PG8_SB
#undef PG8_STAGE
#undef PG8_LDA
#undef PG8_LDB
#undef PG8_MMA
#undef PG8_WAIT_V
#undef PG8_WAIT_L
#undef PG8_BAR
#undef PG8_SCHED
}
}

constexpr int D = 2048, NBATCH = 8, SEQ = 2048, CTXL = 256, DFF = 5632, NMODV = 9, DMODW = NMODV * D  ;
constexpr int M_LAT = NBATCH * SEQ  , M_CTX = NBATCH * CTXL  , M_ALL = M_LAT + M_CTX  ;
constexpr int NH = 16, HD = 64, GW = 64  , GROWS = SEQ / GW  , WIN_R = 8, WIN_C = 16;
constexpr int D_EIN = 5120, D_OIN = 5120, ZE_LD = 3072  , ZO_LD = 5120;
constexpr float EPS = 1e-6f;
constexpr float ACT8_SCALE = 8.0f, W8_SCALE = 1024.0f;
constexpr int NPHASE = 21;

constexpr size_t MiB = 1u << 20;
constexpr size_t WS_CTL = 0, CTL_ZERO_BYTES = 1 * MiB;
constexpr size_t WS_MOD = 1 * MiB;
constexpr size_t WS_WFI = 4 * MiB, WFI_STRIDE = 44 * MiB;
constexpr size_t WS_WFO = 180 * MiB, WFO_STRIDE = 22 * MiB;
constexpr size_t WS_WEI = 268 * MiB, WS_WEO = 288 * MiB, WS_WOI = 296 * MiB, WS_WOO = 316 * MiB;
constexpr size_t WS_X = 324 * MiB;
constexpr size_t WS_HN = 468 * MiB;
constexpr size_t WS_ACT = 540 * MiB;
constexpr size_t WS_Z = 738 * MiB;
constexpr size_t WS_MIX = 918 * MiB;
constexpr size_t WS_VT = 990 * MiB;
constexpr size_t WS_HF = 1026 * MiB;
constexpr size_t WS_PART = 1090 * MiB, PART_STRIDE = 16 * MiB;
constexpr size_t WS_KF = 1138 * MiB;
constexpr size_t WS_END = 1174 * MiB;
constexpr int CW_BAR = 4096;
constexpr int CW_Q = 8192;

constexpr int RING_BYTES = 131072;
constexpr int LDS_BYTES = 163840;
constexpr int MISC_OFF = LDS_BYTES - 256;

#define GAS __attribute__((address_space(1)))
#define LAS __attribute__((address_space(3)))
typedef unsigned short bf16;
typedef float f32x4 __attribute__((ext_vector_type(4)));
typedef float f32x2 __attribute__((ext_vector_type(2)));
typedef unsigned u32x4 __attribute__((ext_vector_type(4)));
typedef unsigned u32x2 __attribute__((ext_vector_type(2)));
typedef short bf16x8 __attribute__((ext_vector_type(8)));
#define LDS_WAIT() asm volatile("s_waitcnt lgkmcnt(0)" ::: "memory")
#define VM_WAIT() asm volatile("s_waitcnt vmcnt(0)" ::: "memory")
__device__ __forceinline__ unsigned f2bf(float f) { unsigned u = __builtin_bit_cast(unsigned, f); return (u + 0x7fffu + ((u >> 16) & 1u)) >> 16; }
__device__ __forceinline__ unsigned pk2(float lo, float hi) { return f2bf(lo) | (f2bf(hi) << 16); }
__device__ __forceinline__ float bf_lo(unsigned v) { return __builtin_bit_cast(float, v << 16); }
__device__ __forceinline__ float bf_hi(unsigned v) { return __builtin_bit_cast(float, v & 0xffff0000u); }
__device__ __forceinline__ float bf2f(bf16 v) { return __builtin_bit_cast(float, (unsigned)v << 16); }
typedef _Float16 f16x4 __attribute__((ext_vector_type(4)));
typedef _Float16 f16x8 __attribute__((ext_vector_type(8)));
typedef float f32x8 __attribute__((ext_vector_type(8)));
__device__ __forceinline__ u32x2 f32x4_to_h4(f32x4 v) { return __builtin_bit_cast(u32x2, __builtin_convertvector(v, f16x4)); }
__device__ __forceinline__ f32x4 h4_to_f32x4(u32x2 v) { return __builtin_convertvector(__builtin_bit_cast(f16x4, v), f32x4); }
__device__ __forceinline__ float clamp448(float x) { return __builtin_fminf(__builtin_fmaxf(x, -448.0f), 448.0f); }
__device__ __forceinline__ unsigned pk4_fp8(float a, float b, float c, float d) {
    unsigned w = 0u; w = __builtin_amdgcn_cvt_pk_fp8_f32(clamp448(a), clamp448(b), w, false); w = __builtin_amdgcn_cvt_pk_fp8_f32(clamp448(c), clamp448(d), w, true); return w; }
__device__ __forceinline__ float fast_sigmoid(float x) { return __builtin_amdgcn_rcpf(1.0f + __builtin_amdgcn_exp2f(-1.44269504089f * x)); }
__device__ __forceinline__ void lds_barrier() { asm volatile("s_waitcnt lgkmcnt(0)" ::: "memory"); __builtin_amdgcn_s_barrier(); asm volatile("" ::: "memory"); }
#define DPP_ADD_(v, ctrl, rmask) ((v) + __builtin_bit_cast(float, __builtin_amdgcn_update_dpp(0, __builtin_bit_cast(int, (v)), (ctrl), (rmask), 0xf, false)))
__device__ __forceinline__ float wave_sum_dpp(float v) {
    v = DPP_ADD_(v, 0xB1, 0xf);
    v = DPP_ADD_(v, 0x4E, 0xf);
    v = DPP_ADD_(v, 0x141, 0xf);
    v = DPP_ADD_(v, 0x140, 0xf);
    v = DPP_ADD_(v, 0x142, 0xa);
    v = DPP_ADD_(v, 0x143, 0xc);
    return __builtin_bit_cast(float, __builtin_amdgcn_readlane(__builtin_bit_cast(int, v), 63));
}
__device__ __forceinline__ float wave_sum(float v) {
#pragma unroll
    for (int o = 1; o < 64; o <<= 1) v += __shfl_xor(v, o);
    return v;
}

#define XB_TMO      128
#define XB_XCNT(j)  (256  + 64 * (j))
#define XB_XSUB(j)  (1280 + 64 * (j))
#define XB_XGEN(j)  (2304 + 64 * (j))
#define XB_TOP      3328
#define XB_TOPGEN   3392
#define XCD_BAR_WORDS 3456
#define XB_SPIN_CAP (1u << 18)

__device__ __forceinline__ unsigned xb_ld(unsigned* p)              { return __hip_atomic_load(p, __ATOMIC_RELAXED, __HIP_MEMORY_SCOPE_AGENT); }
__device__ __forceinline__ unsigned xb_add(unsigned* p, unsigned v) { return __hip_atomic_fetch_add(p, v, __ATOMIC_RELAXED, __HIP_MEMORY_SCOPE_AGENT); }
__device__ __forceinline__ unsigned xb_xcc_id() { return (unsigned)__builtin_amdgcn_s_getreg((3 << 11) | 20) & 0xFu; }
#define XB_SPIN(cond, bar) do { unsigned _sp = 0; while (cond) { __builtin_amdgcn_s_sleep(1); \
    if ((++_sp & 255u) == 0u) { if (xb_ld(&(bar)[XB_TMO])) break; if (_sp > XB_SPIN_CAP) { atomicAdd(&(bar)[XB_TMO], 1u); break; } } } } while (0)

struct XcdBarrier {
    unsigned* bar; unsigned x;
    volatile LAS unsigned* st;
};

__device__ __forceinline__ XcdBarrier xcd_barrier_post(unsigned* bar, volatile LAS unsigned* st) {
    XcdBarrier b; b.bar = bar; b.x = xb_xcc_id(); b.st = st;
    if (threadIdx.x == 0) (void)xb_add(&bar[XB_XCNT(b.x)], 1u);
    return b;
}
__device__ __forceinline__ void xcd_barrier_complete(unsigned* bar, unsigned x, unsigned& nloc, unsigned& nx) {
    const unsigned G = gridDim.x * gridDim.y * gridDim.z;
    unsigned sum, cnt, mine, sp = 0u;
    for (;;) {
        sum = 0u; cnt = 0u; mine = 0u;
#pragma unroll
        for (unsigned j = 0; j < 16; ++j) { const unsigned c = xb_ld(&bar[XB_XCNT(j)]); sum += c; cnt += (c > 0u) ? 1u : 0u; mine = (j == x) ? c : mine; }
        if (sum == G) break;
        __builtin_amdgcn_s_sleep(1);
        if ((++sp & 255u) == 0u) { if (xb_ld(&bar[XB_TMO])) break; if (sp > XB_SPIN_CAP) { atomicAdd(&bar[XB_TMO], 1u); break; } }
    }
    nloc = mine > 0u ? mine : 1u; nx = cnt > 0u ? cnt : 1u;
}

__device__ __forceinline__ void xcd_barrier(const XcdBarrier& b) {
    asm volatile("s_waitcnt vmcnt(0)" ::: "memory");
    __syncthreads();
    if (threadIdx.x == 0) {
        unsigned* bar = b.bar;
        __builtin_amdgcn_s_waitcnt(0);
        unsigned nloc = b.st[0], nx = b.st[1];
        if (nloc == 0u) { xcd_barrier_complete(bar, b.x, nloc, nx); b.st[0] = nloc; b.st[1] = nx; }
        const unsigned old = xb_add(&bar[XB_XSUB(b.x)], 1u);
        const unsigned gen = old / nloc;
        if (old + 1u == (gen + 1u) * nloc) {
            __builtin_amdgcn_fence(__ATOMIC_RELEASE, "agent");
            asm volatile("s_waitcnt vmcnt(0)" ::: "memory");
            const unsigned og = xb_add(&bar[XB_TOP], 1u);
            const unsigned tg = og / nx;
            if (og + 1u == (tg + 1u) * nx) xb_add(&bar[XB_TOPGEN], 1u);
            else XB_SPIN(xb_ld(&bar[XB_TOPGEN]) == tg, bar);
            __builtin_amdgcn_fence(__ATOMIC_ACQUIRE, "agent");
            xb_add(&bar[XB_XGEN(b.x)], 1u);
            asm volatile("s_waitcnt vmcnt(0)" ::: "memory");
        } else {
            XB_SPIN(xb_ld(&bar[XB_XGEN(b.x)]) == gen, bar);
            __builtin_amdgcn_fence(__ATOMIC_ACQUIRE, "agent");
            asm volatile("s_waitcnt vmcnt(0)" ::: "memory");
        }
    }
    __syncthreads();
}

struct Params {
    const float* in[27];
    float* out;
    unsigned char* ws;
    int ph_lo, ph_hi;
};
enum { IN_X = 0, IN_C, IN_CTX, IN_CCTX, IN_WMOD, IN_BMOD, IN_NORMG, IN_FWI, IN_FWO, IN_EWI, IN_SCW, IN_SCB, IN_CCW, IN_CCB, IN_LNG, IN_LNB, IN_EWO,
       IN_OWI, IN_QG, IN_KG, IN_RPB, IN_LCW, IN_LCB, IN_LGW, IN_LGB, IN_LAM, IN_OWO };

struct SchedStd {
    const char* A; const char* Bt; size_t tstep; int nM, nN, G, c, ntiles;
    __device__ __forceinline__ int nt(const pg8::Unit&) const { return ntiles; }
    __device__ __forceinline__ bool next(int i, pg8::Unit& u) const {
        const long L = (long)i * G + c; if (L >= (long)nM * nN) return false;
        pg8::tile_map((int)L, nM, nN, u.pm, u.pn); u.kind = 0; return true;
    }
    __device__ __forceinline__ const char* a_base(const pg8::Unit& u) const { return A + (size_t)u.pm * tstep; }
    __device__ __forceinline__ const char* b_base(const pg8::Unit& u) const { return Bt + (size_t)u.pn * tstep; }
};

struct SchedDown {
    const char* A; const char* Bt; size_t tstep; int G, c, ntiles;
    __device__ __forceinline__ bool next(int i, pg8::Unit& u) const {
        const long L = (long)i * G + c;
        if (L < 512) { pg8::tile_map((int)L, 64, 8, u.pm, u.pn); u.kind = 0; return true; }
        if (L < 768) { const int q = (int)L - 512, t = q & 63; u.pm = 64 + (t >> 3); u.pn = t & 7; u.kind = 1 + (q >> 6); return true; }
        return false;
    }
    __device__ __forceinline__ int q_nt(int kp) const { const int h = ntiles / 4; return (h & 1) ? ((kp & 1) ? h - 1 : h + 1) : h; }
    __device__ __forceinline__ int q_off(int kp) const { const int h = ntiles / 4; return kp * h + (((h & 1) && (kp & 1)) ? 1 : 0); }
    __device__ __forceinline__ int nt(const pg8::Unit& u) const { return u.kind == 0 ? ntiles : q_nt(u.kind - 1); }
    __device__ __forceinline__ const char* a_base(const pg8::Unit& u) const { return A + (size_t)u.pm * tstep + (u.kind > 1 ? (size_t)q_off(u.kind - 1) * 128 : 0); }
    __device__ __forceinline__ const char* b_base(const pg8::Unit& u) const { return Bt + (size_t)u.pn * tstep + (u.kind > 1 ? (size_t)q_off(u.kind - 1) * 128 : 0); }
};
struct SchedOdIn {
    const char* HN; const char* W; size_t tstep; int G, c;
    __device__ __forceinline__ int nt(const pg8::Unit&) const { return D / 64; }
    __device__ __forceinline__ bool next(int i, pg8::Unit& u) const {
        const long L = (long)i * G + c;
        if (L < 72 * 16) { int pm, pnv; pg8::tile_map((int)L, 72, 16, pm, pnv); u.pm = pm; u.pn = pnv < 8 ? pnv : pnv + 4; u.kind = 0; return true; }
        if (L < 72 * 16 + 4 * 72) { int pm, pn; pg8::tile_map((int)L - 72 * 16, 4, 72, pm, pn); u.pm = pm; u.pn = pn; u.kind = 1; return true; }
        return false;
    }
    __device__ __forceinline__ const char* a_base(const pg8::Unit& u) const { return u.kind == 0 ? HN + (size_t)u.pm * tstep : W + (size_t)(8 + u.pm) * tstep; }
    __device__ __forceinline__ const char* b_base(const pg8::Unit& u) const { return u.kind == 0 ? W + (size_t)u.pn * tstep : HN + (size_t)u.pn * tstep; }
};

struct EpiSwiGLU {
    static constexpr bool PERM = true; static constexpr bool FP8 = false;
    unsigned char* O;
    __device__ __forceinline__ void operator()(const f32x4 (&acc)[2][2][4][2], const pg8::Unit& u, int wr, int wc, int fr, int fq) const {
        const int row0 = u.pm * 256 + wr * 64 + fr, col0 = u.pn * 128 + wc * 32 + 8 * fq;
#pragma unroll
        for (int ai = 0; ai < 2; ++ai)
#pragma unroll
            for (int m = 0; m < 4; ++m) {
                unsigned char* rowp = O + (size_t)(row0 + ai * 128 + m * 16) * DFF + col0;
                float v[8];
#pragma unroll
                for (int n = 0; n < 2; ++n)
#pragma unroll
                    for (int j = 0; j < 4; ++j) { const float g = acc[ai][0][m][n][j], up = acc[ai][1][m][n][j]; v[4 * n + j] = g * fast_sigmoid(g) * up * ACT8_SCALE; }
                u32x2 w; w.x = pk4_fp8(v[0], v[1], v[2], v[3]); w.y = pk4_fp8(v[4], v[5], v[6], v[7]);
                *(u32x2*)rowp = w;
            }
    }
};
template <bool BASE_F32, bool OUT_F32, bool FP8_ = false>
struct EpiResid {
    static constexpr bool PERM = true; static constexpr bool FP8 = FP8_;
    const void* base_lat; const void* base_ctx; void* out; const float* gate; float coef; float* part;
    __device__ __forceinline__ void operator()(const f32x4 (&acc)[2][2][4][2], const pg8::Unit& u, int wr, int wc, int fr, int fq) const {
        const float coef = __builtin_bit_cast(float, __builtin_amdgcn_readfirstlane(__builtin_bit_cast(int, this->coef)));
        GAS float* const part = (GAS float*)(((unsigned long long)(unsigned)__builtin_amdgcn_readfirstlane((int)((unsigned long long)this->part >> 32)) << 32) | (unsigned)__builtin_amdgcn_readfirstlane((int)(unsigned long long)this->part));
        const int row0 = u.pm * 256 + wr * 64 + fr, col0 = u.pn * 256 + wc * 32 + 8 * fq;
        const int r = u.pm < 64 ? (u.pm >> 3) : 8;
        const float* gv = gate + (size_t)r * DMODW + col0;
        f32x4 gvv[2][2];
#pragma unroll
        for (int bj = 0; bj < 2; ++bj)
#pragma unroll
            for (int n = 0; n < 2; ++n) gvv[bj][n] = *(const f32x4*)(gv + bj * 128 + 4 * n) * coef;
        if (u.kind >= 2) {
            GAS float* op = part + (size_t)(u.kind - 2) * (PART_STRIDE / 4) + (size_t)(row0 - M_LAT) * D + col0;
#pragma unroll
            for (int ai = 0; ai < 2; ++ai)
#pragma unroll
                for (int m = 0; m < 4; ++m) { const size_t ro = (size_t)(ai * 128 + m * 16) * D;
#pragma unroll
                    for (int bj = 0; bj < 2; ++bj)
#pragma unroll
                        for (int n = 0; n < 2; ++n) *(GAS f32x4*)(op + ro + bj * 128 + 4 * n) = gvv[bj][n] * acc[ai][bj][m][n]; }
            return;
        }
        const size_t eo = (u.pm < 64 ? (size_t)row0 : (size_t)(row0 - M_LAT)) * D + col0;
        const void* bsel = u.pm < 64 ? base_lat : base_ctx;
        const size_t oo = (size_t)row0 * D + col0;
        if constexpr (!BASE_F32) {
            u32x4 hb[2][4][2];
#pragma unroll
            for (int ai = 0; ai < 2; ++ai)
#pragma unroll
                for (int m = 0; m < 4; ++m)
#pragma unroll
                    for (int bj = 0; bj < 2; ++bj) hb[ai][m][bj] = *(const u32x4*)((const _Float16*)bsel + eo + (size_t)(ai * 128 + m * 16) * D + bj * 128);
#pragma unroll
            for (int ai = 0; ai < 2; ++ai)
#pragma unroll
                for (int m = 0; m < 4; ++m)
#pragma unroll
                    for (int bj = 0; bj < 2; ++bj) { const size_t ro = (size_t)(ai * 128 + m * 16) * D + bj * 128; const u32x4 hv = hb[ai][m][bj];
                        const f32x4 v0 = h4_to_f32x4((u32x2){hv.x, hv.y}) + gvv[bj][0] * acc[ai][bj][m][0], v1 = h4_to_f32x4((u32x2){hv.z, hv.w}) + gvv[bj][1] * acc[ai][bj][m][1];
                        if constexpr (OUT_F32) { *(f32x4*)((float*)out + oo + ro) = v0; *(f32x4*)((float*)out + oo + ro + 4) = v1; }
                        else { const u32x2 h0 = f32x4_to_h4(v0), h1 = f32x4_to_h4(v1); *(u32x4*)((_Float16*)out + oo + ro) = (u32x4){h0.x, h0.y, h1.x, h1.y}; } }
        } else {
#pragma unroll
            for (int ai = 0; ai < 2; ++ai)
#pragma unroll
                for (int mh = 0; mh < 2; ++mh) {
                    f32x4 b[2][2][2];
#pragma unroll
                    for (int mm = 0; mm < 2; ++mm)
#pragma unroll
                        for (int bj = 0; bj < 2; ++bj) { const size_t ro = (size_t)(ai * 128 + (2 * mh + mm) * 16) * D + bj * 128;
                            b[mm][bj][0] = *(const f32x4*)((const float*)bsel + eo + ro); b[mm][bj][1] = *(const f32x4*)((const float*)bsel + eo + ro + 4); }
#pragma unroll
                    for (int mm = 0; mm < 2; ++mm)
#pragma unroll
                        for (int bj = 0; bj < 2; ++bj) { const size_t ro = (size_t)(ai * 128 + (2 * mh + mm) * 16) * D + bj * 128;
                            const f32x4 v0 = b[mm][bj][0] + gvv[bj][0] * acc[ai][bj][2 * mh + mm][0], v1 = b[mm][bj][1] + gvv[bj][1] * acc[ai][bj][2 * mh + mm][1];
                            if constexpr (OUT_F32) { *(f32x4*)((float*)out + oo + ro) = v0; *(f32x4*)((float*)out + oo + ro + 4) = v1; }
                            else { const u32x2 h0 = f32x4_to_h4(v0), h1 = f32x4_to_h4(v1); *(u32x4*)((_Float16*)out + oo + ro) = (u32x4){h0.x, h0.y, h1.x, h1.y}; } }
                    asm volatile("" ::: "memory");
                }
        }
    }
};
struct EpiEvIn {
    static constexpr bool PERM = true; static constexpr bool FP8 = false;
    bf16* O;
    __device__ __forceinline__ void operator()(const f32x4 (&acc)[2][2][4][2], const pg8::Unit& u, int wr, int wc, int fr, int fq) const {
        const int row0 = u.pm * 256 + wr * 64 + fr;
        if (u.pn < 4) {
            const int col0 = u.pn * 256 + wc * 32 + 8 * fq;
#pragma unroll
            for (int ai = 0; ai < 2; ++ai)
#pragma unroll
                for (int m = 0; m < 4; ++m) { bf16* rowp = O + (size_t)(row0 + ai * 128 + m * 16) * ZE_LD + col0;
#pragma unroll
                    for (int bj = 0; bj < 2; ++bj) { const f32x4 v0 = acc[ai][bj][m][0], v1 = acc[ai][bj][m][1];
                        u32x4 w; w.x = pg8::cvt_pk_bf16(v0[0], v0[1]); w.y = pg8::cvt_pk_bf16(v0[2], v0[3]); w.z = pg8::cvt_pk_bf16(v1[0], v1[1]); w.w = pg8::cvt_pk_bf16(v1[2], v1[3]);
                        *(u32x4*)(rowp + bj * 128) = w; } }
        } else {
            const bool glu = u.pn >= 12;
            const int col0 = (glu ? 2048 + (u.pn - 12) * 128 : 1024 + (u.pn - 4) * 128) + wc * 32 + 8 * fq;
#pragma unroll
            for (int ai = 0; ai < 2; ++ai)
#pragma unroll
                for (int m = 0; m < 4; ++m) { bf16* rowp = O + (size_t)(row0 + ai * 128 + m * 16) * ZE_LD + col0;
                    float v[8];
#pragma unroll
                    for (int n = 0; n < 2; ++n)
#pragma unroll
                        for (int j = 0; j < 4; ++j) { const float a = acc[ai][0][m][n][j], b = acc[ai][1][m][n][j]; v[4 * n + j] = glu ? a * fast_sigmoid(b) : a * b; }
                    u32x4 w; w.x = pg8::cvt_pk_bf16(v[0], v[1]); w.y = pg8::cvt_pk_bf16(v[2], v[3]); w.z = pg8::cvt_pk_bf16(v[4], v[5]); w.w = pg8::cvt_pk_bf16(v[6], v[7]);
                    *(u32x4*)rowp = w; }
        }
    }
};
struct EpiOdIn {
    static constexpr bool PERM = true; static constexpr bool FP8 = false;
    bf16* ZO; u32x4* KF; u32x2* VF; const float* qg; const float* kg;
    __device__ __forceinline__ void operator()(const f32x4 (&acc)[2][2][4][2], const pg8::Unit& u, int wr, int wc, int fr, int fq) const {
        const int row0 = u.pm * 256 + wr * 64 + fr;
        if (u.kind == 0 && u.pn < 8) {
            const bool isq = u.pn < 4;
            const float* gp = (isq ? qg : kg) + 8 * fq;
            f32x4 gn[2][2];
#pragma unroll
            for (int bj = 0; bj < 2; ++bj)
#pragma unroll
                for (int n = 0; n < 2; ++n) gn[bj][n] = *(const f32x4*)(gp + 32 * bj + 4 * n);
            const float sc = isq ? 0.125f * 1.44269504089f : 1.0f;
            const int col0 = u.pn * 256 + wc * 64 + 8 * fq, hh = 4 * (u.pn & 3) + wc;
#pragma unroll
            for (int ai = 0; ai < 2; ++ai)
#pragma unroll
                for (int m = 0; m < 4; ++m) {
                    float ss = 0.f;
#pragma unroll
                    for (int bj = 0; bj < 2; ++bj)
#pragma unroll
                        for (int n = 0; n < 2; ++n) { const f32x4 v = acc[ai][bj][m][n]; ss += (v[0] * v[0] + v[1] * v[1]) + (v[2] * v[2] + v[3] * v[3]); }
                    ss += __shfl_xor(ss, 16); ss += __shfl_xor(ss, 32);
                    const float rs = sc / sqrtf(ss * (1.0f / HD) + EPS);
                    const int row = row0 + ai * 128 + m * 16;
                    bf16* rowp = ZO + (size_t)row * ZO_LD + col0;
                    u32x4* kfp = KF + ((size_t)((row >> 4) * 16 + hh) * 8 + fq) * 16 + (row & 15);
#pragma unroll
                    for (int bj = 0; bj < 2; ++bj) { const f32x4 v0 = acc[ai][bj][m][0] * rs * gn[bj][0], v1 = acc[ai][bj][m][1] * rs * gn[bj][1];
                        u32x4 w; w.x = pg8::cvt_pk_bf16(v0[0], v0[1]); w.y = pg8::cvt_pk_bf16(v0[2], v0[3]); w.z = pg8::cvt_pk_bf16(v1[0], v1[1]); w.w = pg8::cvt_pk_bf16(v1[2], v1[3]);
                        if (isq) *(u32x4*)(rowp + bj * 32) = w; else kfp[bj * 64] = w; }
                }
            return;
        }
        if (u.kind == 1) {
#pragma unroll
            for (int ai = 0; ai < 2; ++ai)
#pragma unroll
                for (int m = 0; m < 4; ++m) { const int ch = row0 + ai * 128 + m * 16;
#pragma unroll
                    for (int bj = 0; bj < 2; ++bj)
#pragma unroll
                        for (int n = 0; n < 2; ++n) { const int t = u.pn * 256 + bj * 128 + wc * 32 + 8 * fq + 4 * n; const f32x4 v = acc[ai][bj][m][n];
                            u32x2 w; w.x = pg8::cvt_pk_bf16(v[0], v[1]); w.y = pg8::cvt_pk_bf16(v[2], v[3]);
                            VF[((size_t)(((t >> 4) * 16 + (ch >> 6)) * 4 + ((ch >> 4) & 3)) * 4 + ((t >> 2) & 3)) * 16 + (ch & 15)] = w; } }
            return;
        }
        const int col0 = u.pn * 256 + wc * 32 + 8 * fq;
#pragma unroll
        for (int ai = 0; ai < 2; ++ai)
#pragma unroll
            for (int m = 0; m < 4; ++m) { bf16* rowp = ZO + (size_t)(row0 + ai * 128 + m * 16) * ZO_LD + col0;
#pragma unroll
                for (int bj = 0; bj < 2; ++bj) { const f32x4 v0 = acc[ai][bj][m][0], v1 = acc[ai][bj][m][1];
                    u32x4 w; w.x = pg8::cvt_pk_bf16(v0[0], v0[1]); w.y = pg8::cvt_pk_bf16(v0[2], v0[3]); w.z = pg8::cvt_pk_bf16(v1[0], v1[1]); w.w = pg8::cvt_pk_bf16(v1[2], v1[3]);
                    *(u32x4*)(rowp + bj * 128) = w; } }
    }
};

__device__ __forceinline__ int srccol(int map, int n) {
    if (map == 0) return n;
    const int pn = n >> 8, bj = (n >> 7) & 1, i = n & 127;
    if (map == 1) return bj * DFF + 128 * pn + i;
    if (map == 2) {
        if (pn < 4) return n;
        if (pn < 12) return 1024 + bj * 1024 + 128 * (pn - 4) + i;
        return 3072 + bj * 1024 + 128 * (pn - 12) + i;
    }
    if (pn < 8) return 256 * pn + 64 * ((n >> 5) & 3) + 32 * bj + (n & 31);
    return n;
}
constexpr int TR_FI = (D / 64) * (2 * DFF / 64), TR_FO = (DFF / 64) * (D / 64), TR_IN = (D / 64) * (D_EIN / 64), TR_OUT = (D / 64) * (D / 64);
constexpr int TR_NITEMS = 4 * TR_FI + 4 * TR_FO + 2 * TR_IN + 2 * TR_OUT;
#ifndef TR_SA
#define TR_SA 11264
#endif
#ifndef TR_SB
#define TR_SB 768
#endif
constexpr int TR_PRO = TR_NITEMS - 3 * TR_SA - 2 * TR_SB;
constexpr int TR_SLOT[6] = {TR_PRO, TR_PRO + TR_SA, TR_PRO + TR_SA + TR_SB, TR_PRO + 2 * TR_SA + TR_SB, TR_PRO + 3 * TR_SA + TR_SB, TR_NITEMS};
static_assert(TR_SLOT[0] >= TR_FI, "FFN-in q0 is needed by phase 2: prologue");
static_assert(TR_SLOT[1] >= TR_FI + TR_FO + TR_IN, "FFN-out q0 (phase 3) and even-in (phase 5) must be done by the end of slot 0 (phase 2)");
static_assert(TR_SLOT[2] >= TR_FI + TR_FO + TR_IN + TR_OUT + TR_FI, "even-out (phase 7), FFN-in q1 (phase 9) by the end of slot 1 (phase 5)");
static_assert(TR_SLOT[3] >= 3 * TR_FI + 3 * TR_FO + TR_IN + TR_OUT, "FFN-out q1 (10), FFN-in q2 (12), FFN-out q2 (13) by the end of slot 2 (phase 9)");
static_assert(TR_SLOT[4] >= 3 * TR_FI + 3 * TR_FO + 2 * TR_IN + 2 * TR_OUT, "odd-in (15), odd-out (17) by the end of slot 3 (phase 12)");
struct TrItem { const float* src; bf16* dst; int N, K, fp8; };
__device__ __forceinline__ TrItem p0_item_of(const Params& p, int it, int lane) {
    const float* W; bf16* WT; int K, N, map, r = it, f8 = 0;
#define TR_FFN_IN(q)  { W = p.in[IN_FWI] + (size_t)(q) * D * 2 * DFF; WT = (bf16*)(p.ws + WS_WFI + (q) * WFI_STRIDE); K = D; N = 2 * DFF; map = 1; }
#define TR_FFN_OUT(q) { W = p.in[IN_FWO] + (size_t)(q) * DFF * D; WT = (bf16*)(p.ws + WS_WFO + (q) * WFO_STRIDE); K = DFF; N = D; map = 0; f8 = 1; }
    if (r < TR_FI) TR_FFN_IN(0)
    else if ((r -= TR_FI) < TR_FO) TR_FFN_OUT(0)
    else if ((r -= TR_FO) < TR_IN) { W = p.in[IN_EWI]; WT = (bf16*)(p.ws + WS_WEI); K = D; N = D_EIN; map = 2; }
    else if ((r -= TR_IN) < TR_OUT) { W = p.in[IN_EWO]; WT = (bf16*)(p.ws + WS_WEO); K = D; N = D; map = 0; }
    else if ((r -= TR_OUT) < TR_FI) TR_FFN_IN(1)
    else if ((r -= TR_FI) < TR_FO) TR_FFN_OUT(1)
    else if ((r -= TR_FO) < TR_FI) TR_FFN_IN(2)
    else if ((r -= TR_FI) < TR_FO) TR_FFN_OUT(2)
    else if ((r -= TR_FO) < TR_IN) { W = p.in[IN_OWI]; WT = (bf16*)(p.ws + WS_WOI); K = D; N = D_OIN; map = 3; }
    else if ((r -= TR_IN) < TR_OUT) { W = p.in[IN_OWO]; WT = (bf16*)(p.ws + WS_WOO); K = D; N = D; map = 0; }
    else if ((r -= TR_OUT) < TR_FI) TR_FFN_IN(3)
    else { r -= TR_FI; TR_FFN_OUT(3) }
#undef TR_FFN_IN
#undef TR_FFN_OUT
    const int nblk = N / 64, kb = r / nblk, nb = r % nblk, k0 = 64 * kb, n0 = 64 * nb;
    TrItem t; t.src = W + (size_t)k0 * N + srccol(map, n0 + lane); t.N = N; t.K = K; t.fp8 = f8;
    t.dst = f8 ? (bf16*)((unsigned char*)WT + (size_t)n0 * K + k0) : WT + (size_t)n0 * K + k0; return t;
}
__device__ __forceinline__ void tr_range(const Params& p, LAS unsigned char* lds, int first, int stride, int end, int lane, int wave) {
    LAS float* scr = (LAS float*)(lds + wave * (64 * 65 * 4));
    if (first >= end) return;
    float ra[64];
    TrItem cur = p0_item_of(p, first, lane);
#pragma unroll
    for (int i = 0; i < 64; ++i) ra[i] = cur.src[(size_t)i * cur.N];
#pragma unroll 1
    for (int it = first; it < end; it += stride) {
#pragma unroll
        for (int i = 0; i < 64; ++i) scr[i * 65 + lane] = ra[i];
        const bool more = it + stride < end;
        TrItem nxt = cur;
        if (more) { nxt = p0_item_of(p, it + stride, lane);
#pragma unroll
            for (int i = 0; i < 64; ++i) ra[i] = nxt.src[(size_t)i * nxt.N]; }
        LDS_WAIT(); asm volatile("" ::: "memory");
        if (cur.fp8) {
            const int c = lane & 3;
#pragma unroll
            for (int j = 0; j < 4; ++j) { const int n = (lane >> 2) + 16 * j; const LAS float* s = scr + (16 * c) * 65 + n;
                u32x4 o;
                o.x = pk4_fp8(s[0 * 65] * W8_SCALE, s[1 * 65] * W8_SCALE, s[2 * 65] * W8_SCALE, s[3 * 65] * W8_SCALE);
                o.y = pk4_fp8(s[4 * 65] * W8_SCALE, s[5 * 65] * W8_SCALE, s[6 * 65] * W8_SCALE, s[7 * 65] * W8_SCALE);
                o.z = pk4_fp8(s[8 * 65] * W8_SCALE, s[9 * 65] * W8_SCALE, s[10 * 65] * W8_SCALE, s[11 * 65] * W8_SCALE);
                o.w = pk4_fp8(s[12 * 65] * W8_SCALE, s[13 * 65] * W8_SCALE, s[14 * 65] * W8_SCALE, s[15 * 65] * W8_SCALE);
                *(u32x4*)((unsigned char*)cur.dst + (size_t)n * cur.K + 16 * c) = o; }
        } else {
        const int c = lane & 7;
#pragma unroll
        for (int j = 0; j < 8; ++j) { const int n = (lane >> 3) + 8 * j; const LAS float* s = scr + (8 * c) * 65 + n;
            u32x4 o; o.x = pg8::cvt_pk_bf16(s[0 * 65], s[1 * 65]); o.y = pg8::cvt_pk_bf16(s[2 * 65], s[3 * 65]); o.z = pg8::cvt_pk_bf16(s[4 * 65], s[5 * 65]); o.w = pg8::cvt_pk_bf16(s[6 * 65], s[7 * 65]);
            *(u32x4*)(cur.dst + (size_t)n * cur.K + 8 * c) = o; }
        }
        LDS_WAIT(); asm volatile("" ::: "memory");
        cur = nxt;
    }
}
__device__ __forceinline__ void p0_weights(const Params& p, LAS unsigned char* lds, int lane, int wave) {
    tr_range(p, lds, blockIdx.x * 8 + wave, gridDim.x * 8, TR_SLOT[0], lane, wave);
}
__device__ __forceinline__ void tail_convert(const Params& p, LAS unsigned char* lds, int slot, int units, int lane, int wave) {
    const int G = gridDim.x, c = blockIdx.x, rem = units % G;
    if (rem != 0 && c < rem) return;
    const int nw = rem ? G - rem : G, j = rem ? c - rem : c;
    tr_range(p, lds, TR_SLOT[slot] + j * 8 + wave, nw * 8, TR_SLOT[slot + 1], lane, wave);
}
template <class T> __device__ __forceinline__ T* uniform_ptr(T* p) {
    const unsigned long long v = (unsigned long long)p;
    return (T*)(((unsigned long long)(unsigned)__builtin_amdgcn_readfirstlane((int)(v >> 32)) << 32) | (unsigned)__builtin_amdgcn_readfirstlane((int)v));
}
__device__ __forceinline__ void p0_modvec(const Params& p, LAS unsigned char* lds, int tid, int lane, int wave) {
    LAS float* svT = (LAS float*)lds;
    LAS float* red = (LAS float*)(lds + 2048 * 16 * 4);
    volatile LAS int* qslot = (volatile LAS int*)(lds + 2048 * 16 * 4 + 8 * 9 * 64 * 4);
    const float* c = p.in[IN_C]; const float* cc = p.in[IN_CCTX];
    for (int i = tid; i < 9 * 2048; i += 512) { const float v = i < 8 * 2048 ? c[i] : cc[i - 8 * 2048]; svT[(i & 2047) * 16 + (i >> 11)] = v / (1.0f + __expf(-v)); }
    float* MOD = (float*)(p.ws + WS_MOD);
    unsigned* qhead = (unsigned*)(p.ws + WS_CTL) + CW_Q;
    if (tid == 0) qslot[0] = (int)__hip_atomic_fetch_add(qhead, 1u, __ATOMIC_RELAXED, __HIP_MEMORY_SCOPE_AGENT);
    const int ln = lane & 15, lk = lane >> 4;
    const LAS float* svw = svT + (wave * 256 + lk) * 16 + ln;
    int par = 0;
    for (;;) {
        __syncthreads();
        const int item = __builtin_amdgcn_readfirstlane(qslot[par]);
        if (item >= 2 * 288) break;
        const int l = item / 288, col0 = (item % 288) * 64;
        const GAS float* Wu = (const GAS float*)uniform_ptr(p.in[IN_WMOD] + (size_t)l * D * DMODW + col0 + (size_t)(wave * 256) * DMODW);
        const unsigned loff = (unsigned)(lk * DMODW + ln);
        f32x4 acc[4];
#pragma unroll
        for (int j = 0; j < 4; ++j) acc[j] = (f32x4){0.f, 0.f, 0.f, 0.f};
#define MV_LOAD(w, g16) do { _Pragma("unroll") for (int qq = 0; qq < 4; ++qq) { const GAS float* rp_ = Wu + (size_t)(16 * (g16) + 4 * qq) * DMODW; \
            _Pragma("unroll") for (int j = 0; j < 4; ++j) w[4 * qq + j] = (rp_ + 16 * j)[loff]; } asm volatile("" ::: "memory"); } while (0)
#define MV_COMP(w, g16) do { _Pragma("unroll") for (int qq = 0; qq < 4; ++qq) { const float a_ = svw[64 * (4 * (g16) + qq)]; \
            _Pragma("unroll") for (int j = 0; j < 4; ++j) acc[j] = __builtin_amdgcn_mfma_f32_16x16x4f32(a_, w[4 * qq + j], acc[j], 0, 0, 0); } } while (0)
        float wa[16], wb[16], wc[16];
        MV_LOAD(wa, 0); MV_LOAD(wb, 1); MV_LOAD(wc, 2);
        unsigned nxt = 0u;
        if (tid == 0) nxt = __hip_atomic_fetch_add(qhead, 1u, __ATOMIC_RELAXED, __HIP_MEMORY_SCOPE_AGENT);
        MV_COMP(wa, 0); MV_LOAD(wa, 3);
        MV_COMP(wb, 1); MV_LOAD(wb, 4);
        MV_COMP(wc, 2); MV_LOAD(wc, 5);
        MV_COMP(wa, 3); MV_LOAD(wa, 6);
        MV_COMP(wb, 4); MV_LOAD(wb, 7);
        MV_COMP(wc, 5); MV_LOAD(wc, 8);
        MV_COMP(wa, 6); MV_LOAD(wa, 9);
        MV_COMP(wb, 7); MV_LOAD(wb, 10);
        MV_COMP(wc, 8); MV_LOAD(wc, 11);
        MV_COMP(wa, 9); MV_LOAD(wa, 12);
        MV_COMP(wb, 10); MV_LOAD(wb, 13);
        MV_COMP(wc, 11); MV_LOAD(wc, 14);
        MV_COMP(wa, 12); MV_LOAD(wa, 15);
        MV_COMP(wb, 13);
        MV_COMP(wc, 14);
        MV_COMP(wa, 15);
#undef MV_LOAD
#undef MV_COMP
#pragma unroll
        for (int j = 0; j < 4; ++j)
#pragma unroll
            for (int e = 0; e < 4; ++e) { const int r = 4 * lk + e; if (r < 9) red[(wave * 9 + r) * 64 + 16 * j + ln] = acc[j][e]; }
        if (tid == 0) qslot[par ^ 1] = (int)nxt;
        __syncthreads();
        int t2 = tid; asm volatile("" : "+v"(t2));
        for (int o = t2; o < 9 * 64; o += 512) {
            const int r = o >> 6, cn = o & 63; float s = 0.f;
#pragma unroll
            for (int w = 0; w < 8; ++w) s += red[(w * 9 + r) * 64 + cn];
            MOD[((size_t)l * 9 + r) * DMODW + col0 + cn] = s + p.in[IN_BMOD][(size_t)l * DMODW + col0 + cn];
        }
        par ^= 1;
    }
}

template <bool COMBINE, bool SRC_F32>
__device__ __forceinline__ void norm_phase(LAS unsigned char* lds, const void* src_lat, const void* src_ctx, _Float16* xw_ctx, const float* part, int nrows, const float* g, const float* modl, int shift_idx, int scale_idx, bf16* HN, int tid, int lane, int wave) {
    const int gw = blockIdx.x * 8 + wave, NGW = gridDim.x * 8;
    LAS _Float16* Gs = (LAS _Float16*)lds;
    LAS _Float16* Ss = Gs + 9 * D;
    {
        const f32x4 gg = *(const f32x4*)(g + 4 * tid);
        f32x4 s1[9], s0[9];
#pragma unroll
        for (int r = 0; r < 9; ++r) { s1[r] = *(const f32x4*)(modl + (size_t)r * DMODW + scale_idx * D + 4 * tid); s0[r] = *(const f32x4*)(modl + (size_t)r * DMODW + shift_idx * D + 4 * tid); }
#pragma unroll
        for (int r = 0; r < 9; ++r) { *(LAS u32x2*)(Gs + r * D + 4 * tid) = f32x4_to_h4(gg * (1.0f + s1[r])); *(LAS u32x2*)(Ss + r * D + 4 * tid) = f32x4_to_h4(s0[r]); }
    }
    f32x4 v[8], nv[8];
#define NORM_COL(jj) (SRC_F32 ? 4 * lane + 256 * (jj) : 8 * lane + 512 * ((jj) >> 1) + 4 * ((jj) & 1))
#define NORM_LOAD(dst, row) do { const int row_ = (row); const size_t ro_ = (row_ < M_LAT ? (size_t)row_ : (size_t)(row_ - M_LAT)) * D; const void* sp_ = row_ < M_LAT ? src_lat : src_ctx; \
        if constexpr (SRC_F32) { _Pragma("unroll") for (int j = 0; j < 8; ++j) dst[j] = *(const f32x4*)((const float*)sp_ + ro_ + NORM_COL(j)); } \
        else { _Pragma("unroll") for (int j = 0; j < 4; ++j) { const u32x4 hv_ = *(const u32x4*)((const _Float16*)sp_ + ro_ + NORM_COL(2 * j)); dst[2 * j] = h4_to_f32x4((u32x2){hv_.x, hv_.y}); dst[2 * j + 1] = h4_to_f32x4((u32x2){hv_.z, hv_.w}); } } \
        if (COMBINE && row_ >= M_LAT) { f32x4 tp_[3][8]; _Pragma("unroll") for (int q = 0; q < 3; ++q) { const float* pr_ = part + (size_t)q * (PART_STRIDE / 4) + ro_; \
            _Pragma("unroll") for (int j = 0; j < 8; ++j) tp_[q][j] = *(const f32x4*)(pr_ + NORM_COL(j)); } \
            _Pragma("unroll") for (int j = 0; j < 8; ++j) dst[j] += (tp_[0][j] + tp_[1][j]) + tp_[2][j]; } } while (0)
    if (gw < nrows) NORM_LOAD(v, gw);
    lds_barrier();
    for (int row = gw; row < nrows; row += NGW) {
        if (row + NGW < nrows) NORM_LOAD(nv, row + NGW);
        const int r = row < M_LAT ? (row >> 11) : 8;
        float ss = 0.f;
#pragma unroll
        for (int j = 0; j < 8; ++j) ss += (v[j][0] * v[j][0] + v[j][1] * v[j][1]) + (v[j][2] * v[j][2] + v[j][3] * v[j][3]);
        const float rstd = 1.0f / sqrtf(wave_sum_dpp(ss) * (1.0f / D) + EPS);
        bf16* o = HN + (size_t)row * D;
        f32x4 y[8];
#pragma unroll
        for (int j = 0; j < 8; ++j) { const int c = NORM_COL(j); y[j] = (v[j] * rstd) * h4_to_f32x4(*(const LAS u32x2*)(Gs + r * D + c)) + h4_to_f32x4(*(const LAS u32x2*)(Ss + r * D + c)); }
        if constexpr (SRC_F32) {
#pragma unroll
            for (int j = 0; j < 8; ++j) { u32x2 w; w.x = pg8::cvt_pk_bf16(y[j][0], y[j][1]); w.y = pg8::cvt_pk_bf16(y[j][2], y[j][3]); *(u32x2*)(o + NORM_COL(j)) = w; }
        } else {
#pragma unroll
            for (int j = 0; j < 4; ++j) { u32x4 w; w.x = pg8::cvt_pk_bf16(y[2 * j][0], y[2 * j][1]); w.y = pg8::cvt_pk_bf16(y[2 * j][2], y[2 * j][3]); w.z = pg8::cvt_pk_bf16(y[2 * j + 1][0], y[2 * j + 1][1]); w.w = pg8::cvt_pk_bf16(y[2 * j + 1][2], y[2 * j + 1][3]);
                *(u32x4*)(o + NORM_COL(2 * j)) = w; }
        }
        if (COMBINE && row >= M_LAT) {
#pragma unroll
            for (int j = 0; j < 4; ++j) { const u32x2 h0 = f32x4_to_h4(v[2 * j]), h1 = f32x4_to_h4(v[2 * j + 1]); *(u32x4*)(xw_ctx + (size_t)(row - M_LAT) * D + NORM_COL(2 * j)) = (u32x4){h0.x, h0.y, h1.x, h1.y}; }
        }
#pragma unroll
        for (int j = 0; j < 8; ++j) v[j] = nv[j];
    }
    __syncthreads();
#undef NORM_LOAD
#undef NORM_COL
}

template <int NT>
__device__ __forceinline__ void even_conv_unit(const Params& p, LAS unsigned char* lds, int base, int T, int t0, int tid_in, int lane, int wave) {
    int tid = tid_in; asm volatile("" : "+v"(tid));
    const bf16* Z3 = (const bf16*)(p.ws + WS_Z); bf16* MIX = (bf16*)(p.ws + WS_MIX);
    constexpr int NR = NT + 30;
    LAS float* red = (LAS float*)lds;
    LAS float* stat = red + 256;
    const float* ccw = p.in[IN_CCW]; const float* ccb = p.in[IN_CCB]; const float* lng = p.in[IN_LNG]; const float* lnb = p.in[IN_LNB];
    const float* scw = p.in[IN_SCW]; const float* scb = p.in[IN_SCB];
    unsigned pv[NT + 2], bgv[NT], xr[NR];
#pragma unroll
    for (int i = 0; i < NT + 2; ++i) { const int tc = min(max(t0 - 1 + i, 0), T - 1); pv[i] = *(const unsigned*)(Z3 + (size_t)(base + tc) * ZE_LD + 1024 + 2 * tid); }
#pragma unroll
    for (int i = 0; i < NT; ++i) bgv[i] = *(const unsigned*)(Z3 + (size_t)(base + t0 + i) * ZE_LD + 2 * tid);
#pragma unroll
    for (int j = 0; j < NR; ++j) { const int tc = min(max(t0 - 15 + j, 0), T - 1); xr[j] = *(const unsigned*)(Z3 + (size_t)(base + tc) * ZE_LD + 2048 + 2 * tid); }
    const f32x2 cbias = *(const f32x2*)(ccb + 2 * tid);
    if (t0 == 0) pv[0] = 0u;
    if (t0 + NT == T) pv[NT + 1] = 0u;
    { const f32x2 w0 = *(const f32x2*)(scw + 2 * tid), w1 = *(const f32x2*)(scw + 1024 + 2 * tid), w2 = *(const f32x2*)(scw + 2048 + 2 * tid), b = *(const f32x2*)(scb + 2 * tid);
#pragma unroll
      for (int i = 0; i < NT; ++i) {
          const float c0 = w0[0] * bf_lo(pv[i]) + w1[0] * bf_lo(pv[i + 1]) + w2[0] * bf_lo(pv[i + 2]) + b[0];
          const float c1 = w0[1] * bf_hi(pv[i]) + w1[1] * bf_hi(pv[i + 1]) + w2[1] * bf_hi(pv[i + 2]) + b[1];
          *(unsigned*)(MIX + (size_t)(base + t0 + i) * D + 2 * tid) = pg8::cvt_pk_bf16(bf_lo(bgv[i]) * c0, bf_hi(bgv[i]) * c1); } }
    if (t0 < 15 || t0 + NT + 15 > T) {
#pragma unroll
        for (int j = 0; j < NR; ++j) { const int t = t0 - 15 + j; if (t < 0 || t >= T) xr[j] = 0u; }
    }
    f32x2 xf[NR];
#pragma unroll
    for (int j = 0; j < NR; ++j) xf[j] = (f32x2){bf_lo(xr[j]), bf_hi(xr[j])};
    f32x2 acc[NT];
#pragma unroll
    for (int i = 0; i < NT; ++i) acc[i] = cbias;
    {
        const float* wp_ = ccw + 2 * tid;
#pragma unroll
        for (int k = 0; k < 31; ++k) { const f32x2 w = *(const f32x2*)(wp_ + (size_t)k * 1024);
#pragma unroll
            for (int i = 0; i < NT; ++i) acc[i] += w * xf[i + k]; }
    }
#pragma unroll
    for (int i = 0; i < NT; ++i) { const float s = wave_sum_dpp(acc[i][0] + acc[i][1]); if (lane == 0) red[wave * 32 + i] = s; }
    lds_barrier();
    if (tid < NT) { float s = 0.f;
#pragma unroll
        for (int ww = 0; ww < 8; ++ww) s += red[ww * 32 + tid]; stat[tid] = s * (1.0f / 1024.0f); }
    lds_barrier();
#pragma unroll
    for (int i = 0; i < NT; ++i) { const float mu = stat[i]; acc[i] -= mu; }
    lds_barrier();
#pragma unroll
    for (int i = 0; i < NT; ++i) { const float s = wave_sum_dpp(acc[i][0] * acc[i][0] + acc[i][1] * acc[i][1]); if (lane == 0) red[wave * 32 + i] = s; }
    lds_barrier();
    const f32x2 lg = *(const f32x2*)(lng + 2 * tid), lb = *(const f32x2*)(lnb + 2 * tid);
    if (tid < NT) { float s = 0.f;
#pragma unroll
        for (int ww = 0; ww < 8; ++ww) s += red[ww * 32 + tid]; stat[tid] = 1.0f / sqrtf(s * (1.0f / 1024.0f) + EPS); }
    lds_barrier();
#pragma unroll
    for (int i = 0; i < NT; ++i) { const float rs = stat[i]; const float y0 = acc[i][0] * rs * lg[0] + lb[0], y1 = acc[i][1] * rs * lg[1] + lb[1];
        *(unsigned*)(MIX + (size_t)(base + t0 + i) * D + 1024 + 2 * tid) = pg8::cvt_pk_bf16(y0 * fast_sigmoid(y0), y1 * fast_sigmoid(y1)); }
    lds_barrier();
}
__device__ __forceinline__ void even_conv_phase(const Params& p, LAS unsigned char* lds, int tid, int lane, int wave) {
    for (int k = blockIdx.x; k < 512 + 256; k += gridDim.x) {
        if (k < 512) { const int u = (k & 7) * 64 + (k >> 3); even_conv_unit<32>(p, lds, (u >> 6) * SEQ, SEQ, (u & 63) * 32, tid, lane, wave); }
        else { const int v0 = k - 512, v = (v0 & 7) * 32 + (v0 >> 3); even_conv_unit<8>(p, lds, M_LAT + (v >> 5) * CTXL, CTXL, (v & 31) * 8, tid, lane, wave); }
    }
}

__device__ __forceinline__ float rows_max(float v) { float a = v, c = v; asm volatile("s_nop 1\n\tv_permlane16_swap_b32 %0, %1" : "+v"(a), "+v"(c)); v = __builtin_fmaxf(a, c);
    a = v; c = v; asm volatile("s_nop 1\n\tv_permlane32_swap_b32 %0, %1" : "+v"(a), "+v"(c)); return __builtin_fmaxf(a, c); }
__device__ __forceinline__ float rows_sum(float v) { float a = v, c = v; asm volatile("s_nop 1\n\tv_permlane16_swap_b32 %0, %1" : "+v"(a), "+v"(c)); v = a + c;
    a = v; c = v; asm volatile("s_nop 1\n\tv_permlane32_swap_b32 %0, %1" : "+v"(a), "+v"(c)); return a + c; }
__device__ __forceinline__ float max3f(float a, float b, float c) { float r; asm("v_max3_f32 %0, %1, %2, %3" : "=v"(r) : "v"(a), "v"(b), "v"(c)); return r; }
constexpr int ATT_PAD = 471, ATT_HT = 465 + ATT_PAD;
constexpr int ATT_CK_OFF = 4096, ATT_CV_OFF = ATT_CK_OFF + 32768, ATT_Q_OFF = ATT_CV_OFF + 32768, ATT_RING_OFF = ATT_Q_OFF + 8 * 2048, ATT_NSLOT = 9;
static_assert(ATT_HT * 4 <= ATT_CK_OFF && ATT_RING_OFF + ATT_NSLOT * 8192 <= MISC_OFF, "attention LDS map");
__device__ __forceinline__ void attn_wave_unit(const Params& p, const LAS float* rpbh, const LAS u32x4* ckL, const LAS u32x4* cvL, const LAS u32x4* ringL, LAS u32x4* qL, int b, int h, int r, int qg, int lane) {
    const bf16* ZO = (const bf16*)(p.ws + WS_Z); const u32x2* VF = (const u32x2*)(p.ws + WS_VT); bf16* MIX = (bf16*)(p.ws + WS_MIX);
    const int l15 = lane & 15, g = lane >> 4;
    const int c0 = 16 * qg, qc = c0 + l15, qrow = b * SEQ + r * GW + qc;
    const int r0 = min(max(r - WIN_R / 2, 0), GROWS - WIN_R);
    const int kb = qg == 0 ? 0 : (qg == 1 ? 8 : (qg == 2 ? 24 : 32));
    const int cs = min(max(qc - WIN_C / 2, 0), GW - WIN_C);
#pragma unroll
    for (int kk = 0; kk < 2; ++kk) qL[kk * 64 + lane] = *(const u32x4*)(ZO + (size_t)qrow * ZO_LD + h * HD + 8 * g + 32 * kk);
#define ATT_QF() bf16x8 qf[2]; asm volatile("" ::: "memory"); qf[0] = __builtin_bit_cast(bf16x8, qL[lane]); qf[1] = __builtin_bit_cast(bf16x8, qL[64 + lane]);
    unsigned dcol[4];
#pragma unroll
    for (int j = 0; j < 8; ++j) { const int a = j >> 2, e = j & 3, kc = kb + 16 * a + 4 * g + e; const unsigned dc = ((kc >= cs) && (kc < cs + WIN_C)) ? (unsigned)(kc - qc + WIN_C - 1) : 465u;
        if (j & 1) dcol[j >> 1] |= dc << 16; else dcol[j >> 1] = dc; }
    const bool mis = (kb & 8) != 0;
    const unsigned klo_ctx = (unsigned)(g * 16 + l15), klo_ring = (unsigned)((kb >> 4) * 128) + (mis ? (unsigned)(((l15 + 8) >> 4) * 128 + g * 16 + ((l15 + 8) & 15)) : klo_ctx);
    const unsigned vlo_ctx = (unsigned)(g * 16 + l15), vlo_loc = mis ? (unsigned)(((4 * g + 8) >> 4) * 4096 + (((4 * g + 8) >> 2) & 3) * 16 + l15) : vlo_ctx;
    u32x4 vx[4][4];
#define ATT_TOK0(ch) (b * SEQ + (r0 + ((ch) - 8)) * GW + kb)
#define ATT_LOADV(s) do { _Pragma("unroll") for (int c = 0; c < 4; ++c) { const int tb_ = ATT_TOK0(4 * (s) + c) >> 4; \
        _Pragma("unroll") for (int a = 0; a < 2; ++a) { const u32x2* vp_ = VF + ((size_t)(tb_ + a) * 4096 + h * 256); \
            _Pragma("unroll") for (int d = 0; d < 4; ++d) { const u32x2 t_ = (vp_ + d * 64)[vlo_loc]; if (a == 0) { vx[c][d].x = t_.x; vx[c][d].y = t_.y; } else { vx[c][d].z = t_.x; vx[c][d].w = t_.y; } } } } } while (0)
#define ATT_SOFTMAX() \
        float mx_ = -1e30f, my_ = -1e30f; \
        _Pragma("unroll") for (int c = 0; c < 4; ++c) _Pragma("unroll") for (int a = 0; a < 2; ++a) { mx_ = max3f(mx_, sc_[c][a][0], sc_[c][a][1]); my_ = max3f(my_, sc_[c][a][2], sc_[c][a][3]); } \
        mx_ = rows_max(max3f(mx_, my_, my_)); \
        const float mnew_ = fmaxf(mrun, mx_), alpha_ = __builtin_amdgcn_exp2f(mrun - mnew_); mrun = mnew_; \
        float ps_ = 0.f; bf16x8 pf_[4]; \
        _Pragma("unroll") for (int c = 0; c < 4; ++c) { float pe_[8]; \
            _Pragma("unroll") for (int a = 0; a < 2; ++a) _Pragma("unroll") for (int e = 0; e < 4; ++e) { pe_[4 * a + e] = __builtin_amdgcn_exp2f(sc_[c][a][e] - mnew_); ps_ += pe_[4 * a + e]; } \
            u32x4 pw_; pw_.x = pg8::cvt_pk_bf16(pe_[0], pe_[1]); pw_.y = pg8::cvt_pk_bf16(pe_[2], pe_[3]); pw_.z = pg8::cvt_pk_bf16(pe_[4], pe_[5]); pw_.w = pg8::cvt_pk_bf16(pe_[6], pe_[7]); \
            pf_[c] = __builtin_bit_cast(bf16x8, pw_); } \
        lsum = lsum * alpha_ + ps_;
    f32x4 o[4];
#pragma unroll
    for (int d = 0; d < 4; ++d) o[d] = (f32x4){0.f, 0.f, 0.f, 0.f};
    float mrun = -1e30f, lsum = 0.f;
    ATT_LOADV(2);
#pragma unroll 1
    for (int s = 0; s < 2; ++s) {
        f32x4 sc_[4][2]; ATT_QF()
        const LAS u32x4* kb_ = ckL + s * 1024 + klo_ctx;
#pragma unroll
        for (int c = 0; c < 4; ++c)
#pragma unroll
            for (int a = 0; a < 2; ++a) { f32x4 acc_ = (f32x4){0.f, 0.f, 0.f, 0.f};
                acc_ = __builtin_amdgcn_mfma_f32_16x16x32_bf16(__builtin_bit_cast(bf16x8, kb_[c * 256 + a * 128]), qf[0], acc_, 0, 0, 0);
                acc_ = __builtin_amdgcn_mfma_f32_16x16x32_bf16(__builtin_bit_cast(bf16x8, kb_[c * 256 + a * 128 + 64]), qf[1], acc_, 0, 0, 0); sc_[c][a] = acc_; }
        ATT_SOFTMAX()
        const LAS u32x4* vb_ = cvL + s * 1024 + vlo_ctx;
#pragma unroll
        for (int d = 0; d < 4; ++d) { o[d] = o[d] * alpha_;
#pragma unroll
            for (int c = 0; c < 4; ++c) o[d] = __builtin_amdgcn_mfma_f32_16x16x32_bf16(__builtin_bit_cast(bf16x8, vb_[c * 256 + d * 64]), pf_[c], o[d], 0, 0, 0); }
    }
    asm volatile("s_waitcnt vmcnt(0)" ::: "memory"); __builtin_amdgcn_s_barrier(); asm volatile("" ::: "memory");
#pragma unroll 1
    for (int s = 2; s < 4; ++s) {
        f32x4 sc_[4][2]; ATT_QF()
#pragma unroll
        for (int c = 0; c < 4; ++c) { const int rr_ = r0 + 4 * (s - 2) + c; const LAS u32x4* kr_ = ringL + (rr_ % ATT_NSLOT) * 512 + klo_ring;
#pragma unroll
            for (int a = 0; a < 2; ++a) { f32x4 acc_ = (f32x4){0.f, 0.f, 0.f, 0.f};
                acc_ = __builtin_amdgcn_mfma_f32_16x16x32_bf16(__builtin_bit_cast(bf16x8, kr_[a * 128]), qf[0], acc_, 0, 0, 0);
                acc_ = __builtin_amdgcn_mfma_f32_16x16x32_bf16(__builtin_bit_cast(bf16x8, kr_[a * 128 + 64]), qf[1], acc_, 0, 0, 0); sc_[c][a] = acc_; } }
#pragma unroll
        for (int c = 0; c < 4; ++c) { const LAS float* bp_ = rpbh + ((r0 + 4 * (s - 2) + c) - r + WIN_R - 1) * 31;
#pragma unroll
            for (int a = 0; a < 2; ++a)
#pragma unroll
                for (int e = 0; e < 4; ++e) { const int j = 4 * a + e; sc_[c][a][e] += bp_[(j & 1) ? (dcol[j >> 1] >> 16) : (dcol[j >> 1] & 0xffffu)]; } }
        ATT_SOFTMAX()
#pragma unroll
        for (int d = 0; d < 4; ++d) { o[d] = o[d] * alpha_;
#pragma unroll
            for (int c = 0; c < 4; ++c) o[d] = __builtin_amdgcn_mfma_f32_16x16x32_bf16(__builtin_bit_cast(bf16x8, vx[c][d]), pf_[c], o[d], 0, 0, 0); }
        if (s < 3) ATT_LOADV(s + 1);
    }
#undef ATT_TOK0
#undef ATT_LOADV
#undef ATT_SOFTMAX
#undef ATT_QF
    lsum = rows_sum(lsum);
    const float inv = __builtin_amdgcn_rcpf(lsum);
    int le; asm volatile("v_mbcnt_lo_u32_b32 %0, -1, 0\n\tv_mbcnt_hi_u32_b32 %0, -1, %0" : "=v"(le));
    bf16* op = MIX + (size_t)(b * SEQ + r * GW + c0 + (le & 15)) * D + h * HD + 4 * (le >> 4);
#pragma unroll
    for (int d = 0; d < 4; ++d) { u32x2 w; w.x = pg8::cvt_pk_bf16(o[d][0] * inv, o[d][1] * inv); w.y = pg8::cvt_pk_bf16(o[d][2] * inv, o[d][3] * inv);
        *(u32x2*)(op + 16 * d) = w; }
}
__device__ __forceinline__ void attn_phase(const Params& p, LAS unsigned char* lds, int tid, int lane, int wave) {
    LAS float* rpbh = (LAS float*)lds;
    LAS u32x4* ckL = (LAS u32x4*)(lds + ATT_CK_OFF); LAS u32x4* cvL = (LAS u32x4*)(lds + ATT_CV_OFF);
    const u32x4* KF = (const u32x4*)(p.ws + WS_KF); const u32x2* VF8 = (const u32x2*)(p.ws + WS_VT);
    constexpr int NR = NH * GROWS * 4 / 8;
    const bool cl = gridDim.x >= 8;
    const int cls = blockIdx.x & 7, idx = cl ? (int)(blockIdx.x >> 3) : (int)blockIdx.x, cnt = cl ? (int)((gridDim.x - cls + 7) >> 3) : (int)gridDim.x;
    const int Rlo = idx * NR / cnt, Rhi = (idx + 1) * NR / cnt;
    for (int bi = 0; bi < (cl ? 1 : NBATCH); ++bi) {
        const int b = cl ? cls : bi; int hcur = -1, have_hi = -1;
        for (int R = Rlo; R < Rhi; ++R) {
            const int h = R >> 4, j = R & 15;
            int ln; asm volatile("v_mbcnt_lo_u32_b32 %0, -1, 0\n\tv_mbcnt_hi_u32_b32 %0, -1, %0" : "=v"(ln));
            if (h != hcur) {
                __syncthreads();
                const size_t tb0 = (size_t)((M_LAT + b * CTXL) >> 4);
                const int td = wave * 64 + ln;
                for (int i = td; i < ATT_HT; i += 512) rpbh[i] = i < 465 ? p.in[IN_RPB][h * 465 + i] * 1.44269504089f : -1e30f;
                for (int i = td; i < 2048; i += 512) ckL[i] = KF[(tb0 + (i >> 7)) * 2048 + h * 128 + (i & 127)];
                for (int i = td; i < 4096; i += 512) { const int tb = i >> 8, d = (i >> 6) & 3, l_ = i & 63;
                    ((LAS u32x2*)cvL)[((((tb >> 1) * 4 + d) * 64 + l_) << 1) + (tb & 1)] = VF8[(tb0 + tb) * 4096 + h * 256 + d * 64 + l_]; }
                hcur = h; have_hi = -1;
            }
            __syncthreads();
            {
                const int need_lo = min(max(2 * j - WIN_R / 2, 0), GROWS - WIN_R), need_hi = min(max(2 * j + 1 - WIN_R / 2, 0), GROWS - WIN_R) + WIN_R - 1;
                for (int rr = max(need_lo, have_hi + 1); rr <= need_hi; ++rr) {
                    const u32x4* src = KF + ((size_t)(b * (SEQ / 16) + rr * (GW / 16) + (wave >> 1)) * 2048 + h * 128 + (wave & 1) * 64 + ln);
                    const unsigned dst = (unsigned)(unsigned long long)(lds + ATT_RING_OFF + (rr % ATT_NSLOT) * 8192 + wave * 1024);
                    asm volatile("s_mov_b32 m0, %1\n\ts_nop 0\n\tglobal_load_lds_dwordx4 %0, off" :: "v"(src), "s"(dst) : "memory", "m0");
                }
                have_hi = need_hi;
            }
            const int rem = j * 8 + wave;
            attn_wave_unit(p, rpbh, ckL, cvL, (const LAS u32x4*)(lds + ATT_RING_OFF), (LAS u32x4*)(lds + ATT_Q_OFF + wave * 2048), b, h, rem >> 2, rem & 3, ln);
        }
    }
}

__device__ __forceinline__ float gelu_tanh(float x) { const float z = 0.7978845608028654f * (x + 0.044715f * x * x * x); return x * fast_sigmoid(2.0f * z); }
constexpr int LCH = 256;
__device__ __forceinline__ void lru_item(const Params& p, LAS unsigned char* lds, int item, int tid, int lane, int wave) {
    const bf16* ZO = (const bf16*)(p.ws + WS_Z); float* HF = (float*)(p.ws + WS_HF); bf16* MIX = (bf16*)(p.ws + WS_MIX);
    const int b = item >> 5, n = (item >> 1) & 15, half = item & 1, j0 = half * 32;
    LAS float* xcf = (LAS float*)lds;
    LAS bf16* xcb = (LAS bf16*)(lds + LCH * 33 * 4);
    LAS float* As = (LAS float*)(lds + LCH * 33 * 4 + LCH * 72 * 2);
    LAS float* Us = As + LCH * 33;
    LAS float* segA = Us + LCH * 33;
    LAS float* segH = segA + 16 * 32;
    const int ci = lane, cch = n * 64 + ci;
    const float* lcw = p.in[IN_LCW]; const float cw0 = lcw[cch], cw1 = lcw[1024 + cch], cw2 = lcw[2048 + cch], cw3 = lcw[3072 + cch], cb = p.in[IN_LCB][cch];
    const bool own = (ci >> 5) == half; (void)own; (void)cw0; (void)cw1; (void)cw2; (void)cw3; (void)cb;
    const int cpp = lane & 31;
    const f32x2 cwp0 = *(const f32x2*)(lcw + n * 64 + 2 * cpp), cwp1 = *(const f32x2*)(lcw + 1024 + n * 64 + 2 * cpp), cwp2 = *(const f32x2*)(lcw + 2048 + n * 64 + 2 * cpp), cwp3 = *(const f32x2*)(lcw + 3072 + n * 64 + 2 * cpp), cbp = *(const f32x2*)(p.in[IN_LCB] + n * 64 + 2 * cpp);
    const bool ownp = (cpp >> 4) == half;
    const int jb = wave & 1, tb0 = (wave >> 1) * 4, l15 = lane & 15, g = lane >> 4, jl = 16 * jb + l15, gch = n * 64 + j0 + jl;
    const int sc = lane & 31, hi = lane >> 5, sg = 2 * wave + hi;
    const unsigned och = (unsigned)(n * 64 + j0 + sc);
    for (int dir = 0; dir < 2; ++dir) {
        bf16x8 Bg[2][2];
        {
            const float* gw = p.in[IN_LGW] + (size_t)((dir * 2) * 16 + n) * 4096;
#pragma unroll
            for (int gt = 0; gt < 2; ++gt)
#pragma unroll
                for (int kk = 0; kk < 2; ++kk) { const float* wp = gw + (size_t)gt * 16 * 4096 + (size_t)(8 * g + 32 * kk) * 64 + j0 + jl;
                    u32x4 w; w.x = pk2(wp[0], wp[64]); w.y = pk2(wp[128], wp[192]); w.z = pk2(wp[256], wp[320]); w.w = pk2(wp[384], wp[448]); Bg[gt][kk] = __builtin_bit_cast(bf16x8, w); }
        }
        const float br = p.in[IN_LGB][(dir * 2 + 0) * 1024 + gch], bi = p.in[IN_LGB][(dir * 2 + 1) * 1024 + gch];
        const float lam = p.in[IN_LAM][dir * 1024 + gch];
        const float sp8 = -8.0f * log1pf(expf(-lam)) * 1.44269504089f;
        float carry = 0.f;
        const unsigned hoff = (unsigned)((dir == 0 ? 16 * hi : 16 * (1 - hi)) * 1024) + och;
        const unsigned moff = (unsigned)((dir == 0 ? 16 * hi : 16 * (1 - hi)) * D) + 1024u + och;
        const unsigned goff = (unsigned)((dir == 0 ? 16 * hi : 16 * (1 - hi)) * ZO_LD) + 4096u + och;
        u32x4 xraw[5]; unsigned xmsk[5];
#define LRU_LOADX(cidx_) do { const int ci_ = (cidx_); const bool isctx_ = ci_ < 1; const int cc_ = isctx_ ? 0 : ci_ - 1, ncs_ = isctx_ ? 1 : 8, cpos_ = dir == 0 ? cc_ : ncs_ - 1 - cc_; \
        const int base_ = isctx_ ? M_LAT + b * CTXL : b * SEQ, T_ = isctx_ ? CTXL : SEQ, ts_ = cpos_ * LCH - 1; \
        _Pragma("unroll") for (int q = 0; q < 5; ++q) { const int pc = min(q * 512 + tid, 2071), t = ts_ + (pc >> 3), tc = min(max(t, 0), T_ - 1); const unsigned msk = (t == tc) ? 0xffffffffu : 0u; \
            xraw[q] = *(const u32x4*)(ZO + (size_t)(base_ + tc) * ZO_LD + 3072 + n * 64 + (pc & 7) * 8); xmsk[q] = msk; } } while (0)
        LRU_LOADX(0);
        LAS unsigned char* rawt = (LAS unsigned char*)As;
#pragma unroll 1
        for (int cidx = 0; cidx < 9; ++cidx) {
            const bool isctx = cidx < 1;
            const int cc = isctx ? 0 : cidx - 1, ncs = isctx ? 1 : 8, cpos = dir == 0 ? cc : ncs - 1 - cc;
            const int base = isctx ? M_LAT + b * CTXL : b * SEQ, t0 = cpos * LCH;
#pragma unroll
            for (int q = 0; q < 5; ++q) { const int pc = q * 512 + tid; if (pc < 2072) *(LAS u32x4*)(rawt + pc * 16) = xraw[q] & xmsk[q]; }
            lds_barrier();
            {
                const int cp = lane & 31, tg = 2 * wave + (lane >> 5);
                const LAS unsigned* rp_ = (const LAS unsigned*)(rawt + (16 * tg) * 128) + cp;
                unsigned xr_[19];
#pragma unroll
                for (int e = 0; e < 19; ++e) xr_[e] = rp_[e * 32];
                LAS unsigned* xb_ = (LAS unsigned*)(xcb + (16 * tg) * 72) + cp; LAS f32x2* xf_ = (LAS f32x2*)(xcf + (16 * tg) * 33 + ((2 * cp) & 31));
#pragma unroll
                for (int e = 0; e < 16; ++e) {
                    const float y0 = cwp0[0] * bf_lo(xr_[e]) + cwp1[0] * bf_lo(xr_[e + 1]) + cwp2[0] * bf_lo(xr_[e + 2]) + cwp3[0] * bf_lo(xr_[e + 3]) + cbp[0];
                    const float y1 = cwp0[1] * bf_hi(xr_[e]) + cwp1[1] * bf_hi(xr_[e + 1]) + cwp2[1] * bf_hi(xr_[e + 2]) + cwp3[1] * bf_hi(xr_[e + 3]) + cbp[1];
                    xb_[e * 36] = pg8::cvt_pk_bf16(y0, y1);
                    if (ownp) { LAS float* q_ = (LAS float*)xf_ + e * 33; q_[0] = y0; q_[1] = y1; }
                }
            }
            if (cidx + 1 < 9) LRU_LOADX(cidx + 1);
            lds_barrier();
#pragma unroll 1
            for (int q = 0; q < 4; ++q) {
                const int tb = tb0 + q;
                const bf16x8 a0 = *(const LAS bf16x8*)(xcb + (16 * tb + l15) * 72 + 8 * g), a1 = *(const LAS bf16x8*)(xcb + (16 * tb + l15) * 72 + 8 * g + 32);
                f32x4 gr_ = (f32x4){0.f, 0.f, 0.f, 0.f}, gi_ = (f32x4){0.f, 0.f, 0.f, 0.f};
                gr_ = __builtin_amdgcn_mfma_f32_16x16x32_bf16(a0, Bg[0][0], gr_, 0, 0, 0); gr_ = __builtin_amdgcn_mfma_f32_16x16x32_bf16(a1, Bg[0][1], gr_, 0, 0, 0);
                gi_ = __builtin_amdgcn_mfma_f32_16x16x32_bf16(a0, Bg[1][0], gi_, 0, 0, 0); gi_ = __builtin_amdgcn_mfma_f32_16x16x32_bf16(a1, Bg[1][1], gi_, 0, 0, 0);
#pragma unroll
                for (int e = 0; e < 4; ++e) {
                    const int tl = 16 * tb + 4 * g + e;
                    const float rg = fast_sigmoid(gr_[e] + br), ig = fast_sigmoid(gi_[e] + bi);
                    const float la2 = sp8 * rg, a = __builtin_amdgcn_exp2f(la2);
                    const float em = __builtin_fmaf(-a, a, 1.0f);
                    As[tl * 33 + jl] = a; Us[tl * 33 + jl] = __builtin_amdgcn_sqrtf(em) * ig * xcf[tl * 33 + jl];
                }
            }
            lds_barrier();
            float av[16], uv[16];
            {
                float A = 1.f, H = 0.f;
                const LAS float* ap_ = As + (dir ? (LCH - 1 - 16 * sg) : 16 * sg) * 33 + sc; const LAS float* up_ = Us + (dir ? (LCH - 1 - 16 * sg) : 16 * sg) * 33 + sc;
#pragma unroll
                for (int e = 0; e < 16; ++e) { av[e] = dir ? ap_[-e * 33] : ap_[e * 33]; uv[e] = dir ? up_[-e * 33] : up_[e * 33]; H = av[e] * H + uv[e]; A *= av[e]; }
                segA[sg * 32 + sc] = A; segH[sg * 32 + sc] = H;
            }
            const int rbase = dir == 0 ? base + t0 + 32 * wave : base + t0 + LCH - 1 - 32 * wave - 16;
            float hfv[16]; unsigned grv[16];
            if (!isctx && dir == 1) {
                const float* hp_ = HF + (size_t)rbase * 1024; const bf16* gp_ = ZO + (size_t)rbase * ZO_LD;
#pragma unroll
                for (int e = 0; e < 16; ++e) { hfv[e] = (hp_ - (size_t)e * 1024)[hoff]; grv[e] = (unsigned)(gp_ - (size_t)e * ZO_LD)[goff]; }
            }
            lds_barrier();
            {
                float hin = carry, mine = 0.f;
#pragma unroll
                for (int s2 = 0; s2 < 16; ++s2) { if (s2 == sg) mine = hin; hin = segA[s2 * 32 + sc] * hin + segH[s2 * 32 + sc]; }
                carry = hin;
                if (!isctx) {
                    float hcur = mine;
                    if (dir == 0) {
                        float* hp_ = HF + (size_t)rbase * 1024;
#pragma unroll
                        for (int e = 0; e < 16; ++e) { hcur = av[e] * hcur + uv[e]; (hp_ + (size_t)e * 1024)[hoff] = hcur; }
                    } else {
                        bf16* mp_ = MIX + (size_t)rbase * D;
#pragma unroll
                        for (int e = 0; e < 16; ++e) { hcur = av[e] * hcur + uv[e];
                            { const float o_ = (hfv[e] + hcur) * gelu_tanh(__builtin_bit_cast(float, grv[e] << 16)); (mp_ - (size_t)e * D)[moff] = (bf16)pg8::cvt_pk_bf16(o_, o_); } }
                    }
                }
            }
        }
#undef LRU_LOADX
        VM_WAIT(); __syncthreads();
    }
}


#if MK_SPLIT
#define GRID_BAR() do { } while (0)
#else
#define GRID_BAR() xcd_barrier(bar)
#endif
#ifndef PH_MASK
#define PH_MASK 0xffffffffu
#endif
#define IN(k) (lo <= (k) && (k) < hi && ((PH_MASK >> (k)) & 1u))
#ifndef PROBE_MASK
#define PROBE_MASK 0u
#endif
#ifndef PROBE_MULT
#define PROBE_MULT 4
#endif
#if PROBE_MASK
#define PROBE_STAMP(k) do { if (blockIdx.x == 0 && threadIdx.x == 0) { volatile LAS unsigned long long* pw = (volatile LAS unsigned long long*)(lds + MISC_OFF + 128); \
        const unsigned long long t_ = __builtin_amdgcn_s_memrealtime(); if ((PROBE_MASK >> (k)) & 1u) pw[1] += t_ - pw[0]; pw[0] = t_; } } while (0)
#else
#define PROBE_STAMP(k) do { } while (0)
#endif
#define SEAM(k) do { if (IN(k) && IN((k) + 1)) GRID_BAR(); PROBE_STAMP(k); } while (0)

template <int L>
__device__ __forceinline__ void layer_body(const Params& p, LAS unsigned char* lds, const XcdBarrier& bar, const int lo, const int hi) {
    constexpr int l = L;
    const int tid = threadIdx.x, lane = tid & 63, wave = __builtin_amdgcn_readfirstlane(tid >> 6);
    const int G = gridDim.x;
    float* MOD = (float*)(p.ws + WS_MOD);
    _Float16* X = (_Float16*)(p.ws + WS_X);
    bf16* HN = (bf16*)(p.ws + WS_HN);
    unsigned char* ACT = p.ws + WS_ACT;
    bf16* Z = (bf16*)(p.ws + WS_Z);
    bf16* MIX = (bf16*)(p.ws + WS_MIX);
    float* PART = (float*)(p.ws + WS_PART);
        const int pb = 1 + 10 * l;
        const float* modl = MOD + (size_t)l * 9 * DMODW;
        const float* ng = p.in[IN_NORMG] + (size_t)l * 3 * D;
        constexpr bool first = (l == 0);
        const void* xs_lat = first ? (const void*)p.in[IN_X] : (const void*)X; const void* xs_ctx = first ? (const void*)p.in[IN_CTX] : (const void*)(X + (size_t)M_LAT * D);

        if (IN(pb + 0)) norm_phase<!first, first>(lds, xs_lat, xs_ctx, X + (size_t)M_LAT * D, PART, M_ALL, ng + 0 * D, modl, 0, 1, HN, tid, lane, wave);
        SEAM(pb + 0);
        if (IN(pb + 1)) {
            SchedStd S{(const char*)HN, (const char*)(p.ws + WS_WFI + (size_t)(l * 2 + 0) * WFI_STRIDE), (size_t)256 * D * 2, M_ALL / 256, 2 * DFF / 256, G, (int)blockIdx.x, D / 64};
            EpiSwiGLU E{ACT};
            pg8::gemm_phase<EpiSwiGLU, SchedStd>(lds, D, S, E);
            tail_convert(p, lds, first ? 0 : 3, (M_ALL / 256) * (2 * DFF / 256), lane, wave);
        }
        SEAM(pb + 1);
        if (IN(pb + 2)) {
            SchedDown S{(const char*)ACT, (const char*)(p.ws + WS_WFO + (size_t)(l * 2 + 0) * WFO_STRIDE), (size_t)256 * DFF, G, (int)blockIdx.x, DFF / 128};
            EpiResid<first, false, true> E{xs_lat, xs_ctx, X, modl + 2 * D, 0.5f / (ACT8_SCALE * W8_SCALE), PART};
            pg8::gemm_phase<EpiResid<first, false, true>, SchedDown>(lds, DFF / 2, S, E);
        }
        SEAM(pb + 2);
        if (IN(pb + 3)) norm_phase<true, false>(lds, X, X + (size_t)M_LAT * D, X + (size_t)M_LAT * D, PART, M_ALL, ng + 1 * D, modl, 3, 4, HN, tid, lane, wave);
        SEAM(pb + 3);
        if constexpr (first) {
            if (IN(pb + 4)) {
                SchedStd S{(const char*)HN, (const char*)(p.ws + WS_WEI), (size_t)256 * D * 2, M_ALL / 256, D_EIN / 256, G, (int)blockIdx.x, D / 64};
                EpiEvIn E{Z};
                pg8::gemm_phase<EpiEvIn, SchedStd>(lds, D, S, E);
                tail_convert(p, lds, 1, (M_ALL / 256) * (D_EIN / 256), lane, wave);
            }
            SEAM(pb + 4);
            if (IN(pb + 5)) even_conv_phase(p, lds, tid, lane, wave);
            SEAM(pb + 5);
            if (IN(pb + 6)) {
                SchedDown S{(const char*)MIX, (const char*)(p.ws + WS_WEO), (size_t)256 * D * 2, G, (int)blockIdx.x, D / 64};
                EpiResid<false, false> E{X, X + (size_t)M_LAT * D, X, modl + 5 * D, 1.0f, PART};
                pg8::gemm_phase<EpiResid<false, false>, SchedDown>(lds, D, S, E);
            }
            SEAM(pb + 6);
        } else {
            if (IN(pb + 4)) {
                SchedOdIn S{(const char*)HN, (const char*)(p.ws + WS_WOI), (size_t)256 * D * 2, G, (int)blockIdx.x};
                EpiOdIn E{Z, (u32x4*)(p.ws + WS_KF), (u32x2*)(p.ws + WS_VT), p.in[IN_QG], p.in[IN_KG]};
                pg8::gemm_phase<EpiOdIn, SchedOdIn>(lds, D, S, E);
                tail_convert(p, lds, 4, 72 * 16 + 4 * 72, lane, wave);
            }
            SEAM(pb + 4);
            if (IN(pb + 5)) {
#ifndef NO_LRU
                for (int k = blockIdx.x; k < 256; k += G) lru_item(p, lds, (k & 7) * 32 + (k >> 3), tid, lane, wave);
#endif
#if PROBE_MASK
                __syncthreads();
                if (blockIdx.x == 0 && threadIdx.x == 0) { volatile LAS unsigned long long* pw = (volatile LAS unsigned long long*)(lds + MISC_OFF + 128);
                    const unsigned long long t_ = __builtin_amdgcn_s_memrealtime(); if ((PROBE_MASK >> 30) & 1u) pw[1] += t_ - pw[0]; }
#endif
#ifndef NO_ATTN
                attn_phase(p, lds, tid, lane, wave);
#endif
            }
            SEAM(pb + 5);
            if (IN(pb + 6)) {
                SchedStd S{(const char*)MIX, (const char*)(p.ws + WS_WOO), (size_t)256 * D * 2, M_LAT / 256, D / 256, G, (int)blockIdx.x, D / 64};
                EpiResid<false, false> E{X, X + (size_t)M_LAT * D, X, modl + 5 * D, 1.0f, PART};
                pg8::gemm_phase<EpiResid<false, false>, SchedStd>(lds, D, S, E);
            }
            SEAM(pb + 6);
        }
        const int nrows2 = first ? M_ALL : M_LAT;
        if (IN(pb + 7)) norm_phase<first, false>(lds, X, X + (size_t)M_LAT * D, X + (size_t)M_LAT * D, PART, nrows2, ng + 2 * D, modl, 6, 7, HN, tid, lane, wave);
        SEAM(pb + 7);
        if (IN(pb + 8)) {
            SchedStd S{(const char*)HN, (const char*)(p.ws + WS_WFI + (size_t)(l * 2 + 1) * WFI_STRIDE), (size_t)256 * D * 2, nrows2 / 256, 2 * DFF / 256, G, (int)blockIdx.x, D / 64};
            EpiSwiGLU E{ACT};
            pg8::gemm_phase<EpiSwiGLU, SchedStd>(lds, D, S, E);
            if constexpr (first) tail_convert(p, lds, 2, (M_ALL / 256) * (2 * DFF / 256), lane, wave);
        }
        SEAM(pb + 8);
        if (IN(pb + 9)) {
            if constexpr (first) {
                SchedDown S{(const char*)ACT, (const char*)(p.ws + WS_WFO + (size_t)(l * 2 + 1) * WFO_STRIDE), (size_t)256 * DFF, G, (int)blockIdx.x, DFF / 128};
                EpiResid<false, false, true> E{X, X + (size_t)M_LAT * D, X, modl + 8 * D, 0.5f / (ACT8_SCALE * W8_SCALE), PART};
                pg8::gemm_phase<EpiResid<false, false, true>, SchedDown>(lds, DFF / 2, S, E);
            } else {
                SchedStd S{(const char*)ACT, (const char*)(p.ws + WS_WFO + (size_t)(l * 2 + 1) * WFO_STRIDE), (size_t)256 * DFF, M_LAT / 256, D / 256, G, (int)blockIdx.x, DFF / 128};
                EpiResid<false, true, true> E{X, X + (size_t)M_LAT * D, p.out, modl + 8 * D, 0.5f / (ACT8_SCALE * W8_SCALE), PART};
                pg8::gemm_phase<EpiResid<false, true, true>, SchedStd>(lds, DFF / 2, S, E);
            }
        }
        SEAM(pb + 9);
}
__global__ void __launch_bounds__(512, 2) mega_fwd(Params p) {
    extern __shared__ __attribute__((aligned(16))) unsigned char lds_raw[];
    LAS unsigned char* lds = (LAS unsigned char*)lds_raw;
    volatile LAS unsigned* MISC = (volatile LAS unsigned*)(lds + MISC_OFF);
    const int tid = threadIdx.x, lane = tid & 63, wave = __builtin_amdgcn_readfirstlane(tid >> 6);
    const int G = gridDim.x;
    if (tid < 64) MISC[tid] = 0u;
    __syncthreads();
    unsigned* ctl = (unsigned*)(p.ws + WS_CTL);
#if MK_SPLIT
    XcdBarrier bar; bar.bar = ctl + CW_BAR; bar.x = 0; bar.st = MISC + 8;
#else
    XcdBarrier bar = xcd_barrier_post(ctl + CW_BAR, MISC + 8);
#endif
    const int lo = p.ph_lo, hi = p.ph_hi;
#if PROBE_MASK
    if (blockIdx.x == 0 && tid == 0) { volatile LAS unsigned long long* pw = (volatile LAS unsigned long long*)(lds + MISC_OFF + 128); pw[0] = __builtin_amdgcn_s_memrealtime(); pw[1] = 0ull; }
#endif

    float* MOD = (float*)(p.ws + WS_MOD);
    float* X = (float*)(p.ws + WS_X);
    bf16* HN = (bf16*)(p.ws + WS_HN);
    bf16* ACT = (bf16*)(p.ws + WS_ACT);
    bf16* Z = (bf16*)(p.ws + WS_Z);
    bf16* MIX = (bf16*)(p.ws + WS_MIX);

    if (IN(0)) {
#ifndef NO_WEIGHTS
        p0_weights(p, lds, lane, wave); __syncthreads();
#endif
#if PROBE_MASK
        if (blockIdx.x == 0 && threadIdx.x == 0) { volatile LAS unsigned long long* pw = (volatile LAS unsigned long long*)(lds + MISC_OFF + 128);
            const unsigned long long t_ = __builtin_amdgcn_s_memrealtime(); if ((PROBE_MASK >> 29) & 1u) pw[1] += t_ - pw[0]; }
#endif
#ifndef NO_MODVEC
        p0_modvec(p, lds, tid, lane, wave); __syncthreads();
#endif
    }
    SEAM(0);

    layer_body<0>(p, lds, bar, lo, hi);
    layer_body<1>(p, lds, bar, lo, hi);
#if PROBE_MASK
    if (blockIdx.x == 0 && tid == 0) { volatile LAS unsigned long long* pw = (volatile LAS unsigned long long*)(lds + MISC_OFF + 128); const unsigned long long t0 = __builtin_amdgcn_s_memrealtime(), dt = (unsigned long long)PROBE_MULT * pw[1];
        while (__builtin_amdgcn_s_memrealtime() - t0 < dt) __builtin_amdgcn_s_sleep(8); }
#endif
#undef IN
#undef SEAM
#undef GRID_BAR
}

extern "C" void kernel_launch(void* const* d_in, const int* in_sizes, int n_in, void* d_out, int out_size, void* d_ws, size_t ws_size, hipStream_t stream) {
    static int grid = 0;
    if (grid == 0) {
        if (n_in != 27 || in_sizes[0] != M_LAT * D || out_size != M_LAT * D || ws_size < WS_END) {
            fprintf(stderr, "kernel_launch: unexpected shapes (n_in %d, in0 %d, out %d, ws %zu; need ws >= %zu); nothing launched\n", n_in, n_in > 0 ? in_sizes[0] : -1, out_size, ws_size, (size_t)WS_END); grid = -1; return; }
        int dev = 0, cus = 0, per_cu = 0;
        if (hipGetDevice(&dev) != hipSuccess || hipDeviceGetAttribute(&cus, hipDeviceAttributeMultiprocessorCount, dev) != hipSuccess) { fprintf(stderr, "kernel_launch: device query failed\n"); grid = -1; return; }
        if (hipFuncSetAttribute((const void*)mega_fwd, hipFuncAttributeMaxDynamicSharedMemorySize, LDS_BYTES) != hipSuccess) { fprintf(stderr, "kernel_launch: hipFuncSetAttribute failed\n"); grid = -1; return; }
        if (hipOccupancyMaxActiveBlocksPerMultiprocessor(&per_cu, (const void*)mega_fwd, 512, LDS_BYTES) != hipSuccess || per_cu < 1) {
            fprintf(stderr, "kernel_launch: occupancy query reports %d workgroups per CU\n", per_cu); }
        (void)hipGetLastError();
        grid = cus;
    }
    if (grid < 0) return;
    if (hipMemsetAsync((char*)d_ws + WS_CTL, 0, CTL_ZERO_BYTES, stream) != hipSuccess) { fprintf(stderr, "kernel_launch: memset failed\n"); return; }
    Params a{};
    for (int i = 0; i < 27; ++i) a.in[i] = (const float*)d_in[i];
    a.out = (float*)d_out; a.ws = (unsigned char*)d_ws;
#if MK_SPLIT
    for (int ph = 0; ph < NPHASE; ++ph) { a.ph_lo = ph; a.ph_hi = ph + 1; hipLaunchKernelGGL(mega_fwd, dim3(grid), dim3(512), LDS_BYTES, stream, a); }
#else
    a.ph_lo = 0; a.ph_hi = NPHASE;
    hipLaunchKernelGGL(mega_fwd, dim3(grid), dim3(512), LDS_BYTES, stream, a);
#endif
    const hipError_t le = hipPeekAtLastError();
    if (le != hipSuccess) fprintf(stderr, "kernel_launch: launch failed: %s\n", hipGetErrorName(le));
}
```
